# Optimizing an MI355X kernel written in HIP

```python
import math
import jax, jax.numpy as jnp
from jax import lax
import numpy as np

D_MODEL = 1024
BATCH = 16
SEQ = 256
DEPTH = 4
DEC_BATCH = 2
DEC_SEQ = 1024
PAST_LEN = 256

GRID_W = 64
D_MIX = D_MODEL
D_RNN = D_MIX // 2
N_LRU_HEADS = 8
LRU_HEAD_DIM = D_RNN // N_LRU_HEADS
LRU_C = 8.0
CONV_WIDTH = 4
CONV_LEFT = CONV_WIDTH // 2
D_POOL = D_MIX // 4
POOL_WINDOWS = (2, 4, 8, 16)
N_POOL_GROUPS = len(POOL_WINDOWS)
POOL_GROUP_DIM = D_POOL // N_POOL_GROUPS
D_FOURIER = D_MIX // 4
N_FOURIER_HEADS = 4
FOURIER_HEAD_DIM = D_FOURIER // N_FOURIER_HEADS
D_IN = 2 * D_RNN + D_POOL + D_FOURIER
D_FF = 4 * D_MODEL
N_MOD = 6
EPS = 1e-6

kernel_name = "hybrid_rglru_pool_fourier_diffusion_step"


def rms_norm(x, g):
    xf = x.astype(jnp.float32)
    y = xf * lax.rsqrt(jnp.mean(xf * xf, axis=-1, keepdims=True) + EPS)
    return (y * g.astype(jnp.float32)).astype(x.dtype)


def centred_dwconv(x, w, b):
    L = x.shape[1]
    xp = jnp.pad(x, ((0, 0), (CONV_LEFT, CONV_WIDTH - 1 - CONV_LEFT), (0, 0)))
    y = b
    for k in range(CONV_WIDTH):
        y = y + xp[:, k:k + L] * w[k]
    return y


def _lin_combine(e1, e2):
    a1, b1 = e1
    a2, b2 = e2
    return a1 * a2, a2 * b1 + b2


def rg_lru(x, w_r, b_r, w_i, b_i, lam, h0, reverse):
    B, L, _ = x.shape
    xh = x.reshape(B, L, N_LRU_HEADS, LRU_HEAD_DIM)
    r = jax.nn.sigmoid((jnp.einsum('blhi,hij->blhj', xh, w_r).reshape(B, L, D_RNN) + b_r).astype(jnp.float32))
    i = jax.nn.sigmoid((jnp.einsum('blhi,hij->blhj', xh, w_i).reshape(B, L, D_RNN) + b_i).astype(jnp.float32))
    log_a = -LRU_C * r * jax.nn.softplus(-lam.astype(jnp.float32))
    a = jnp.exp(log_a)
    mult = jnp.sqrt(-jnp.expm1(2.0 * log_a))
    bterm = mult * (i * x.astype(jnp.float32))
    a_cum, b_cum = lax.associative_scan(_lin_combine, (a, bterm), axis=1, reverse=reverse)
    hs = a_cum * h0.astype(jnp.float32)[:, None, :] + b_cum
    final = hs[:, 0] if reverse else hs[:, -1]
    return hs, final


def _bounds(n, w):
    idx = np.arange(n)
    lo = np.clip(idx - w // 2, 0, n)
    hi = np.clip(idx - w // 2 + w, 0, n)
    return lo, hi, (hi - lo).astype(np.float32)


def pool_1d(x, w):
    L = x.shape[1]
    cs = jnp.pad(jnp.cumsum(x, axis=1), ((0, 0), (1, 0), (0, 0)))
    lo, hi, cnt = _bounds(L, w)
    return (cs[:, hi] - cs[:, lo]) / jnp.asarray(cnt)[None, :, None]


def pool_2d(x, w, rows):
    B, L, C = x.shape
    g = x.reshape(B, rows, GRID_W, C)
    cs = jnp.cumsum(jnp.cumsum(g, axis=1), axis=2)
    cs = jnp.pad(cs, ((0, 0), (1, 0), (1, 0), (0, 0)))
    rlo, rhi, rc = _bounds(rows, w)
    clo, chi, cc = _bounds(GRID_W, w)
    top_hi = cs[:, rhi]
    top_lo = cs[:, rlo]
    s = top_hi[:, :, chi] - top_lo[:, :, chi] - top_hi[:, :, clo] + top_lo[:, :, clo]
    cnt = jnp.asarray(np.outer(rc, cc).astype(np.float32))
    return (s / cnt[None, :, :, None]).reshape(B, L, C)


def mixer(h, p, l, h0, grid_rows):
    B, L, _ = h.shape
    u = h @ p['w_in'][l]
    xr = u[..., :D_RNN]
    xg = u[..., D_RNN:2 * D_RNN]
    xp = u[..., 2 * D_RNN:2 * D_RNN + D_POOL]
    xf = u[..., 2 * D_RNN + D_POOL:]

    xc = centred_dwconv(xr, p['conv_w'][l], p['conv_b'][l])
    hf, sf = rg_lru(xc, p['lru_wr'][l, 0], p['lru_br'][l, 0], p['lru_wi'][l, 0], p['lru_bi'][l, 0],
                    p['lru_lambda'][l, 0], h0[:, 0], reverse=False)
    hb, sb = rg_lru(xc, p['lru_wr'][l, 1], p['lru_br'][l, 1], p['lru_wi'][l, 1], p['lru_bi'][l, 1],
                    p['lru_lambda'][l, 1], h0[:, 1], reverse=True)
    out_a = ((hf + hb) * jax.nn.gelu(xg.astype(jnp.float32))).astype(h.dtype)
    final_state = jnp.stack([sf, sb], axis=1)

    xpf = xp.astype(jnp.float32)
    pooled = []
    for gi, w in enumerate(POOL_WINDOWS):
        xs = xpf[..., gi * POOL_GROUP_DIM:(gi + 1) * POOL_GROUP_DIM]
        m = pool_1d(xs, w) if grid_rows is None else pool_2d(xs, w, grid_rows)
        pooled.append(m - xs)
    pooled = jnp.stack(pooled, axis=2).astype(h.dtype)
    out_b = jnp.einsum('blgi,gij->blgj', pooled, p['pool_w'][l]).reshape(B, L, D_POOL) * p['pool_scale'][l]

    xfh = xf.astype(jnp.float32).reshape(B, L, N_FOURIER_HEADS, FOURIER_HEAD_DIM)
    four = jnp.real(jnp.fft.fft2(xfh, axes=(1, 3), norm='ortho')).reshape(B, L, D_FOURIER).astype(h.dtype)
    out_c = four @ p['fourier_w'][l]

    cat = jnp.concatenate([out_a, out_b, out_c], axis=-1)
    return cat @ p['w_out'][l], final_state


def run_layer(x, cond, p, l, h0, grid_rows):
    mods = jax.nn.silu(cond) @ p['w_mod'][l] + p['b_mod'][l]
    mods = mods.reshape(mods.shape[:-1] + (N_MOD, D_MODEL))
    if mods.ndim == 2:
        mods = mods[None]
    mods = mods[:, None]
    sh1, sc1, g1, sh2, sc2, g2 = [mods[:, :, k] for k in range(N_MOD)]
    h = rms_norm(x, p['norm1_g'][l]) * (1.0 + sc1) + sh1
    out, st = mixer(h, p, l, h0, grid_rows)
    x = x + g1 * out
    h2 = rms_norm(x, p['norm2_g'][l]) * (1.0 + sc2) + sh2
    ff = jnp.square(jax.nn.relu(h2 @ p['mlp_w1'][l])) @ p['mlp_w2'][l]
    x = x + g2 * ff
    return x, st


def setup_inputs(seed: int = 0) -> dict:
    key = jax.random.key(seed)
    ks = jax.random.split(key, 24)

    def nrm(k, shape, scale):
        return jax.random.normal(k, shape, jnp.float32) * scale

    u = jax.random.uniform(ks[16], (DEPTH, 2, D_RNN), jnp.float32, minval=0.9, maxval=0.999)
    s = u ** (1.0 / LRU_C)
    lam = jnp.log(s) - jnp.log1p(-s)
    return {
        'x_prompt': nrm(ks[0], (BATCH, SEQ, D_MODEL), 1.0),
        'x_sample': nrm(ks[1], (DEC_BATCH, DEC_SEQ, D_MODEL), 1.0),
        'state_rglru': nrm(ks[2], (DEC_BATCH, DEPTH, 2, D_RNN), 0.5),
        'c': nrm(ks[3], (DEC_BATCH, D_MODEL), 1.0),
        'c_ctx': nrm(ks[4], (D_MODEL,), 1.0),
        'norm1_g': 1.0 + nrm(ks[5], (DEPTH, D_MODEL), 0.1),
        'norm2_g': 1.0 + nrm(ks[6], (DEPTH, D_MODEL), 0.1),
        'final_g': 1.0 + nrm(ks[7], (D_MODEL,), 0.1),
        'w_mod': nrm(ks[8], (DEPTH, D_MODEL, N_MOD * D_MODEL), 0.5 * D_MODEL ** -0.5),
        'b_mod': nrm(ks[9], (DEPTH, N_MOD * D_MODEL), 0.02),
        'w_in': nrm(ks[10], (DEPTH, D_MODEL, D_IN), D_MODEL ** -0.5),
        'conv_w': nrm(ks[11], (DEPTH, CONV_WIDTH, D_RNN), CONV_WIDTH ** -0.5),
        'conv_b': nrm(ks[12], (DEPTH, D_RNN), 0.02),
        'lru_wr': nrm(ks[13], (DEPTH, 2, N_LRU_HEADS, LRU_HEAD_DIM, LRU_HEAD_DIM), LRU_HEAD_DIM ** -0.5),
        'lru_br': nrm(ks[14], (DEPTH, 2, D_RNN), 0.1),
        'lru_wi': nrm(ks[15], (DEPTH, 2, N_LRU_HEADS, LRU_HEAD_DIM, LRU_HEAD_DIM), LRU_HEAD_DIM ** -0.5),
        'lru_bi': nrm(ks[17], (DEPTH, 2, D_RNN), 0.1),
        'lru_lambda': lam,
        'pool_w': nrm(ks[18], (DEPTH, N_POOL_GROUPS, POOL_GROUP_DIM, POOL_GROUP_DIM), POOL_GROUP_DIM ** -0.5),
        'pool_scale': 1.0 + nrm(ks[19], (DEPTH, D_POOL), 0.1),
        'fourier_w': nrm(ks[20], (DEPTH, D_FOURIER, D_FOURIER), D_FOURIER ** -0.5),
        'w_out': nrm(ks[21], (DEPTH, D_MIX, D_MODEL), D_MIX ** -0.5),
        'mlp_w1': nrm(ks[22], (DEPTH, D_MODEL, D_FF), D_MODEL ** -0.5),
        'mlp_w2': nrm(ks[23], (DEPTH, D_FF, D_MODEL), D_FF ** -0.5),
    }


def reference(x_prompt, x_sample, state_rglru, c, c_ctx, norm1_g, norm2_g, final_g, w_mod, b_mod, w_in,
              conv_w, conv_b, lru_wr, lru_br, lru_wi, lru_bi, lru_lambda, pool_w, pool_scale, fourier_w,
              w_out, mlp_w1, mlp_w2):
    p = {'norm1_g': norm1_g, 'norm2_g': norm2_g, 'w_mod': w_mod, 'b_mod': b_mod, 'w_in': w_in,
         'conv_w': conv_w, 'conv_b': conv_b, 'lru_wr': lru_wr, 'lru_br': lru_br, 'lru_wi': lru_wi,
         'lru_bi': lru_bi, 'lru_lambda': lru_lambda, 'pool_w': pool_w, 'pool_scale': pool_scale,
         'fourier_w': fourier_w, 'w_out': w_out, 'mlp_w1': mlp_w1, 'mlp_w2': mlp_w2}

    xc = x_prompt
    h0_ctx = jnp.zeros((x_prompt.shape[0], 2, D_RNN), x_prompt.dtype)
    states = []
    for l in range(DEPTH):
        xc, st = run_layer(xc, c_ctx, p, l, h0_ctx, None)
        states.append(st.astype(x_prompt.dtype))
    y_prompt = rms_norm(xc, final_g)
    new_state_rglru = jnp.stack(states, axis=1)

    rows = x_sample.shape[1] // GRID_W
    xs = x_sample
    for l in range(DEPTH):
        xs, _ = run_layer(xs, c, p, l, state_rglru[:, l], rows)
    y_sample = rms_norm(xs, final_g)

    return (y_prompt, y_sample, new_state_rglru)
```

```cpp
#include <hip/hip_runtime.h>
#include <hip/hip_cooperative_groups.h>
#include <cstdio>
#include <cstdint>
namespace cg = cooperative_groups;
#define MK_PER_PHASE 1
namespace pg8 {
#define PG8_LAS __attribute__((address_space(3)))
typedef unsigned short bf16_t;
typedef short bf16x8 __attribute__((ext_vector_type(8)));
typedef float f32x4 __attribute__((ext_vector_type(4)));
typedef unsigned u32x4 __attribute__((ext_vector_type(4)));
constexpr int BM = 256, BK = 64, HALF = 128, HTB = HALF * BK * 2  , STAGE_BYTES = 8 * HTB, NXCD = 8, WGM = 8;

__host__ __device__ __forceinline__ int lds_byte(int r, int c) { const int st = (r >> 4) * 2 + (c >> 5), rr = r & 15, cc = c & 31, ob = rr * 64 + cc * 2; return st * 1024 + (ob ^ (((ob >> 9) & 1) << 5)); }
__host__ __device__ __forceinline__ void stage_rc(int b, int& R, int& C) { const int st = b / 1024, sb = b % 1024, swz = sb ^ (((sb >> 9) & 1) << 5); R = (st >> 1) * 16 + swz / 64; C = (st & 1) * 32 + (swz % 64) / 2; }
__host__ __device__ __forceinline__ int perm32(int rho) { const int n = rho >> 4, i = rho & 15; return 8 * (i >> 2) + 4 * n + (i & 3); }

struct Unit { int pm, pn; };
struct Gemm { const bf16_t* A; const bf16_t* Bt; int M, N, K; };

struct StaticOrder {
    int nM, nN, nwg, G, c;
    __host__ __device__ void init(int M, int N, int G_, int c_) { nM = M / BM; nN = N / BM; nwg = nM * nN; G = G_; c = c_; }
    __host__ __device__ bool next(int i, Unit& u) const {
        const long L = (long)i * G + c; if (L >= nwg) return false;
        int wgid = (int)L; { const int q = nwg / NXCD, r = nwg % NXCD, xcd = wgid % NXCD, off = wgid / NXCD; wgid = (xcd < r ? xcd * (q + 1) : r * (q + 1) + (xcd - r) * q) + off; }
        const int nig = WGM * nN, gid = wgid / nig, fm = gid * WGM, gsz = (nM - fm) < WGM ? (nM - fm) : WGM;
        u.pm = fm + ((wgid % nig) % gsz); u.pn = (wgid % nig) / gsz; return true;
    }
    __device__ __forceinline__ void a_ready(const Unit&) const {}
    __device__ __forceinline__ void done(const Unit&) const {}
};

__device__ __forceinline__ unsigned cvt_pk_bf16(float lo, float hi) { unsigned r; asm volatile("v_cvt_pk_bf16_f32 %0, %1, %2" : "=v"(r) : "v"(lo), "v"(hi)); return r; }
typedef float f32x2 __attribute__((ext_vector_type(2)));
typedef unsigned u32x2 __attribute__((ext_vector_type(2)));
constexpr int NIN = 1792, DM = 1024, DFF = 4096, NU = 1280, SSQW = 16;
constexpr size_t XCT_LAT_OFF = (size_t)16 * 4 * 128 * 256;
__device__ __forceinline__ int cond_of_panel(int pm) { return pm < 16 ? 0 : (pm < 20 ? 1 : 2); }
__device__ __forceinline__ float row_rstd(const float* ssq, int row) {
    const f32x4* sp = (const f32x4*)(ssq + (size_t)row * SSQW);
    const f32x4 s = (sp[0] + sp[1]) + (sp[2] + sp[3]);
    return 1.0f / sqrtf(((s[0] + s[1]) + (s[2] + s[3])) * (1.0f / 1024.0f) + 1e-6f);
}
struct EpiIn {
    static constexpr bool PERM = true, AFTER_DRAIN = false;
    bf16_t* U; bf16_t* XCT; const float* ssq; const float* bias;
    __device__ __forceinline__ void operator()(const f32x4 (&acc)[2][2][4][2], const Unit& u, int wr, int wc, int fr, int fq) const {
        const int cond = cond_of_panel(u.pm);
        const int bcol0 = u.pn * BM + wc * 32 + 8 * fq;
        f32x4 bv[2][2];
#pragma unroll
        for (int bj = 0; bj < 2; ++bj)
#pragma unroll
            for (int n = 0; n < 2; ++n) bv[bj][n] = *(const f32x4*)(bias + cond * NIN + bcol0 + bj * HALF + 4 * n);
#pragma unroll
        for (int ai = 0; ai < 2; ++ai)
#pragma unroll
            for (int m = 0; m < 4; ++m) {
                const int row = u.pm * BM + ai * HALF + wr * 64 + m * 16 + fr;
                const float rs = row_rstd(ssq, row);
#pragma unroll
                for (int bj = 0; bj < 2; ++bj) {
                    const f32x4 v0 = acc[ai][bj][m][0] * rs + bv[bj][0], v1 = acc[ai][bj][m][1] * rs + bv[bj][1];
                    u32x4 w; w.x = cvt_pk_bf16(v0[0], v0[1]); w.y = cvt_pk_bf16(v0[2], v0[3]); w.z = cvt_pk_bf16(v1[0], v1[1]); w.w = cvt_pk_bf16(v1[2], v1[3]);
                    if (u.pn < 5) { *(u32x4*)(U + (size_t)row * NU + bcol0 + bj * HALF) = w; }
                    else {
                        const int cc = bcol0 + bj * HALF - NU, hd = cc >> 7, mm = cc & 127;
                        bf16_t* p; int ls;
                        if (u.pm < 16) { ls = 256; p = XCT + ((size_t)(u.pm * 4 + hd) * 128 + mm) * 256 + (row & 255); }
                        else { const int rl = row - 4096; ls = 1024; p = XCT + XCT_LAT_OFF + ((size_t)((rl >> 10) * 4 + hd) * 128 + mm) * 1024 + (rl & 1023); }
                        p[0] = (bf16_t)(w.x & 0xffffu); p[ls] = (bf16_t)(w.x >> 16); p[2 * ls] = (bf16_t)(w.y & 0xffffu); p[3 * ls] = (bf16_t)(w.y >> 16);
                        p[4 * ls] = (bf16_t)(w.z & 0xffffu); p[5 * ls] = (bf16_t)(w.z >> 16); p[6 * ls] = (bf16_t)(w.w & 0xffffu); p[7 * ls] = (bf16_t)(w.w >> 16);
                    }
                }
                asm volatile("" ::: "memory");
            }
    }
};
struct EpiUp {
    static constexpr bool PERM = true, AFTER_DRAIN = false;
    bf16_t* H; const float* ssq; const float* bias;
    __device__ __forceinline__ void operator()(const f32x4 (&acc)[2][2][4][2], const Unit& u, int wr, int wc, int fr, int fq) const {
        const int cond = cond_of_panel(u.pm);
        const int bcol0 = u.pn * BM + wc * 32 + 8 * fq;
        f32x4 bv[2][2];
#pragma unroll
        for (int bj = 0; bj < 2; ++bj)
#pragma unroll
            for (int n = 0; n < 2; ++n) bv[bj][n] = *(const f32x4*)(bias + cond * DFF + bcol0 + bj * HALF + 4 * n);
#pragma unroll
        for (int ai = 0; ai < 2; ++ai)
#pragma unroll
            for (int m = 0; m < 4; ++m) {
                const int row = u.pm * BM + ai * HALF + wr * 64 + m * 16 + fr;
                const float rs = row_rstd(ssq, row);
#pragma unroll
                for (int bj = 0; bj < 2; ++bj) {
                    f32x4 v0 = acc[ai][bj][m][0] * rs + bv[bj][0], v1 = acc[ai][bj][m][1] * rs + bv[bj][1];
                    v0 = __builtin_elementwise_max(v0, (f32x4){0.f, 0.f, 0.f, 0.f}); v1 = __builtin_elementwise_max(v1, (f32x4){0.f, 0.f, 0.f, 0.f});
                    v0 = v0 * v0; v1 = v1 * v1;
                    u32x4 w; w.x = cvt_pk_bf16(v0[0], v0[1]); w.y = cvt_pk_bf16(v0[2], v0[3]); w.z = cvt_pk_bf16(v1[0], v1[1]); w.w = cvt_pk_bf16(v1[2], v1[3]);
                    *(u32x4*)(H + (size_t)row * DFF + bcol0 + bj * HALF) = w;
                }
                if (m & 1) asm volatile("" ::: "memory");
            }
    }
};
struct EpiRes {
    static constexpr bool PERM = false, AFTER_DRAIN = false;
    float* X; bf16_t* A; const float* gate; const float* Gn; float* ssq_out;
    __device__ __forceinline__ void operator()(const f32x4 (&acc)[2][2][4][2], const Unit& u, int wr, int wc, int fr, int fq) const {
        const int cond = cond_of_panel(u.pm);
        const int col0 = u.pn * BM + wc * 32 + 4 * fq;
#pragma unroll
        for (int ai = 0; ai < 2; ++ai)
#pragma unroll
            for (int m = 0; m < 4; ++m) {
                const int row = u.pm * BM + ai * HALF + wr * 64 + m * 16 + fr;
                float q = 0.f;
#pragma unroll
                for (int bj = 0; bj < 2; ++bj)
#pragma unroll
                    for (int n = 0; n < 2; ++n) {
                        const int c = col0 + bj * HALF + n * 16;
                        float* xp = X + (size_t)row * DM + c;
                        const f32x4 g4 = *(const f32x4*)(gate + cond * 6144 + c);
                        const f32x4 x1 = *(const f32x4*)xp + g4 * acc[ai][bj][m][n];
                        *(f32x4*)xp = x1;
                        q += (x1[0] * x1[0] + x1[1] * x1[1]) + (x1[2] * x1[2] + x1[3] * x1[3]);
                        if (Gn) { const f32x4 a = x1 * *(const f32x4*)(Gn + cond * DM + c); u32x2 w; w.x = cvt_pk_bf16(a[0], a[1]); w.y = cvt_pk_bf16(a[2], a[3]);
                            *(u32x2*)(A + (size_t)row * DM + c) = w; }
                    }
                q += __shfl_xor(q, 16); q += __shfl_xor(q, 32);
                if (fq == 0) ssq_out[(size_t)row * SSQW + u.pn * 4 + wc] = q;
                if (m & 1) asm volatile("" ::: "memory");
            }
    }
};
template <class Epi, class Sched, bool ALIGN_EPI = false, bool SP2 = false>
__device__ __forceinline__ void gemm_phase(PG8_LAS unsigned char* lds, const Gemm g, const Sched& S, const Epi& E) {
    int tid_ = threadIdx.x; asm volatile("" : "+v"(tid_)); const int tid = tid_, wid = __builtin_amdgcn_readfirstlane(tid >> 6), lane = tid & 63, wr = wid >> 2, wc = wid & 3, fr = lane & 15, fq = lane >> 4;
    const int K = g.K, nt = K / BK;
    unsigned voffA[2], voffB[2];
#pragma unroll
    for (int i = 0; i < 2; ++i) { int R, C; stage_rc(tid * 16 + i * 8192, R, C); const int Rb = Epi::PERM ? ((R & ~31) + perm32(R & 31)) : R;
        voffA[i] = (unsigned)(R * K + C) * 2u; voffB[i] = (unsigned)(Rb * K + C) * 2u; }
    const size_t kstep = (size_t)(BK * 2);
    const size_t hstep = (size_t)HALF * K * 2;
    const size_t tstep = 2 * hstep;
    const unsigned ldsw = (unsigned)wid * 1024u;
    const int aoff = lds_byte(wr * 64 + fr, fq * 8), boff = lds_byte(wc * 32 + fr, fq * 8);
#define PG8_SA(b, h) (((b) * 2 + (h)) * HTB)
#define PG8_SB(b, h) ((4 + (b) * 2 + (h)) * HTB)
#define PG8_STAGE(bufoff, gbase, voff) do { _Pragma("unroll") for (int _i = 0; _i < 2; ++_i) \
        __builtin_amdgcn_global_load_lds((const unsigned*)((const char*)(gbase) + (voff)[_i]), (PG8_LAS unsigned*)(lds + (bufoff) + ldsw + _i * 8192), 16, 0, 0); } while (0)
#define PG8_LDA(dst, b, h) do { _Pragma("unroll") for (int m = 0; m < 4; ++m) _Pragma("unroll") for (int k = 0; k < 2; ++k) dst[m][k] = *(const PG8_LAS bf16x8*)(lds + PG8_SA(b, h) + aoff + m * 2048 + k * 1024); } while (0)
#define PG8_LDB(dst, b, h) do { _Pragma("unroll") for (int n = 0; n < 2; ++n) _Pragma("unroll") for (int k = 0; k < 2; ++k) dst[n][k] = *(const PG8_LAS bf16x8*)(lds + PG8_SB(b, h) + boff + n * 2048 + k * 1024); } while (0)
#define PG8_MMA(ai, bj, At, Bt) do { __builtin_amdgcn_s_setprio(1); _Pragma("unroll") for (int m = 0; m < 4; ++m) _Pragma("unroll") for (int n = 0; n < 2; ++n) _Pragma("unroll") for (int k = 0; k < 2; ++k) \
        acc[ai][bj][m][n] = __builtin_amdgcn_mfma_f32_16x16x32_bf16(Bt[n][k], At[m][k], acc[ai][bj][m][n], 0, 0, 0); __builtin_amdgcn_s_setprio(0); } while (0)
#define PG8_WAIT_V(n) asm volatile("s_waitcnt vmcnt(" #n ")" ::: "memory")
#define PG8_WAIT_L(n) asm volatile("s_waitcnt lgkmcnt(" #n ")" ::: "memory")
#define PG8_BAR __builtin_amdgcn_s_barrier()
#define PG8_SCHED __builtin_amdgcn_sched_barrier(0)
    Unit cur, nxt; int ui = 0;
    if (!S.next(0, cur)) return;
    f32x4 acc[2][2][4][2];
#pragma unroll
    for (int a = 0; a < 2; ++a)
#pragma unroll
        for (int b = 0; b < 2; ++b)
#pragma unroll
            for (int m = 0; m < 4; ++m)
#pragma unroll
                for (int n = 0; n < 2; ++n) acc[a][b][m][n] = (f32x4){0.f, 0.f, 0.f, 0.f};
    bf16x8 At[4][2], B0[2][2], B1[2][2];
    const char* cA = (const char*)g.A + (size_t)cur.pm * tstep; const char* cB = (const char*)g.Bt + (size_t)cur.pn * tstep;
    S.a_ready(cur);
    if constexpr (SP2) {
        PG8_STAGE(PG8_SB(0, 0), cB, voffB); PG8_STAGE(PG8_SB(0, 1), cB + hstep, voffB); PG8_STAGE(PG8_SA(0, 0), cA, voffA); PG8_STAGE(PG8_SA(0, 1), cA + hstep, voffA);
        if (wr == 1) PG8_BAR;
        PG8_WAIT_V(2); PG8_BAR;
        PG8_STAGE(PG8_SB(1, 0), cB + kstep, voffB); PG8_STAGE(PG8_SA(1, 0), cA + kstep, voffA); PG8_STAGE(PG8_SB(1, 1), cB + hstep + kstep, voffB);
        PG8_WAIT_V(6); PG8_BAR;
    } else {
        PG8_STAGE(PG8_SB(0, 0), cB, voffB); PG8_STAGE(PG8_SA(0, 0), cA, voffA); PG8_STAGE(PG8_SB(0, 1), cB + hstep, voffB); PG8_STAGE(PG8_SA(0, 1), cA + hstep, voffA);
        if (wr == 1) PG8_BAR;
        PG8_WAIT_V(4); PG8_BAR;
        PG8_STAGE(PG8_SB(1, 0), cB + kstep, voffB); PG8_STAGE(PG8_SA(1, 0), cA + kstep, voffA); PG8_STAGE(PG8_SB(1, 1), cB + hstep + kstep, voffB);
        PG8_WAIT_V(6); PG8_BAR;
    }
    for (;;) {
        const bool has_next = S.next(ui + 1, nxt);
        const char* nA = has_next ? (const char*)g.A + (size_t)nxt.pm * tstep : cA; const char* nB = has_next ? (const char*)g.Bt + (size_t)nxt.pn * tstep : cB;
        for (int t = 0; t < nt; t += 2) {
            const bool last = (t == nt - 2);
            const char* a1 = cA + (size_t)(t + 1) * kstep;
            const char* a2 = last ? nA : cA + (size_t)(t + 2) * kstep; const char* b2 = last ? nB : cB + (size_t)(t + 2) * kstep;
            const char* a3 = a2 + kstep; const char* b3 = b2 + kstep;
            if (last && has_next) S.a_ready(nxt);
            if constexpr (SP2) {
            PG8_LDB(B0, 0, 0); PG8_LDB(B1, 0, 1); PG8_SCHED; PG8_LDA(At, 0, 0); PG8_STAGE(PG8_SA(1, 1), a1 + hstep, voffA);
            PG8_WAIT_V(8); PG8_WAIT_L(0); PG8_BAR; PG8_MMA(0, 0, At, B0); PG8_MMA(0, 1, At, B1); PG8_BAR; PG8_SCHED;
            PG8_LDA(At, 0, 1); PG8_STAGE(PG8_SB(0, 0), b2, voffB); PG8_STAGE(PG8_SB(0, 1), b2 + hstep, voffB); PG8_STAGE(PG8_SA(0, 0), a2, voffA);
            PG8_WAIT_V(8); PG8_WAIT_L(0); PG8_BAR; PG8_MMA(1, 0, At, B0); PG8_MMA(1, 1, At, B1); PG8_BAR; PG8_SCHED;
            PG8_LDB(B0, 1, 0); PG8_LDB(B1, 1, 1); PG8_SCHED; PG8_LDA(At, 1, 0); PG8_STAGE(PG8_SA(0, 1), a2 + hstep, voffA);
            PG8_WAIT_V(8); PG8_WAIT_L(0); PG8_BAR; PG8_MMA(0, 0, At, B0); PG8_MMA(0, 1, At, B1); PG8_BAR; PG8_SCHED;
            PG8_LDA(At, 1, 1); PG8_STAGE(PG8_SB(1, 0), b3, voffB); PG8_STAGE(PG8_SB(1, 1), b3 + hstep, voffB); PG8_STAGE(PG8_SA(1, 0), a3, voffA);
            PG8_WAIT_V(8); PG8_WAIT_L(0); PG8_BAR; PG8_MMA(1, 0, At, B0); PG8_MMA(1, 1, At, B1); PG8_BAR; PG8_SCHED;
            } else {
            PG8_LDB(B0, 0, 0); PG8_SCHED; PG8_LDA(At, 0, 0); PG8_STAGE(PG8_SA(1, 1), a1 + hstep, voffA);
            PG8_WAIT_L(8); PG8_BAR; PG8_WAIT_L(0); PG8_MMA(0, 0, At, B0); PG8_BAR; PG8_SCHED;
            PG8_LDB(B1, 0, 1); PG8_STAGE(PG8_SB(0, 0), b2, voffB);
            PG8_BAR; PG8_WAIT_L(0); PG8_MMA(0, 1, At, B1); PG8_BAR;
            PG8_LDA(At, 0, 1); PG8_STAGE(PG8_SA(0, 0), a2, voffA);
            PG8_BAR; PG8_WAIT_L(0); PG8_MMA(1, 0, At, B0); PG8_BAR; PG8_SCHED;
            PG8_STAGE(PG8_SB(0, 1), b2 + hstep, voffB);
            PG8_WAIT_V(6); PG8_BAR; PG8_MMA(1, 1, At, B1); PG8_BAR;
            PG8_LDB(B0, 1, 0); PG8_SCHED; PG8_LDA(At, 1, 0); PG8_STAGE(PG8_SA(0, 1), a2 + hstep, voffA);
            PG8_WAIT_L(8); PG8_BAR; PG8_WAIT_L(0); PG8_MMA(0, 0, At, B0); PG8_BAR; PG8_SCHED;
            PG8_LDB(B1, 1, 1); PG8_STAGE(PG8_SB(1, 0), b3, voffB);
            PG8_BAR; PG8_WAIT_L(0); PG8_MMA(0, 1, At, B1); PG8_BAR;
            PG8_LDA(At, 1, 1); PG8_STAGE(PG8_SA(1, 0), a3, voffA);
            PG8_BAR; PG8_WAIT_L(0); PG8_MMA(1, 0, At, B0); PG8_BAR; PG8_SCHED;
            PG8_STAGE(PG8_SB(1, 1), b3 + hstep, voffB);
            PG8_WAIT_V(6); PG8_BAR; PG8_MMA(1, 1, At, B1); PG8_BAR;
            }
        }
        if constexpr (ALIGN_EPI) { if (wr == 0) PG8_BAR; }
        if constexpr (!Epi::AFTER_DRAIN) { E(acc, cur, wr, wc, fr, fq); S.done(cur); }
        if (!has_next) break;
#pragma unroll
        for (int a = 0; a < 2; ++a)
#pragma unroll
            for (int b = 0; b < 2; ++b)
#pragma unroll
                for (int m = 0; m < 4; ++m)
#pragma unroll
                    for (int n = 0; n < 2; ++n) acc[a][b][m][n] = (f32x4){0.f, 0.f, 0.f, 0.f};
        cur = nxt; cA = nA; cB = nB; ++ui;
        if constexpr (ALIGN_EPI) { if (wr == 1) PG8_BAR; }
    }
    PG8_WAIT_V(0);
    if constexpr (!ALIGN_EPI) { if (wr == 0) PG8_BAR; }
    PG8_BAR;
    if constexpr (Epi::AFTER_DRAIN) { E.fused(acc, cur, wr, wc, fr, fq, lds, wid, lane); S.done(cur); }
#undef PG8_SA
#undef PG8_SB
#undef PG8_STAGE
#undef PG8_LDA
#undef PG8_LDB
#undef PG8_MMA
#undef PG8_WAIT_V
#undef PG8_WAIT_L
#undef PG8_BAR
#undef PG8_SCHED
}
}
#define GAS __attribute__((address_space(1)))
#define LAS __attribute__((address_space(3)))
typedef unsigned short bf16;
typedef unsigned v4u __attribute__((ext_vector_type(4)));
typedef unsigned v2u __attribute__((ext_vector_type(2)));
typedef float f32x4 __attribute__((ext_vector_type(4)));
typedef float f32x2 __attribute__((ext_vector_type(2)));
typedef short bf16x8 __attribute__((ext_vector_type(8)));
constexpr int NWAVES = 8, NTHREADS = 512;
constexpr int M_TOK = 6144, M_CTX = 4096, DMODEL = 1024, NINP = 1792, NUC = 1280, FFD = 4096, DEPTHL = 4, DRNN = 512;
constexpr int LDS_BYTES = 147456;
constexpr size_t al256(size_t x) { return (x + 255) & ~(size_t)255; }
constexpr size_t WS_CTL = 0, CTL_BYTES = 1u << 20;
constexpr size_t WS_MODS = WS_CTL + CTL_BYTES;
constexpr size_t WS_GV = WS_MODS + al256((size_t)4 * 3 * 6144 * 4);
constexpr size_t WS_BIASIN = WS_GV + al256((size_t)4 * 2 * 3 * 1024 * 4);
constexpr size_t WS_BIAS1 = WS_BIASIN + al256((size_t)4 * 3 * NINP * 4);
constexpr size_t WS_SSQ = WS_BIAS1 + al256((size_t)4 * 3 * FFD * 4);
constexpr size_t WS_WIN = WS_SSQ + al256((size_t)9 * M_TOK * 16 * 4);
constexpr size_t WS_WOUT = WS_WIN + al256((size_t)4 * NINP * 1024 * 2);
constexpr size_t WS_W1 = WS_WOUT + al256((size_t)4 * 1024 * 1024 * 2);
constexpr size_t WS_W2 = WS_W1 + al256((size_t)4 * FFD * 1024 * 2);
constexpr size_t WS_WG = WS_W2 + al256((size_t)4 * FFD * 1024 * 2);
constexpr size_t WS_T256 = WS_WG + al256((size_t)4 * 8 * 4 * 2 * 32 * 64 * 2);
constexpr size_t WS_T1024 = WS_T256 + al256((size_t)256 * 512 * 2);
constexpr size_t WS_X = WS_T1024 + al256((size_t)1024 * 2048 * 2);
constexpr size_t WS_A = WS_X + al256((size_t)M_TOK * 1024 * 4);
constexpr size_t WS_U = WS_A + al256((size_t)M_TOK * 1024 * 2);
constexpr size_t WS_XCT = WS_U + al256((size_t)M_TOK * NUC * 2);
constexpr size_t WS_CAT = WS_XCT + al256((size_t)M_TOK * 512 * 2);
constexpr size_t WS_HF = WS_CAT + al256((size_t)M_TOK * 1024 * 2);
constexpr size_t WS_HID = WS_HF + al256((size_t)M_TOK * 512 * 4);
constexpr size_t WS_END = WS_HID + al256((size_t)M_TOK * FFD * 2);
static_assert(WS_END <= ((size_t)256 << 20), "workspace map exceeds 256 MiB");

__device__ __forceinline__ unsigned f2bf(float f) { unsigned u = __builtin_bit_cast(unsigned, f); return (u + 0x7fffu + ((u >> 16) & 1u)) >> 16; }
__device__ __forceinline__ unsigned pk2(float lo, float hi) { return f2bf(lo) | (f2bf(hi) << 16); }
__device__ __forceinline__ float bf2f(unsigned short b) { return __builtin_bit_cast(float, (unsigned)b << 16); }
__device__ __forceinline__ float bflo(unsigned w) { return __builtin_bit_cast(float, w << 16); }
__device__ __forceinline__ float bfhi(unsigned w) { return __builtin_bit_cast(float, w & 0xffff0000u); }
__device__ __forceinline__ float wave_sum(float v) {
#pragma unroll
    for (int o = 1; o < 64; o <<= 1) v += __shfl_xor(v, o);
    return v;
}
__device__ __forceinline__ float rdlane(float v, int l) { return __builtin_bit_cast(float, __builtin_amdgcn_readlane(__builtin_bit_cast(int, v), l)); }

__device__ __forceinline__ int launder_v(int x) { asm volatile("" : "+v"(x)); return x; }
__device__ __forceinline__ int launder_s(int x) { asm volatile("" : "+s"(x)); return x; }
#define CAS __attribute__((address_space(4)))
typedef const float* cfp_t;
struct Params { const float* in[24]; float* out; unsigned char* ws; int ph_lo, ph_hi; };
struct Frame {
    LAS unsigned char* lds;
    int tid, lane, wave, G, bid;
    __device__ __forceinline__ void relaunder() { tid = launder_v((int)threadIdx.x); lane = tid & 63; wave = __builtin_amdgcn_readfirstlane(tid >> 6); bid = launder_s(bid);
        size_t z = 0; asm volatile("" : "+s"(z), "+s"(in)); ws = ws0 + z; out = out0 + z; }
    __device__ __forceinline__ const float* inp(int i) const { return (const float*)(const GAS float*)in[i]; }
    const CAS cfp_t* in; float* out; unsigned char* ws; float* out0; unsigned char* ws0;
};
enum { I_XP = 0, I_XS, I_STATE, I_C, I_CCTX, I_N1G, I_N2G, I_FG, I_WMOD, I_BMOD, I_WIN, I_CONVW, I_CONVB, I_WR, I_BR, I_WI, I_BI, I_LAM, I_POOLW, I_POOLS, I_FW, I_WOUT, I_W1, I_W2 };
__device__ __forceinline__ void p0a_mods(const Frame& F) {
    LAS float* sl = (LAS float*)F.lds;
    LAS float* red = sl + 3 * 1024;
    const float* c_ctx = F.inp(I_CCTX); const float* cv = F.inp(I_C);
    for (int i = F.tid; i < 3 * 1024; i += NTHREADS) { const int cd = i >> 10, k = i & 1023; const float c = cd == 0 ? c_ctx[k] : cv[(cd - 1) * 1024 + k]; sl[i] = c / (1.0f + expf(-c)); }
    __syncthreads();
    float* mods = (float*)(F.ws + WS_MODS);
    for (int it = F.bid; it < 256; it += F.G) {
        const int l = it >> 6, ch = it & 63;
        const float* W = F.inp(I_WMOD) + (size_t)l * 1024 * 6144 + ch * 96;
        if (F.tid < 504) {
            const int c4 = F.tid % 24, kr = F.tid / 24;
            f32x4 a0 = {0.f, 0.f, 0.f, 0.f}, a1 = a0, a2 = a0;
#pragma unroll 4
            for (int k = kr; k < 1024; k += 21) { const f32x4 w = *(const f32x4*)(W + (size_t)k * 6144 + c4 * 4); a0 += w * sl[k]; a1 += w * sl[1024 + k]; a2 += w * sl[2048 + k]; }
            *(LAS f32x4*)(red + (kr * 3 + 0) * 96 + c4 * 4) = a0; *(LAS f32x4*)(red + (kr * 3 + 1) * 96 + c4 * 4) = a1; *(LAS f32x4*)(red + (kr * 3 + 2) * 96 + c4 * 4) = a2;
        }
        __syncthreads();
        if (F.tid < 288) { const int cd = F.tid / 96, col = F.tid % 96; float s = 0.f;
#pragma unroll
            for (int kr = 0; kr < 21; ++kr) s += red[(kr * 3 + cd) * 96 + col];
            mods[(size_t)(l * 3 + cd) * 6144 + ch * 96 + col] = s + F.inp(I_BMOD)[l * 6144 + ch * 96 + col]; }
        __syncthreads();
    }
}

template <bool BIAS>
__device__ __forceinline__ void strip_item(const float* W, int N, int kb, int ke, int n0, bf16* WT, int ldt, int trow0, const float* sh, float* bias_out, int bstride, LAS float* scr, int lane) {
    float b0 = 0.f, b1 = 0.f, b2 = 0.f;
    const int nn = lane & 31, half = lane >> 5;
    for (int k0 = kb; k0 < ke; k0 += 64) {
#pragma unroll 8
        for (int i = 0; i < 32; ++i) { const int kk = 2 * i + half; scr[kk * 33 + nn] = W[(size_t)(k0 + kk) * N + n0 + nn]; }
        asm volatile("s_waitcnt lgkmcnt(0)" ::: "memory");
        const int c = lane & 7;
#pragma unroll
        for (int j = 0; j < 4; ++j) { const int n = (lane >> 3) + 8 * j; const LAS float* s = scr + (8 * c) * 33 + n;
            v4u o; o.x = pk2(s[0 * 33], s[1 * 33]); o.y = pk2(s[2 * 33], s[3 * 33]); o.z = pk2(s[4 * 33], s[5 * 33]); o.w = pk2(s[6 * 33], s[7 * 33]);
            *(v4u*)(WT + (size_t)(trow0 + n) * ldt + k0 + 8 * c) = o; }
        if (BIAS) {
            const float s0 = sh[k0 + lane], s1 = sh[6144 + k0 + lane], s2 = sh[2 * 6144 + k0 + lane];
#pragma unroll 8
            for (int kk = 0; kk < 32; ++kk) { const float w = scr[(half * 32 + kk) * 33 + nn]; const int src = half * 32 + kk;
                b0 += w * __shfl(s0, src); b1 += w * __shfl(s1, src); b2 += w * __shfl(s2, src); }
        }
        asm volatile("s_waitcnt lgkmcnt(0)" ::: "memory");
    }
    if (BIAS) {
        b0 += __shfl_xor(b0, 32); b1 += __shfl_xor(b1, 32); b2 += __shfl_xor(b2, 32);
        if (lane < 32) { bias_out[n0 + lane] = b0; bias_out[bstride + n0 + lane] = b1; bias_out[2 * bstride + n0 + lane] = b2; }
    }
}
__device__ __forceinline__ float dft64(float tabreg, int c, int mm) { const int m = mm & 63; const int idx = (mm < 64) ? ((c * m) & 63) : ((c * m - 16) & 63); return __shfl(tabreg, idx); }

__device__ __forceinline__ void p0b_prepare(Frame F) {
    const int gw = F.bid * NWAVES + F.wave, NGW = F.G * NWAVES;
    const float tabreg = cospif((float)F.lane * (1.0f / 32.0f)) * 0.125f;
    constexpr int N_FOUT = 1024, N_FIN = 1024, N_POOLF = 256, N_FBIAS = 16, N_W1 = 512, N_W2 = 512, N_WIN = 160, N_WOUTA = 128, N_ROWS = M_TOK;
    constexpr int NITEMS = N_FOUT + N_FIN + N_POOLF + N_FBIAS + N_W1 + N_W2 + N_WIN + N_WOUTA + N_ROWS;
    for (int it = gw; it < NITEMS; it += NGW) {
        int r = it; F.relaunder(); const int lane = F.lane;
        LAS float* scr = (LAS float*)(F.lds + F.wave * 16384);
        const float* mods = (const float*)(F.ws + WS_MODS);
        bf16* WINT = (bf16*)(F.ws + WS_WIN); bf16* WOUTT = (bf16*)(F.ws + WS_WOUT); bf16* W1T = (bf16*)(F.ws + WS_W1); bf16* W2T = (bf16*)(F.ws + WS_W2);
        float* BIASIN = (float*)(F.ws + WS_BIASIN); float* BIAS1 = (float*)(F.ws + WS_BIAS1);

        if (r < N_FOUT) {
            const int l = r >> 8, it16 = (r >> 4) & 15, nb = r & 15, lr = lane & 15, lq = lane >> 4;
            const float* fw = F.inp(I_FW) + (size_t)l * 65536 + (size_t)(it16 * 16 + lr) * 256 + lq;
            const float* wo = F.inp(I_WOUT) + (size_t)l * 1048576 + (size_t)(768 + lq) * 1024 + nb * 64 + lr;
            f32x4 acc[4];
#pragma unroll
            for (int nt = 0; nt < 4; ++nt) acc[nt] = (f32x4){0.f, 0.f, 0.f, 0.f};
#pragma unroll 4
            for (int ks = 0; ks < 64; ++ks) { const float av = fw[4 * ks];
#pragma unroll
                for (int nt = 0; nt < 4; ++nt) acc[nt] = __builtin_amdgcn_mfma_f32_16x16x4f32(av, wo[(size_t)(4 * ks) * 1024 + 16 * nt], acc[nt], 0, 0, 0); }
#pragma unroll
            for (int nt = 0; nt < 4; ++nt) { v2u o; o.x = pk2(acc[nt][0], acc[nt][1]); o.y = pk2(acc[nt][2], acc[nt][3]);
                *(v2u*)(WOUTT + (size_t)l * 1048576 + (size_t)(nb * 64 + 16 * nt + lr) * 1024 + 768 + it16 * 16 + 4 * lq) = o; }
            continue;
        }
        r -= N_FOUT;
        if (r < N_FIN) {
            const int l = r >> 8, hd = (r >> 6) & 3, kt = r & 63, lr = lane & 15, lq = lane >> 4;
            const float* wp = F.inp(I_WIN) + (size_t)l * 1024 * 1536 + (size_t)(kt * 16 + lr) * 1536 + 1280 + 64 * hd + lq;
            f32x4 acc[8];
#pragma unroll
            for (int nt = 0; nt < 8; ++nt) acc[nt] = (f32x4){0.f, 0.f, 0.f, 0.f};
#pragma unroll 2
            for (int ks = 0; ks < 16; ++ks) { const float av = wp[4 * ks]; const int c = 4 * ks + lq;
#pragma unroll
                for (int nt = 0; nt < 8; ++nt) acc[nt] = __builtin_amdgcn_mfma_f32_16x16x4f32(av, dft64(tabreg, c, 16 * nt + lr), acc[nt], 0, 0, 0); }
#pragma unroll
            for (int nt = 0; nt < 8; ++nt) { v2u o; o.x = pk2(acc[nt][0], acc[nt][1]); o.y = pk2(acc[nt][2], acc[nt][3]);
                *(v2u*)(WINT + (size_t)l * NINP * 1024 + (size_t)(1280 + 128 * hd + 16 * nt + lr) * 1024 + kt * 16 + 4 * lq) = o; }
            continue;
        }
        r -= N_FIN;
        if (r < N_POOLF) {
            const int l = r >> 6, g = (r >> 4) & 3, nb = r & 15, lr = lane & 15, lq = lane >> 4;
            const float* pw = F.inp(I_POOLW) + (size_t)(l * 4 + g) * 4096 + lr * 64 + lq;
            const float* ps = F.inp(I_POOLS) + l * 256 + 64 * g + lq;
            const float* wo = F.inp(I_WOUT) + (size_t)l * 1048576 + (size_t)(512 + 64 * g + lq) * 1024 + nb * 64 + lr;
            f32x4 acc[4][4];
#pragma unroll
            for (int mt = 0; mt < 4; ++mt)
#pragma unroll
                for (int nt = 0; nt < 4; ++nt) acc[mt][nt] = (f32x4){0.f, 0.f, 0.f, 0.f};
#pragma unroll 2
            for (int ks = 0; ks < 16; ++ks) { const float sc = ps[4 * ks]; float av[4], bv[4];
#pragma unroll
                for (int mt = 0; mt < 4; ++mt) av[mt] = pw[mt * 1024 + 4 * ks] * sc;
#pragma unroll
                for (int nt = 0; nt < 4; ++nt) bv[nt] = wo[(size_t)(4 * ks) * 1024 + 16 * nt];
#pragma unroll
                for (int mt = 0; mt < 4; ++mt)
#pragma unroll
                    for (int nt = 0; nt < 4; ++nt) acc[mt][nt] = __builtin_amdgcn_mfma_f32_16x16x4f32(av[mt], bv[nt], acc[mt][nt], 0, 0, 0); }
#pragma unroll
            for (int mt = 0; mt < 4; ++mt)
#pragma unroll
                for (int nt = 0; nt < 4; ++nt) { v2u o; o.x = pk2(acc[mt][nt][0], acc[mt][nt][1]); o.y = pk2(acc[mt][nt][2], acc[mt][nt][3]);
                    *(v2u*)(WOUTT + (size_t)l * 1048576 + (size_t)(nb * 64 + 16 * nt + lr) * 1024 + 512 + 64 * g + 16 * mt + 4 * lq) = o; }
            continue;
        }
        r -= N_POOLF;
        if (r < N_FBIAS) {
            const int l = r >> 2, hd = r & 3;
            const float* wp = F.inp(I_WIN) + (size_t)l * 1024 * 1536 + 1280 + 64 * hd + lane;
            const float* sh = mods + (size_t)l * 3 * 6144;
            float b0 = 0.f, b1 = 0.f, b2 = 0.f;
#pragma unroll 8
            for (int k = 0; k < 1024; ++k) { const float w = wp[(size_t)k * 1536]; b0 += w * sh[k]; b1 += w * sh[6144 + k]; b2 += w * sh[2 * 6144 + k]; }
            for (int hf = 0; hf < 2; ++hf) {
                const int mm = hf * 64 + lane; float s0 = 0.f, s1 = 0.f, s2 = 0.f;
#pragma unroll 8
                for (int c = 0; c < 64; ++c) { const int idx = hf == 0 ? ((c * lane) & 63) : ((c * lane - 16) & 63); const float dv = __shfl(tabreg, idx);
                    s0 += __shfl(b0, c) * dv; s1 += __shfl(b1, c) * dv; s2 += __shfl(b2, c) * dv; }
                float* bo = BIASIN + (size_t)l * 3 * NINP + 1280 + 128 * hd + mm;
                bo[0] = s0; bo[NINP] = s1; bo[2 * NINP] = s2;
            }
            continue;
        }
        r -= N_FBIAS;
        if (r < N_W1) {
            const int l = r >> 7, nb = r & 127;
            strip_item<true>(F.inp(I_W1) + (size_t)l * 1024 * 4096, 4096, 0, 1024, nb * 32, W1T + (size_t)l * 4096 * 1024, 1024, nb * 32,
                             mods + (size_t)l * 3 * 6144 + 3 * 1024, BIAS1 + (size_t)l * 3 * FFD, FFD, scr, lane);
            continue;
        }
        r -= N_W1;
        if (r < N_W2) {
            const int l = r >> 7, nb = (r >> 2) & 31, kq = r & 3;
            strip_item<false>(F.inp(I_W2) + (size_t)l * 4096 * 1024, 1024, kq * 1024, kq * 1024 + 1024, nb * 32, W2T + (size_t)l * 1024 * 4096, 4096, nb * 32, nullptr, nullptr, 0, scr, lane);
            continue;
        }
        r -= N_W2;
        if (r < N_WIN) {
            const int l = r / 40, nb = r % 40;
            strip_item<true>(F.inp(I_WIN) + (size_t)l * 1024 * 1536, 1536, 0, 1024, nb * 32, WINT + (size_t)l * NINP * 1024, 1024, nb * 32,
                             mods + (size_t)l * 3 * 6144, BIASIN + (size_t)l * 3 * NINP, NINP, scr, lane);
            continue;
        }
        r -= N_WIN;
        if (r < N_WOUTA) {
            const int l = r >> 5, nb = r & 31;
            strip_item<false>(F.inp(I_WOUT) + (size_t)l * 1048576, 1024, 0, 512, nb * 32, WOUTT + (size_t)l * 1048576, 1024, nb * 32, nullptr, nullptr, 0, scr, lane);
            continue;
        }
        r -= N_WOUTA;
        {
            const int cond = r < M_CTX ? 0 : 1 + ((r - M_CTX) >> 10);
            const float* src = r < M_CTX ? F.inp(I_XP) + (size_t)r * 1024 : F.inp(I_XS) + (size_t)(r - M_CTX) * 1024;
            const f32x4* xr = (const f32x4*)src + lane;
            const f32x4* gp = (const f32x4*)F.inp(I_N1G) + lane;
            const f32x4* sp = (const f32x4*)(mods + (size_t)cond * 6144 + 1024) + lane;
            f32x4 v[4]; float s = 0.f;
#pragma unroll
            for (int j = 0; j < 4; ++j) { v[j] = xr[64 * j]; s += (v[j][0] * v[j][0] + v[j][1] * v[j][1]) + (v[j][2] * v[j][2] + v[j][3] * v[j][3]); }
            s = wave_sum(s);
            f32x4* xo = (f32x4*)((float*)(F.ws + WS_X) + (size_t)r * 1024) + lane;
            v2u* ao = (v2u*)((bf16*)(F.ws + WS_A) + (size_t)r * 1024) + lane;
#pragma unroll
            for (int j = 0; j < 4; ++j) { xo[64 * j] = v[j]; const f32x4 a = v[j] * (gp[64 * j] * (sp[64 * j] + 1.0f));
                v2u w; w.x = pk2(a[0], a[1]); w.y = pk2(a[2], a[3]); ao[64 * j] = w; }
            if (lane < 16) ((float*)(F.ws + WS_SSQ))[(size_t)r * 16 + lane] = lane == 0 ? s : 0.f;
        }
    }
    F.relaunder();
    const float* mods = (const float*)(F.ws + WS_MODS);
    const int gt = F.bid * NTHREADS + F.tid, NGT = F.G * NTHREADS;
    {
        float* GV = (float*)(F.ws + WS_GV);
        for (int i = gt; i < 4 * 2 * 3 * 1024; i += NGT) { const int c = i & 1023, cd = (i >> 10) % 3, w = (i / 3072) & 1, l = i / 6144;
            const float g = (w == 0 ? F.inp(I_N1G) : F.inp(I_N2G))[l * 1024 + c]; GV[i] = g * (1.0f + mods[(size_t)(l * 3 + cd) * 6144 + (w == 0 ? 1 : 4) * 1024 + c]); }
    }
    {
        bf16* WG = (bf16*)(F.ws + WS_WG);
        for (int i = gt; i < 4 * 8 * 4 * 2 * 32 * 64; i += NGT) { const int k = i & 63, n = (i >> 6) & 31, dir = (i >> 11) & 1, q = (i >> 12) & 3, h = (i >> 14) & 7, l = i >> 17;
            const float* src = n < 16 ? F.inp(I_WR) : F.inp(I_WI);
            WG[i] = (bf16)f2bf(src[((size_t)((l * 2 + dir) * 8 + h) * 64 + k) * 64 + 16 * q + (n & 15)]); }
    }
    {
        for (int i = gt; i < (256 * 512 + 1024 * 2048) / 8; i += NGT) {
            int L, e; bf16* T;
            if (i < 256 * 512 / 8) { L = 256; e = i * 8; T = (bf16*)(F.ws + WS_T256); } else { L = 1024; e = (i - 256 * 512 / 8) * 8; T = (bf16*)(F.ws + WS_T1024); }
            const int kpos = e / (2 * L), k2 = e % (2 * L), sn = k2 >= L, l0 = k2 - (sn ? L : 0);
            const float scale = L == 256 ? 0.0625f : 0.03125f, inv = 2.0f / (float)L;
            float v[8];
#pragma unroll
            for (int j = 0; j < 8; ++j) { const int a = (kpos * (l0 + j)) & (L - 1); v[j] = sn ? -sinpif((float)a * inv) * scale : cospif((float)a * inv) * scale; }
            v4u o; o.x = pk2(v[0], v[1]); o.y = pk2(v[2], v[3]); o.z = pk2(v[4], v[5]); o.w = pk2(v[6], v[7]);
            *(v4u*)(T + e) = o;
        }
    }
}
__device__ __forceinline__ float sigmoidf_(float x) { return 1.0f / (1.0f + expf(-x)); }
__device__ __forceinline__ float gelu_tanh(float x) { return 0.5f * x * (1.0f + tanhf(0.7978845608028654f * (x + 0.044715f * x * x * x))); }
__device__ __forceinline__ void seq_geom(int seq, int& L, int& row0) { if (seq < 16) { L = 256; row0 = seq * 256; } else { L = 1024; row0 = M_CTX + (seq - 16) * 1024; } }

__device__ __forceinline__ void lru_unit(Frame F, int l, int seq, int h, int q) {
    F.relaunder();
    int L, row0; seq_geom(seq, L, row0);
    const int tid = F.tid, lane = F.lane, wave = F.wave;
    LAS bf16* XR = (LAS bf16*)F.lds;
    LAS bf16* XC = (LAS bf16*)(F.lds + 37440);
    LAS float* AA = (LAS float*)(F.lds + 74304);
    LAS float* BB = (LAS float*)(F.lds + 90688);
    LAS float* SEGP = (LAS float*)(F.lds + 107072);
    LAS float* SEGH = (LAS float*)(F.lds + 109120);
    LAS float* SEGC = (LAS float*)(F.lds + 111168);
    LAS float* CAR = (LAS float*)(F.lds + 113216);
    LAS float* GI = (LAS float*)(F.lds + 113280);
    const bf16* U = (const bf16*)(F.ws + WS_U);
    bf16* CAT = (bf16*)(F.ws + WS_CAT);
    float* HF = (float*)(F.ws + WS_HF);
    const int chb = 64 * h + 16 * q;
    const int nchunks = L >> 8;
    const int cg = tid & 7;
    float cw[4][8], cb[8];
#pragma unroll
    for (int k = 0; k < 4; ++k)
#pragma unroll
        for (int c = 0; c < 8; ++c) cw[k][c] = F.inp(I_CONVW)[(l * 4 + k) * 512 + 64 * h + 8 * cg + c];
#pragma unroll
    for (int c = 0; c < 8; ++c) cb[c] = F.inp(I_CONVB)[l * 512 + 64 * h + 8 * cg + c];
#pragma unroll 1
    for (int dir = 0; dir < 2; ++dir) {
        const int j16 = lane & 15;
        const float br = F.inp(I_BR)[(l * 2 + dir) * 512 + chb + j16], bi = F.inp(I_BI)[(l * 2 + dir) * 512 + chb + j16];
        const float sp8 = -8.0f * log1pf(expf(-F.inp(I_LAM)[(l * 2 + dir) * 512 + chb + j16]));
        const bf16* WG = (const bf16*)(F.ws + WS_WG) + (size_t)((((l * 8 + h) * 4 + q) * 2 + dir) * 32) * 64;
        bf16x8 bw[2][2];
#pragma unroll
        for (int nt = 0; nt < 2; ++nt)
#pragma unroll
            for (int ks = 0; ks < 2; ++ks) bw[nt][ks] = *(const bf16x8*)(WG + (size_t)(16 * nt + j16) * 64 + 32 * ks + 8 * (lane >> 4));
        if (tid < 16) CAR[tid] = seq < 16 ? 0.f : F.inp(I_STATE)[(((seq - 16) * 4 + l) * 2 + dir) * 512 + chb + tid];
#pragma unroll 1
        for (int cc = 0; cc < nchunks; ++cc) {
            const int ci = dir == 0 ? cc : nchunks - 1 - cc, c0 = ci * 256;
            for (int id = tid; id < 260 * 8; id += NTHREADS) { const int tr = id >> 3, v = id & 7, t = c0 - 2 + tr;
                v4u x = {0u, 0u, 0u, 0u};
                if (t >= 0 && t < L) x = *(const v4u*)(U + (size_t)(row0 + t) * NUC + 64 * h + 8 * v);
                *(LAS v4u*)(XR + tr * 72 + 8 * v) = x; }
            __syncthreads();
#pragma unroll
            for (int i = 0; i < 4; ++i) { const int tl = (tid >> 3) + 64 * i;
                float o[8];
#pragma unroll
                for (int c = 0; c < 8; ++c) o[c] = cb[c];
#pragma unroll
                for (int k = 0; k < 4; ++k) { const v4u x = *(const LAS v4u*)(XR + (tl + k) * 72 + 8 * cg);
                    o[0] += bflo(x.x) * cw[k][0]; o[1] += bfhi(x.x) * cw[k][1]; o[2] += bflo(x.y) * cw[k][2]; o[3] += bfhi(x.y) * cw[k][3];
                    o[4] += bflo(x.z) * cw[k][4]; o[5] += bfhi(x.z) * cw[k][5]; o[6] += bflo(x.w) * cw[k][6]; o[7] += bfhi(x.w) * cw[k][7]; }
                v4u w; w.x = pk2(o[0], o[1]); w.y = pk2(o[2], o[3]); w.z = pk2(o[4], o[5]); w.w = pk2(o[6], o[7]);
                *(LAS v4u*)(XC + tl * 72 + 8 * cg) = w;
                if ((cg >> 1) == q) {
#pragma unroll
                    for (int c = 0; c < 8; ++c) BB[tl * 16 + (cg & 1) * 8 + c] = o[c]; }
            }
            __syncthreads();
#pragma unroll
            for (int mt = 0; mt < 2; ++mt) {
                f32x4 ar = {0.f, 0.f, 0.f, 0.f}, ai = ar;
#pragma unroll
                for (int ks = 0; ks < 2; ++ks) { const bf16x8 a = *(const LAS bf16x8*)(XC + (32 * wave + 16 * mt + j16) * 72 + 32 * ks + 8 * (lane >> 4));
                    ar = __builtin_amdgcn_mfma_f32_16x16x32_bf16(a, bw[0][ks], ar, 0, 0, 0);
                    ai = __builtin_amdgcn_mfma_f32_16x16x32_bf16(a, bw[1][ks], ai, 0, 0, 0); }
#pragma unroll
                for (int rg = 0; rg < 4; ++rg) { const int tl = 32 * wave + 16 * mt + 4 * (lane >> 4) + rg; AA[tl * 16 + j16] = ar[rg]; GI[tl * 16 + j16] = ai[rg]; }
            }
#pragma unroll 1
            for (int e = 0; e < 8; ++e) { const int tl = 32 * wave + 16 * (e >> 2) + 4 * (lane >> 4) + (e & 3);
                const float r = sigmoidf_(AA[tl * 16 + j16] + br), ig = sigmoidf_(GI[tl * 16 + j16] + bi);
                const float la = sp8 * r, a = expf(la), mult = sqrtf(-expm1f(2.0f * la));
                const float xc = BB[tl * 16 + j16];
                AA[tl * 16 + j16] = a; BB[tl * 16 + j16] = mult * (ig * xc); }
            __syncthreads();
            { const int j = tid & 15, sg = tid >> 4; float P = 1.f, Hl = 0.f;
#pragma unroll
                for (int i = 0; i < 8; ++i) { const int tl = 8 * sg + (dir == 0 ? i : 7 - i); const float a = AA[tl * 16 + j], b = BB[tl * 16 + j];
                    Hl = a * Hl + b; P *= a; AA[tl * 16 + j] = P; BB[tl * 16 + j] = Hl; }
                SEGP[sg * 16 + j] = P; SEGH[sg * 16 + j] = Hl; }
            __syncthreads();
            if (tid < 16) { float c = CAR[tid];
                for (int s = 0; s < 32; ++s) { const int sg = dir == 0 ? s : 31 - s; SEGC[sg * 16 + tid] = c; c = SEGP[sg * 16 + tid] * c + SEGH[sg * 16 + tid]; }
                CAR[tid] = c; }
            __syncthreads();
            { const int j = tid & 15, sg = tid >> 4; const float cin = SEGC[sg * 16 + j];
#pragma unroll 2
                for (int i = 0; i < 8; ++i) { const int tl = 8 * sg + i; const float hv = BB[tl * 16 + j] + AA[tl * 16 + j] * cin;
                    const size_t row = (size_t)(row0 + c0 + tl);
                    if (dir == 0) HF[row * DRNN + chb + j] = hv;
                    else { const float hf = HF[row * DRNN + chb + j]; const float xg = bf2f(U[row * NUC + 512 + chb + j]);
                        CAT[row * DMODEL + chb + j] = (bf16)f2bf((hf + hv) * gelu_tanh(xg)); } }
            }
            __syncthreads();
        }
        if (seq < 16 && tid < 16) F.out[(size_t)M_TOK * DMODEL + (size_t)((seq * 4 + l) * 2 + dir) * 512 + chb + tid] = CAR[tid];
        __syncthreads();
    }
}

__device__ __forceinline__ void pool1d_unit(Frame F, int seq, int tb) {
    F.relaunder();
    const bf16* U = (const bf16*)(F.ws + WS_U); bf16* CAT = (bf16*)(F.ws + WS_CAT);
    const int row0 = seq * 256;
#pragma unroll
    for (int i = 0; i < 4; ++i) { const int id = F.tid + NTHREADS * i, t = tb * 64 + (id >> 5), v = id & 31, g = v >> 3, hw = 1 << g;
        const int lo = max(t - hw, 0), hi = min(t + hw, 256);
        float s[8];
#pragma unroll
        for (int c = 0; c < 8; ++c) s[c] = 0.f;
        for (int tt = lo; tt < hi; ++tt) { const v4u x = *(const v4u*)(U + (size_t)(row0 + tt) * NUC + 1024 + 8 * v);
            s[0] += bflo(x.x); s[1] += bfhi(x.x); s[2] += bflo(x.y); s[3] += bfhi(x.y); s[4] += bflo(x.z); s[5] += bfhi(x.z); s[6] += bflo(x.w); s[7] += bfhi(x.w); }
        const float inv = 1.0f / (float)(hi - lo);
        const v4u x = *(const v4u*)(U + (size_t)(row0 + t) * NUC + 1024 + 8 * v);
        v4u o; o.x = pk2(s[0] * inv - bflo(x.x), s[1] * inv - bfhi(x.x)); o.y = pk2(s[2] * inv - bflo(x.y), s[3] * inv - bfhi(x.y));
        o.z = pk2(s[4] * inv - bflo(x.z), s[5] * inv - bfhi(x.z)); o.w = pk2(s[6] * inv - bflo(x.w), s[7] * inv - bfhi(x.w));
        *(v4u*)(CAT + (size_t)(row0 + t) * DMODEL + 512 + 8 * v) = o; }
}
__device__ __forceinline__ void pool2d_unit(Frame F, int b, int g, int qq) {
    F.relaunder();
    const bf16* U = (const bf16*)(F.ws + WS_U); bf16* CAT = (bf16*)(F.ws + WS_CAT);
    LAS float* T1 = (LAS float*)F.lds;
    LAS float* T2 = (LAS float*)(F.lds + 65536);
    const int row0 = M_CTX + b * 1024, colb = 64 * g + 16 * qq, hw = 1 << g;
#pragma unroll
    for (int i = 0; i < 4; ++i) { const int id = F.tid + NTHREADS * i, t = id >> 1, hf = id & 1;
        const v4u x = *(const v4u*)(U + (size_t)(row0 + t) * NUC + 1024 + colb + 8 * hf);
        LAS float* d = T1 + t * 16 + 8 * hf;
        d[0] = bflo(x.x); d[1] = bfhi(x.x); d[2] = bflo(x.y); d[3] = bfhi(x.y); d[4] = bflo(x.z); d[5] = bfhi(x.z); d[6] = bflo(x.w); d[7] = bfhi(x.w); }
    __syncthreads();
    const int j = F.tid & 15, tq = F.tid >> 4;
    for (int i = 0; i < 32; ++i) { const int t = tq + 32 * i, r = t >> 6, c = t & 63, lo = max(c - hw, 0), hi = min(c + hw, 64);
        float s = 0.f;
        for (int c2 = lo; c2 < hi; ++c2) s += T1[(r * 64 + c2) * 16 + j];
        T2[t * 16 + j] = s / (float)(hi - lo); }
    __syncthreads();
    for (int i = 0; i < 32; ++i) { const int t = tq + 32 * i, r = t >> 6, c = t & 63, lo = max(r - hw, 0), hi = min(r + hw, 16);
        float s = 0.f;
        for (int r2 = lo; r2 < hi; ++r2) s += T2[(r2 * 64 + c) * 16 + j];
        CAT[(size_t)(row0 + t) * DMODEL + 512 + colb + j] = (bf16)f2bf(s / (float)(hi - lo) - T1[t * 16 + j]); }
    __syncthreads();
}
__device__ __forceinline__ void fourier_unit(Frame F, int seq, int hd, int nb) {
    F.relaunder();
    int L, row0; seq_geom(seq, L, row0);
    const int lane = F.lane, wave = F.wave, j16 = lane & 15, kq = 8 * (lane >> 4);
    const bf16* XCT = (const bf16*)(F.ws + WS_XCT) + (seq < 16 ? (size_t)(seq * 4 + hd) * 128 * 256 : pg8::XCT_LAT_OFF + (size_t)((seq - 16) * 4 + hd) * 128 * 1024);
    const bf16* T = seq < 16 ? (const bf16*)(F.ws + WS_T256) : (const bf16*)(F.ws + WS_T1024);
    const int K2 = 2 * L, kw = K2 / 8, kbeg = wave * kw;
    const int part = kbeg >= L;
    const bf16* Ab = XCT + (size_t)(part * 64) * L + (kbeg - part * L);
    const bf16* Bb = T + (size_t)(nb * 64) * K2 + kbeg;
    f32x4 acc[4][4];
#pragma unroll
    for (int mt = 0; mt < 4; ++mt)
#pragma unroll
        for (int nt = 0; nt < 4; ++nt) acc[mt][nt] = (f32x4){0.f, 0.f, 0.f, 0.f};
    for (int ks = 0; ks < kw; ks += 32) {
        bf16x8 a[4], b[4];
#pragma unroll
        for (int mt = 0; mt < 4; ++mt) a[mt] = *(const bf16x8*)(Ab + (size_t)(16 * mt + j16) * L + ks + kq);
#pragma unroll
        for (int nt = 0; nt < 4; ++nt) b[nt] = *(const bf16x8*)(Bb + (size_t)(16 * nt + j16) * K2 + ks + kq);
#pragma unroll
        for (int mt = 0; mt < 4; ++mt)
#pragma unroll
            for (int nt = 0; nt < 4; ++nt) acc[mt][nt] = __builtin_amdgcn_mfma_f32_16x16x32_bf16(a[mt], b[nt], acc[mt][nt], 0, 0, 0);
    }
    LAS float* red = (LAS float*)F.lds;
#pragma unroll
    for (int mt = 0; mt < 4; ++mt)
#pragma unroll
        for (int nt = 0; nt < 4; ++nt) *(LAS f32x4*)(red + (size_t)(wave * 64 + 16 * nt + j16) * 68 + 16 * mt + 4 * (lane >> 4)) = acc[mt][nt];
    __syncthreads();
    { const int kp = F.tid >> 3, mg = F.tid & 7;
        f32x4 s0 = {0.f, 0.f, 0.f, 0.f}, s1 = s0;
#pragma unroll
        for (int w = 0; w < 8; ++w) { const LAS f32x4* p = (const LAS f32x4*)(red + (size_t)(w * 64 + kp) * 68 + 8 * mg); s0 += p[0]; s1 += p[1]; }
        v4u o; o.x = pk2(s0[0], s0[1]); o.y = pk2(s0[2], s0[3]); o.z = pk2(s1[0], s1[1]); o.w = pk2(s1[2], s1[3]);
        *(v4u*)((bf16*)(F.ws + WS_CAT) + (size_t)(row0 + nb * 64 + kp) * DMODEL + 768 + 64 * hd + 8 * mg) = o; }
    __syncthreads();
}
__device__ __forceinline__ void mixer_phase(const Frame& F, int l) {
    constexpr int N_LRU_LAT = 64, N_FOU_LAT = 128, N_P2D = 32, N_LRU_CTX = 512, N_FOU_CTX = 256, N_P1D = 64;
    constexpr int NUNITS = N_LRU_LAT + N_FOU_LAT + N_P2D + N_LRU_CTX + N_FOU_CTX + N_P1D;
    for (int it = F.bid; it < NUNITS; it += F.G) {
        int r = it;
        if (r < N_LRU_LAT) {
#ifndef SKIP_LRU
 lru_unit(F, l, 16 + (r >> 5), (r >> 2) & 7, r & 3);
#endif
 continue; } r -= N_LRU_LAT;
        if (r < N_FOU_LAT) {
#ifndef SKIP_FOU
 fourier_unit(F, 16 + (r >> 6), (r >> 4) & 3, r & 15);
#endif
 continue; } r -= N_FOU_LAT;
        if (r < N_P2D) {
#ifndef SKIP_POOL
 pool2d_unit(F, r >> 4, (r >> 2) & 3, r & 3);
#endif
 continue; } r -= N_P2D;
        if (r < N_LRU_CTX) {
#ifndef SKIP_LRU
 lru_unit(F, l, r >> 5, (r >> 2) & 7, r & 3);
#endif
 continue; } r -= N_LRU_CTX;
        if (r < N_FOU_CTX) {
#ifndef SKIP_FOU
 fourier_unit(F, r >> 4, (r >> 2) & 3, r & 3);
#endif
 continue; } r -= N_FOU_CTX;
#ifndef SKIP_POOL
        pool1d_unit(F, r >> 2, r & 3);
#endif
    }
}
#ifndef MK_PER_PHASE
#define MK_PER_PHASE 0
#endif
constexpr int N_PHASES = 2 + 5 * DEPTHL + 1;
__device__ __forceinline__ void final_norm(const Frame& F) {
    const int gw = F.bid * NWAVES + F.wave, NGW = F.G * NWAVES;
    const float* X = (const float*)(F.ws + WS_X); const float* ssq = (const float*)(F.ws + WS_SSQ) + (size_t)8 * M_TOK * 16;
    const f32x4* gp = (const f32x4*)F.inp(I_FG) + F.lane;
    for (int r = gw; r < M_TOK; r += NGW) {
        const float rs = pg8::row_rstd(ssq, r);
        const f32x4* xr = (const f32x4*)(X + (size_t)r * 1024) + F.lane; f32x4* o = (f32x4*)(F.out + (size_t)r * 1024) + F.lane;
#pragma unroll
        for (int j = 0; j < 4; ++j) o[64 * j] = xr[64 * j] * rs * gp[64 * j];
    }
}
__global__ void __launch_bounds__(NTHREADS, 2) mega(Params p) {
    extern __shared__ __attribute__((aligned(16))) unsigned char lds[];
    Frame F;
    F.lds = (LAS unsigned char*)lds; F.tid = threadIdx.x; F.lane = F.tid & 63; F.wave = __builtin_amdgcn_readfirstlane(F.tid >> 6);
    F.G = gridDim.x; F.bid = blockIdx.x; F.in = (const CAS cfp_t*)__builtin_amdgcn_kernarg_segment_ptr(); F.out0 = p.out; F.ws0 = p.ws; F.out = p.out; F.ws = p.ws;
    cg::grid_group grid = cg::this_grid();
    for (int ph = p.ph_lo; ph < p.ph_hi; ++ph) {
        F.relaunder();
        bf16* A = (bf16*)(F.ws + WS_A); bf16* CAT = (bf16*)(F.ws + WS_CAT); bf16* HID = (bf16*)(F.ws + WS_HID); bf16* U = (bf16*)(F.ws + WS_U); bf16* XCT = (bf16*)(F.ws + WS_XCT);
        float* X = (float*)(F.ws + WS_X); float* SSQ = (float*)(F.ws + WS_SSQ); const float* MODS = (const float*)(F.ws + WS_MODS); const float* GV = (const float*)(F.ws + WS_GV);
        if (ph == 0) {
#ifndef SKIP_P0A
 p0a_mods(F);
#endif
 }
        else if (ph == 1) {
#ifndef SKIP_P0B
 p0b_prepare(F);
#endif
 }
        else if (ph == N_PHASES - 1) final_norm(F);
        else {
            const int l = (ph - 2) / 5, k = (ph - 2) % 5;
            if (k == 0) {
                pg8::Gemm g{A, (const bf16*)(F.ws + WS_WIN) + (size_t)l * NINP * 1024, M_TOK, NINP, 1024}; pg8::StaticOrder S; S.init(M_TOK, NINP, F.G, F.bid);
                pg8::EpiIn E{U, XCT, SSQ + (size_t)(2 * l) * M_TOK * 16, (const float*)(F.ws + WS_BIASIN) + (size_t)l * 3 * NINP};
#ifndef SKIP_G1
                pg8::gemm_phase<pg8::EpiIn, pg8::StaticOrder, true, true>(F.lds, g, S, E);
#endif
            } else if (k == 1) {
#ifndef SKIP_MIX
                mixer_phase(F, l);
#endif
            } else if (k == 2 || k == 4) {
                const bool dn = k == 4;
                pg8::Gemm g{dn ? HID : CAT, dn ? (const bf16*)(F.ws + WS_W2) + (size_t)l * FFD * 1024 : (const bf16*)(F.ws + WS_WOUT) + (size_t)l * 1024 * 1024, M_TOK, 1024, dn ? FFD : 1024};
                pg8::StaticOrder S; S.init(M_TOK, 1024, F.G, F.bid);
                const float* Gn = dn ? (l < DEPTHL - 1 ? GV + (size_t)((l + 1) * 2 * 3) * 1024 : nullptr) : GV + (size_t)((l * 2 + 1) * 3) * 1024;
                const int inst = dn ? (l < DEPTHL - 1 ? 2 * (l + 1) : 8) : 2 * l + 1;
                pg8::EpiRes E{X, A, MODS + (size_t)l * 3 * 6144 + (dn ? 5 : 2) * 1024, Gn, SSQ + (size_t)inst * M_TOK * 16};
#ifndef SKIP_G24
                pg8::gemm_phase<pg8::EpiRes, pg8::StaticOrder, true, true>(F.lds, g, S, E);
#endif
            } else {
                pg8::Gemm g{A, (const bf16*)(F.ws + WS_W1) + (size_t)l * FFD * 1024, M_TOK, FFD, 1024}; pg8::StaticOrder S; S.init(M_TOK, FFD, F.G, F.bid);
                pg8::EpiUp E{HID, SSQ + (size_t)(2 * l + 1) * M_TOK * 16, (const float*)(F.ws + WS_BIAS1) + (size_t)l * 3 * FFD};
#ifndef SKIP_G3
                pg8::gemm_phase<pg8::EpiUp, pg8::StaticOrder, true, true>(F.lds, g, S, E);
#endif
            }
        }
        if (ph + 1 < p.ph_hi) grid.sync();
    }
}

extern "C" void kernel_launch(void* const* d_in, const int* in_sizes, int n_in, void* d_out, int out_size, void* d_ws, size_t ws_size, hipStream_t stream) {
    static int grid = 0;
    if (grid == 0) {
        if (n_in != 24 || ws_size < WS_END) { fprintf(stderr, "kernel_launch: expected 24 inputs and >= %zu bytes of workspace (got %d, %zu)\n", (size_t)WS_END, n_in, ws_size); grid = -1; return; }
        int dev = 0, cus = 0, per_cu = 0;
        if (hipGetDevice(&dev) != hipSuccess || hipDeviceGetAttribute(&cus, hipDeviceAttributeMultiprocessorCount, dev) != hipSuccess) { grid = -1; return; }
        if (hipFuncSetAttribute((const void*)mega, hipFuncAttributeMaxDynamicSharedMemorySize, LDS_BYTES) != hipSuccess) { fprintf(stderr, "kernel_launch: hipFuncSetAttribute failed\n"); grid = -1; return; }
        if (hipOccupancyMaxActiveBlocksPerMultiprocessor(&per_cu, (const void*)mega, NTHREADS, LDS_BYTES) != hipSuccess || per_cu < 1) { fprintf(stderr, "kernel_launch: occupancy query says %d blocks per CU\n", per_cu); grid = -1; return; }
        grid = cus;
    }
    if (grid < 0) return;
    Params p{};
    for (int i = 0; i < 24; ++i) p.in[i] = (const float*)d_in[i];
    p.out = (float*)d_out; p.ws = (unsigned char*)d_ws;
#if MK_PER_PHASE
    for (int ph = 0; ph < N_PHASES; ++ph) { p.ph_lo = ph; p.ph_hi = ph + 1; hipLaunchKernelGGL(mega, dim3(grid), dim3(NTHREADS), LDS_BYTES, stream, p); }
#else
    p.ph_lo = 0; p.ph_hi = N_PHASES;
    void* args[] = {&p};
    hipError_t e = hipLaunchCooperativeKernel((const void*)mega, dim3(grid), dim3(NTHREADS), args, LDS_BYTES, stream);
    if (e != hipSuccess) fprintf(stderr, "kernel_launch: cooperative launch failed: %s (grid %d)\n", hipGetErrorString(e), grid);
#endif
}
```

```cpp
#include <hip/hip_runtime.h>
#include <hip/hip_cooperative_groups.h>
#include <cstdio>
#include <cstdint>
namespace cg = cooperative_groups;
#define MK_PER_PHASE 0
namespace pg8 {
#define PG8_LAS __attribute__((address_space(3)))
typedef unsigned short bf16_t;
typedef short bf16x8 __attribute__((ext_vector_type(8)));
typedef float f32x4 __attribute__((ext_vector_type(4)));
typedef unsigned u32x4 __attribute__((ext_vector_type(4)));
constexpr int BM = 256, BK = 64, HALF = 128, HTB = HALF * BK * 2  , STAGE_BYTES = 8 * HTB, NXCD = 8, WGM = 8;

__host__ __device__ __forceinline__ int lds_byte(int r, int c) { const int st = (r >> 4) * 2 + (c >> 5), rr = r & 15, cc = c & 31, ob = rr * 64 + cc * 2; return st * 1024 + (ob ^ (((ob >> 9) & 1) << 5)); }
__host__ __device__ __forceinline__ void stage_rc(int b, int& R, int& C) { const int st = b / 1024, sb = b % 1024, swz = sb ^ (((sb >> 9) & 1) << 5); R = (st >> 1) * 16 + swz / 64; C = (st & 1) * 32 + (swz % 64) / 2; }
__host__ __device__ __forceinline__ int perm32(int rho) { const int n = rho >> 4, i = rho & 15; return 8 * (i >> 2) + 4 * n + (i & 3); }

struct Unit { int pm, pn; };
struct Gemm { const bf16_t* A; const bf16_t* Bt; int M, N, K; };

struct StaticOrder {
    int nM, nN, nwg, G, c;
    __host__ __device__ void init(int M, int N, int G_, int c_) { nM = M / BM; nN = N / BM; nwg = nM * nN; G = G_; c = c_; }
    __host__ __device__ bool next(int i, Unit& u) const {
        const long L = (long)i * G + c; if (L >= nwg) return false;
        int wgid = (int)L; { const int q = nwg / NXCD, r = nwg % NXCD, xcd = wgid % NXCD, off = wgid / NXCD; wgid = (xcd < r ? xcd * (q + 1) : r * (q + 1) + (xcd - r) * q) + off; }
        const int nig = WGM * nN, gid = wgid / nig, fm = gid * WGM, gsz = (nM - fm) < WGM ? (nM - fm) : WGM;
        u.pm = fm + ((wgid % nig) % gsz); u.pn = (wgid % nig) / gsz; return true;
    }
    __device__ __forceinline__ void a_ready(const Unit&) const {}
    __device__ __forceinline__ void done(const Unit&) const {}
};

__device__ __forceinline__ unsigned cvt_pk_bf16(float lo, float hi) { unsigned r; asm volatile("v_cvt_pk_bf16_f32 %0, %1, %2" : "=v"(r) : "v"(lo), "v"(hi)); return r; }
typedef float f32x2 __attribute__((ext_vector_type(2)));
typedef unsigned u32x2 __attribute__((ext_vector_type(2)));
constexpr int NIN = 1792, DM = 1024, DFF = 4096, NU = 1280, SSQW = 16;
constexpr size_t XCT_LAT_OFF = (size_t)16 * 4 * 128 * 256;
__device__ __forceinline__ int cond_of_panel(int pm) { return pm < 16 ? 0 : (pm < 20 ? 1 : 2); }
__device__ __forceinline__ float row_rstd(const float* ssq, int row) {
    const f32x4* sp = (const f32x4*)(ssq + (size_t)row * SSQW);
    const f32x4 s = (sp[0] + sp[1]) + (sp[2] + sp[3]);
    return 1.0f / sqrtf(((s[0] + s[1]) + (s[2] + s[3])) * (1.0f / 1024.0f) + 1e-6f);
}
struct EpiIn {
    static constexpr bool PERM = true, AFTER_DRAIN = false;
    bf16_t* U; bf16_t* XCT; const float* ssq; const float* bias;
    __device__ __forceinline__ void operator()(const f32x4 (&acc)[2][2][4][2], const Unit& u, int wr, int wc, int fr, int fq) const {
        const int cond = cond_of_panel(u.pm);
        const int bcol0 = u.pn * BM + wc * 32 + 8 * fq;
        f32x4 bv[2][2];
#pragma unroll
        for (int bj = 0; bj < 2; ++bj)
#pragma unroll
            for (int n = 0; n < 2; ++n) bv[bj][n] = *(const f32x4*)(bias + cond * NIN + bcol0 + bj * HALF + 4 * n);
#pragma unroll
        for (int ai = 0; ai < 2; ++ai)
#pragma unroll
            for (int m = 0; m < 4; ++m) {
                const int row = u.pm * BM + ai * HALF + wr * 64 + m * 16 + fr;
                const float rs = row_rstd(ssq, row);
#pragma unroll
                for (int bj = 0; bj < 2; ++bj) {
                    const f32x4 v0 = acc[ai][bj][m][0] * rs + bv[bj][0], v1 = acc[ai][bj][m][1] * rs + bv[bj][1];
                    u32x4 w; w.x = cvt_pk_bf16(v0[0], v0[1]); w.y = cvt_pk_bf16(v0[2], v0[3]); w.z = cvt_pk_bf16(v1[0], v1[1]); w.w = cvt_pk_bf16(v1[2], v1[3]);
                    if (u.pn < 5) { *(u32x4*)(U + (size_t)row * NU + bcol0 + bj * HALF) = w; }
                    else {
                        const int cc = bcol0 + bj * HALF - NU, hd = cc >> 7, mm = cc & 127;
                        bf16_t* p; int ls;
                        if (u.pm < 16) { ls = 256; p = XCT + ((size_t)(u.pm * 4 + hd) * 128 + mm) * 256 + (row & 255); }
                        else { const int rl = row - 4096; ls = 1024; p = XCT + XCT_LAT_OFF + ((size_t)((rl >> 10) * 4 + hd) * 128 + mm) * 1024 + (rl & 1023); }
                        p[0] = (bf16_t)(w.x & 0xffffu); p[ls] = (bf16_t)(w.x >> 16); p[2 * ls] = (bf16_t)(w.y & 0xffffu); p[3 * ls] = (bf16_t)(w.y >> 16);
                        p[4 * ls] = (bf16_t)(w.z & 0xffffu); p[5 * ls] = (bf16_t)(w.z >> 16); p[6 * ls] = (bf16_t)(w.w & 0xffffu); p[7 * ls] = (bf16_t)(w.w >> 16);
                    }
                }
                asm volatile("" ::: "memory");
            }
    }
};
struct EpiUp {
    static constexpr bool PERM = true, AFTER_DRAIN = false;
    bf16_t* H; const float* ssq; const float* bias;
    __device__ __forceinline__ void operator()(const f32x4 (&acc)[2][2][4][2], const Unit& u, int wr, int wc, int fr, int fq) const {
        const int cond = cond_of_panel(u.pm);
        const int bcol0 = u.pn * BM + wc * 32 + 8 * fq;
        f32x4 bv[2][2];
#pragma unroll
        for (int bj = 0; bj < 2; ++bj)
#pragma unroll
            for (int n = 0; n < 2; ++n) bv[bj][n] = *(const f32x4*)(bias + cond * DFF + bcol0 + bj * HALF + 4 * n);
#pragma unroll
        for (int ai = 0; ai < 2; ++ai)
#pragma unroll
            for (int m = 0; m < 4; ++m) {
                const int row = u.pm * BM + ai * HALF + wr * 64 + m * 16 + fr;
                const float rs = row_rstd(ssq, row);
#pragma unroll
                for (int bj = 0; bj < 2; ++bj) {
                    f32x4 v0 = acc[ai][bj][m][0] * rs + bv[bj][0], v1 = acc[ai][bj][m][1] * rs + bv[bj][1];
                    v0 = __builtin_elementwise_max(v0, (f32x4){0.f, 0.f, 0.f, 0.f}); v1 = __builtin_elementwise_max(v1, (f32x4){0.f, 0.f, 0.f, 0.f});
                    v0 = v0 * v0; v1 = v1 * v1;
                    u32x4 w; w.x = cvt_pk_bf16(v0[0], v0[1]); w.y = cvt_pk_bf16(v0[2], v0[3]); w.z = cvt_pk_bf16(v1[0], v1[1]); w.w = cvt_pk_bf16(v1[2], v1[3]);
                    *(u32x4*)(H + (size_t)row * DFF + bcol0 + bj * HALF) = w;
                }
                if (m & 1) asm volatile("" ::: "memory");
            }
    }
};
struct EpiRes {
    static constexpr bool PERM = false, AFTER_DRAIN = false;
    float* X; bf16_t* A; const float* gate; const float* Gn; float* ssq_out;
    __device__ __forceinline__ void operator()(const f32x4 (&acc)[2][2][4][2], const Unit& u, int wr, int wc, int fr, int fq) const {
        const int cond = cond_of_panel(u.pm);
        const int col0 = u.pn * BM + wc * 32 + 4 * fq;
#pragma unroll
        for (int ai = 0; ai < 2; ++ai)
#pragma unroll
            for (int m = 0; m < 4; ++m) {
                const int row = u.pm * BM + ai * HALF + wr * 64 + m * 16 + fr;
                float q = 0.f;
#pragma unroll
                for (int bj = 0; bj < 2; ++bj)
#pragma unroll
                    for (int n = 0; n < 2; ++n) {
                        const int c = col0 + bj * HALF + n * 16;
                        float* xp = X + (size_t)row * DM + c;
                        const f32x4 g4 = *(const f32x4*)(gate + cond * 6144 + c);
                        const f32x4 x1 = *(const f32x4*)xp + g4 * acc[ai][bj][m][n];
                        *(f32x4*)xp = x1;
                        q += (x1[0] * x1[0] + x1[1] * x1[1]) + (x1[2] * x1[2] + x1[3] * x1[3]);
                        if (Gn) { const f32x4 a = x1 * *(const f32x4*)(Gn + cond * DM + c); u32x2 w; w.x = cvt_pk_bf16(a[0], a[1]); w.y = cvt_pk_bf16(a[2], a[3]);
                            *(u32x2*)(A + (size_t)row * DM + c) = w; }
                    }
                q += __shfl_xor(q, 16); q += __shfl_xor(q, 32);
                if (fq == 0) ssq_out[(size_t)row * SSQW + u.pn * 4 + wc] = q;
                if (m & 1) asm volatile("" ::: "memory");
            }
    }
};
template <class Epi, class Sched, bool ALIGN_EPI = false, bool SP2 = false>
__device__ __forceinline__ void gemm_phase(PG8_LAS unsigned char* lds, const Gemm g, const Sched& S, const Epi& E) {
    int tid_ = threadIdx.x; asm volatile("" : "+v"(tid_)); const int tid = tid_, wid = __builtin_amdgcn_readfirstlane(tid >> 6), lane = tid & 63, wr = wid >> 2, wc = wid & 3, fr = lane & 15, fq = lane >> 4;
    const int K = g.K, nt = K / BK;
    unsigned voffA[2], voffB[2];
#pragma unroll
    for (int i = 0; i < 2; ++i) { int R, C; stage_rc(tid * 16 + i * 8192, R, C); const int Rb = Epi::PERM ? ((R & ~31) + perm32(R & 31)) : R;
        voffA[i] = (unsigned)(R * K + C) * 2u; voffB[i] = (unsigned)(Rb * K + C) * 2u; }
    const size_t kstep = (size_t)(BK * 2);
    const size_t hstep = (size_t)HALF * K * 2;
    const size_t tstep = 2 * hstep;
    const unsigned ldsw = (unsigned)wid * 1024u;
    const int aoff = lds_byte(wr * 64 + fr, fq * 8), boff = lds_byte(wc * 32 + fr, fq * 8);
#define PG8_SA(b, h) (((b) * 2 + (h)) * HTB)
#define PG8_SB(b, h) ((4 + (b) * 2 + (h)) * HTB)
#define PG8_STAGE(bufoff, gbase, voff) do { _Pragma("unroll") for (int _i = 0; _i < 2; ++_i) \
        __builtin_amdgcn_global_load_lds((const unsigned*)((const char*)(gbase) + (voff)[_i]), (PG8_LAS unsigned*)(lds + (bufoff) + ldsw + _i * 8192), 16, 0, 0); } while (0)
#define PG8_LDA(dst, b, h) do { _Pragma("unroll") for (int m = 0; m < 4; ++m) _Pragma("unroll") for (int k = 0; k < 2; ++k) dst[m][k] = *(const PG8_LAS bf16x8*)(lds + PG8_SA(b, h) + aoff + m * 2048 + k * 1024); } while (0)
#define PG8_LDB(dst, b, h) do { _Pragma("unroll") for (int n = 0; n < 2; ++n) _Pragma("unroll") for (int k = 0; k < 2; ++k) dst[n][k] = *(const PG8_LAS bf16x8*)(lds + PG8_SB(b, h) + boff + n * 2048 + k * 1024); } while (0)
#define PG8_MMA(ai, bj, At, Bt) do { __builtin_amdgcn_s_setprio(1); _Pragma("unroll") for (int m = 0; m < 4; ++m) _Pragma("unroll") for (int n = 0; n < 2; ++n) _Pragma("unroll") for (int k = 0; k < 2; ++k) \
        acc[ai][bj][m][n] = __builtin_amdgcn_mfma_f32_16x16x32_bf16(Bt[n][k], At[m][k], acc[ai][bj][m][n], 0, 0, 0); __builtin_amdgcn_s_setprio(0); } while (0)
#define PG8_WAIT_V(n) asm volatile("s_waitcnt vmcnt(" #n ")" ::: "memory")
#define PG8_WAIT_L(n) asm volatile("s_waitcnt lgkmcnt(" #n ")" ::: "memory")
#define PG8_BAR __builtin_amdgcn_s_barrier()
#define PG8_SCHED __builtin_amdgcn_sched_barrier(0)
    Unit cur, nxt; int ui = 0;
    if (!S.next(0, cur)) return;
    f32x4 acc[2][2][4][2];
#pragma unroll
    for (int a = 0; a < 2; ++a)
#pragma unroll
        for (int b = 0; b < 2; ++b)
#pragma unroll
            for (int m = 0; m < 4; ++m)
#pragma unroll
                for (int n = 0; n < 2; ++n) acc[a][b][m][n] = (f32x4){0.f, 0.f, 0.f, 0.f};
    bf16x8 At[4][2], B0[2][2], B1[2][2];
    const char* cA = (const char*)g.A + (size_t)cur.pm * tstep; const char* cB = (const char*)g.Bt + (size_t)cur.pn * tstep;
    S.a_ready(cur);
    if constexpr (SP2) {
        PG8_STAGE(PG8_SB(0, 0), cB, voffB); PG8_STAGE(PG8_SB(0, 1), cB + hstep, voffB); PG8_STAGE(PG8_SA(0, 0), cA, voffA); PG8_STAGE(PG8_SA(0, 1), cA + hstep, voffA);
        if (wr == 1) PG8_BAR;
        PG8_WAIT_V(2); PG8_BAR;
        PG8_STAGE(PG8_SB(1, 0), cB + kstep, voffB); PG8_STAGE(PG8_SA(1, 0), cA + kstep, voffA); PG8_STAGE(PG8_SB(1, 1), cB + hstep + kstep, voffB);
        PG8_WAIT_V(6); PG8_BAR;
    } else {
        PG8_STAGE(PG8_SB(0, 0), cB, voffB); PG8_STAGE(PG8_SA(0, 0), cA, voffA); PG8_STAGE(PG8_SB(0, 1), cB + hstep, voffB); PG8_STAGE(PG8_SA(0, 1), cA + hstep, voffA);
        if (wr == 1) PG8_BAR;
        PG8_WAIT_V(4); PG8_BAR;
        PG8_STAGE(PG8_SB(1, 0), cB + kstep, voffB); PG8_STAGE(PG8_SA(1, 0), cA + kstep, voffA); PG8_STAGE(PG8_SB(1, 1), cB + hstep + kstep, voffB);
        PG8_WAIT_V(6); PG8_BAR;
    }
    for (;;) {
        const bool has_next = S.next(ui + 1, nxt);
        const char* nA = has_next ? (const char*)g.A + (size_t)nxt.pm * tstep : cA; const char* nB = has_next ? (const char*)g.Bt + (size_t)nxt.pn * tstep : cB;
        for (int t = 0; t < nt; t += 2) {
            const bool last = (t == nt - 2);
            const char* a1 = cA + (size_t)(t + 1) * kstep;
            const char* a2 = last ? nA : cA + (size_t)(t + 2) * kstep; const char* b2 = last ? nB : cB + (size_t)(t + 2) * kstep;
            const char* a3 = a2 + kstep; const char* b3 = b2 + kstep;
            if (last && has_next) S.a_ready(nxt);
            if constexpr (SP2) {
            PG8_LDB(B0, 0, 0); PG8_LDB(B1, 0, 1); PG8_SCHED; PG8_LDA(At, 0, 0); PG8_STAGE(PG8_SA(1, 1), a1 + hstep, voffA);
            PG8_WAIT_V(8); PG8_WAIT_L(0); PG8_BAR; PG8_MMA(0, 0, At, B0); PG8_MMA(0, 1, At, B1); PG8_BAR; PG8_SCHED;
            PG8_LDA(At, 0, 1); PG8_STAGE(PG8_SB(0, 0), b2, voffB); PG8_STAGE(PG8_SB(0, 1), b2 + hstep, voffB); PG8_STAGE(PG8_SA(0, 0), a2, voffA);
            PG8_WAIT_V(8); PG8_WAIT_L(0); PG8_BAR; PG8_MMA(1, 0, At, B0); PG8_MMA(1, 1, At, B1); PG8_BAR; PG8_SCHED;
            PG8_LDB(B0, 1, 0); PG8_LDB(B1, 1, 1); PG8_SCHED; PG8_LDA(At, 1, 0); PG8_STAGE(PG8_SA(0, 1), a2 + hstep, voffA);
            PG8_WAIT_V(8); PG8_WAIT_L(0); PG8_BAR; PG8_MMA(0, 0, At, B0); PG8_MMA(0, 1, At, B1); PG8_BAR; PG8_SCHED;
            PG8_LDA(At, 1, 1); PG8_STAGE(PG8_SB(1, 0), b3, voffB); PG8_STAGE(PG8_SB(1, 1), b3 + hstep, voffB); PG8_STAGE(PG8_SA(1, 0), a3, voffA);
            PG8_WAIT_V(8); PG8_WAIT_L(0); PG8_BAR; PG8_MMA(1, 0, At, B0); PG8_MMA(1, 1, At, B1); PG8_BAR; PG8_SCHED;
            } else {
            PG8_LDB(B0, 0, 0); PG8_SCHED; PG8_LDA(At, 0, 0); PG8_STAGE(PG8_SA(1, 1), a1 + hstep, voffA);
            PG8_WAIT_L(8); PG8_BAR; PG8_WAIT_L(0); PG8_MMA(0, 0, At, B0); PG8_BAR; PG8_SCHED;
            PG8_LDB(B1, 0, 1); PG8_STAGE(PG8_SB(0, 0), b2, voffB);
            PG8_BAR; PG8_WAIT_L(0); PG8_MMA(0, 1, At, B1); PG8_BAR;
            PG8_LDA(At, 0, 1); PG8_STAGE(PG8_SA(0, 0), a2, voffA);
            PG8_BAR; PG8_WAIT_L(0); PG8_MMA(1, 0, At, B0); PG8_BAR; PG8_SCHED;
            PG8_STAGE(PG8_SB(0, 1), b2 + hstep, voffB);
            PG8_WAIT_V(6); PG8_BAR; PG8_MMA(1, 1, At, B1); PG8_BAR;
            PG8_LDB(B0, 1, 0); PG8_SCHED; PG8_LDA(At, 1, 0); PG8_STAGE(PG8_SA(0, 1), a2 + hstep, voffA);
            PG8_WAIT_L(8); PG8_BAR; PG8_WAIT_L(0); PG8_MMA(0, 0, At, B0); PG8_BAR; PG8_SCHED;
            PG8_LDB(B1, 1, 1); PG8_STAGE(PG8_SB(1, 0), b3, voffB);
            PG8_BAR; PG8_WAIT_L(0); PG8_MMA(0, 1, At, B1); PG8_BAR;
            PG8_LDA(At, 1, 1); PG8_STAGE(PG8_SA(1, 0), a3, voffA);
            PG8_BAR; PG8_WAIT_L(0); PG8_MMA(1, 0, At, B0); PG8_BAR; PG8_SCHED;
            PG8_STAGE(PG8_SB(1, 1), b3 + hstep, voffB);
            PG8_WAIT_V(6); PG8_BAR; PG8_MMA(1, 1, At, B1); PG8_BAR;
            }
        }
        if constexpr (ALIGN_EPI) { if (wr == 0) PG8_BAR; }
        if constexpr (!Epi::AFTER_DRAIN) { E(acc, cur, wr, wc, fr, fq); S.done(cur); }
        if (!has_next) break;
#pragma unroll
        for (int a = 0; a < 2; ++a)
#pragma unroll
            for (int b = 0; b < 2; ++b)
#pragma unroll
                for (int m = 0; m < 4; ++m)
#pragma unroll
                    for (int n = 0; n < 2; ++n) acc[a][b][m][n] = (f32x4){0.f, 0.f, 0.f, 0.f};
        cur = nxt; cA = nA; cB = nB; ++ui;
        if constexpr (ALIGN_EPI) { if (wr == 1) PG8_BAR; }
    }
    PG8_WAIT_V(0);
    if constexpr (!ALIGN_EPI) { if (wr == 0) PG8_BAR; }
    PG8_BAR;
    if constexpr (Epi::AFTER_DRAIN) { E.fused(acc, cur, wr, wc, fr, fq, lds, wid, lane); S.done(cur); }
#undef PG8_SA
#undef PG8_SB
#undef PG8_STAGE
#undef PG8_LDA
#undef PG8_LDB
#undef PG8_MMA
#undef PG8_WAIT_V
#undef PG8_WAIT_L
#undef PG8_BAR
#undef PG8_SCHED
}
}
#define GAS __attribute__((address_space(1)))
#define LAS __attribute__((address_space(3)))
typedef unsigned short bf16;
typedef unsigned v4u __attribute__((ext_vector_type(4)));
typedef unsigned v2u __attribute__((ext_vector_type(2)));
typedef float f32x4 __attribute__((ext_vector_type(4)));
typedef float f32x2 __attribute__((ext_vector_type(2)));
typedef short bf16x8 __attribute__((ext_vector_type(8)));
constexpr int NWAVES = 8, NTHREADS = 512;
constexpr int M_TOK = 6144, M_CTX = 4096, DMODEL = 1024, NINP = 1792, NUC = 1280, FFD = 4096, DEPTHL = 4, DRNN = 512;
constexpr int LDS_BYTES = 147456;
constexpr size_t al256(size_t x) { return (x + 255) & ~(size_t)255; }
constexpr size_t WS_CTL = 0, CTL_BYTES = 1u << 20;
constexpr size_t WS_MODS = WS_CTL + CTL_BYTES;
constexpr size_t WS_GV = WS_MODS + al256((size_t)4 * 3 * 6144 * 4);
constexpr size_t WS_BIASIN = WS_GV + al256((size_t)4 * 2 * 3 * 1024 * 4);
constexpr size_t WS_BIAS1 = WS_BIASIN + al256((size_t)4 * 3 * NINP * 4);
constexpr size_t WS_SSQ = WS_BIAS1 + al256((size_t)4 * 3 * FFD * 4);
constexpr size_t WS_WIN = WS_SSQ + al256((size_t)9 * M_TOK * 16 * 4);
constexpr size_t WS_WOUT = WS_WIN + al256((size_t)4 * NINP * 1024 * 2);
constexpr size_t WS_W1 = WS_WOUT + al256((size_t)4 * 1024 * 1024 * 2);
constexpr size_t WS_W2 = WS_W1 + al256((size_t)4 * FFD * 1024 * 2);
constexpr size_t WS_WG = WS_W2 + al256((size_t)4 * FFD * 1024 * 2);
constexpr size_t WS_T256 = WS_WG + al256((size_t)4 * 8 * 4 * 2 * 32 * 64 * 2);
constexpr size_t WS_T1024 = WS_T256 + al256((size_t)256 * 512 * 2);
constexpr size_t WS_X = WS_T1024 + al256((size_t)1024 * 2048 * 2);
constexpr size_t WS_A = WS_X + al256((size_t)M_TOK * 1024 * 4);
constexpr size_t WS_U = WS_A + al256((size_t)M_TOK * 1024 * 2);
constexpr size_t WS_XCT = WS_U + al256((size_t)M_TOK * NUC * 2);
constexpr size_t WS_CAT = WS_XCT + al256((size_t)M_TOK * 512 * 2);
constexpr size_t WS_HF = WS_CAT + al256((size_t)M_TOK * 1024 * 2);
constexpr size_t WS_HID = WS_HF + al256((size_t)M_TOK * 512 * 4);
constexpr size_t WS_END = WS_HID + al256((size_t)M_TOK * FFD * 2);
static_assert(WS_END <= ((size_t)256 << 20), "workspace map exceeds 256 MiB");

__device__ __forceinline__ unsigned f2bf(float f) { unsigned u = __builtin_bit_cast(unsigned, f); return (u + 0x7fffu + ((u >> 16) & 1u)) >> 16; }
__device__ __forceinline__ unsigned pk2(float lo, float hi) { return f2bf(lo) | (f2bf(hi) << 16); }
__device__ __forceinline__ float bf2f(unsigned short b) { return __builtin_bit_cast(float, (unsigned)b << 16); }
__device__ __forceinline__ float bflo(unsigned w) { return __builtin_bit_cast(float, w << 16); }
__device__ __forceinline__ float bfhi(unsigned w) { return __builtin_bit_cast(float, w & 0xffff0000u); }
__device__ __forceinline__ float wave_sum(float v) {
#pragma unroll
    for (int o = 1; o < 64; o <<= 1) v += __shfl_xor(v, o);
    return v;
}
__device__ __forceinline__ float rdlane(float v, int l) { return __builtin_bit_cast(float, __builtin_amdgcn_readlane(__builtin_bit_cast(int, v), l)); }

__device__ __forceinline__ int launder_v(int x) { asm volatile("" : "+v"(x)); return x; }
__device__ __forceinline__ int launder_s(int x) { asm volatile("" : "+s"(x)); return x; }
#define CAS __attribute__((address_space(4)))
typedef const float* cfp_t;
struct Params { const float* in[24]; float* out; unsigned char* ws; int ph_lo, ph_hi; };
struct Frame {
    LAS unsigned char* lds;
    int tid, lane, wave, G, bid;
    __device__ __forceinline__ void relaunder() { tid = launder_v((int)threadIdx.x); lane = tid & 63; wave = __builtin_amdgcn_readfirstlane(tid >> 6); bid = launder_s(bid);
        size_t z = 0; asm volatile("" : "+s"(z), "+s"(in)); ws = ws0 + z; out = out0 + z; }
    __device__ __forceinline__ const float* inp(int i) const { return (const float*)(const GAS float*)in[i]; }
    const CAS cfp_t* in; float* out; unsigned char* ws; float* out0; unsigned char* ws0;
};
enum { I_XP = 0, I_XS, I_STATE, I_C, I_CCTX, I_N1G, I_N2G, I_FG, I_WMOD, I_BMOD, I_WIN, I_CONVW, I_CONVB, I_WR, I_BR, I_WI, I_BI, I_LAM, I_POOLW, I_POOLS, I_FW, I_WOUT, I_W1, I_W2 };
#define XB_TMO      128
#define XB_XCNT(j)  (256  + 64 * (j))
#define XB_XSUB(j)  (1280 + 64 * (j))
#define XB_XGEN(j)  (2304 + 64 * (j))
#define XB_TOP      3328
#define XB_TOPGEN   3392
#define XCD_BAR_WORDS 3456
#define XB_SPIN_CAP (1u << 18)

__device__ __forceinline__ unsigned xb_ld(unsigned* p)              { return __hip_atomic_load(p, __ATOMIC_RELAXED, __HIP_MEMORY_SCOPE_AGENT); }
__device__ __forceinline__ unsigned xb_add(unsigned* p, unsigned v) { return __hip_atomic_fetch_add(p, v, __ATOMIC_RELAXED, __HIP_MEMORY_SCOPE_AGENT); }
__device__ __forceinline__ unsigned xb_xcc_id() { return (unsigned)__builtin_amdgcn_s_getreg((3 << 11) | 20) & 0xFu; }
#define XB_SPIN(cond, bar) do { unsigned _sp = 0; while (cond) { __builtin_amdgcn_s_sleep(1); \
    if ((++_sp & 255u) == 0u) { if (xb_ld(&(bar)[XB_TMO])) break; if (_sp > XB_SPIN_CAP) { atomicAdd(&(bar)[XB_TMO], 1u); break; } } } } while (0)

struct XcdBarrier {
    unsigned* bar; unsigned x;
    volatile LAS unsigned* st;
};

__device__ __forceinline__ XcdBarrier xcd_barrier_post(unsigned* bar, volatile LAS unsigned* st) {
    XcdBarrier b; b.bar = bar; b.x = xb_xcc_id(); b.st = st;
    if (threadIdx.x == 0) (void)xb_add(&bar[XB_XCNT(b.x)], 1u);
    return b;
}
__device__ __forceinline__ void xcd_barrier_complete(unsigned* bar, unsigned x, unsigned& nloc, unsigned& nx) {
    const unsigned G = gridDim.x * gridDim.y * gridDim.z;
    unsigned sum, cnt, mine, sp = 0u;
    for (;;) {
        sum = 0u; cnt = 0u; mine = 0u;
#pragma unroll
        for (unsigned j = 0; j < 16; ++j) { const unsigned c = xb_ld(&bar[XB_XCNT(j)]); sum += c; cnt += (c > 0u) ? 1u : 0u; mine = (j == x) ? c : mine; }
        if (sum == G) break;
        __builtin_amdgcn_s_sleep(1);
        if ((++sp & 255u) == 0u) { if (xb_ld(&bar[XB_TMO])) break; if (sp > XB_SPIN_CAP) { atomicAdd(&bar[XB_TMO], 1u); break; } }
    }
    nloc = mine > 0u ? mine : 1u; nx = cnt > 0u ? cnt : 1u;
}

__device__ __forceinline__ void xcd_barrier(const XcdBarrier& b) {
    asm volatile("s_waitcnt vmcnt(0)" ::: "memory");
    __syncthreads();
    if (threadIdx.x == 0) {
        unsigned* bar = b.bar;
        __builtin_amdgcn_s_waitcnt(0);
        unsigned nloc = b.st[0], nx = b.st[1];
        if (nloc == 0u) { xcd_barrier_complete(bar, b.x, nloc, nx); b.st[0] = nloc; b.st[1] = nx; }
        const unsigned old = xb_add(&bar[XB_XSUB(b.x)], 1u);
        const unsigned gen = old / nloc;
        if (old + 1u == (gen + 1u) * nloc) {
            __builtin_amdgcn_fence(__ATOMIC_RELEASE, "agent");
            asm volatile("s_waitcnt vmcnt(0)" ::: "memory");
            const unsigned og = xb_add(&bar[XB_TOP], 1u);
            const unsigned tg = og / nx;
            if (og + 1u == (tg + 1u) * nx) xb_add(&bar[XB_TOPGEN], 1u);
            else XB_SPIN(xb_ld(&bar[XB_TOPGEN]) == tg, bar);
            __builtin_amdgcn_fence(__ATOMIC_ACQUIRE, "agent");
            xb_add(&bar[XB_XGEN(b.x)], 1u);
            asm volatile("s_waitcnt vmcnt(0)" ::: "memory");
        } else {
            XB_SPIN(xb_ld(&bar[XB_XGEN(b.x)]) == gen, bar);
            __builtin_amdgcn_fence(__ATOMIC_ACQUIRE, "agent");
            asm volatile("s_waitcnt vmcnt(0)" ::: "memory");
        }
    }
    __syncthreads();
}
__device__ __forceinline__ void p0a_mods(const Frame& F) {
    LAS float* sl = (LAS float*)F.lds;
    LAS float* red = sl + 3 * 1024;
    const float* c_ctx = F.inp(I_CCTX); const float* cv = F.inp(I_C);
    for (int i = F.tid; i < 3 * 1024; i += NTHREADS) { const int cd = i >> 10, k = i & 1023; const float c = cd == 0 ? c_ctx[k] : cv[(cd - 1) * 1024 + k]; sl[i] = c / (1.0f + expf(-c)); }
    __syncthreads();
    float* mods = (float*)(F.ws + WS_MODS);
    for (int it = F.bid; it < 256; it += F.G) {
        const int l = it >> 6, ch = it & 63;
        const float* W = F.inp(I_WMOD) + (size_t)l * 1024 * 6144 + ch * 96;
        if (F.tid < 504) {
            const int c4 = F.tid % 24, kr = F.tid / 24;
            f32x4 a0 = {0.f, 0.f, 0.f, 0.f}, a1 = a0, a2 = a0;
#pragma unroll 4
            for (int k = kr; k < 1024; k += 21) { const f32x4 w = *(const f32x4*)(W + (size_t)k * 6144 + c4 * 4); a0 += w * sl[k]; a1 += w * sl[1024 + k]; a2 += w * sl[2048 + k]; }
            *(LAS f32x4*)(red + (kr * 3 + 0) * 96 + c4 * 4) = a0; *(LAS f32x4*)(red + (kr * 3 + 1) * 96 + c4 * 4) = a1; *(LAS f32x4*)(red + (kr * 3 + 2) * 96 + c4 * 4) = a2;
        }
        __syncthreads();
        if (F.tid < 288) { const int cd = F.tid / 96, col = F.tid % 96; float s = 0.f;
#pragma unroll
            for (int kr = 0; kr < 21; ++kr) s += red[(kr * 3 + cd) * 96 + col];
            mods[(size_t)(l * 3 + cd) * 6144 + ch * 96 + col] = s + F.inp(I_BMOD)[l * 6144 + ch * 96 + col]; }
        __syncthreads();
    }
}

template <bool BIAS>
__device__ __forceinline__ void strip_item(const float* W, int N, int kb, int ke, int n0, bf16* WT, int ldt, int trow0, const float* sh, float* bias_out, int bstride, LAS float* scr, int lane) {
    float b0 = 0.f, b1 = 0.f, b2 = 0.f;
    const int nn = lane & 31, half = lane >> 5;
    for (int k0 = kb; k0 < ke; k0 += 64) {
#pragma unroll 8
        for (int i = 0; i < 32; ++i) { const int kk = 2 * i + half; scr[kk * 33 + nn] = W[(size_t)(k0 + kk) * N + n0 + nn]; }
        asm volatile("s_waitcnt lgkmcnt(0)" ::: "memory");
        const int c = lane & 7;
#pragma unroll
        for (int j = 0; j < 4; ++j) { const int n = (lane >> 3) + 8 * j; const LAS float* s = scr + (8 * c) * 33 + n;
            v4u o; o.x = pk2(s[0 * 33], s[1 * 33]); o.y = pk2(s[2 * 33], s[3 * 33]); o.z = pk2(s[4 * 33], s[5 * 33]); o.w = pk2(s[6 * 33], s[7 * 33]);
            *(v4u*)(WT + (size_t)(trow0 + n) * ldt + k0 + 8 * c) = o; }
        if (BIAS) {
            const float s0 = sh[k0 + lane], s1 = sh[6144 + k0 + lane], s2 = sh[2 * 6144 + k0 + lane];
#pragma unroll 8
            for (int kk = 0; kk < 32; ++kk) { const float w = scr[(half * 32 + kk) * 33 + nn]; const int src = half * 32 + kk;
                b0 += w * __shfl(s0, src); b1 += w * __shfl(s1, src); b2 += w * __shfl(s2, src); }
        }
        asm volatile("s_waitcnt lgkmcnt(0)" ::: "memory");
    }
    if (BIAS) {
        b0 += __shfl_xor(b0, 32); b1 += __shfl_xor(b1, 32); b2 += __shfl_xor(b2, 32);
        if (lane < 32) { bias_out[n0 + lane] = b0; bias_out[bstride + n0 + lane] = b1; bias_out[2 * bstride + n0 + lane] = b2; }
    }
}
__device__ __forceinline__ float dft64(float tabreg, int c, int mm) { const int m = mm & 63; const int idx = (mm < 64) ? ((c * m) & 63) : ((c * m - 16) & 63); return __shfl(tabreg, idx); }

__device__ __forceinline__ void p0b_prepare(Frame F) {
    const int gw = F.bid * NWAVES + F.wave, NGW = F.G * NWAVES;
    const float tabreg = cospif((float)F.lane * (1.0f / 32.0f)) * 0.125f;
    constexpr int N_FOUT = 1024, N_FIN = 1024, N_POOLF = 256, N_FBIAS = 16, N_W1 = 512, N_W2 = 512, N_WIN = 160, N_WOUTA = 128, N_ROWS = M_TOK;
    constexpr int NITEMS = N_FOUT + N_FIN + N_POOLF + N_FBIAS + N_W1 + N_W2 + N_WIN + N_WOUTA + N_ROWS;
    for (int it = gw; it < NITEMS; it += NGW) {
        int r = it; F.relaunder(); const int lane = F.lane;
        LAS float* scr = (LAS float*)(F.lds + F.wave * 16384);
        const float* mods = (const float*)(F.ws + WS_MODS);
        bf16* WINT = (bf16*)(F.ws + WS_WIN); bf16* WOUTT = (bf16*)(F.ws + WS_WOUT); bf16* W1T = (bf16*)(F.ws + WS_W1); bf16* W2T = (bf16*)(F.ws + WS_W2);
        float* BIASIN = (float*)(F.ws + WS_BIASIN); float* BIAS1 = (float*)(F.ws + WS_BIAS1);

        if (r < N_FOUT) {
            const int l = r >> 8, it16 = (r >> 4) & 15, nb = r & 15, lr = lane & 15, lq = lane >> 4;
            const float* fw = F.inp(I_FW) + (size_t)l * 65536 + (size_t)(it16 * 16 + lr) * 256 + lq;
            const float* wo = F.inp(I_WOUT) + (size_t)l * 1048576 + (size_t)(768 + lq) * 1024 + nb * 64 + lr;
            f32x4 acc[4];
#pragma unroll
            for (int nt = 0; nt < 4; ++nt) acc[nt] = (f32x4){0.f, 0.f, 0.f, 0.f};
#pragma unroll 4
            for (int ks = 0; ks < 64; ++ks) { const float av = fw[4 * ks];
#pragma unroll
                for (int nt = 0; nt < 4; ++nt) acc[nt] = __builtin_amdgcn_mfma_f32_16x16x4f32(av, wo[(size_t)(4 * ks) * 1024 + 16 * nt], acc[nt], 0, 0, 0); }
#pragma unroll
            for (int nt = 0; nt < 4; ++nt) { v2u o; o.x = pk2(acc[nt][0], acc[nt][1]); o.y = pk2(acc[nt][2], acc[nt][3]);
                *(v2u*)(WOUTT + (size_t)l * 1048576 + (size_t)(nb * 64 + 16 * nt + lr) * 1024 + 768 + it16 * 16 + 4 * lq) = o; }
            continue;
        }
        r -= N_FOUT;
        if (r < N_FIN) {
            const int l = r >> 8, hd = (r >> 6) & 3, kt = r & 63, lr = lane & 15, lq = lane >> 4;
            const float* wp = F.inp(I_WIN) + (size_t)l * 1024 * 1536 + (size_t)(kt * 16 + lr) * 1536 + 1280 + 64 * hd + lq;
            f32x4 acc[8];
#pragma unroll
            for (int nt = 0; nt < 8; ++nt) acc[nt] = (f32x4){0.f, 0.f, 0.f, 0.f};
#pragma unroll 2
            for (int ks = 0; ks < 16; ++ks) { const float av = wp[4 * ks]; const int c = 4 * ks + lq;
#pragma unroll
                for (int nt = 0; nt < 8; ++nt) acc[nt] = __builtin_amdgcn_mfma_f32_16x16x4f32(av, dft64(tabreg, c, 16 * nt + lr), acc[nt], 0, 0, 0); }
#pragma unroll
            for (int nt = 0; nt < 8; ++nt) { v2u o; o.x = pk2(acc[nt][0], acc[nt][1]); o.y = pk2(acc[nt][2], acc[nt][3]);
                *(v2u*)(WINT + (size_t)l * NINP * 1024 + (size_t)(1280 + 128 * hd + 16 * nt + lr) * 1024 + kt * 16 + 4 * lq) = o; }
            continue;
        }
        r -= N_FIN;
        if (r < N_POOLF) {
            const int l = r >> 6, g = (r >> 4) & 3, nb = r & 15, lr = lane & 15, lq = lane >> 4;
            const float* pw = F.inp(I_POOLW) + (size_t)(l * 4 + g) * 4096 + lr * 64 + lq;
            const float* ps = F.inp(I_POOLS) + l * 256 + 64 * g + lq;
            const float* wo = F.inp(I_WOUT) + (size_t)l * 1048576 + (size_t)(512 + 64 * g + lq) * 1024 + nb * 64 + lr;
            f32x4 acc[4][4];
#pragma unroll
            for (int mt = 0; mt < 4; ++mt)
#pragma unroll
                for (int nt = 0; nt < 4; ++nt) acc[mt][nt] = (f32x4){0.f, 0.f, 0.f, 0.f};
#pragma unroll 2
            for (int ks = 0; ks < 16; ++ks) { const float sc = ps[4 * ks]; float av[4], bv[4];
#pragma unroll
                for (int mt = 0; mt < 4; ++mt) av[mt] = pw[mt * 1024 + 4 * ks] * sc;
#pragma unroll
                for (int nt = 0; nt < 4; ++nt) bv[nt] = wo[(size_t)(4 * ks) * 1024 + 16 * nt];
#pragma unroll
                for (int mt = 0; mt < 4; ++mt)
#pragma unroll
                    for (int nt = 0; nt < 4; ++nt) acc[mt][nt] = __builtin_amdgcn_mfma_f32_16x16x4f32(av[mt], bv[nt], acc[mt][nt], 0, 0, 0); }
#pragma unroll
            for (int mt = 0; mt < 4; ++mt)
#pragma unroll
                for (int nt = 0; nt < 4; ++nt) { v2u o; o.x = pk2(acc[mt][nt][0], acc[mt][nt][1]); o.y = pk2(acc[mt][nt][2], acc[mt][nt][3]);
                    *(v2u*)(WOUTT + (size_t)l * 1048576 + (size_t)(nb * 64 + 16 * nt + lr) * 1024 + 512 + 64 * g + 16 * mt + 4 * lq) = o; }
            continue;
        }
        r -= N_POOLF;
        if (r < N_FBIAS) {
            const int l = r >> 2, hd = r & 3;
            const float* wp = F.inp(I_WIN) + (size_t)l * 1024 * 1536 + 1280 + 64 * hd + lane;
            const float* sh = mods + (size_t)l * 3 * 6144;
            float b0 = 0.f, b1 = 0.f, b2 = 0.f;
#pragma unroll 8
            for (int k = 0; k < 1024; ++k) { const float w = wp[(size_t)k * 1536]; b0 += w * sh[k]; b1 += w * sh[6144 + k]; b2 += w * sh[2 * 6144 + k]; }
            for (int hf = 0; hf < 2; ++hf) {
                const int mm = hf * 64 + lane; float s0 = 0.f, s1 = 0.f, s2 = 0.f;
#pragma unroll 8
                for (int c = 0; c < 64; ++c) { const int idx = hf == 0 ? ((c * lane) & 63) : ((c * lane - 16) & 63); const float dv = __shfl(tabreg, idx);
                    s0 += __shfl(b0, c) * dv; s1 += __shfl(b1, c) * dv; s2 += __shfl(b2, c) * dv; }
                float* bo = BIASIN + (size_t)l * 3 * NINP + 1280 + 128 * hd + mm;
                bo[0] = s0; bo[NINP] = s1; bo[2 * NINP] = s2;
            }
            continue;
        }
        r -= N_FBIAS;
        if (r < N_W1) {
            const int l = r >> 7, nb = r & 127;
            strip_item<true>(F.inp(I_W1) + (size_t)l * 1024 * 4096, 4096, 0, 1024, nb * 32, W1T + (size_t)l * 4096 * 1024, 1024, nb * 32,
                             mods + (size_t)l * 3 * 6144 + 3 * 1024, BIAS1 + (size_t)l * 3 * FFD, FFD, scr, lane);
            continue;
        }
        r -= N_W1;
        if (r < N_W2) {
            const int l = r >> 7, nb = (r >> 2) & 31, kq = r & 3;
            strip_item<false>(F.inp(I_W2) + (size_t)l * 4096 * 1024, 1024, kq * 1024, kq * 1024 + 1024, nb * 32, W2T + (size_t)l * 1024 * 4096, 4096, nb * 32, nullptr, nullptr, 0, scr, lane);
            continue;
        }
        r -= N_W2;
        if (r < N_WIN) {
            const int l = r / 40, nb = r % 40;
            strip_item<true>(F.inp(I_WIN) + (size_t)l * 1024 * 1536, 1536, 0, 1024, nb * 32, WINT + (size_t)l * NINP * 1024, 1024, nb * 32,
                             mods + (size_t)l * 3 * 6144, BIASIN + (size_t)l * 3 * NINP, NINP, scr, lane);
            continue;
        }
        r -= N_WIN;
        if (r < N_WOUTA) {
            const int l = r >> 5, nb = r & 31;
            strip_item<false>(F.inp(I_WOUT) + (size_t)l * 1048576, 1024, 0, 512, nb * 32, WOUTT + (size_t)l * 1048576, 1024, nb * 32, nullptr, nullptr, 0, scr, lane);
            continue;
        }
        r -= N_WOUTA;
        {
            const int cond = r < M_CTX ? 0 : 1 + ((r - M_CTX) >> 10);
            const float* src = r < M_CTX ? F.inp(I_XP) + (size_t)r * 1024 : F.inp(I_XS) + (size_t)(r - M_CTX) * 1024;
            const f32x4* xr = (const f32x4*)src + lane;
            const f32x4* gp = (const f32x4*)F.inp(I_N1G) + lane;
            const f32x4* sp = (const f32x4*)(mods + (size_t)cond * 6144 + 1024) + lane;
            f32x4 v[4]; float s = 0.f;
#pragma unroll
            for (int j = 0; j < 4; ++j) { v[j] = xr[64 * j]; s += (v[j][0] * v[j][0] + v[j][1] * v[j][1]) + (v[j][2] * v[j][2] + v[j][3] * v[j][3]); }
            s = wave_sum(s);
            f32x4* xo = (f32x4*)((float*)(F.ws + WS_X) + (size_t)r * 1024) + lane;
            v2u* ao = (v2u*)((bf16*)(F.ws + WS_A) + (size_t)r * 1024) + lane;
#pragma unroll
            for (int j = 0; j < 4; ++j) { xo[64 * j] = v[j]; const f32x4 a = v[j] * (gp[64 * j] * (sp[64 * j] + 1.0f));
                v2u w; w.x = pk2(a[0], a[1]); w.y = pk2(a[2], a[3]); ao[64 * j] = w; }
            if (lane < 16) ((float*)(F.ws + WS_SSQ))[(size_t)r * 16 + lane] = lane == 0 ? s : 0.f;
        }
    }
    F.relaunder();
    const float* mods = (const float*)(F.ws + WS_MODS);
    const int gt = F.bid * NTHREADS + F.tid, NGT = F.G * NTHREADS;
    {
        float* GV = (float*)(F.ws + WS_GV);
        for (int i = gt; i < 4 * 2 * 3 * 1024; i += NGT) { const int c = i & 1023, cd = (i >> 10) % 3, w = (i / 3072) & 1, l = i / 6144;
            const float g = (w == 0 ? F.inp(I_N1G) : F.inp(I_N2G))[l * 1024 + c]; GV[i] = g * (1.0f + mods[(size_t)(l * 3 + cd) * 6144 + (w == 0 ? 1 : 4) * 1024 + c]); }
    }
    {
        bf16* WG = (bf16*)(F.ws + WS_WG);
        for (int i = gt; i < 4 * 8 * 4 * 2 * 32 * 64; i += NGT) { const int k = i & 63, n = (i >> 6) & 31, dir = (i >> 11) & 1, q = (i >> 12) & 3, h = (i >> 14) & 7, l = i >> 17;
            const float* src = n < 16 ? F.inp(I_WR) : F.inp(I_WI);
            WG[i] = (bf16)f2bf(src[((size_t)((l * 2 + dir) * 8 + h) * 64 + k) * 64 + 16 * q + (n & 15)]); }
    }
    {
        for (int i = gt; i < (256 * 512 + 1024 * 2048) / 8; i += NGT) {
            int L, e; bf16* T;
            if (i < 256 * 512 / 8) { L = 256; e = i * 8; T = (bf16*)(F.ws + WS_T256); } else { L = 1024; e = (i - 256 * 512 / 8) * 8; T = (bf16*)(F.ws + WS_T1024); }
            const int kpos = e / (2 * L), k2 = e % (2 * L), sn = k2 >= L, l0 = k2 - (sn ? L : 0);
            const float scale = L == 256 ? 0.0625f : 0.03125f, inv = 2.0f / (float)L;
            float v[8];
#pragma unroll
            for (int j = 0; j < 8; ++j) { const int a = (kpos * (l0 + j)) & (L - 1); v[j] = sn ? -sinpif((float)a * inv) * scale : cospif((float)a * inv) * scale; }
            v4u o; o.x = pk2(v[0], v[1]); o.y = pk2(v[2], v[3]); o.z = pk2(v[4], v[5]); o.w = pk2(v[6], v[7]);
            *(v4u*)(T + e) = o;
        }
    }
}
__device__ __forceinline__ float sigmoidf_(float x) { return 1.0f / (1.0f + expf(-x)); }
__device__ __forceinline__ float gelu_tanh(float x) { return 0.5f * x * (1.0f + tanhf(0.7978845608028654f * (x + 0.044715f * x * x * x))); }
__device__ __forceinline__ void seq_geom(int seq, int& L, int& row0) { if (seq < 16) { L = 256; row0 = seq * 256; } else { L = 1024; row0 = M_CTX + (seq - 16) * 1024; } }

__device__ __forceinline__ void lru_unit(Frame F, int l, int seq, int h, int q) {
    F.relaunder();
    int L, row0; seq_geom(seq, L, row0);
    const int tid = F.tid, lane = F.lane, wave = F.wave;
    LAS bf16* XR = (LAS bf16*)F.lds;
    LAS bf16* XC = (LAS bf16*)(F.lds + 37440);
    LAS float* AA = (LAS float*)(F.lds + 74304);
    LAS float* BB = (LAS float*)(F.lds + 90688);
    LAS float* SEGP = (LAS float*)(F.lds + 107072);
    LAS float* SEGH = (LAS float*)(F.lds + 109120);
    LAS float* SEGC = (LAS float*)(F.lds + 111168);
    LAS float* CAR = (LAS float*)(F.lds + 113216);
    LAS float* GI = (LAS float*)(F.lds + 113280);
    const bf16* U = (const bf16*)(F.ws + WS_U);
    bf16* CAT = (bf16*)(F.ws + WS_CAT);
    float* HF = (float*)(F.ws + WS_HF);
    const int chb = 64 * h + 16 * q;
    const int nchunks = L >> 8;
    const int cg = tid & 7;
    float cw[4][8], cb[8];
#pragma unroll
    for (int k = 0; k < 4; ++k)
#pragma unroll
        for (int c = 0; c < 8; ++c) cw[k][c] = F.inp(I_CONVW)[(l * 4 + k) * 512 + 64 * h + 8 * cg + c];
#pragma unroll
    for (int c = 0; c < 8; ++c) cb[c] = F.inp(I_CONVB)[l * 512 + 64 * h + 8 * cg + c];
#pragma unroll 1
    for (int dir = 0; dir < 2; ++dir) {
        const int j16 = lane & 15;
        const float br = F.inp(I_BR)[(l * 2 + dir) * 512 + chb + j16], bi = F.inp(I_BI)[(l * 2 + dir) * 512 + chb + j16];
        const float sp8 = -8.0f * log1pf(expf(-F.inp(I_LAM)[(l * 2 + dir) * 512 + chb + j16]));
        const bf16* WG = (const bf16*)(F.ws + WS_WG) + (size_t)((((l * 8 + h) * 4 + q) * 2 + dir) * 32) * 64;
        bf16x8 bw[2][2];
#pragma unroll
        for (int nt = 0; nt < 2; ++nt)
#pragma unroll
            for (int ks = 0; ks < 2; ++ks) bw[nt][ks] = *(const bf16x8*)(WG + (size_t)(16 * nt + j16) * 64 + 32 * ks + 8 * (lane >> 4));
        if (tid < 16) CAR[tid] = seq < 16 ? 0.f : F.inp(I_STATE)[(((seq - 16) * 4 + l) * 2 + dir) * 512 + chb + tid];
#pragma unroll 1
        for (int cc = 0; cc < nchunks; ++cc) {
            const int ci = dir == 0 ? cc : nchunks - 1 - cc, c0 = ci * 256;
            for (int id = tid; id < 260 * 8; id += NTHREADS) { const int tr = id >> 3, v = id & 7, t = c0 - 2 + tr;
                v4u x = {0u, 0u, 0u, 0u};
                if (t >= 0 && t < L) x = *(const v4u*)(U + (size_t)(row0 + t) * NUC + 64 * h + 8 * v);
                *(LAS v4u*)(XR + tr * 72 + 8 * v) = x; }
            __syncthreads();
#pragma unroll
            for (int i = 0; i < 4; ++i) { const int tl = (tid >> 3) + 64 * i;
                float o[8];
#pragma unroll
                for (int c = 0; c < 8; ++c) o[c] = cb[c];
#pragma unroll
                for (int k = 0; k < 4; ++k) { const v4u x = *(const LAS v4u*)(XR + (tl + k) * 72 + 8 * cg);
                    o[0] += bflo(x.x) * cw[k][0]; o[1] += bfhi(x.x) * cw[k][1]; o[2] += bflo(x.y) * cw[k][2]; o[3] += bfhi(x.y) * cw[k][3];
                    o[4] += bflo(x.z) * cw[k][4]; o[5] += bfhi(x.z) * cw[k][5]; o[6] += bflo(x.w) * cw[k][6]; o[7] += bfhi(x.w) * cw[k][7]; }
                v4u w; w.x = pk2(o[0], o[1]); w.y = pk2(o[2], o[3]); w.z = pk2(o[4], o[5]); w.w = pk2(o[6], o[7]);
                *(LAS v4u*)(XC + tl * 72 + 8 * cg) = w;
                if ((cg >> 1) == q) {
#pragma unroll
                    for (int c = 0; c < 8; ++c) BB[tl * 16 + (cg & 1) * 8 + c] = o[c]; }
            }
            __syncthreads();
#pragma unroll
            for (int mt = 0; mt < 2; ++mt) {
                f32x4 ar = {0.f, 0.f, 0.f, 0.f}, ai = ar;
#pragma unroll
                for (int ks = 0; ks < 2; ++ks) { const bf16x8 a = *(const LAS bf16x8*)(XC + (32 * wave + 16 * mt + j16) * 72 + 32 * ks + 8 * (lane >> 4));
                    ar = __builtin_amdgcn_mfma_f32_16x16x32_bf16(a, bw[0][ks], ar, 0, 0, 0);
                    ai = __builtin_amdgcn_mfma_f32_16x16x32_bf16(a, bw[1][ks], ai, 0, 0, 0); }
#pragma unroll
                for (int rg = 0; rg < 4; ++rg) { const int tl = 32 * wave + 16 * mt + 4 * (lane >> 4) + rg; AA[tl * 16 + j16] = ar[rg]; GI[tl * 16 + j16] = ai[rg]; }
            }
#pragma unroll 1
            for (int e = 0; e < 8; ++e) { const int tl = 32 * wave + 16 * (e >> 2) + 4 * (lane >> 4) + (e & 3);
                const float r = sigmoidf_(AA[tl * 16 + j16] + br), ig = sigmoidf_(GI[tl * 16 + j16] + bi);
                const float la = sp8 * r, a = expf(la), mult = sqrtf(-expm1f(2.0f * la));
                const float xc = BB[tl * 16 + j16];
                AA[tl * 16 + j16] = a; BB[tl * 16 + j16] = mult * (ig * xc); }
            __syncthreads();
            { const int j = tid & 15, sg = tid >> 4; float P = 1.f, Hl = 0.f;
#pragma unroll
                for (int i = 0; i < 8; ++i) { const int tl = 8 * sg + (dir == 0 ? i : 7 - i); const float a = AA[tl * 16 + j], b = BB[tl * 16 + j];
                    Hl = a * Hl + b; P *= a; AA[tl * 16 + j] = P; BB[tl * 16 + j] = Hl; }
                SEGP[sg * 16 + j] = P; SEGH[sg * 16 + j] = Hl; }
            __syncthreads();
            if (tid < 16) { float c = CAR[tid];
                for (int s = 0; s < 32; ++s) { const int sg = dir == 0 ? s : 31 - s; SEGC[sg * 16 + tid] = c; c = SEGP[sg * 16 + tid] * c + SEGH[sg * 16 + tid]; }
                CAR[tid] = c; }
            __syncthreads();
            { const int j = tid & 15, sg = tid >> 4; const float cin = SEGC[sg * 16 + j];
#pragma unroll 2
                for (int i = 0; i < 8; ++i) { const int tl = 8 * sg + i; const float hv = BB[tl * 16 + j] + AA[tl * 16 + j] * cin;
                    const size_t row = (size_t)(row0 + c0 + tl);
                    if (dir == 0) HF[row * DRNN + chb + j] = hv;
                    else { const float hf = HF[row * DRNN + chb + j]; const float xg = bf2f(U[row * NUC + 512 + chb + j]);
                        CAT[row * DMODEL + chb + j] = (bf16)f2bf((hf + hv) * gelu_tanh(xg)); } }
            }
            __syncthreads();
        }
        if (seq < 16 && tid < 16) F.out[(size_t)M_TOK * DMODEL + (size_t)((seq * 4 + l) * 2 + dir) * 512 + chb + tid] = CAR[tid];
        __syncthreads();
    }
}

__device__ __forceinline__ void pool1d_unit(Frame F, int seq, int tb) {
    F.relaunder();
    const bf16* U = (const bf16*)(F.ws + WS_U); bf16* CAT = (bf16*)(F.ws + WS_CAT);
    const int row0 = seq * 256;
#pragma unroll
    for (int i = 0; i < 4; ++i) { const int id = F.tid + NTHREADS * i, t = tb * 64 + (id >> 5), v = id & 31, g = v >> 3, hw = 1 << g;
        const int lo = max(t - hw, 0), hi = min(t + hw, 256);
        float s[8];
#pragma unroll
        for (int c = 0; c < 8; ++c) s[c] = 0.f;
        for (int tt = lo; tt < hi; ++tt) { const v4u x = *(const v4u*)(U + (size_t)(row0 + tt) * NUC + 1024 + 8 * v);
            s[0] += bflo(x.x); s[1] += bfhi(x.x); s[2] += bflo(x.y); s[3] += bfhi(x.y); s[4] += bflo(x.z); s[5] += bfhi(x.z); s[6] += bflo(x.w); s[7] += bfhi(x.w); }
        const float inv = 1.0f / (float)(hi - lo);
        const v4u x = *(const v4u*)(U + (size_t)(row0 + t) * NUC + 1024 + 8 * v);
        v4u o; o.x = pk2(s[0] * inv - bflo(x.x), s[1] * inv - bfhi(x.x)); o.y = pk2(s[2] * inv - bflo(x.y), s[3] * inv - bfhi(x.y));
        o.z = pk2(s[4] * inv - bflo(x.z), s[5] * inv - bfhi(x.z)); o.w = pk2(s[6] * inv - bflo(x.w), s[7] * inv - bfhi(x.w));
        *(v4u*)(CAT + (size_t)(row0 + t) * DMODEL + 512 + 8 * v) = o; }
}
__device__ __forceinline__ void pool2d_unit(Frame F, int b, int g, int qq) {
    F.relaunder();
    const bf16* U = (const bf16*)(F.ws + WS_U); bf16* CAT = (bf16*)(F.ws + WS_CAT);
    LAS float* T1 = (LAS float*)F.lds;
    LAS float* T2 = (LAS float*)(F.lds + 65536);
    const int row0 = M_CTX + b * 1024, colb = 64 * g + 16 * qq, hw = 1 << g;
#pragma unroll
    for (int i = 0; i < 4; ++i) { const int id = F.tid + NTHREADS * i, t = id >> 1, hf = id & 1;
        const v4u x = *(const v4u*)(U + (size_t)(row0 + t) * NUC + 1024 + colb + 8 * hf);
        LAS float* d = T1 + t * 16 + 8 * hf;
        d[0] = bflo(x.x); d[1] = bfhi(x.x); d[2] = bflo(x.y); d[3] = bfhi(x.y); d[4] = bflo(x.z); d[5] = bfhi(x.z); d[6] = bflo(x.w); d[7] = bfhi(x.w); }
    __syncthreads();
    const int j = F.tid & 15, tq = F.tid >> 4;
    for (int i = 0; i < 32; ++i) { const int t = tq + 32 * i, r = t >> 6, c = t & 63, lo = max(c - hw, 0), hi = min(c + hw, 64);
        float s = 0.f;
        for (int c2 = lo; c2 < hi; ++c2) s += T1[(r * 64 + c2) * 16 + j];
        T2[t * 16 + j] = s / (float)(hi - lo); }
    __syncthreads();
    for (int i = 0; i < 32; ++i) { const int t = tq + 32 * i, r = t >> 6, c = t & 63, lo = max(r - hw, 0), hi = min(r + hw, 16);
        float s = 0.f;
        for (int r2 = lo; r2 < hi; ++r2) s += T2[(r2 * 64 + c) * 16 + j];
        CAT[(size_t)(row0 + t) * DMODEL + 512 + colb + j] = (bf16)f2bf(s / (float)(hi - lo) - T1[t * 16 + j]); }
    __syncthreads();
}
__device__ __forceinline__ void fourier_unit(Frame F, int seq, int hd, int nb) {
    F.relaunder();
    int L, row0; seq_geom(seq, L, row0);
    const int lane = F.lane, wave = F.wave, j16 = lane & 15, kq = 8 * (lane >> 4);
    const bf16* XCT = (const bf16*)(F.ws + WS_XCT) + (seq < 16 ? (size_t)(seq * 4 + hd) * 128 * 256 : pg8::XCT_LAT_OFF + (size_t)((seq - 16) * 4 + hd) * 128 * 1024);
    const bf16* T = seq < 16 ? (const bf16*)(F.ws + WS_T256) : (const bf16*)(F.ws + WS_T1024);
    const int K2 = 2 * L, kw = K2 / 8, kbeg = wave * kw;
    const int part = kbeg >= L;
    const bf16* Ab = XCT + (size_t)(part * 64) * L + (kbeg - part * L);
    const bf16* Bb = T + (size_t)(nb * 64) * K2 + kbeg;
    f32x4 acc[4][4];
#pragma unroll
    for (int mt = 0; mt < 4; ++mt)
#pragma unroll
        for (int nt = 0; nt < 4; ++nt) acc[mt][nt] = (f32x4){0.f, 0.f, 0.f, 0.f};
    for (int ks = 0; ks < kw; ks += 32) {
        bf16x8 a[4], b[4];
#pragma unroll
        for (int mt = 0; mt < 4; ++mt) a[mt] = *(const bf16x8*)(Ab + (size_t)(16 * mt + j16) * L + ks + kq);
#pragma unroll
        for (int nt = 0; nt < 4; ++nt) b[nt] = *(const bf16x8*)(Bb + (size_t)(16 * nt + j16) * K2 + ks + kq);
#pragma unroll
        for (int mt = 0; mt < 4; ++mt)
#pragma unroll
            for (int nt = 0; nt < 4; ++nt) acc[mt][nt] = __builtin_amdgcn_mfma_f32_16x16x32_bf16(a[mt], b[nt], acc[mt][nt], 0, 0, 0);
    }
    LAS float* red = (LAS float*)F.lds;
#pragma unroll
    for (int mt = 0; mt < 4; ++mt)
#pragma unroll
        for (int nt = 0; nt < 4; ++nt) *(LAS f32x4*)(red + (size_t)(wave * 64 + 16 * nt + j16) * 68 + 16 * mt + 4 * (lane >> 4)) = acc[mt][nt];
    __syncthreads();
    { const int kp = F.tid >> 3, mg = F.tid & 7;
        f32x4 s0 = {0.f, 0.f, 0.f, 0.f}, s1 = s0;
#pragma unroll
        for (int w = 0; w < 8; ++w) { const LAS f32x4* p = (const LAS f32x4*)(red + (size_t)(w * 64 + kp) * 68 + 8 * mg); s0 += p[0]; s1 += p[1]; }
        v4u o; o.x = pk2(s0[0], s0[1]); o.y = pk2(s0[2], s0[3]); o.z = pk2(s1[0], s1[1]); o.w = pk2(s1[2], s1[3]);
        *(v4u*)((bf16*)(F.ws + WS_CAT) + (size_t)(row0 + nb * 64 + kp) * DMODEL + 768 + 64 * hd + 8 * mg) = o; }
    __syncthreads();
}
__device__ __forceinline__ void mixer_phase(const Frame& F, int l) {
    constexpr int N_LRU_LAT = 64, N_FOU_LAT = 128, N_P2D = 32, N_LRU_CTX = 512, N_FOU_CTX = 256, N_P1D = 64;
    constexpr int NUNITS = N_LRU_LAT + N_FOU_LAT + N_P2D + N_LRU_CTX + N_FOU_CTX + N_P1D;
    for (int it = F.bid; it < NUNITS; it += F.G) {
        int r = it;
        if (r < N_LRU_LAT) {
#ifndef SKIP_LRU
 lru_unit(F, l, 16 + (r >> 5), (r >> 2) & 7, r & 3);
#endif
 continue; } r -= N_LRU_LAT;
        if (r < N_FOU_LAT) {
#ifndef SKIP_FOU
 fourier_unit(F, 16 + (r >> 6), (r >> 4) & 3, r & 15);
#endif
 continue; } r -= N_FOU_LAT;
        if (r < N_P2D) {
#ifndef SKIP_POOL
 pool2d_unit(F, r >> 4, (r >> 2) & 3, r & 3);
#endif
 continue; } r -= N_P2D;
        if (r < N_LRU_CTX) {
#ifndef SKIP_LRU
 lru_unit(F, l, r >> 5, (r >> 2) & 7, r & 3);
#endif
 continue; } r -= N_LRU_CTX;
        if (r < N_FOU_CTX) {
#ifndef SKIP_FOU
 fourier_unit(F, r >> 4, (r >> 2) & 3, r & 3);
#endif
 continue; } r -= N_FOU_CTX;
#ifndef SKIP_POOL
        pool1d_unit(F, r >> 2, r & 3);
#endif
    }
}
#ifndef MK_PER_PHASE
#define MK_PER_PHASE 0
#endif
#ifndef MK_BARRIER
#define MK_BARRIER 1
#endif
constexpr int N_PHASES = 2 + 5 * DEPTHL + 1;
constexpr int CW_BAR = 4096;
__device__ __forceinline__ void final_norm(const Frame& F) {
    const int gw = F.bid * NWAVES + F.wave, NGW = F.G * NWAVES;
    const float* X = (const float*)(F.ws + WS_X); const float* ssq = (const float*)(F.ws + WS_SSQ) + (size_t)8 * M_TOK * 16;
    const f32x4* gp = (const f32x4*)F.inp(I_FG) + F.lane;
    for (int r = gw; r < M_TOK; r += NGW) {
        const float rs = pg8::row_rstd(ssq, r);
        const f32x4* xr = (const f32x4*)(X + (size_t)r * 1024) + F.lane; f32x4* o = (f32x4*)(F.out + (size_t)r * 1024) + F.lane;
#pragma unroll
        for (int j = 0; j < 4; ++j) o[64 * j] = xr[64 * j] * rs * gp[64 * j];
    }
}
__global__ void __launch_bounds__(NTHREADS, 2) mega(Params p) {
    extern __shared__ __attribute__((aligned(16))) unsigned char lds[];
    Frame F;
    F.lds = (LAS unsigned char*)lds; F.tid = threadIdx.x; F.lane = F.tid & 63; F.wave = __builtin_amdgcn_readfirstlane(F.tid >> 6);
    F.G = gridDim.x; F.bid = blockIdx.x; F.in = (const CAS cfp_t*)__builtin_amdgcn_kernarg_segment_ptr(); F.out0 = p.out; F.ws0 = p.ws; F.out = p.out; F.ws = p.ws;
#if MK_BARRIER
    volatile LAS unsigned* bst = (volatile LAS unsigned*)(F.lds + LDS_BYTES - 64);
    if (F.tid < 2) bst[F.tid] = 0u;
    __syncthreads();
    XcdBarrier bar = xcd_barrier_post((unsigned*)(p.ws + WS_CTL) + CW_BAR, bst);
#else
    cg::grid_group grid = cg::this_grid();
#endif
    for (int ph = p.ph_lo; ph < p.ph_hi; ++ph) {
        F.relaunder();
        bf16* A = (bf16*)(F.ws + WS_A); bf16* CAT = (bf16*)(F.ws + WS_CAT); bf16* HID = (bf16*)(F.ws + WS_HID); bf16* U = (bf16*)(F.ws + WS_U); bf16* XCT = (bf16*)(F.ws + WS_XCT);
        float* X = (float*)(F.ws + WS_X); float* SSQ = (float*)(F.ws + WS_SSQ); const float* MODS = (const float*)(F.ws + WS_MODS); const float* GV = (const float*)(F.ws + WS_GV);
        if (ph == 0) {
#ifndef SKIP_P0A
 p0a_mods(F);
#endif
 }
        else if (ph == 1) {
#ifndef SKIP_P0B
 p0b_prepare(F);
#endif
 }
        else if (ph == N_PHASES - 1) final_norm(F);
        else {
            const int l = (ph - 2) / 5, k = (ph - 2) % 5;
            if (k == 0) {
                pg8::Gemm g{A, (const bf16*)(F.ws + WS_WIN) + (size_t)l * NINP * 1024, M_TOK, NINP, 1024}; pg8::StaticOrder S; S.init(M_TOK, NINP, F.G, F.bid);
                pg8::EpiIn E{U, XCT, SSQ + (size_t)(2 * l) * M_TOK * 16, (const float*)(F.ws + WS_BIASIN) + (size_t)l * 3 * NINP};
#ifndef SKIP_G1
                pg8::gemm_phase<pg8::EpiIn, pg8::StaticOrder, true, true>(F.lds, g, S, E);
#endif
            } else if (k == 1) {
#ifndef SKIP_MIX
                mixer_phase(F, l);
#endif
            } else if (k == 2 || k == 4) {
                const bool dn = k == 4;
                pg8::Gemm g{dn ? HID : CAT, dn ? (const bf16*)(F.ws + WS_W2) + (size_t)l * FFD * 1024 : (const bf16*)(F.ws + WS_WOUT) + (size_t)l * 1024 * 1024, M_TOK, 1024, dn ? FFD : 1024};
                pg8::StaticOrder S; S.init(M_TOK, 1024, F.G, F.bid);
                const float* Gn = dn ? (l < DEPTHL - 1 ? GV + (size_t)((l + 1) * 2 * 3) * 1024 : nullptr) : GV + (size_t)((l * 2 + 1) * 3) * 1024;
                const int inst = dn ? (l < DEPTHL - 1 ? 2 * (l + 1) : 8) : 2 * l + 1;
                pg8::EpiRes E{X, A, MODS + (size_t)l * 3 * 6144 + (dn ? 5 : 2) * 1024, Gn, SSQ + (size_t)inst * M_TOK * 16};
#ifndef SKIP_G24
                pg8::gemm_phase<pg8::EpiRes, pg8::StaticOrder, true, true>(F.lds, g, S, E);
#endif
            } else {
                pg8::Gemm g{A, (const bf16*)(F.ws + WS_W1) + (size_t)l * FFD * 1024, M_TOK, FFD, 1024}; pg8::StaticOrder S; S.init(M_TOK, FFD, F.G, F.bid);
                pg8::EpiUp E{HID, SSQ + (size_t)(2 * l + 1) * M_TOK * 16, (const float*)(F.ws + WS_BIAS1) + (size_t)l * 3 * FFD};
#ifndef SKIP_G3
                pg8::gemm_phase<pg8::EpiUp, pg8::StaticOrder, true, true>(F.lds, g, S, E);
#endif
            }
        }
#if MK_BARRIER
        if (ph + 1 < p.ph_hi) xcd_barrier(bar);
#else
        if (ph + 1 < p.ph_hi) grid.sync();
#endif
    }
}

extern "C" void kernel_launch(void* const* d_in, const int* in_sizes, int n_in, void* d_out, int out_size, void* d_ws, size_t ws_size, hipStream_t stream) {
    static int grid = 0;
    if (grid == 0) {
        if (n_in != 24 || ws_size < WS_END) { fprintf(stderr, "kernel_launch: expected 24 inputs and >= %zu bytes of workspace (got %d, %zu)\n", (size_t)WS_END, n_in, ws_size); grid = -1; return; }
        int dev = 0, cus = 0, per_cu = 0;
        if (hipGetDevice(&dev) != hipSuccess || hipDeviceGetAttribute(&cus, hipDeviceAttributeMultiprocessorCount, dev) != hipSuccess) { grid = -1; return; }
        if (hipFuncSetAttribute((const void*)mega, hipFuncAttributeMaxDynamicSharedMemorySize, LDS_BYTES) != hipSuccess) { fprintf(stderr, "kernel_launch: hipFuncSetAttribute failed\n"); grid = -1; return; }
        if (hipOccupancyMaxActiveBlocksPerMultiprocessor(&per_cu, (const void*)mega, NTHREADS, LDS_BYTES) != hipSuccess || per_cu < 1) { fprintf(stderr, "kernel_launch: occupancy query says %d blocks per CU\n", per_cu); grid = -1; return; }
        grid = cus;
    }
    if (grid < 0) return;
    Params p{};
    for (int i = 0; i < 24; ++i) p.in[i] = (const float*)d_in[i];
    p.out = (float*)d_out; p.ws = (unsigned char*)d_ws;
    hipMemsetAsync((char*)d_ws + WS_CTL, 0, CTL_BYTES, stream);
#if MK_PER_PHASE
    for (int ph = 0; ph < N_PHASES; ++ph) { p.ph_lo = ph; p.ph_hi = ph + 1; hipLaunchKernelGGL(mega, dim3(grid), dim3(NTHREADS), LDS_BYTES, stream, p); }
#else
    p.ph_lo = 0; p.ph_hi = N_PHASES;
    void* args[] = {&p};
    hipError_t e = hipLaunchCooperativeKernel((const void*)mega, dim3(grid), dim3(NTHREADS), args, LDS_BYTES, stream);
    if (e != hipSuccess) fprintf(stderr, "kernel_launch: cooperative launch failed: %s (grid %d)\n", hipGetErrorString(e), grid);
#endif
}
```

```cpp
#include <hip/hip_runtime.h>
#include <hip/hip_cooperative_groups.h>
#include <cstdio>
#include <cstdint>
namespace cg = cooperative_groups;
#define MK_PER_PHASE 0
namespace pg8 {
#define PG8_LAS __attribute__((address_space(3)))
typedef unsigned short bf16_t;
typedef short bf16x8 __attribute__((ext_vector_type(8)));
typedef float f32x4 __attribute__((ext_vector_type(4)));
typedef unsigned u32x4 __attribute__((ext_vector_type(4)));
constexpr int BM = 256, BK = 64, HALF = 128, HTB = HALF * BK * 2  , STAGE_BYTES = 8 * HTB, NXCD = 8, WGM = 8;

__host__ __device__ __forceinline__ int lds_byte(int r, int c) { const int st = (r >> 4) * 2 + (c >> 5), rr = r & 15, cc = c & 31, ob = rr * 64 + cc * 2; return st * 1024 + (ob ^ (((ob >> 9) & 1) << 5)); }
__host__ __device__ __forceinline__ void stage_rc(int b, int& R, int& C) { const int st = b / 1024, sb = b % 1024, swz = sb ^ (((sb >> 9) & 1) << 5); R = (st >> 1) * 16 + swz / 64; C = (st & 1) * 32 + (swz % 64) / 2; }
__host__ __device__ __forceinline__ int perm32(int rho) { const int n = rho >> 4, i = rho & 15; return 8 * (i >> 2) + 4 * n + (i & 3); }

struct Unit { int pm, pn; };
struct Gemm { const bf16_t* A; const bf16_t* Bt; int M, N, K; };

struct StaticOrder {
    int nM, nN, nwg, G, c;
    __host__ __device__ void init(int M, int N, int G_, int c_) { nM = M / BM; nN = N / BM; nwg = nM * nN; G = G_; c = c_; }
    __host__ __device__ bool next(int i, Unit& u) const {
        const long L = (long)i * G + c; if (L >= nwg) return false;
        int wgid = (int)L; { const int q = nwg / NXCD, r = nwg % NXCD, xcd = wgid % NXCD, off = wgid / NXCD; wgid = (xcd < r ? xcd * (q + 1) : r * (q + 1) + (xcd - r) * q) + off; }
        const int nig = WGM * nN, gid = wgid / nig, fm = gid * WGM, gsz = (nM - fm) < WGM ? (nM - fm) : WGM;
        u.pm = fm + ((wgid % nig) % gsz); u.pn = (wgid % nig) / gsz; return true;
    }
    __device__ __forceinline__ void a_ready(const Unit&) const {}
    __device__ __forceinline__ void done(const Unit&) const {}
};

__device__ __forceinline__ unsigned cvt_pk_bf16(float lo, float hi) { unsigned r; asm volatile("v_cvt_pk_bf16_f32 %0, %1, %2" : "=v"(r) : "v"(lo), "v"(hi)); return r; }
typedef float f32x2 __attribute__((ext_vector_type(2)));
typedef unsigned u32x2 __attribute__((ext_vector_type(2)));
constexpr int NIN = 1792, DM = 1024, DFF = 4096, NU = 1280, SSQW = 16;
constexpr size_t XCT_LAT_OFF = (size_t)16 * 4 * 128 * 256;
__device__ __forceinline__ int cond_of_panel(int pm) { return pm < 16 ? 0 : (pm < 20 ? 1 : 2); }
__device__ __forceinline__ float row_rstd(const float* ssq, int row) {
    const f32x4* sp = (const f32x4*)(ssq + (size_t)row * SSQW);
    const f32x4 s = (sp[0] + sp[1]) + (sp[2] + sp[3]);
    return 1.0f / sqrtf(((s[0] + s[1]) + (s[2] + s[3])) * (1.0f / 1024.0f) + 1e-6f);
}
struct EpiIn {
    static constexpr bool PERM = true, AFTER_DRAIN = false;
    bf16_t* U; bf16_t* XCT; const float* ssq; const float* bias;
    __device__ __forceinline__ void operator()(const f32x4 (&acc)[2][2][4][2], const Unit& u, int wr, int wc, int fr, int fq) const {
        const int cond = cond_of_panel(u.pm);
        const int bcol0 = u.pn * BM + wc * 32 + 8 * fq;
        f32x4 bv[2][2];
#pragma unroll
        for (int bj = 0; bj < 2; ++bj)
#pragma unroll
            for (int n = 0; n < 2; ++n) bv[bj][n] = *(const f32x4*)(bias + cond * NIN + bcol0 + bj * HALF + 4 * n);
#pragma unroll
        for (int ai = 0; ai < 2; ++ai)
#pragma unroll
            for (int m = 0; m < 4; ++m) {
                const int row = u.pm * BM + ai * HALF + wr * 64 + m * 16 + fr;
                const float rs = row_rstd(ssq, row);
#pragma unroll
                for (int bj = 0; bj < 2; ++bj) {
                    const f32x4 v0 = acc[ai][bj][m][0] * rs + bv[bj][0], v1 = acc[ai][bj][m][1] * rs + bv[bj][1];
                    u32x4 w; w.x = cvt_pk_bf16(v0[0], v0[1]); w.y = cvt_pk_bf16(v0[2], v0[3]); w.z = cvt_pk_bf16(v1[0], v1[1]); w.w = cvt_pk_bf16(v1[2], v1[3]);
                    if (u.pn < 5) { *(u32x4*)(U + (size_t)row * NU + bcol0 + bj * HALF) = w; }
                    else {
                        const int cc = bcol0 + bj * HALF - NU, hd = cc >> 7, mm = cc & 127;
                        bf16_t* p; int ls;
                        if (u.pm < 16) { ls = 256; p = XCT + ((size_t)(u.pm * 4 + hd) * 128 + mm) * 256 + (row & 255); }
                        else { const int rl = row - 4096; ls = 1024; p = XCT + XCT_LAT_OFF + ((size_t)((rl >> 10) * 4 + hd) * 128 + mm) * 1024 + (rl & 1023); }
                        p[0] = (bf16_t)(w.x & 0xffffu); p[ls] = (bf16_t)(w.x >> 16); p[2 * ls] = (bf16_t)(w.y & 0xffffu); p[3 * ls] = (bf16_t)(w.y >> 16);
                        p[4 * ls] = (bf16_t)(w.z & 0xffffu); p[5 * ls] = (bf16_t)(w.z >> 16); p[6 * ls] = (bf16_t)(w.w & 0xffffu); p[7 * ls] = (bf16_t)(w.w >> 16);
                    }
                }
                asm volatile("" ::: "memory");
            }
    }
};
struct EpiUp {
    static constexpr bool PERM = true, AFTER_DRAIN = false;
    bf16_t* H; const float* ssq; const float* bias;
    __device__ __forceinline__ void operator()(const f32x4 (&acc)[2][2][4][2], const Unit& u, int wr, int wc, int fr, int fq) const {
        const int cond = cond_of_panel(u.pm);
        const int bcol0 = u.pn * BM + wc * 32 + 8 * fq;
        f32x4 bv[2][2];
#pragma unroll
        for (int bj = 0; bj < 2; ++bj)
#pragma unroll
            for (int n = 0; n < 2; ++n) bv[bj][n] = *(const f32x4*)(bias + cond * DFF + bcol0 + bj * HALF + 4 * n);
#pragma unroll
        for (int ai = 0; ai < 2; ++ai)
#pragma unroll
            for (int m = 0; m < 4; ++m) {
                const int row = u.pm * BM + ai * HALF + wr * 64 + m * 16 + fr;
                const float rs = row_rstd(ssq, row);
#pragma unroll
                for (int bj = 0; bj < 2; ++bj) {
                    f32x4 v0 = acc[ai][bj][m][0] * rs + bv[bj][0], v1 = acc[ai][bj][m][1] * rs + bv[bj][1];
                    v0 = __builtin_elementwise_max(v0, (f32x4){0.f, 0.f, 0.f, 0.f}); v1 = __builtin_elementwise_max(v1, (f32x4){0.f, 0.f, 0.f, 0.f});
                    v0 = v0 * v0; v1 = v1 * v1;
                    u32x4 w; w.x = cvt_pk_bf16(v0[0], v0[1]); w.y = cvt_pk_bf16(v0[2], v0[3]); w.z = cvt_pk_bf16(v1[0], v1[1]); w.w = cvt_pk_bf16(v1[2], v1[3]);
                    *(u32x4*)(H + (size_t)row * DFF + bcol0 + bj * HALF) = w;
                }
                if (m & 1) asm volatile("" ::: "memory");
            }
    }
};
struct EpiRes {
    static constexpr bool PERM = false, AFTER_DRAIN = false;
    float* X; bf16_t* A; const float* gate; const float* Gn; float* ssq_out;
    __device__ __forceinline__ void operator()(const f32x4 (&acc)[2][2][4][2], const Unit& u, int wr, int wc, int fr, int fq) const {
        const int cond = cond_of_panel(u.pm);
        const int col0 = u.pn * BM + wc * 32 + 4 * fq;
#pragma unroll
        for (int ai = 0; ai < 2; ++ai)
#pragma unroll
            for (int m = 0; m < 4; ++m) {
                const int row = u.pm * BM + ai * HALF + wr * 64 + m * 16 + fr;
                float q = 0.f;
#pragma unroll
                for (int bj = 0; bj < 2; ++bj)
#pragma unroll
                    for (int n = 0; n < 2; ++n) {
                        const int c = col0 + bj * HALF + n * 16;
                        float* xp = X + (size_t)row * DM + c;
                        const f32x4 g4 = *(const f32x4*)(gate + cond * 6144 + c);
                        const f32x4 x1 = *(const f32x4*)xp + g4 * acc[ai][bj][m][n];
                        *(f32x4*)xp = x1;
                        q += (x1[0] * x1[0] + x1[1] * x1[1]) + (x1[2] * x1[2] + x1[3] * x1[3]);
                        if (Gn) { const f32x4 a = x1 * *(const f32x4*)(Gn + cond * DM + c); u32x2 w; w.x = cvt_pk_bf16(a[0], a[1]); w.y = cvt_pk_bf16(a[2], a[3]);
                            *(u32x2*)(A + (size_t)row * DM + c) = w; }
                    }
                q += __shfl_xor(q, 16); q += __shfl_xor(q, 32);
                if (fq == 0) ssq_out[(size_t)row * SSQW + u.pn * 4 + wc] = q;
                if (m & 1) asm volatile("" ::: "memory");
            }
    }
};
template <class Epi, class Sched, bool ALIGN_EPI = false, bool SP2 = false>
__device__ __forceinline__ void gemm_phase(PG8_LAS unsigned char* lds, const Gemm g, const Sched& S, const Epi& E) {
    int tid_ = threadIdx.x; asm volatile("" : "+v"(tid_)); const int tid = tid_, wid = __builtin_amdgcn_readfirstlane(tid >> 6), lane = tid & 63, wr = wid >> 2, wc = wid & 3, fr = lane & 15, fq = lane >> 4;
    const int K = g.K, nt = K / BK;
    unsigned voffA[2], voffB[2];
#pragma unroll
    for (int i = 0; i < 2; ++i) { int R, C; stage_rc(tid * 16 + i * 8192, R, C); const int Rb = Epi::PERM ? ((R & ~31) + perm32(R & 31)) : R;
        voffA[i] = (unsigned)(R * K + C) * 2u; voffB[i] = (unsigned)(Rb * K + C) * 2u; }
    const size_t kstep = (size_t)(BK * 2);
    const size_t hstep = (size_t)HALF * K * 2;
    const size_t tstep = 2 * hstep;
    const unsigned ldsw = (unsigned)wid * 1024u;
    const int aoff = lds_byte(wr * 64 + fr, fq * 8), boff = lds_byte(wc * 32 + fr, fq * 8);
#define PG8_SA(b, h) (((b) * 2 + (h)) * HTB)
#define PG8_SB(b, h) ((4 + (b) * 2 + (h)) * HTB)
#define PG8_STAGE(bufoff, gbase, voff) do { _Pragma("unroll") for (int _i = 0; _i < 2; ++_i) \
        __builtin_amdgcn_global_load_lds((const unsigned*)((const char*)(gbase) + (voff)[_i]), (PG8_LAS unsigned*)(lds + (bufoff) + ldsw + _i * 8192), 16, 0, 0); } while (0)
#define PG8_LDA(dst, b, h) do { _Pragma("unroll") for (int m = 0; m < 4; ++m) _Pragma("unroll") for (int k = 0; k < 2; ++k) dst[m][k] = *(const PG8_LAS bf16x8*)(lds + PG8_SA(b, h) + aoff + m * 2048 + k * 1024); } while (0)
#define PG8_LDB(dst, b, h) do { _Pragma("unroll") for (int n = 0; n < 2; ++n) _Pragma("unroll") for (int k = 0; k < 2; ++k) dst[n][k] = *(const PG8_LAS bf16x8*)(lds + PG8_SB(b, h) + boff + n * 2048 + k * 1024); } while (0)
#define PG8_MMA(ai, bj, At, Bt) do { __builtin_amdgcn_s_setprio(1); _Pragma("unroll") for (int m = 0; m < 4; ++m) _Pragma("unroll") for (int n = 0; n < 2; ++n) _Pragma("unroll") for (int k = 0; k < 2; ++k) \
        acc[ai][bj][m][n] = __builtin_amdgcn_mfma_f32_16x16x32_bf16(Bt[n][k], At[m][k], acc[ai][bj][m][n], 0, 0, 0); __builtin_amdgcn_s_setprio(0); } while (0)
#define PG8_WAIT_V(n) asm volatile("s_waitcnt vmcnt(" #n ")" ::: "memory")
#define PG8_WAIT_L(n) asm volatile("s_waitcnt lgkmcnt(" #n ")" ::: "memory")
#define PG8_BAR __builtin_amdgcn_s_barrier()
#define PG8_SCHED __builtin_amdgcn_sched_barrier(0)
    Unit cur, nxt; int ui = 0;
    if (!S.next(0, cur)) return;
    f32x4 acc[2][2][4][2];
#pragma unroll
    for (int a = 0; a < 2; ++a)
#pragma unroll
        for (int b = 0; b < 2; ++b)
#pragma unroll
            for (int m = 0; m < 4; ++m)
#pragma unroll
                for (int n = 0; n < 2; ++n) acc[a][b][m][n] = (f32x4){0.f, 0.f, 0.f, 0.f};
    bf16x8 At[4][2], B0[2][2], B1[2][2];
    const char* cA = (const char*)g.A + (size_t)cur.pm * tstep; const char* cB = (const char*)g.Bt + (size_t)cur.pn * tstep;
    S.a_ready(cur);
    if constexpr (SP2) {
        PG8_STAGE(PG8_SB(0, 0), cB, voffB); PG8_STAGE(PG8_SB(0, 1), cB + hstep, voffB); PG8_STAGE(PG8_SA(0, 0), cA, voffA); PG8_STAGE(PG8_SA(0, 1), cA + hstep, voffA);
        if (wr == 1) PG8_BAR;
        PG8_WAIT_V(2); PG8_BAR;
        PG8_STAGE(PG8_SB(1, 0), cB + kstep, voffB); PG8_STAGE(PG8_SA(1, 0), cA + kstep, voffA); PG8_STAGE(PG8_SB(1, 1), cB + hstep + kstep, voffB);
        PG8_WAIT_V(6); PG8_BAR;
    } else {
        PG8_STAGE(PG8_SB(0, 0), cB, voffB); PG8_STAGE(PG8_SA(0, 0), cA, voffA); PG8_STAGE(PG8_SB(0, 1), cB + hstep, voffB); PG8_STAGE(PG8_SA(0, 1), cA + hstep, voffA);
        if (wr == 1) PG8_BAR;
        PG8_WAIT_V(4); PG8_BAR;
        PG8_STAGE(PG8_SB(1, 0), cB + kstep, voffB); PG8_STAGE(PG8_SA(1, 0), cA + kstep, voffA); PG8_STAGE(PG8_SB(1, 1), cB + hstep + kstep, voffB);
        PG8_WAIT_V(6); PG8_BAR;
    }
    for (;;) {
        const bool has_next = S.next(ui + 1, nxt);
        const char* nA = has_next ? (const char*)g.A + (size_t)nxt.pm * tstep : cA; const char* nB = has_next ? (const char*)g.Bt + (size_t)nxt.pn * tstep : cB;
        for (int t = 0; t < nt; t += 2) {
            const bool last = (t == nt - 2);
            const char* a1 = cA + (size_t)(t + 1) * kstep;
            const char* a2 = last ? nA : cA + (size_t)(t + 2) * kstep; const char* b2 = last ? nB : cB + (size_t)(t + 2) * kstep;
            const char* a3 = a2 + kstep; const char* b3 = b2 + kstep;
            if (last && has_next) S.a_ready(nxt);
            if constexpr (SP2) {
            PG8_LDB(B0, 0, 0); PG8_LDB(B1, 0, 1); PG8_SCHED; PG8_LDA(At, 0, 0); PG8_STAGE(PG8_SA(1, 1), a1 + hstep, voffA);
            PG8_WAIT_V(8); PG8_WAIT_L(0); PG8_BAR; PG8_MMA(0, 0, At, B0); PG8_MMA(0, 1, At, B1); PG8_BAR; PG8_SCHED;
            PG8_LDA(At, 0, 1); PG8_STAGE(PG8_SB(0, 0), b2, voffB); PG8_STAGE(PG8_SB(0, 1), b2 + hstep, voffB); PG8_STAGE(PG8_SA(0, 0), a2, voffA);
            PG8_WAIT_V(8); PG8_WAIT_L(0); PG8_BAR; PG8_MMA(1, 0, At, B0); PG8_MMA(1, 1, At, B1); PG8_BAR; PG8_SCHED;
            PG8_LDB(B0, 1, 0); PG8_LDB(B1, 1, 1); PG8_SCHED; PG8_LDA(At, 1, 0); PG8_STAGE(PG8_SA(0, 1), a2 + hstep, voffA);
            PG8_WAIT_V(8); PG8_WAIT_L(0); PG8_BAR; PG8_MMA(0, 0, At, B0); PG8_MMA(0, 1, At, B1); PG8_BAR; PG8_SCHED;
            PG8_LDA(At, 1, 1); PG8_STAGE(PG8_SB(1, 0), b3, voffB); PG8_STAGE(PG8_SB(1, 1), b3 + hstep, voffB); PG8_STAGE(PG8_SA(1, 0), a3, voffA);
            PG8_WAIT_V(8); PG8_WAIT_L(0); PG8_BAR; PG8_MMA(1, 0, At, B0); PG8_MMA(1, 1, At, B1); PG8_BAR; PG8_SCHED;
            } else {
            PG8_LDB(B0, 0, 0); PG8_SCHED; PG8_LDA(At, 0, 0); PG8_STAGE(PG8_SA(1, 1), a1 + hstep, voffA);
            PG8_WAIT_L(8); PG8_BAR; PG8_WAIT_L(0); PG8_MMA(0, 0, At, B0); PG8_BAR; PG8_SCHED;
            PG8_LDB(B1, 0, 1); PG8_STAGE(PG8_SB(0, 0), b2, voffB);
            PG8_BAR; PG8_WAIT_L(0); PG8_MMA(0, 1, At, B1); PG8_BAR;
            PG8_LDA(At, 0, 1); PG8_STAGE(PG8_SA(0, 0), a2, voffA);
            PG8_BAR; PG8_WAIT_L(0); PG8_MMA(1, 0, At, B0); PG8_BAR; PG8_SCHED;
            PG8_STAGE(PG8_SB(0, 1), b2 + hstep, voffB);
            PG8_WAIT_V(6); PG8_BAR; PG8_MMA(1, 1, At, B1); PG8_BAR;
            PG8_LDB(B0, 1, 0); PG8_SCHED; PG8_LDA(At, 1, 0); PG8_STAGE(PG8_SA(0, 1), a2 + hstep, voffA);
            PG8_WAIT_L(8); PG8_BAR; PG8_WAIT_L(0); PG8_MMA(0, 0, At, B0); PG8_BAR; PG8_SCHED;
            PG8_LDB(B1, 1, 1); PG8_STAGE(PG8_SB(1, 0), b3, voffB);
            PG8_BAR; PG8_WAIT_L(0); PG8_MMA(0, 1, At, B1); PG8_BAR;
            PG8_LDA(At, 1, 1); PG8_STAGE(PG8_SA(1, 0), a3, voffA);
            PG8_BAR; PG8_WAIT_L(0); PG8_MMA(1, 0, At, B0); PG8_BAR; PG8_SCHED;
            PG8_STAGE(PG8_SB(1, 1), b3 + hstep, voffB);
            PG8_WAIT_V(6); PG8_BAR; PG8_MMA(1, 1, At, B1); PG8_BAR;
            }
        }
        if constexpr (ALIGN_EPI) { if (wr == 0) PG8_BAR; }
        if constexpr (!Epi::AFTER_DRAIN) { E(acc, cur, wr, wc, fr, fq); S.done(cur); }
        if (!has_next) break;
#pragma unroll
        for (int a = 0; a < 2; ++a)
#pragma unroll
            for (int b = 0; b < 2; ++b)
#pragma unroll
                for (int m = 0; m < 4; ++m)
#pragma unroll
                    for (int n = 0; n < 2; ++n) acc[a][b][m][n] = (f32x4){0.f, 0.f, 0.f, 0.f};
        cur = nxt; cA = nA; cB = nB; ++ui;
        if constexpr (ALIGN_EPI) { if (wr == 1) PG8_BAR; }
    }
    PG8_WAIT_V(0);
    if constexpr (!ALIGN_EPI) { if (wr == 0) PG8_BAR; }
    PG8_BAR;
    if constexpr (Epi::AFTER_DRAIN) { E.fused(acc, cur, wr, wc, fr, fq, lds, wid, lane); S.done(cur); }
#undef PG8_SA
#undef PG8_SB
#undef PG8_STAGE
#undef PG8_LDA
#undef PG8_LDB
#undef PG8_MMA
#undef PG8_WAIT_V
#undef PG8_WAIT_L
#undef PG8_BAR
#undef PG8_SCHED
}
}
#define GAS __attribute__((address_space(1)))
#define LAS __attribute__((address_space(3)))
typedef unsigned short bf16;
typedef unsigned v4u __attribute__((ext_vector_type(4)));
typedef unsigned v2u __attribute__((ext_vector_type(2)));
typedef float f32x4 __attribute__((ext_vector_type(4)));
typedef float f32x2 __attribute__((ext_vector_type(2)));
typedef short bf16x8 __attribute__((ext_vector_type(8)));
constexpr int NWAVES = 8, NTHREADS = 512;
constexpr int M_TOK = 6144, M_CTX = 4096, DMODEL = 1024, NINP = 1792, NUC = 1280, FFD = 4096, DEPTHL = 4, DRNN = 512;
constexpr int LDS_BYTES = 147456;
constexpr size_t al256(size_t x) { return (x + 255) & ~(size_t)255; }
constexpr size_t WS_CTL = 0, CTL_BYTES = 1u << 20;
constexpr size_t WS_MODS = WS_CTL + CTL_BYTES;
constexpr size_t WS_GV = WS_MODS + al256((size_t)4 * 3 * 6144 * 4);
constexpr size_t WS_BIASIN = WS_GV + al256((size_t)4 * 2 * 3 * 1024 * 4);
constexpr size_t WS_BIAS1 = WS_BIASIN + al256((size_t)4 * 3 * NINP * 4);
constexpr size_t WS_SSQ = WS_BIAS1 + al256((size_t)4 * 3 * FFD * 4);
constexpr size_t WS_WIN = WS_SSQ + al256((size_t)9 * M_TOK * 16 * 4);
constexpr size_t WS_WOUT = WS_WIN + al256((size_t)4 * NINP * 1024 * 2);
constexpr size_t WS_W1 = WS_WOUT + al256((size_t)4 * 1024 * 1024 * 2);
constexpr size_t WS_W2 = WS_W1 + al256((size_t)4 * FFD * 1024 * 2);
constexpr size_t WS_WG = WS_W2 + al256((size_t)4 * FFD * 1024 * 2);
constexpr size_t WS_T256 = WS_WG + al256((size_t)4 * 8 * 4 * 2 * 32 * 64 * 2);
constexpr size_t WS_T1024 = WS_T256 + al256((size_t)256 * 512 * 2);
constexpr size_t WS_X = WS_T1024 + al256((size_t)1024 * 2048 * 2);
constexpr size_t WS_A = WS_X + al256((size_t)M_TOK * 1024 * 4);
constexpr size_t WS_U = WS_A + al256((size_t)M_TOK * 1024 * 2);
constexpr size_t WS_XCT = WS_U + al256((size_t)M_TOK * NUC * 2);
constexpr size_t WS_CAT = WS_XCT + al256((size_t)M_TOK * 512 * 2);
constexpr size_t WS_HF = WS_CAT + al256((size_t)M_TOK * 1024 * 2);
constexpr size_t WS_PB = WS_HF + al256((size_t)M_TOK * 512 * 4);
constexpr size_t WS_HID = WS_PB + al256((size_t)M_TOK * 512 * 4);
constexpr size_t WS_END = WS_HID + al256((size_t)M_TOK * FFD * 2);
static_assert(WS_END <= ((size_t)256 << 20), "workspace map exceeds 256 MiB");

__device__ __forceinline__ unsigned f2bf(float f) { unsigned u = __builtin_bit_cast(unsigned, f); return (u + 0x7fffu + ((u >> 16) & 1u)) >> 16; }
__device__ __forceinline__ unsigned pk2(float lo, float hi) { return f2bf(lo) | (f2bf(hi) << 16); }
__device__ __forceinline__ float bf2f(unsigned short b) { return __builtin_bit_cast(float, (unsigned)b << 16); }
__device__ __forceinline__ float bflo(unsigned w) { return __builtin_bit_cast(float, w << 16); }
__device__ __forceinline__ float bfhi(unsigned w) { return __builtin_bit_cast(float, w & 0xffff0000u); }
__device__ __forceinline__ float wave_sum(float v) {
#pragma unroll
    for (int o = 1; o < 64; o <<= 1) v += __shfl_xor(v, o);
    return v;
}
__device__ __forceinline__ float rdlane(float v, int l) { return __builtin_bit_cast(float, __builtin_amdgcn_readlane(__builtin_bit_cast(int, v), l)); }

__device__ __forceinline__ int launder_v(int x) { asm volatile("" : "+v"(x)); return x; }
__device__ __forceinline__ int launder_s(int x) { asm volatile("" : "+s"(x)); return x; }
#define CAS __attribute__((address_space(4)))
typedef const float* cfp_t;
struct Params { const float* in[24]; float* out; unsigned char* ws; int ph_lo, ph_hi; };
struct Frame {
    LAS unsigned char* lds;
    int tid, lane, wave, G, bid;
    __device__ __forceinline__ void relaunder() { tid = launder_v((int)threadIdx.x); lane = tid & 63; wave = __builtin_amdgcn_readfirstlane(tid >> 6); bid = launder_s(bid);
        size_t z = 0; asm volatile("" : "+s"(z), "+s"(in)); ws = ws0 + z; out = out0 + z; }
    __device__ __forceinline__ const float* inp(int i) const { return (const float*)(const GAS float*)in[i]; }
    const CAS cfp_t* in; float* out; unsigned char* ws; float* out0; unsigned char* ws0;
};
enum { I_XP = 0, I_XS, I_STATE, I_C, I_CCTX, I_N1G, I_N2G, I_FG, I_WMOD, I_BMOD, I_WIN, I_CONVW, I_CONVB, I_WR, I_BR, I_WI, I_BI, I_LAM, I_POOLW, I_POOLS, I_FW, I_WOUT, I_W1, I_W2 };
#define XB_TMO      128
#define XB_XCNT(j)  (256  + 64 * (j))
#define XB_XSUB(j)  (1280 + 64 * (j))
#define XB_XGEN(j)  (2304 + 64 * (j))
#define XB_TOP      3328
#define XB_TOPGEN   3392
#define XCD_BAR_WORDS 3456
#define XB_SPIN_CAP (1u << 18)

__device__ __forceinline__ unsigned xb_ld(unsigned* p)              { return __hip_atomic_load(p, __ATOMIC_RELAXED, __HIP_MEMORY_SCOPE_AGENT); }
__device__ __forceinline__ unsigned xb_add(unsigned* p, unsigned v) { return __hip_atomic_fetch_add(p, v, __ATOMIC_RELAXED, __HIP_MEMORY_SCOPE_AGENT); }
__device__ __forceinline__ unsigned xb_xcc_id() { return (unsigned)__builtin_amdgcn_s_getreg((3 << 11) | 20) & 0xFu; }
#define XB_SPIN(cond, bar) do { unsigned _sp = 0; while (cond) { __builtin_amdgcn_s_sleep(1); \
    if ((++_sp & 255u) == 0u) { if (xb_ld(&(bar)[XB_TMO])) break; if (_sp > XB_SPIN_CAP) { atomicAdd(&(bar)[XB_TMO], 1u); break; } } } } while (0)

struct XcdBarrier {
    unsigned* bar; unsigned x;
    volatile LAS unsigned* st;
};

__device__ __forceinline__ XcdBarrier xcd_barrier_post(unsigned* bar, volatile LAS unsigned* st) {
    XcdBarrier b; b.bar = bar; b.x = xb_xcc_id(); b.st = st;
    if (threadIdx.x == 0) (void)xb_add(&bar[XB_XCNT(b.x)], 1u);
    return b;
}
__device__ __forceinline__ void xcd_barrier_complete(unsigned* bar, unsigned x, unsigned& nloc, unsigned& nx) {
    const unsigned G = gridDim.x * gridDim.y * gridDim.z;
    unsigned sum, cnt, mine, sp = 0u;
    for (;;) {
        sum = 0u; cnt = 0u; mine = 0u;
#pragma unroll
        for (unsigned j = 0; j < 16; ++j) { const unsigned c = xb_ld(&bar[XB_XCNT(j)]); sum += c; cnt += (c > 0u) ? 1u : 0u; mine = (j == x) ? c : mine; }
        if (sum == G) break;
        __builtin_amdgcn_s_sleep(1);
        if ((++sp & 255u) == 0u) { if (xb_ld(&bar[XB_TMO])) break; if (sp > XB_SPIN_CAP) { atomicAdd(&bar[XB_TMO], 1u); break; } }
    }
    nloc = mine > 0u ? mine : 1u; nx = cnt > 0u ? cnt : 1u;
}

__device__ __forceinline__ void xcd_barrier(const XcdBarrier& b) {
    asm volatile("s_waitcnt vmcnt(0)" ::: "memory");
    __syncthreads();
    if (threadIdx.x == 0) {
        unsigned* bar = b.bar;
        __builtin_amdgcn_s_waitcnt(0);
        unsigned nloc = b.st[0], nx = b.st[1];
        if (nloc == 0u) { xcd_barrier_complete(bar, b.x, nloc, nx); b.st[0] = nloc; b.st[1] = nx; }
        const unsigned old = xb_add(&bar[XB_XSUB(b.x)], 1u);
        const unsigned gen = old / nloc;
        if (old + 1u == (gen + 1u) * nloc) {
            __builtin_amdgcn_fence(__ATOMIC_RELEASE, "agent");
            asm volatile("s_waitcnt vmcnt(0)" ::: "memory");
            const unsigned og = xb_add(&bar[XB_TOP], 1u);
            const unsigned tg = og / nx;
            if (og + 1u == (tg + 1u) * nx) xb_add(&bar[XB_TOPGEN], 1u);
            else XB_SPIN(xb_ld(&bar[XB_TOPGEN]) == tg, bar);
            __builtin_amdgcn_fence(__ATOMIC_ACQUIRE, "agent");
            xb_add(&bar[XB_XGEN(b.x)], 1u);
            asm volatile("s_waitcnt vmcnt(0)" ::: "memory");
        } else {
            XB_SPIN(xb_ld(&bar[XB_XGEN(b.x)]) == gen, bar);
            __builtin_amdgcn_fence(__ATOMIC_ACQUIRE, "agent");
            asm volatile("s_waitcnt vmcnt(0)" ::: "memory");
        }
    }
    __syncthreads();
}
__device__ __forceinline__ void p0a_mods(const Frame& F) {
    LAS float* sl = (LAS float*)F.lds;
    LAS float* red = sl + 3 * 1024;
    const float* c_ctx = F.inp(I_CCTX); const float* cv = F.inp(I_C);
    for (int i = F.tid; i < 3 * 1024; i += NTHREADS) { const int cd = i >> 10, k = i & 1023; const float c = cd == 0 ? c_ctx[k] : cv[(cd - 1) * 1024 + k]; sl[i] = c / (1.0f + expf(-c)); }
    __syncthreads();
    float* mods = (float*)(F.ws + WS_MODS);
    for (int it = F.bid; it < 256; it += F.G) {
        const int l = it >> 6, ch = it & 63;
        const float* W = F.inp(I_WMOD) + (size_t)l * 1024 * 6144 + ch * 96;
        if (F.tid < 504) {
            const int c4 = F.tid % 24, kr = F.tid / 24;
            f32x4 a0 = {0.f, 0.f, 0.f, 0.f}, a1 = a0, a2 = a0;
#pragma unroll 4
            for (int k = kr; k < 1024; k += 21) { const f32x4 w = *(const f32x4*)(W + (size_t)k * 6144 + c4 * 4); a0 += w * sl[k]; a1 += w * sl[1024 + k]; a2 += w * sl[2048 + k]; }
            *(LAS f32x4*)(red + (kr * 3 + 0) * 96 + c4 * 4) = a0; *(LAS f32x4*)(red + (kr * 3 + 1) * 96 + c4 * 4) = a1; *(LAS f32x4*)(red + (kr * 3 + 2) * 96 + c4 * 4) = a2;
        }
        __syncthreads();
        if (F.tid < 288) { const int cd = F.tid / 96, col = F.tid % 96; float s = 0.f;
#pragma unroll
            for (int kr = 0; kr < 21; ++kr) s += red[(kr * 3 + cd) * 96 + col];
            mods[(size_t)(l * 3 + cd) * 6144 + ch * 96 + col] = s + F.inp(I_BMOD)[l * 6144 + ch * 96 + col]; }
        __syncthreads();
    }
}

template <bool BIAS>
__device__ __forceinline__ void strip_item(const float* W, int N, int kb, int ke, int n0, bf16* WT, int ldt, int trow0, const float* sh, float* bias_out, int bstride, LAS float* scr, int lane) {
    float b0 = 0.f, b1 = 0.f, b2 = 0.f;
    const int nn = lane & 31, half = lane >> 5;
    for (int k0 = kb; k0 < ke; k0 += 64) {
#pragma unroll 8
        for (int i = 0; i < 32; ++i) { const int kk = 2 * i + half; scr[kk * 33 + nn] = W[(size_t)(k0 + kk) * N + n0 + nn]; }
        asm volatile("s_waitcnt lgkmcnt(0)" ::: "memory");
        const int c = lane & 7;
#pragma unroll
        for (int j = 0; j < 4; ++j) { const int n = (lane >> 3) + 8 * j; const LAS float* s = scr + (8 * c) * 33 + n;
            v4u o; o.x = pk2(s[0 * 33], s[1 * 33]); o.y = pk2(s[2 * 33], s[3 * 33]); o.z = pk2(s[4 * 33], s[5 * 33]); o.w = pk2(s[6 * 33], s[7 * 33]);
            *(v4u*)(WT + (size_t)(trow0 + n) * ldt + k0 + 8 * c) = o; }
        if (BIAS) {
            const float s0 = sh[k0 + lane], s1 = sh[6144 + k0 + lane], s2 = sh[2 * 6144 + k0 + lane];
#pragma unroll 8
            for (int kk = 0; kk < 32; ++kk) { const float w = scr[(half * 32 + kk) * 33 + nn]; const int src = half * 32 + kk;
                b0 += w * __shfl(s0, src); b1 += w * __shfl(s1, src); b2 += w * __shfl(s2, src); }
        }
        asm volatile("s_waitcnt lgkmcnt(0)" ::: "memory");
    }
    if (BIAS) {
        b0 += __shfl_xor(b0, 32); b1 += __shfl_xor(b1, 32); b2 += __shfl_xor(b2, 32);
        if (lane < 32) { bias_out[n0 + lane] = b0; bias_out[bstride + n0 + lane] = b1; bias_out[2 * bstride + n0 + lane] = b2; }
    }
}
__device__ __forceinline__ float dft64(float tabreg, int c, int mm) { const int m = mm & 63; const int idx = (mm < 64) ? ((c * m) & 63) : ((c * m - 16) & 63); return __shfl(tabreg, idx); }

__device__ __forceinline__ void p0b_prepare(Frame F) {
    const int gw = F.bid * NWAVES + F.wave, NGW = F.G * NWAVES;
    const float tabreg = cospif((float)F.lane * (1.0f / 32.0f)) * 0.125f;
    constexpr int N_FOUT = 1024, N_FIN = 1024, N_POOLF = 256, N_FBIAS = 16, N_W1 = 512, N_W2 = 512, N_WIN = 160, N_WOUTA = 128, N_ROWS = M_TOK;
    constexpr int NITEMS = N_FOUT + N_FIN + N_POOLF + N_FBIAS + N_W1 + N_W2 + N_WIN + N_WOUTA + N_ROWS;
    for (int it = gw; it < NITEMS; it += NGW) {
        int r = it; F.relaunder(); const int lane = F.lane;
        LAS float* scr = (LAS float*)(F.lds + F.wave * 16384);
        const float* mods = (const float*)(F.ws + WS_MODS);
        bf16* WINT = (bf16*)(F.ws + WS_WIN); bf16* WOUTT = (bf16*)(F.ws + WS_WOUT); bf16* W1T = (bf16*)(F.ws + WS_W1); bf16* W2T = (bf16*)(F.ws + WS_W2);
        float* BIASIN = (float*)(F.ws + WS_BIASIN); float* BIAS1 = (float*)(F.ws + WS_BIAS1);

        if (r < N_FOUT) {
            const int l = r >> 8, it16 = (r >> 4) & 15, nb = r & 15, lr = lane & 15, lq = lane >> 4;
            const float* fw = F.inp(I_FW) + (size_t)l * 65536 + (size_t)(it16 * 16 + lr) * 256 + lq;
            const float* wo = F.inp(I_WOUT) + (size_t)l * 1048576 + (size_t)(768 + lq) * 1024 + nb * 64 + lr;
            f32x4 acc[4];
#pragma unroll
            for (int nt = 0; nt < 4; ++nt) acc[nt] = (f32x4){0.f, 0.f, 0.f, 0.f};
#pragma unroll 4
            for (int ks = 0; ks < 64; ++ks) { const float av = fw[4 * ks];
#pragma unroll
                for (int nt = 0; nt < 4; ++nt) acc[nt] = __builtin_amdgcn_mfma_f32_16x16x4f32(av, wo[(size_t)(4 * ks) * 1024 + 16 * nt], acc[nt], 0, 0, 0); }
#pragma unroll
            for (int nt = 0; nt < 4; ++nt) { v2u o; o.x = pk2(acc[nt][0], acc[nt][1]); o.y = pk2(acc[nt][2], acc[nt][3]);
                *(v2u*)(WOUTT + (size_t)l * 1048576 + (size_t)(nb * 64 + 16 * nt + lr) * 1024 + 768 + it16 * 16 + 4 * lq) = o; }
            continue;
        }
        r -= N_FOUT;
        if (r < N_FIN) {
            const int l = r >> 8, hd = (r >> 6) & 3, kt = r & 63, lr = lane & 15, lq = lane >> 4;
            const float* wp = F.inp(I_WIN) + (size_t)l * 1024 * 1536 + (size_t)(kt * 16 + lr) * 1536 + 1280 + 64 * hd + lq;
            f32x4 acc[8];
#pragma unroll
            for (int nt = 0; nt < 8; ++nt) acc[nt] = (f32x4){0.f, 0.f, 0.f, 0.f};
#pragma unroll 2
            for (int ks = 0; ks < 16; ++ks) { const float av = wp[4 * ks]; const int c = 4 * ks + lq;
#pragma unroll
                for (int nt = 0; nt < 8; ++nt) acc[nt] = __builtin_amdgcn_mfma_f32_16x16x4f32(av, dft64(tabreg, c, 16 * nt + lr), acc[nt], 0, 0, 0); }
#pragma unroll
            for (int nt = 0; nt < 8; ++nt) { v2u o; o.x = pk2(acc[nt][0], acc[nt][1]); o.y = pk2(acc[nt][2], acc[nt][3]);
                *(v2u*)(WINT + (size_t)l * NINP * 1024 + (size_t)(1280 + 128 * hd + 16 * nt + lr) * 1024 + kt * 16 + 4 * lq) = o; }
            continue;
        }
        r -= N_FIN;
        if (r < N_POOLF) {
            const int l = r >> 6, g = (r >> 4) & 3, nb = r & 15, lr = lane & 15, lq = lane >> 4;
            const float* pw = F.inp(I_POOLW) + (size_t)(l * 4 + g) * 4096 + lr * 64 + lq;
            const float* ps = F.inp(I_POOLS) + l * 256 + 64 * g + lq;
            const float* wo = F.inp(I_WOUT) + (size_t)l * 1048576 + (size_t)(512 + 64 * g + lq) * 1024 + nb * 64 + lr;
            f32x4 acc[4][4];
#pragma unroll
            for (int mt = 0; mt < 4; ++mt)
#pragma unroll
                for (int nt = 0; nt < 4; ++nt) acc[mt][nt] = (f32x4){0.f, 0.f, 0.f, 0.f};
#pragma unroll 2
            for (int ks = 0; ks < 16; ++ks) { const float sc = ps[4 * ks]; float av[4], bv[4];
#pragma unroll
                for (int mt = 0; mt < 4; ++mt) av[mt] = pw[mt * 1024 + 4 * ks] * sc;
#pragma unroll
                for (int nt = 0; nt < 4; ++nt) bv[nt] = wo[(size_t)(4 * ks) * 1024 + 16 * nt];
#pragma unroll
                for (int mt = 0; mt < 4; ++mt)
#pragma unroll
                    for (int nt = 0; nt < 4; ++nt) acc[mt][nt] = __builtin_amdgcn_mfma_f32_16x16x4f32(av[mt], bv[nt], acc[mt][nt], 0, 0, 0); }
#pragma unroll
            for (int mt = 0; mt < 4; ++mt)
#pragma unroll
                for (int nt = 0; nt < 4; ++nt) { v2u o; o.x = pk2(acc[mt][nt][0], acc[mt][nt][1]); o.y = pk2(acc[mt][nt][2], acc[mt][nt][3]);
                    *(v2u*)(WOUTT + (size_t)l * 1048576 + (size_t)(nb * 64 + 16 * nt + lr) * 1024 + 512 + 64 * g + 16 * mt + 4 * lq) = o; }
            continue;
        }
        r -= N_POOLF;
        if (r < N_FBIAS) {
            const int l = r >> 2, hd = r & 3;
            const float* wp = F.inp(I_WIN) + (size_t)l * 1024 * 1536 + 1280 + 64 * hd + lane;
            const float* sh = mods + (size_t)l * 3 * 6144;
            float b0 = 0.f, b1 = 0.f, b2 = 0.f;
#pragma unroll 8
            for (int k = 0; k < 1024; ++k) { const float w = wp[(size_t)k * 1536]; b0 += w * sh[k]; b1 += w * sh[6144 + k]; b2 += w * sh[2 * 6144 + k]; }
            for (int hf = 0; hf < 2; ++hf) {
                const int mm = hf * 64 + lane; float s0 = 0.f, s1 = 0.f, s2 = 0.f;
#pragma unroll 8
                for (int c = 0; c < 64; ++c) { const int idx = hf == 0 ? ((c * lane) & 63) : ((c * lane - 16) & 63); const float dv = __shfl(tabreg, idx);
                    s0 += __shfl(b0, c) * dv; s1 += __shfl(b1, c) * dv; s2 += __shfl(b2, c) * dv; }
                float* bo = BIASIN + (size_t)l * 3 * NINP + 1280 + 128 * hd + mm;
                bo[0] = s0; bo[NINP] = s1; bo[2 * NINP] = s2;
            }
            continue;
        }
        r -= N_FBIAS;
        if (r < N_W1) {
            const int l = r >> 7, nb = r & 127;
            strip_item<true>(F.inp(I_W1) + (size_t)l * 1024 * 4096, 4096, 0, 1024, nb * 32, W1T + (size_t)l * 4096 * 1024, 1024, nb * 32,
                             mods + (size_t)l * 3 * 6144 + 3 * 1024, BIAS1 + (size_t)l * 3 * FFD, FFD, scr, lane);
            continue;
        }
        r -= N_W1;
        if (r < N_W2) {
            const int l = r >> 7, nb = (r >> 2) & 31, kq = r & 3;
            strip_item<false>(F.inp(I_W2) + (size_t)l * 4096 * 1024, 1024, kq * 1024, kq * 1024 + 1024, nb * 32, W2T + (size_t)l * 1024 * 4096, 4096, nb * 32, nullptr, nullptr, 0, scr, lane);
            continue;
        }
        r -= N_W2;
        if (r < N_WIN) {
            const int l = r / 40, nb = r % 40;
            strip_item<true>(F.inp(I_WIN) + (size_t)l * 1024 * 1536, 1536, 0, 1024, nb * 32, WINT + (size_t)l * NINP * 1024, 1024, nb * 32,
                             mods + (size_t)l * 3 * 6144, BIASIN + (size_t)l * 3 * NINP, NINP, scr, lane);
            continue;
        }
        r -= N_WIN;
        if (r < N_WOUTA) {
            const int l = r >> 5, nb = r & 31;
            strip_item<false>(F.inp(I_WOUT) + (size_t)l * 1048576, 1024, 0, 512, nb * 32, WOUTT + (size_t)l * 1048576, 1024, nb * 32, nullptr, nullptr, 0, scr, lane);
            continue;
        }
        r -= N_WOUTA;
        {
            const int cond = r < M_CTX ? 0 : 1 + ((r - M_CTX) >> 10);
            const float* src = r < M_CTX ? F.inp(I_XP) + (size_t)r * 1024 : F.inp(I_XS) + (size_t)(r - M_CTX) * 1024;
            const f32x4* xr = (const f32x4*)src + lane;
            const f32x4* gp = (const f32x4*)F.inp(I_N1G) + lane;
            const f32x4* sp = (const f32x4*)(mods + (size_t)cond * 6144 + 1024) + lane;
            f32x4 v[4]; float s = 0.f;
#pragma unroll
            for (int j = 0; j < 4; ++j) { v[j] = xr[64 * j]; s += (v[j][0] * v[j][0] + v[j][1] * v[j][1]) + (v[j][2] * v[j][2] + v[j][3] * v[j][3]); }
            s = wave_sum(s);
            f32x4* xo = (f32x4*)((float*)(F.ws + WS_X) + (size_t)r * 1024) + lane;
            v2u* ao = (v2u*)((bf16*)(F.ws + WS_A) + (size_t)r * 1024) + lane;
#pragma unroll
            for (int j = 0; j < 4; ++j) { xo[64 * j] = v[j]; const f32x4 a = v[j] * (gp[64 * j] * (sp[64 * j] + 1.0f));
                v2u w; w.x = pk2(a[0], a[1]); w.y = pk2(a[2], a[3]); ao[64 * j] = w; }
            if (lane < 16) ((float*)(F.ws + WS_SSQ))[(size_t)r * 16 + lane] = lane == 0 ? s : 0.f;
        }
    }
    F.relaunder();
    const float* mods = (const float*)(F.ws + WS_MODS);
    const int gt = F.bid * NTHREADS + F.tid, NGT = F.G * NTHREADS;
    {
        float* GV = (float*)(F.ws + WS_GV);
        for (int i = gt; i < 4 * 2 * 3 * 1024; i += NGT) { const int c = i & 1023, cd = (i >> 10) % 3, w = (i / 3072) & 1, l = i / 6144;
            const float g = (w == 0 ? F.inp(I_N1G) : F.inp(I_N2G))[l * 1024 + c]; GV[i] = g * (1.0f + mods[(size_t)(l * 3 + cd) * 6144 + (w == 0 ? 1 : 4) * 1024 + c]); }
    }
    {
        bf16* WG = (bf16*)(F.ws + WS_WG);
        for (int i = gt; i < 4 * 8 * 4 * 2 * 32 * 64; i += NGT) { const int k = i & 63, n = (i >> 6) & 31, dir = (i >> 11) & 1, q = (i >> 12) & 3, h = (i >> 14) & 7, l = i >> 17;
            const float* src = n < 16 ? F.inp(I_WR) : F.inp(I_WI);
            WG[i] = (bf16)f2bf(src[((size_t)((l * 2 + dir) * 8 + h) * 64 + k) * 64 + 16 * q + (n & 15)]); }
    }
    {
        for (int i = gt; i < (256 * 512 + 1024 * 2048) / 8; i += NGT) {
            int L, e; bf16* T;
            if (i < 256 * 512 / 8) { L = 256; e = i * 8; T = (bf16*)(F.ws + WS_T256); } else { L = 1024; e = (i - 256 * 512 / 8) * 8; T = (bf16*)(F.ws + WS_T1024); }
            const int kpos = e / (2 * L), k2 = e % (2 * L), sn = k2 >= L, l0 = k2 - (sn ? L : 0);
            const float scale = L == 256 ? 0.0625f : 0.03125f, inv = 2.0f / (float)L;
            float v[8];
#pragma unroll
            for (int j = 0; j < 8; ++j) { const int a = (kpos * (l0 + j)) & (L - 1); v[j] = sn ? -sinpif((float)a * inv) * scale : cospif((float)a * inv) * scale; }
            v4u o; o.x = pk2(v[0], v[1]); o.y = pk2(v[2], v[3]); o.z = pk2(v[4], v[5]); o.w = pk2(v[6], v[7]);
            *(v4u*)(T + e) = o;
        }
    }
}
__device__ __forceinline__ float sigmoidf_(float x) { return 1.0f / (1.0f + expf(-x)); }
__device__ __forceinline__ float gelu_tanh(float x) { return 0.5f * x * (1.0f + tanhf(0.7978845608028654f * (x + 0.044715f * x * x * x))); }
__device__ __forceinline__ void seq_geom(int seq, int& L, int& row0) { if (seq < 16) { L = 256; row0 = seq * 256; } else { L = 1024; row0 = M_CTX + (seq - 16) * 1024; } }

__device__ __forceinline__ float fexp(float x) { return __builtin_amdgcn_exp2f(x * 1.4426950408889634f); }
__device__ __forceinline__ float fsigmoid(float x) { return __builtin_amdgcn_rcpf(1.0f + __builtin_amdgcn_exp2f(x * -1.4426950408889634f)); }
__device__ __forceinline__ float fgelu_tanh(float x) { return x * fsigmoid(1.5957691216057308f * (x + 0.044715f * x * x * x)); }
__device__ __forceinline__ float neg_expm1(float y) {
    float p = 1.0f / 720.0f; p = p * y + (1.0f / 120.0f); p = p * y + (1.0f / 24.0f); p = p * y + (1.0f / 6.0f); p = p * y + 0.5f; p = p * y + 1.0f;
    return y < -0.5f ? 1.0f - fexp(y) : -y * p;
}
__device__ __forceinline__ void lru_unit(Frame F, int l, int seq, int h, int q) {
    F.relaunder();
    int L, row0; seq_geom(seq, L, row0);
    const int tid = F.tid, lane = F.lane, wave = F.wave;
    LAS bf16* XR = (LAS bf16*)F.lds;
    LAS bf16* XC = (LAS bf16*)(F.lds + 37440);
    LAS float* AA = (LAS float*)(F.lds + 37440);
    LAS float* BB = (LAS float*)(F.lds + 74304);
    LAS bf16* XG = (LAS bf16*)(F.lds + 107072);
    LAS float* XCF = (LAS float*)(F.lds + 115264);
    LAS float* SEGP = (LAS float*)(F.lds + 131648);
    LAS float* SEGH = SEGP + 512; LAS float* SEGC = SEGP + 1024; LAS float* SEGQ = SEGP + 1536;
    LAS float* CARF = SEGP + 2048;
    LAS float* H0B = CARF + 16;
    LAS float* CHKP = CARF + 32;
    LAS float* CHKH = CARF + 96;
    LAS float* CINB = CARF + 160;
    const bf16* U = (const bf16*)(F.ws + WS_U);
    bf16* CAT = (bf16*)(F.ws + WS_CAT);
    float* HFG = (float*)(F.ws + WS_HF); float* PBG = (float*)(F.ws + WS_PB);
    const int chb = 64 * h + 16 * q;
    const int nch = L >> 8;
    const int cg = tid & 7, j16 = lane & 15, lq = lane >> 4;
    float gbr[2], gbi[2], sp8[2];
#pragma unroll
    for (int d = 0; d < 2; ++d) { gbr[d] = F.inp(I_BR)[(l * 2 + d) * 512 + chb + j16]; gbi[d] = F.inp(I_BI)[(l * 2 + d) * 512 + chb + j16];
        sp8[d] = -8.0f * log1pf(expf(-F.inp(I_LAM)[(l * 2 + d) * 512 + chb + j16])); }
    if (tid < 16) { CARF[tid] = seq < 16 ? 0.f : F.inp(I_STATE)[(((seq - 16) * 4 + l) * 2 + 0) * 512 + chb + tid];
                    H0B[tid] = seq < 16 ? 0.f : F.inp(I_STATE)[(((seq - 16) * 4 + l) * 2 + 1) * 512 + chb + tid]; }
#pragma unroll 1
    for (int c = 0; c < nch; ++c) {
        const int c0 = c * 256; const bool last = c == nch - 1;
        v4u xv[5];
#pragma unroll
        for (int i = 0; i < 5; ++i) { const int id = tid + NTHREADS * i, tr = id >> 3, v = id & 7, t = c0 - 2 + tr; xv[i] = (v4u){0u, 0u, 0u, 0u};
            if (id < 260 * 8 && t >= 0 && t < L) xv[i] = *(const v4u*)(U + (size_t)(row0 + t) * NUC + 64 * h + 8 * v); }
        const v4u gv = *(const v4u*)(U + (size_t)(row0 + c0 + (tid >> 1)) * NUC + 512 + chb + 8 * (tid & 1));
        const int cgo = launder_v(64 * h + 8 * cg);
        f32x4 cwv[4][2], cbv[2];
#pragma unroll
        for (int k = 0; k < 4; ++k) { cwv[k][0] = *(const f32x4*)(F.inp(I_CONVW) + (l * 4 + k) * 512 + cgo); cwv[k][1] = *(const f32x4*)(F.inp(I_CONVW) + (l * 4 + k) * 512 + cgo + 4); }
        cbv[0] = *(const f32x4*)(F.inp(I_CONVB) + l * 512 + cgo); cbv[1] = *(const f32x4*)(F.inp(I_CONVB) + l * 512 + cgo + 4);
        bf16x8 bw[4][2];
        { const bf16* WG = (const bf16*)(F.ws + WS_WG) + (size_t)(((l * 8 + h) * 4 + q) * 2) * 32 * 64 + launder_v(j16 * 64 + 8 * lq);
#pragma unroll
            for (int nt = 0; nt < 4; ++nt)
#pragma unroll
                for (int ks = 0; ks < 2; ++ks) bw[nt][ks] = *(const bf16x8*)(WG + (size_t)(16 * nt) * 64 + 32 * ks); }
#pragma unroll
        for (int i = 0; i < 5; ++i) { const int id = tid + NTHREADS * i; if (id < 260 * 8) *(LAS v4u*)(XR + (id >> 3) * 72 + 8 * (id & 7)) = xv[i]; }
        *(LAS v4u*)(XG + tid * 8) = gv;
        __syncthreads();
#pragma unroll
        for (int i = 0; i < 4; ++i) { const int tl = (tid >> 3) + 64 * i;
            f32x4 o0 = cbv[0], o1 = cbv[1];
#pragma unroll
            for (int k = 0; k < 4; ++k) { const v4u x = *(const LAS v4u*)(XR + (tl + k) * 72 + 8 * cg);
                o0 += (f32x4){bflo(x.x), bfhi(x.x), bflo(x.y), bfhi(x.y)} * cwv[k][0]; o1 += (f32x4){bflo(x.z), bfhi(x.z), bflo(x.w), bfhi(x.w)} * cwv[k][1]; }
            v4u w; w.x = pk2(o0[0], o0[1]); w.y = pk2(o0[2], o0[3]); w.z = pk2(o1[0], o1[1]); w.w = pk2(o1[2], o1[3]);
            *(LAS v4u*)(XC + tl * 72 + 8 * cg) = w;
            if ((cg >> 1) == q) { *(LAS f32x4*)(XCF + tl * 16 + (cg & 1) * 8) = o0; *(LAS f32x4*)(XCF + tl * 16 + (cg & 1) * 8 + 4) = o1; } }
        __syncthreads();
        f32x4 acc[2][4];
#pragma unroll
        for (int mt = 0; mt < 2; ++mt) {
#pragma unroll
            for (int nt = 0; nt < 4; ++nt) acc[mt][nt] = (f32x4){0.f, 0.f, 0.f, 0.f};
#pragma unroll
            for (int ks = 0; ks < 2; ++ks) { const bf16x8 a = *(const LAS bf16x8*)(XC + (32 * wave + 16 * mt + j16) * 72 + 32 * ks + 8 * lq);
#pragma unroll
                for (int nt = 0; nt < 4; ++nt) acc[mt][nt] = __builtin_amdgcn_mfma_f32_16x16x32_bf16(a, bw[nt][ks], acc[mt][nt], 0, 0, 0); }
        }
        __syncthreads();
#pragma unroll
        for (int mt = 0; mt < 2; ++mt)
#pragma unroll
            for (int rg = 0; rg < 4; ++rg) { const int tl = 32 * wave + 16 * mt + 4 * lq + rg;
                const float xc = XCF[tl * 16 + j16];
#pragma unroll
                for (int d = 0; d < 2; ++d) { const float r = fsigmoid(acc[mt][2 * d][rg] + gbr[d]), ig = fsigmoid(acc[mt][2 * d + 1][rg] + gbi[d]);
                    const float la = sp8[d] * r, a = fexp(la), bt = sqrtf(neg_expm1(2.0f * la)) * (ig * xc);
                    AA[d * 4096 + tl * 16 + j16] = a; BB[d * 4096 + tl * 16 + j16] = bt; } }
        __syncthreads();
        { const int d = tid >> 8, sg = (tid >> 4) & 15, j = tid & 15; LAS float* ap = AA + d * 4096 + (16 * sg) * 16 + j; LAS float* bp = BB + d * 4096 + (16 * sg) * 16 + j;
            float av[16], bv[16];
#pragma unroll
            for (int i = 0; i < 16; ++i) { av[i] = ap[i * 16]; bv[i] = bp[i * 16]; }
            float P = 1.f, Hl = 0.f;
            if (d == 0) {
#pragma unroll
                for (int i = 0; i < 16; ++i) { Hl = av[i] * Hl + bv[i]; P *= av[i]; av[i] = P; bv[i] = Hl; }
            } else {
#pragma unroll
                for (int i = 15; i >= 0; --i) { Hl = av[i] * Hl + bv[i]; P *= av[i]; av[i] = P; bv[i] = Hl; }
            }
#pragma unroll
            for (int i = 0; i < 16; ++i) { ap[i * 16] = av[i]; bp[i * 16] = bv[i]; }
            SEGP[d * 256 + sg * 16 + j] = P; SEGH[d * 256 + sg * 16 + j] = Hl; }
        __syncthreads();
        if ((tid & 255) < 16) { const int d = tid >> 8, j = tid & 15;
            float pv[16], hv[16];
#pragma unroll
            for (int s = 0; s < 16; ++s) { pv[s] = SEGP[d * 256 + s * 16 + j]; hv[s] = SEGH[d * 256 + s * 16 + j]; }
            if (d == 0) { float cv = CARF[j];
#pragma unroll
                for (int s = 0; s < 16; ++s) { const float t = cv; cv = pv[s] * cv + hv[s]; hv[s] = t; }
                CARF[j] = cv;
#pragma unroll
                for (int s = 0; s < 16; ++s) SEGC[s * 16 + j] = hv[s];
            } else { float cv = last ? H0B[j] : 0.f, qv = 1.f;
#pragma unroll
                for (int s = 15; s >= 0; --s) { const float t = cv, tq = qv; cv = pv[s] * cv + hv[s]; qv *= pv[s]; hv[s] = t; pv[s] = tq; }
                CHKP[c * 16 + j] = qv; CHKH[c * 16 + j] = cv;
#pragma unroll
                for (int s = 0; s < 16; ++s) { SEGC[256 + s * 16 + j] = hv[s]; SEGQ[256 + s * 16 + j] = pv[s]; }
            } }
        __syncthreads();
        { const int tl = tid >> 1, hf8 = 8 * (tid & 1), sg = tl >> 4; const size_t row = (size_t)(row0 + c0 + tl);
            float hs[8], pb[8];
#pragma unroll
            for (int e4 = 0; e4 < 2; ++e4) { const int o = tl * 16 + hf8 + 4 * e4, so = sg * 16 + hf8 + 4 * e4;
                const f32x4 af = *(const LAS f32x4*)(AA + o), bf = *(const LAS f32x4*)(BB + o), ab = *(const LAS f32x4*)(AA + 4096 + o), bb = *(const LAS f32x4*)(BB + 4096 + o);
                const f32x4 cf = *(const LAS f32x4*)(SEGC + so), cbk = *(const LAS f32x4*)(SEGC + 256 + so), qb = *(const LAS f32x4*)(SEGQ + 256 + so);
                const f32x4 s = (bf + af * cf) + (bb + ab * cbk), pq = ab * qb;
#pragma unroll
                for (int e = 0; e < 4; ++e) { hs[4 * e4 + e] = s[e]; pb[4 * e4 + e] = pq[e]; } }
            if (last) { const v4u g = *(const LAS v4u*)(XG + tid * 8);
                v4u o; o.x = pk2(hs[0] * fgelu_tanh(bflo(g.x)), hs[1] * fgelu_tanh(bfhi(g.x))); o.y = pk2(hs[2] * fgelu_tanh(bflo(g.y)), hs[3] * fgelu_tanh(bfhi(g.y)));
                o.z = pk2(hs[4] * fgelu_tanh(bflo(g.z)), hs[5] * fgelu_tanh(bfhi(g.z))); o.w = pk2(hs[6] * fgelu_tanh(bflo(g.w)), hs[7] * fgelu_tanh(bfhi(g.w)));
                *(v4u*)(CAT + row * DMODEL + chb + hf8) = o; }
            else { f32x4* sp = (f32x4*)(HFG + row * DRNN + chb + hf8); f32x4* pp = (f32x4*)(PBG + row * DRNN + chb + hf8);
                sp[0] = (f32x4){hs[0], hs[1], hs[2], hs[3]}; sp[1] = (f32x4){hs[4], hs[5], hs[6], hs[7]};
                pp[0] = (f32x4){pb[0], pb[1], pb[2], pb[3]}; pp[1] = (f32x4){pb[4], pb[5], pb[6], pb[7]}; } }
        __syncthreads();
    }
    if (nch > 1) {
        if (tid < 16) { float cv = CHKH[(nch - 1) * 16 + tid];
            for (int c = nch - 2; c >= 0; --c) { CINB[c * 16 + tid] = cv; cv = CHKP[c * 16 + tid] * cv + CHKH[c * 16 + tid]; } }
        __syncthreads();
#pragma unroll
        for (int i = 0; i < 3; ++i) if (i < nch - 1) { const int tk = (tid >> 1) + 256 * i, hf8 = 8 * (tid & 1); const size_t row = (size_t)(row0 + tk);
            const f32x4* sp = (const f32x4*)(HFG + row * DRNN + chb + hf8); const f32x4* pp = (const f32x4*)(PBG + row * DRNN + chb + hf8);
            const f32x4 s0 = sp[0], s1 = sp[1], p0 = pp[0], p1 = pp[1];
            const v4u g = *(const v4u*)(U + row * NUC + 512 + chb + hf8);
            const f32x4 c0v = *(const LAS f32x4*)(CINB + i * 16 + hf8), c1v = *(const LAS f32x4*)(CINB + i * 16 + hf8 + 4);
            const f32x4 h0 = s0 + p0 * c0v, h1 = s1 + p1 * c1v;
            v4u o; o.x = pk2(h0[0] * fgelu_tanh(bflo(g.x)), h0[1] * fgelu_tanh(bfhi(g.x))); o.y = pk2(h0[2] * fgelu_tanh(bflo(g.y)), h0[3] * fgelu_tanh(bfhi(g.y)));
            o.z = pk2(h1[0] * fgelu_tanh(bflo(g.z)), h1[1] * fgelu_tanh(bfhi(g.z))); o.w = pk2(h1[2] * fgelu_tanh(bflo(g.w)), h1[3] * fgelu_tanh(bfhi(g.w)));
            *(v4u*)(CAT + row * DMODEL + chb + hf8) = o; }
    } else if (tid < 32) {
        const int d = tid >> 4, j = tid & 15;
        F.out[(size_t)M_TOK * DMODEL + (size_t)((seq * 4 + l) * 2 + d) * 512 + chb + j] = d == 0 ? CARF[j] : CHKH[j];
    }
    __syncthreads();
}

__device__ __forceinline__ void pool1d_unit(Frame F, int seq, int tb) {
    F.relaunder();
    const bf16* U = (const bf16*)(F.ws + WS_U); bf16* CAT = (bf16*)(F.ws + WS_CAT);
    const int row0 = seq * 256;
#pragma unroll 1
    for (int i = 0; i < 4; ++i) { const int id = F.tid + NTHREADS * i, t = tb * 64 + (id >> 5), v = id & 31, g = v >> 3, hw = 1 << g;
        const int lo = max(t - hw, 0), hi = min(t + hw, 256);
        v4u x[16];
#pragma unroll
        for (int k = 0; k < 16; ++k) { const int tt = t - 8 + k; x[k] = (v4u){0u, 0u, 0u, 0u}; if (tt >= lo && tt < hi) x[k] = *(const v4u*)(U + (size_t)(row0 + tt) * NUC + 1024 + 8 * v); }
        float s[8];
#pragma unroll
        for (int c = 0; c < 8; ++c) s[c] = 0.f;
#pragma unroll
        for (int k = 0; k < 16; ++k) { s[0] += bflo(x[k].x); s[1] += bfhi(x[k].x); s[2] += bflo(x[k].y); s[3] += bfhi(x[k].y); s[4] += bflo(x[k].z); s[5] += bfhi(x[k].z); s[6] += bflo(x[k].w); s[7] += bfhi(x[k].w); }
        const float inv = 1.0f / (float)(hi - lo);
        const v4u xs = x[8];
        v4u o; o.x = pk2(s[0] * inv - bflo(xs.x), s[1] * inv - bfhi(xs.x)); o.y = pk2(s[2] * inv - bflo(xs.y), s[3] * inv - bfhi(xs.y));
        o.z = pk2(s[4] * inv - bflo(xs.z), s[5] * inv - bfhi(xs.z)); o.w = pk2(s[6] * inv - bflo(xs.w), s[7] * inv - bfhi(xs.w));
        *(v4u*)(CAT + (size_t)(row0 + t) * DMODEL + 512 + 8 * v) = o; }
}
__device__ __forceinline__ void pool2d_unit(Frame F, int b, int g, int oc) {
    F.relaunder();
    const bf16* U = (const bf16*)(F.ws + WS_U); bf16* CAT = (bf16*)(F.ws + WS_CAT);
    LAS float* T1 = (LAS float*)F.lds;
    LAS float* T2 = (LAS float*)(F.lds + 32768);
    const int row0 = M_CTX + b * 1024, colb = 64 * g + 8 * oc, hw = 1 << g;
#pragma unroll
    for (int i = 0; i < 2; ++i) { const int t = F.tid + NTHREADS * i;
        const v4u x = *(const v4u*)(U + (size_t)(row0 + t) * NUC + 1024 + colb);
        *(LAS f32x4*)(T1 + t * 8) = (f32x4){bflo(x.x), bfhi(x.x), bflo(x.y), bfhi(x.y)}; *(LAS f32x4*)(T1 + t * 8 + 4) = (f32x4){bflo(x.z), bfhi(x.z), bflo(x.w), bfhi(x.w)}; }
    __syncthreads();
    const int j4 = 4 * (F.tid & 1), tq = F.tid >> 1;
#pragma unroll
    for (int i = 0; i < 4; ++i) { const int t = tq + 256 * i, r = t >> 6, c = t & 63, lo = max(c - hw, 0), hi = min(c + hw, 64);
        f32x4 s = {0.f, 0.f, 0.f, 0.f};
        for (int c2 = lo; c2 < hi; ++c2) s += *(const LAS f32x4*)(T1 + (r * 64 + c2) * 8 + j4);
        *(LAS f32x4*)(T2 + t * 8 + j4) = s * (1.0f / (float)(hi - lo)); }
    __syncthreads();
#pragma unroll
    for (int i = 0; i < 4; ++i) { const int t = tq + 256 * i, r = t >> 6, c = t & 63, lo = max(r - hw, 0), hi = min(r + hw, 16);
        f32x4 s = {0.f, 0.f, 0.f, 0.f};
        for (int r2 = lo; r2 < hi; ++r2) s += *(const LAS f32x4*)(T2 + (r2 * 64 + c) * 8 + j4);
        const f32x4 o = s * (1.0f / (float)(hi - lo)) - *(const LAS f32x4*)(T1 + t * 8 + j4);
        v2u w; w.x = pk2(o[0], o[1]); w.y = pk2(o[2], o[3]);
        *(v2u*)(CAT + (size_t)(row0 + t) * DMODEL + 512 + colb + j4) = w; }
    __syncthreads();
}
__device__ __forceinline__ void fourier_unit(Frame F, int seq, int hd, int nb) {
    F.relaunder();
    int L, row0; seq_geom(seq, L, row0);
    const int lane = F.lane, wave = F.wave, j16 = lane & 15, kq = 8 * (lane >> 4);
    const bf16* XCT = (const bf16*)(F.ws + WS_XCT) + (seq < 16 ? (size_t)(seq * 4 + hd) * 128 * 256 : pg8::XCT_LAT_OFF + (size_t)((seq - 16) * 4 + hd) * 128 * 1024);
    const bf16* T = seq < 16 ? (const bf16*)(F.ws + WS_T256) : (const bf16*)(F.ws + WS_T1024);
    const int K2 = 2 * L, kw = K2 / 8, kbeg = wave * kw;
    const int part = kbeg >= L;
    const bf16* Ab = XCT + (size_t)(part * 64) * L + (kbeg - part * L);
    const bf16* Bb = T + (size_t)(nb * 64) * K2 + kbeg;
    f32x4 acc[4][4];
#pragma unroll
    for (int mt = 0; mt < 4; ++mt)
#pragma unroll
        for (int nt = 0; nt < 4; ++nt) acc[mt][nt] = (f32x4){0.f, 0.f, 0.f, 0.f};
    for (int ks = 0; ks < kw; ks += 32) {
        bf16x8 a[4], b[4];
#pragma unroll
        for (int mt = 0; mt < 4; ++mt) a[mt] = *(const bf16x8*)(Ab + (size_t)(16 * mt + j16) * L + ks + kq);
#pragma unroll
        for (int nt = 0; nt < 4; ++nt) b[nt] = *(const bf16x8*)(Bb + (size_t)(16 * nt + j16) * K2 + ks + kq);
#pragma unroll
        for (int mt = 0; mt < 4; ++mt)
#pragma unroll
            for (int nt = 0; nt < 4; ++nt) acc[mt][nt] = __builtin_amdgcn_mfma_f32_16x16x32_bf16(a[mt], b[nt], acc[mt][nt], 0, 0, 0);
    }
    LAS float* red = (LAS float*)F.lds;
#pragma unroll
    for (int mt = 0; mt < 4; ++mt)
#pragma unroll
        for (int nt = 0; nt < 4; ++nt) *(LAS f32x4*)(red + (size_t)(wave * 64 + 16 * nt + j16) * 68 + 16 * mt + 4 * (lane >> 4)) = acc[mt][nt];
    __syncthreads();
    { const int kp = F.tid >> 3, mg = F.tid & 7;
        f32x4 s0 = {0.f, 0.f, 0.f, 0.f}, s1 = s0;
#pragma unroll
        for (int w = 0; w < 8; ++w) { const LAS f32x4* p = (const LAS f32x4*)(red + (size_t)(w * 64 + kp) * 68 + 8 * mg); s0 += p[0]; s1 += p[1]; }
        v4u o; o.x = pk2(s0[0], s0[1]); o.y = pk2(s0[2], s0[3]); o.z = pk2(s1[0], s1[1]); o.w = pk2(s1[2], s1[3]);
        *(v4u*)((bf16*)(F.ws + WS_CAT) + (size_t)(row0 + nb * 64 + kp) * DMODEL + 768 + 64 * hd + 8 * mg) = o; }
    __syncthreads();
}
#ifndef REP_LRU
#define REP_LRU 1
#endif
#ifndef REP_FOU
#define REP_FOU 1
#endif
#ifndef REP_POOL
#define REP_POOL 1
#endif
__device__ __forceinline__ void mixer_phase(const Frame& F, int l) {
    constexpr int N_LRU_LAT = 64, N_FOU_LAT = 128, N_P2D = 64, N_LRU_CTX = 512, N_FOU_CTX = 256, N_P1D = 64;
    constexpr int NREST = N_FOU_LAT + N_P2D + N_LRU_CTX + N_FOU_CTX + N_P1D;
    const int nlat = F.G >= 128 ? 64 : F.G / 4;
    if (F.bid < nlat) {
        for (int r = F.bid; r < N_LRU_LAT; r += nlat) {
#ifndef SKIP_LRU
            for (int rp = 0; rp < REP_LRU; ++rp) lru_unit(F, l, 16 + (r >> 5), (r >> 2) & 7, r & 3);
#endif
        }
        return;
    }
    for (int it = F.bid - nlat; it < NREST; it += F.G - nlat) {
        int r = it;
        if (r < N_P2D) {
#ifndef SKIP_POOL
            for (int rp = 0; rp < REP_POOL; ++rp) pool2d_unit(F, r >> 5, (r >> 3) & 3, r & 7);
#endif
            continue; } r -= N_P2D;
        if (r < N_FOU_LAT) {
#ifndef SKIP_FOU
            for (int rp = 0; rp < REP_FOU; ++rp) fourier_unit(F, 16 + (r >> 6), (r >> 4) & 3, r & 15);
#endif
            continue; } r -= N_FOU_LAT;
        if (r < N_LRU_CTX) {
#ifndef SKIP_LRU
            for (int rp = 0; rp < REP_LRU; ++rp) lru_unit(F, l, r >> 5, (r >> 2) & 7, r & 3);
#endif
            continue; } r -= N_LRU_CTX;
        if (r < N_FOU_CTX) {
#ifndef SKIP_FOU
            for (int rp = 0; rp < REP_FOU; ++rp) fourier_unit(F, r >> 4, (r >> 2) & 3, r & 3);
#endif
            continue; } r -= N_FOU_CTX;
#ifndef SKIP_POOL
        for (int rp = 0; rp < REP_POOL; ++rp) pool1d_unit(F, r >> 2, r & 3);
#endif
    }
}
#ifndef MK_PER_PHASE
#define MK_PER_PHASE 0
#endif
#ifndef MK_BARRIER
#define MK_BARRIER 1
#endif
#ifndef REP_P0
#define REP_P0 1
#endif
#ifndef REP_MIX
#define REP_MIX 1
#endif
#ifndef REP_G1
#define REP_G1 1
#endif
#ifndef REP_G3
#define REP_G3 1
#endif
constexpr int N_PHASES = 2 + 5 * DEPTHL + 1;
constexpr int CW_BAR = 4096;
__device__ __forceinline__ void final_norm(const Frame& F) {
    const int gw = F.bid * NWAVES + F.wave, NGW = F.G * NWAVES;
    const float* X = (const float*)(F.ws + WS_X); const float* ssq = (const float*)(F.ws + WS_SSQ) + (size_t)8 * M_TOK * 16;
    const f32x4* gp = (const f32x4*)F.inp(I_FG) + F.lane;
    for (int r = gw; r < M_TOK; r += NGW) {
        const float rs = pg8::row_rstd(ssq, r);
        const f32x4* xr = (const f32x4*)(X + (size_t)r * 1024) + F.lane; f32x4* o = (f32x4*)(F.out + (size_t)r * 1024) + F.lane;
#pragma unroll
        for (int j = 0; j < 4; ++j) o[64 * j] = xr[64 * j] * rs * gp[64 * j];
    }
}
__global__ void __launch_bounds__(NTHREADS, 2) mega(Params p) {
    extern __shared__ __attribute__((aligned(16))) unsigned char lds[];
    Frame F;
    F.lds = (LAS unsigned char*)lds; F.tid = threadIdx.x; F.lane = F.tid & 63; F.wave = __builtin_amdgcn_readfirstlane(F.tid >> 6);
    F.G = gridDim.x; F.bid = blockIdx.x; F.in = (const CAS cfp_t*)__builtin_amdgcn_kernarg_segment_ptr(); F.out0 = p.out; F.ws0 = p.ws; F.out = p.out; F.ws = p.ws;
#if MK_BARRIER
    volatile LAS unsigned* bst = (volatile LAS unsigned*)(F.lds + LDS_BYTES - 64);
    if (F.tid < 2) bst[F.tid] = 0u;
    __syncthreads();
    XcdBarrier bar = xcd_barrier_post((unsigned*)(p.ws + WS_CTL) + CW_BAR, bst);
#else
    cg::grid_group grid = cg::this_grid();
#endif
    for (int ph = p.ph_lo; ph < p.ph_hi; ++ph) {
        F.relaunder();
        bf16* A = (bf16*)(F.ws + WS_A); bf16* CAT = (bf16*)(F.ws + WS_CAT); bf16* HID = (bf16*)(F.ws + WS_HID); bf16* U = (bf16*)(F.ws + WS_U); bf16* XCT = (bf16*)(F.ws + WS_XCT);
        float* X = (float*)(F.ws + WS_X); float* SSQ = (float*)(F.ws + WS_SSQ); const float* MODS = (const float*)(F.ws + WS_MODS); const float* GV = (const float*)(F.ws + WS_GV);
        if (ph == 0) {
#ifndef SKIP_P0A
 for (int rep = 0; rep < REP_P0; ++rep) p0a_mods(F);
#endif
 }
        else if (ph == 1) {
#ifndef SKIP_P0B
 for (int rep = 0; rep < REP_P0; ++rep) p0b_prepare(F);
#endif
 }
        else if (ph == N_PHASES - 1) final_norm(F);
        else {
            const int l = (ph - 2) / 5, k = (ph - 2) % 5;
            if (k == 0) {
                pg8::Gemm g{A, (const bf16*)(F.ws + WS_WIN) + (size_t)l * NINP * 1024, M_TOK, NINP, 1024}; pg8::StaticOrder S; S.init(M_TOK, NINP, F.G, F.bid);
                pg8::EpiIn E{U, XCT, SSQ + (size_t)(2 * l) * M_TOK * 16, (const float*)(F.ws + WS_BIASIN) + (size_t)l * 3 * NINP};
#ifndef SKIP_G1
                for (int rep = 0; rep < REP_G1; ++rep) pg8::gemm_phase<pg8::EpiIn, pg8::StaticOrder, true, true>(F.lds, g, S, E);
#endif
            } else if (k == 1) {
#ifndef SKIP_MIX
                for (int rep = 0; rep < REP_MIX; ++rep) mixer_phase(F, l);
#endif
            } else if (k == 2 || k == 4) {
                const bool dn = k == 4;
                pg8::Gemm g{dn ? HID : CAT, dn ? (const bf16*)(F.ws + WS_W2) + (size_t)l * FFD * 1024 : (const bf16*)(F.ws + WS_WOUT) + (size_t)l * 1024 * 1024, M_TOK, 1024, dn ? FFD : 1024};
                pg8::StaticOrder S; S.init(M_TOK, 1024, F.G, F.bid);
                const float* Gn = dn ? (l < DEPTHL - 1 ? GV + (size_t)((l + 1) * 2 * 3) * 1024 : nullptr) : GV + (size_t)((l * 2 + 1) * 3) * 1024;
                const int inst = dn ? (l < DEPTHL - 1 ? 2 * (l + 1) : 8) : 2 * l + 1;
                pg8::EpiRes E{X, A, MODS + (size_t)l * 3 * 6144 + (dn ? 5 : 2) * 1024, Gn, SSQ + (size_t)inst * M_TOK * 16};
#ifndef SKIP_G24
                pg8::gemm_phase<pg8::EpiRes, pg8::StaticOrder, true, true>(F.lds, g, S, E);
#endif
            } else {
                pg8::Gemm g{A, (const bf16*)(F.ws + WS_W1) + (size_t)l * FFD * 1024, M_TOK, FFD, 1024}; pg8::StaticOrder S; S.init(M_TOK, FFD, F.G, F.bid);
                pg8::EpiUp E{HID, SSQ + (size_t)(2 * l + 1) * M_TOK * 16, (const float*)(F.ws + WS_BIAS1) + (size_t)l * 3 * FFD};
#ifndef SKIP_G3
                for (int rep = 0; rep < REP_G3; ++rep) pg8::gemm_phase<pg8::EpiUp, pg8::StaticOrder, true, true>(F.lds, g, S, E);
#endif
            }
        }
#if MK_BARRIER
        if (ph + 1 < p.ph_hi) xcd_barrier(bar);
#else
        if (ph + 1 < p.ph_hi) grid.sync();
#endif
    }
}

extern "C" void kernel_launch(void* const* d_in, const int* in_sizes, int n_in, void* d_out, int out_size, void* d_ws, size_t ws_size, hipStream_t stream) {
    static int grid = 0;
    if (grid == 0) {
        if (n_in != 24 || ws_size < WS_END) { fprintf(stderr, "kernel_launch: expected 24 inputs and >= %zu bytes of workspace (got %d, %zu)\n", (size_t)WS_END, n_in, ws_size); grid = -1; return; }
        int dev = 0, cus = 0, per_cu = 0;
        if (hipGetDevice(&dev) != hipSuccess || hipDeviceGetAttribute(&cus, hipDeviceAttributeMultiprocessorCount, dev) != hipSuccess) { grid = -1; return; }
        if (hipFuncSetAttribute((const void*)mega, hipFuncAttributeMaxDynamicSharedMemorySize, LDS_BYTES) != hipSuccess) { fprintf(stderr, "kernel_launch: hipFuncSetAttribute failed\n"); grid = -1; return; }
        if (hipOccupancyMaxActiveBlocksPerMultiprocessor(&per_cu, (const void*)mega, NTHREADS, LDS_BYTES) != hipSuccess || per_cu < 1) { fprintf(stderr, "kernel_launch: occupancy query says %d blocks per CU\n", per_cu); grid = -1; return; }
        grid = cus;
    }
    if (grid < 0) return;
    Params p{};
    for (int i = 0; i < 24; ++i) p.in[i] = (const float*)d_in[i];
    p.out = (float*)d_out; p.ws = (unsigned char*)d_ws;
    hipMemsetAsync((char*)d_ws + WS_CTL, 0, CTL_BYTES, stream);
#if MK_PER_PHASE
    for (int ph = 0; ph < N_PHASES; ++ph) { p.ph_lo = ph; p.ph_hi = ph + 1; hipLaunchKernelGGL(mega, dim3(grid), dim3(NTHREADS), LDS_BYTES, stream, p); }
#else
    p.ph_lo = 0; p.ph_hi = N_PHASES;
    void* args[] = {&p};
    hipError_t e = hipLaunchCooperativeKernel((const void*)mega, dim3(grid), dim3(NTHREADS), args, LDS_BYTES, stream);
    if (e != hipSuccess) fprintf(stderr, "kernel_launch: cooperative launch failed: %s (grid %d)\n", hipGetErrorString(e), grid);
#endif
}
```

```cpp
#include <hip/hip_runtime.h>
#include <hip/hip_cooperative_groups.h>
#include <cstdio>
#include <cstdint>
namespace cg = cooperative_groups;
#define MK_PER_PHASE 0
namespace pg8 {
#define PG8_LAS __attribute__((address_space(3)))
typedef unsigned short bf16_t;
typedef short bf16x8 __attribute__((ext_vector_type(8)));
typedef float f32x4 __attribute__((ext_vector_type(4)));
typedef unsigned u32x4 __attribute__((ext_vector_type(4)));
constexpr int BM = 256, BK = 64, HALF = 128, HTB = HALF * BK * 2  , STAGE_BYTES = 8 * HTB, NXCD = 8, WGM = 8;

__host__ __device__ __forceinline__ int lds_byte(int r, int c) { const int st = (r >> 4) * 2 + (c >> 5), rr = r & 15, cc = c & 31, ob = rr * 64 + cc * 2; return st * 1024 + (ob ^ (((ob >> 9) & 1) << 5)); }
__host__ __device__ __forceinline__ void stage_rc(int b, int& R, int& C) { const int st = b / 1024, sb = b % 1024, swz = sb ^ (((sb >> 9) & 1) << 5); R = (st >> 1) * 16 + swz / 64; C = (st & 1) * 32 + (swz % 64) / 2; }
__host__ __device__ __forceinline__ int perm32(int rho) { const int n = rho >> 4, i = rho & 15; return 8 * (i >> 2) + 4 * n + (i & 3); }

struct Unit { int pm, pn; };
struct Gemm { const bf16_t* A; const bf16_t* Bt; int M, N, K; };

struct StaticOrder {
    int nM, nN, nwg, G, c;
    __host__ __device__ void init(int M, int N, int G_, int c_) { nM = M / BM; nN = N / BM; nwg = nM * nN; G = G_; c = c_; }
    __host__ __device__ bool next(int i, Unit& u) const {
        const long L = (long)i * G + c; if (L >= nwg) return false;
        int wgid = (int)L; { const int q = nwg / NXCD, r = nwg % NXCD, xcd = wgid % NXCD, off = wgid / NXCD; wgid = (xcd < r ? xcd * (q + 1) : r * (q + 1) + (xcd - r) * q) + off; }
        const int nig = WGM * nN, gid = wgid / nig, fm = gid * WGM, gsz = (nM - fm) < WGM ? (nM - fm) : WGM;
        u.pm = fm + ((wgid % nig) % gsz); u.pn = (wgid % nig) / gsz; return true;
    }
    __device__ __forceinline__ void a_ready(const Unit&) const {}
    __device__ __forceinline__ void done(const Unit&) const {}
};

__device__ __forceinline__ unsigned cvt_pk_bf16(float lo, float hi) { unsigned r; asm volatile("v_cvt_pk_bf16_f32 %0, %1, %2" : "=v"(r) : "v"(lo), "v"(hi)); return r; }
typedef float f32x2 __attribute__((ext_vector_type(2)));
typedef unsigned u32x2 __attribute__((ext_vector_type(2)));
constexpr int NIN = 1792, DM = 1024, DFF = 4096, NU = 1280, SSQW = 16;
constexpr size_t XCT_LAT_OFF = (size_t)16 * 4 * 128 * 256;
__device__ __forceinline__ int cond_of_panel(int pm) { return pm < 16 ? 0 : (pm < 20 ? 1 : 2); }
__device__ __forceinline__ float row_rstd(const float* ssq, int row) {
    const f32x4* sp = (const f32x4*)(ssq + (size_t)row * SSQW);
    const f32x4 s = (sp[0] + sp[1]) + (sp[2] + sp[3]);
    return 1.0f / sqrtf(((s[0] + s[1]) + (s[2] + s[3])) * (1.0f / 1024.0f) + 1e-6f);
}
struct EpiIn {
    static constexpr bool PERM = true, AFTER_DRAIN = false;
    bf16_t* U; bf16_t* XCT; const float* ssq; const float* bias;
    __device__ __forceinline__ void operator()(const f32x4 (&acc)[2][2][4][2], const Unit& u, int wr, int wc, int fr, int fq) const {
        const int cond = cond_of_panel(u.pm);
        const int bcol0 = u.pn * BM + wc * 32 + 8 * fq;
        f32x4 bv[2][2];
#pragma unroll
        for (int bj = 0; bj < 2; ++bj)
#pragma unroll
            for (int n = 0; n < 2; ++n) bv[bj][n] = *(const f32x4*)(bias + cond * NIN + bcol0 + bj * HALF + 4 * n);
#pragma unroll
        for (int ai = 0; ai < 2; ++ai)
#pragma unroll
            for (int m = 0; m < 4; ++m) {
                const int row = u.pm * BM + ai * HALF + wr * 64 + m * 16 + fr;
                const float rs = row_rstd(ssq, row);
#pragma unroll
                for (int bj = 0; bj < 2; ++bj) {
                    const f32x4 v0 = acc[ai][bj][m][0] * rs + bv[bj][0], v1 = acc[ai][bj][m][1] * rs + bv[bj][1];
                    u32x4 w; w.x = cvt_pk_bf16(v0[0], v0[1]); w.y = cvt_pk_bf16(v0[2], v0[3]); w.z = cvt_pk_bf16(v1[0], v1[1]); w.w = cvt_pk_bf16(v1[2], v1[3]);
                    if (u.pn < 5) { *(u32x4*)(U + (size_t)row * NU + bcol0 + bj * HALF) = w; }
                    else {
                        const int cc = bcol0 + bj * HALF - NU, hd = cc >> 7, mm = cc & 127;
                        bf16_t* p; int ls;
                        if (u.pm < 16) { ls = 256; p = XCT + ((size_t)(u.pm * 4 + hd) * 128 + mm) * 256 + (row & 255); }
                        else { const int rl = row - 4096; ls = 1024; p = XCT + XCT_LAT_OFF + ((size_t)((rl >> 10) * 4 + hd) * 128 + mm) * 1024 + (rl & 1023); }
                        p[0] = (bf16_t)(w.x & 0xffffu); p[ls] = (bf16_t)(w.x >> 16); p[2 * ls] = (bf16_t)(w.y & 0xffffu); p[3 * ls] = (bf16_t)(w.y >> 16);
                        p[4 * ls] = (bf16_t)(w.z & 0xffffu); p[5 * ls] = (bf16_t)(w.z >> 16); p[6 * ls] = (bf16_t)(w.w & 0xffffu); p[7 * ls] = (bf16_t)(w.w >> 16);
                    }
                }
                asm volatile("" ::: "memory");
            }
    }
};
struct EpiUp {
    static constexpr bool PERM = true, AFTER_DRAIN = false;
    bf16_t* H; const float* ssq; const float* bias;
    __device__ __forceinline__ void operator()(const f32x4 (&acc)[2][2][4][2], const Unit& u, int wr, int wc, int fr, int fq) const {
        const int cond = cond_of_panel(u.pm);
        const int bcol0 = u.pn * BM + wc * 32 + 8 * fq;
        f32x4 bv[2][2];
#pragma unroll
        for (int bj = 0; bj < 2; ++bj)
#pragma unroll
            for (int n = 0; n < 2; ++n) bv[bj][n] = *(const f32x4*)(bias + cond * DFF + bcol0 + bj * HALF + 4 * n);
#pragma unroll
        for (int ai = 0; ai < 2; ++ai)
#pragma unroll
            for (int m = 0; m < 4; ++m) {
                const int row = u.pm * BM + ai * HALF + wr * 64 + m * 16 + fr;
                const float rs = row_rstd(ssq, row);
#pragma unroll
                for (int bj = 0; bj < 2; ++bj) {
                    f32x4 v0 = acc[ai][bj][m][0] * rs + bv[bj][0], v1 = acc[ai][bj][m][1] * rs + bv[bj][1];
                    v0 = __builtin_elementwise_max(v0, (f32x4){0.f, 0.f, 0.f, 0.f}); v1 = __builtin_elementwise_max(v1, (f32x4){0.f, 0.f, 0.f, 0.f});
                    v0 = v0 * v0; v1 = v1 * v1;
                    u32x4 w; w.x = cvt_pk_bf16(v0[0], v0[1]); w.y = cvt_pk_bf16(v0[2], v0[3]); w.z = cvt_pk_bf16(v1[0], v1[1]); w.w = cvt_pk_bf16(v1[2], v1[3]);
                    *(u32x4*)(H + (size_t)row * DFF + bcol0 + bj * HALF) = w;
                }
                if (m & 1) asm volatile("" ::: "memory");
            }
    }
};
struct EpiRes {
    static constexpr bool PERM = false, AFTER_DRAIN = false;
    float* X; bf16_t* A; const float* gate; const float* Gn; float* ssq_out;
    __device__ __forceinline__ void operator()(const f32x4 (&acc)[2][2][4][2], const Unit& u, int wr, int wc, int fr, int fq) const {
        const int cond = cond_of_panel(u.pm);
        const int col0 = u.pn * BM + wc * 32 + 4 * fq;
#pragma unroll
        for (int ai = 0; ai < 2; ++ai)
#pragma unroll
            for (int m = 0; m < 4; ++m) {
                const int row = u.pm * BM + ai * HALF + wr * 64 + m * 16 + fr;
                float q = 0.f;
#pragma unroll
                for (int bj = 0; bj < 2; ++bj)
#pragma unroll
                    for (int n = 0; n < 2; ++n) {
                        const int c = col0 + bj * HALF + n * 16;
                        float* xp = X + (size_t)row * DM + c;
                        const f32x4 g4 = *(const f32x4*)(gate + cond * 6144 + c);
                        const f32x4 x1 = *(const f32x4*)xp + g4 * acc[ai][bj][m][n];
                        *(f32x4*)xp = x1;
                        q += (x1[0] * x1[0] + x1[1] * x1[1]) + (x1[2] * x1[2] + x1[3] * x1[3]);
                        if (Gn) { const f32x4 a = x1 * *(const f32x4*)(Gn + cond * DM + c); u32x2 w; w.x = cvt_pk_bf16(a[0], a[1]); w.y = cvt_pk_bf16(a[2], a[3]);
                            *(u32x2*)(A + (size_t)row * DM + c) = w; }
                    }
                q += __shfl_xor(q, 16); q += __shfl_xor(q, 32);
                if (fq == 0) ssq_out[(size_t)row * SSQW + u.pn * 4 + wc] = q;
                if (m & 1) asm volatile("" ::: "memory");
            }
    }
};
template <class Epi, class Sched, bool ALIGN_EPI = false, bool SP2 = false>
__device__ __forceinline__ void gemm_phase(PG8_LAS unsigned char* lds, const Gemm g, const Sched& S, const Epi& E) {
    int tid_ = threadIdx.x; asm volatile("" : "+v"(tid_)); const int tid = tid_, wid = __builtin_amdgcn_readfirstlane(tid >> 6), lane = tid & 63, wr = wid >> 2, wc = wid & 3, fr = lane & 15, fq = lane >> 4;
    const int K = g.K, nt = K / BK;
    unsigned voffA[2], voffB[2];
#pragma unroll
    for (int i = 0; i < 2; ++i) { int R, C; stage_rc(tid * 16 + i * 8192, R, C); const int Rb = Epi::PERM ? ((R & ~31) + perm32(R & 31)) : R;
        voffA[i] = (unsigned)(R * K + C) * 2u; voffB[i] = (unsigned)(Rb * K + C) * 2u; }
    const size_t kstep = (size_t)(BK * 2);
    const size_t hstep = (size_t)HALF * K * 2;
    const size_t tstep = 2 * hstep;
    const unsigned ldsw = (unsigned)wid * 1024u;
    const int aoff = lds_byte(wr * 64 + fr, fq * 8), boff = lds_byte(wc * 32 + fr, fq * 8);
#define PG8_SA(b, h) (((b) * 2 + (h)) * HTB)
#define PG8_SB(b, h) ((4 + (b) * 2 + (h)) * HTB)
#define PG8_STAGE(bufoff, gbase, voff) do { _Pragma("unroll") for (int _i = 0; _i < 2; ++_i) \
        __builtin_amdgcn_global_load_lds((const unsigned*)((const char*)(gbase) + (voff)[_i]), (PG8_LAS unsigned*)(lds + (bufoff) + ldsw + _i * 8192), 16, 0, 0); } while (0)
#define PG8_LDA(dst, b, h) do { _Pragma("unroll") for (int m = 0; m < 4; ++m) _Pragma("unroll") for (int k = 0; k < 2; ++k) dst[m][k] = *(const PG8_LAS bf16x8*)(lds + PG8_SA(b, h) + aoff + m * 2048 + k * 1024); } while (0)
#define PG8_LDB(dst, b, h) do { _Pragma("unroll") for (int n = 0; n < 2; ++n) _Pragma("unroll") for (int k = 0; k < 2; ++k) dst[n][k] = *(const PG8_LAS bf16x8*)(lds + PG8_SB(b, h) + boff + n * 2048 + k * 1024); } while (0)
#define PG8_MMA(ai, bj, At, Bt) do { __builtin_amdgcn_s_setprio(1); _Pragma("unroll") for (int m = 0; m < 4; ++m) _Pragma("unroll") for (int n = 0; n < 2; ++n) _Pragma("unroll") for (int k = 0; k < 2; ++k) \
        acc[ai][bj][m][n] = __builtin_amdgcn_mfma_f32_16x16x32_bf16(Bt[n][k], At[m][k], acc[ai][bj][m][n], 0, 0, 0); __builtin_amdgcn_s_setprio(0); } while (0)
#define PG8_WAIT_V(n) asm volatile("s_waitcnt vmcnt(" #n ")" ::: "memory")
#define PG8_WAIT_L(n) asm volatile("s_waitcnt lgkmcnt(" #n ")" ::: "memory")
#define PG8_BAR __builtin_amdgcn_s_barrier()
#define PG8_SCHED __builtin_amdgcn_sched_barrier(0)
    Unit cur, nxt; int ui = 0;
    if (!S.next(0, cur)) return;
    f32x4 acc[2][2][4][2];
#pragma unroll
    for (int a = 0; a < 2; ++a)
#pragma unroll
        for (int b = 0; b < 2; ++b)
#pragma unroll
            for (int m = 0; m < 4; ++m)
#pragma unroll
                for (int n = 0; n < 2; ++n) acc[a][b][m][n] = (f32x4){0.f, 0.f, 0.f, 0.f};
    bf16x8 At[4][2], B0[2][2], B1[2][2];
    const char* cA = (const char*)g.A + (size_t)cur.pm * tstep; const char* cB = (const char*)g.Bt + (size_t)cur.pn * tstep;
    S.a_ready(cur);
    if constexpr (SP2) {
        PG8_STAGE(PG8_SB(0, 0), cB, voffB); PG8_STAGE(PG8_SB(0, 1), cB + hstep, voffB); PG8_STAGE(PG8_SA(0, 0), cA, voffA); PG8_STAGE(PG8_SA(0, 1), cA + hstep, voffA);
        if (wr == 1) PG8_BAR;
        PG8_WAIT_V(2); PG8_BAR;
        PG8_STAGE(PG8_SB(1, 0), cB + kstep, voffB); PG8_STAGE(PG8_SA(1, 0), cA + kstep, voffA); PG8_STAGE(PG8_SB(1, 1), cB + hstep + kstep, voffB);
        PG8_WAIT_V(6); PG8_BAR;
    } else {
        PG8_STAGE(PG8_SB(0, 0), cB, voffB); PG8_STAGE(PG8_SA(0, 0), cA, voffA); PG8_STAGE(PG8_SB(0, 1), cB + hstep, voffB); PG8_STAGE(PG8_SA(0, 1), cA + hstep, voffA);
        if (wr == 1) PG8_BAR;
        PG8_WAIT_V(4); PG8_BAR;
        PG8_STAGE(PG8_SB(1, 0), cB + kstep, voffB); PG8_STAGE(PG8_SA(1, 0), cA + kstep, voffA); PG8_STAGE(PG8_SB(1, 1), cB + hstep + kstep, voffB);
        PG8_WAIT_V(6); PG8_BAR;
    }
    for (;;) {
        const bool has_next = S.next(ui + 1, nxt);
        const char* nA = has_next ? (const char*)g.A + (size_t)nxt.pm * tstep : cA; const char* nB = has_next ? (const char*)g.Bt + (size_t)nxt.pn * tstep : cB;
        for (int t = 0; t < nt; t += 2) {
            const bool last = (t == nt - 2);
            const char* a1 = cA + (size_t)(t + 1) * kstep;
            const char* a2 = last ? nA : cA + (size_t)(t + 2) * kstep; const char* b2 = last ? nB : cB + (size_t)(t + 2) * kstep;
            const char* a3 = a2 + kstep; const char* b3 = b2 + kstep;
            if (last && has_next) S.a_ready(nxt);
            if constexpr (SP2) {
            PG8_LDB(B0, 0, 0); PG8_LDB(B1, 0, 1); PG8_SCHED; PG8_LDA(At, 0, 0); PG8_STAGE(PG8_SA(1, 1), a1 + hstep, voffA);
            PG8_WAIT_V(8); PG8_WAIT_L(0); PG8_BAR; PG8_MMA(0, 0, At, B0); PG8_MMA(0, 1, At, B1); PG8_BAR; PG8_SCHED;
            PG8_LDA(At, 0, 1); PG8_STAGE(PG8_SB(0, 0), b2, voffB); PG8_STAGE(PG8_SB(0, 1), b2 + hstep, voffB); PG8_STAGE(PG8_SA(0, 0), a2, voffA);
            PG8_WAIT_V(8); PG8_WAIT_L(0); PG8_BAR; PG8_MMA(1, 0, At, B0); PG8_MMA(1, 1, At, B1); PG8_BAR; PG8_SCHED;
            PG8_LDB(B0, 1, 0); PG8_LDB(B1, 1, 1); PG8_SCHED; PG8_LDA(At, 1, 0); PG8_STAGE(PG8_SA(0, 1), a2 + hstep, voffA);
            PG8_WAIT_V(8); PG8_WAIT_L(0); PG8_BAR; PG8_MMA(0, 0, At, B0); PG8_MMA(0, 1, At, B1); PG8_BAR; PG8_SCHED;
            PG8_LDA(At, 1, 1); PG8_STAGE(PG8_SB(1, 0), b3, voffB); PG8_STAGE(PG8_SB(1, 1), b3 + hstep, voffB); PG8_STAGE(PG8_SA(1, 0), a3, voffA);
            PG8_WAIT_V(8); PG8_WAIT_L(0); PG8_BAR; PG8_MMA(1, 0, At, B0); PG8_MMA(1, 1, At, B1); PG8_BAR; PG8_SCHED;
            } else {
            PG8_LDB(B0, 0, 0); PG8_SCHED; PG8_LDA(At, 0, 0); PG8_STAGE(PG8_SA(1, 1), a1 + hstep, voffA);
            PG8_WAIT_L(8); PG8_BAR; PG8_WAIT_L(0); PG8_MMA(0, 0, At, B0); PG8_BAR; PG8_SCHED;
            PG8_LDB(B1, 0, 1); PG8_STAGE(PG8_SB(0, 0), b2, voffB);
            PG8_BAR; PG8_WAIT_L(0); PG8_MMA(0, 1, At, B1); PG8_BAR;
            PG8_LDA(At, 0, 1); PG8_STAGE(PG8_SA(0, 0), a2, voffA);
            PG8_BAR; PG8_WAIT_L(0); PG8_MMA(1, 0, At, B0); PG8_BAR; PG8_SCHED;
            PG8_STAGE(PG8_SB(0, 1), b2 + hstep, voffB);
            PG8_WAIT_V(6); PG8_BAR; PG8_MMA(1, 1, At, B1); PG8_BAR;
            PG8_LDB(B0, 1, 0); PG8_SCHED; PG8_LDA(At, 1, 0); PG8_STAGE(PG8_SA(0, 1), a2 + hstep, voffA);
            PG8_WAIT_L(8); PG8_BAR; PG8_WAIT_L(0); PG8_MMA(0, 0, At, B0); PG8_BAR; PG8_SCHED;
            PG8_LDB(B1, 1, 1); PG8_STAGE(PG8_SB(1, 0), b3, voffB);
            PG8_BAR; PG8_WAIT_L(0); PG8_MMA(0, 1, At, B1); PG8_BAR;
            PG8_LDA(At, 1, 1); PG8_STAGE(PG8_SA(1, 0), a3, voffA);
            PG8_BAR; PG8_WAIT_L(0); PG8_MMA(1, 0, At, B0); PG8_BAR; PG8_SCHED;
            PG8_STAGE(PG8_SB(1, 1), b3 + hstep, voffB);
            PG8_WAIT_V(6); PG8_BAR; PG8_MMA(1, 1, At, B1); PG8_BAR;
            }
        }
        if constexpr (ALIGN_EPI) { if (wr == 0) PG8_BAR; }
        if constexpr (!Epi::AFTER_DRAIN) { E(acc, cur, wr, wc, fr, fq); S.done(cur); }
        if (!has_next) break;
#pragma unroll
        for (int a = 0; a < 2; ++a)
#pragma unroll
            for (int b = 0; b < 2; ++b)
#pragma unroll
                for (int m = 0; m < 4; ++m)
#pragma unroll
                    for (int n = 0; n < 2; ++n) acc[a][b][m][n] = (f32x4){0.f, 0.f, 0.f, 0.f};
        cur = nxt; cA = nA; cB = nB; ++ui;
        if constexpr (ALIGN_EPI) { if (wr == 1) PG8_BAR; }
    }
    PG8_WAIT_V(0);
    if constexpr (!ALIGN_EPI) { if (wr == 0) PG8_BAR; }
    PG8_BAR;
    if constexpr (Epi::AFTER_DRAIN) { E.fused(acc, cur, wr, wc, fr, fq, lds, wid, lane); S.done(cur); }
#undef PG8_SA
#undef PG8_SB
#undef PG8_STAGE
#undef PG8_LDA
#undef PG8_LDB
#undef PG8_MMA
#undef PG8_WAIT_V
#undef PG8_WAIT_L
#undef PG8_BAR
#undef PG8_SCHED
}
struct StaticOrder128 {
    int nM, nN, nwg, G, c;
    __host__ __device__ void init(int M, int N, int G_, int c_) { nM = M / BM; nN = N / HALF; nwg = nM * nN; G = G_; c = c_; }
    __host__ __device__ bool next(int i, Unit& u) const {
        const long L = (long)i * G + c; if (L >= nwg) return false;
        int wgid = (int)L; { const int q = nwg / NXCD, r = nwg % NXCD, xcd = wgid % NXCD, off = wgid / NXCD; wgid = (xcd < r ? xcd * (q + 1) : r * (q + 1) + (xcd - r) * q) + off; }
        const int nig = WGM * nN, gid = wgid / nig, fm = gid * WGM, gsz = (nM - fm) < WGM ? (nM - fm) : WGM;
        u.pm = fm + ((wgid % nig) % gsz); u.pn = (wgid % nig) / gsz; return true;
    }
    __device__ __forceinline__ void a_ready(const Unit&) const {}
    __device__ __forceinline__ void done(const Unit&) const {}
};
template <class Epi, class Sched>
__device__ __forceinline__ void gemm_phase_n128(PG8_LAS unsigned char* lds, const Gemm g, const Sched& S, const Epi& E) {
    int tid_ = threadIdx.x; asm volatile("" : "+v"(tid_));
    const int tid = tid_, wid = __builtin_amdgcn_readfirstlane(tid >> 6), lane = tid & 63, wh = wid >> 2, wr = wid >> 1, wc = wid & 1, fr = lane & 15, fq = lane >> 4;
    const int K = g.K, nt = K / BK;
    unsigned voffA[2], voffB[2];
#pragma unroll
    for (int i = 0; i < 2; ++i) { int R, C; stage_rc(tid * 16 + i * 8192, R, C); const int Rb = Epi::PERM ? ((R & ~31) + perm32(R & 31)) : R;
        voffA[i] = (unsigned)(R * K + C) * 2u; voffB[i] = (unsigned)(Rb * K + C) * 2u; }
    const size_t kstep = (size_t)(BK * 2);
    const size_t hstep = (size_t)HALF * K * 2;
    const size_t tstep = 2 * hstep;
    const unsigned ldsw = (unsigned)wid * 1024u;
    const int aoff = lds_byte(wr * 32 + fr, fq * 8), boff = lds_byte(wc * 64 + fr, fq * 8);
#define PG8_SA(b, h) (((b) * 2 + (h)) * HTB)
#define PG8_SB(b) ((4 + (b) * 2) * HTB)
#define PG8_STAGE(bufoff, gbase, voff) do { _Pragma("unroll") for (int _i = 0; _i < 2; ++_i) \
        __builtin_amdgcn_global_load_lds((const unsigned*)((const char*)(gbase) + (voff)[_i]), (PG8_LAS unsigned*)(lds + (bufoff) + ldsw + _i * 8192), 16, 0, 0); } while (0)
#define PG8_LDA(dst, b, h) do { _Pragma("unroll") for (int m = 0; m < 2; ++m) _Pragma("unroll") for (int k = 0; k < 2; ++k) dst[m][k] = *(const PG8_LAS bf16x8*)(lds + PG8_SA(b, h) + aoff + m * 2048 + k * 1024); } while (0)
#define PG8_LDB(dst, b) do { _Pragma("unroll") for (int n = 0; n < 4; ++n) _Pragma("unroll") for (int k = 0; k < 2; ++k) dst[n][k] = *(const PG8_LAS bf16x8*)(lds + PG8_SB(b) + boff + n * 2048 + k * 1024); } while (0)
#define PG8_MMA(ai, At, Bt) do { __builtin_amdgcn_s_setprio(1); _Pragma("unroll") for (int m = 0; m < 2; ++m) _Pragma("unroll") for (int n = 0; n < 4; ++n) _Pragma("unroll") for (int k = 0; k < 2; ++k) \
        acc[ai][m][n] = __builtin_amdgcn_mfma_f32_16x16x32_bf16(Bt[n][k], At[m][k], acc[ai][m][n], 0, 0, 0); __builtin_amdgcn_s_setprio(0); } while (0)
#define PG8_WAIT_V(n) asm volatile("s_waitcnt vmcnt(" #n ")" ::: "memory")
#define PG8_WAIT_L(n) asm volatile("s_waitcnt lgkmcnt(" #n ")" ::: "memory")
#define PG8_BAR __builtin_amdgcn_s_barrier()
#define PG8_SCHED __builtin_amdgcn_sched_barrier(0)
    Unit cur, nxt; int ui = 0;
    if (!S.next(0, cur)) return;
    f32x4 acc[2][2][4];
#pragma unroll
    for (int a = 0; a < 2; ++a)
#pragma unroll
        for (int m = 0; m < 2; ++m)
#pragma unroll
            for (int n = 0; n < 4; ++n) acc[a][m][n] = (f32x4){0.f, 0.f, 0.f, 0.f};
    bf16x8 At[2][2], Bf[4][2];
    const char* cA = (const char*)g.A + (size_t)cur.pm * tstep; const char* cB = (const char*)g.Bt + (size_t)cur.pn * hstep;
    S.a_ready(cur);
    PG8_STAGE(PG8_SB(0), cB, voffB); PG8_STAGE(PG8_SA(0, 0), cA, voffA); PG8_STAGE(PG8_SA(0, 1), cA + hstep, voffA);
    if (wh == 1) PG8_BAR;
    PG8_WAIT_V(2); PG8_BAR;
    PG8_STAGE(PG8_SB(1), cB + kstep, voffB); PG8_STAGE(PG8_SA(1, 0), cA + kstep, voffA);
    PG8_WAIT_V(4); PG8_BAR;
    for (;;) {
        const bool has_next = S.next(ui + 1, nxt);
        const char* nA = has_next ? (const char*)g.A + (size_t)nxt.pm * tstep : cA; const char* nB = has_next ? (const char*)g.Bt + (size_t)nxt.pn * hstep : cB;
        for (int t = 0; t < nt; t += 2) {
            const bool last = (t == nt - 2);
            const char* a1 = cA + (size_t)(t + 1) * kstep;
            const char* a2 = last ? nA : cA + (size_t)(t + 2) * kstep; const char* b2 = last ? nB : cB + (size_t)(t + 2) * kstep;
            const char* a3 = a2 + kstep; const char* b3 = b2 + kstep;
            if (last && has_next) S.a_ready(nxt);
            PG8_LDB(Bf, 0); PG8_SCHED; PG8_LDA(At, 0, 0); PG8_STAGE(PG8_SA(1, 1), a1 + hstep, voffA);
            PG8_WAIT_V(6); PG8_WAIT_L(0); PG8_BAR; PG8_MMA(0, At, Bf); PG8_BAR; PG8_SCHED;
            PG8_LDA(At, 0, 1); PG8_STAGE(PG8_SB(0), b2, voffB); PG8_STAGE(PG8_SA(0, 0), a2, voffA);
            PG8_WAIT_V(6); PG8_WAIT_L(0); PG8_BAR; PG8_MMA(1, At, Bf); PG8_BAR; PG8_SCHED;
            PG8_LDB(Bf, 1); PG8_SCHED; PG8_LDA(At, 1, 0); PG8_STAGE(PG8_SA(0, 1), a2 + hstep, voffA);
            PG8_WAIT_V(6); PG8_WAIT_L(0); PG8_BAR; PG8_MMA(0, At, Bf); PG8_BAR; PG8_SCHED;
            PG8_LDA(At, 1, 1); PG8_STAGE(PG8_SB(1), b3, voffB); PG8_STAGE(PG8_SA(1, 0), a3, voffA);
            PG8_WAIT_V(6); PG8_WAIT_L(0); PG8_BAR; PG8_MMA(1, At, Bf); PG8_BAR; PG8_SCHED;
        }
        if (wh == 0) PG8_BAR;
        E(acc, cur, wr, wc, fr, fq); S.done(cur);
        if (!has_next) break;
#pragma unroll
        for (int a = 0; a < 2; ++a)
#pragma unroll
            for (int m = 0; m < 2; ++m)
#pragma unroll
                for (int n = 0; n < 4; ++n) acc[a][m][n] = (f32x4){0.f, 0.f, 0.f, 0.f};
        cur = nxt; cA = nA; cB = nB; ++ui;
        if (wh == 1) PG8_BAR;
    }
    PG8_WAIT_V(0);
    PG8_BAR;
#undef PG8_SA
#undef PG8_SB
#undef PG8_STAGE
#undef PG8_LDA
#undef PG8_LDB
#undef PG8_MMA
#undef PG8_WAIT_V
#undef PG8_WAIT_L
#undef PG8_BAR
#undef PG8_SCHED
}
struct EpiUp128 {
    static constexpr bool PERM = true;
    bf16_t* H; const float* ssq; const float* bias;
    __device__ __forceinline__ void operator()(const f32x4 (&acc)[2][2][4], const Unit& u, int wr, int wc, int fr, int fq) const {
        const int cond = cond_of_panel(u.pm);
        const int bcol0 = u.pn * HALF + wc * 64 + 8 * fq;
        f32x4 bv[2][2];
#pragma unroll
        for (int g2 = 0; g2 < 2; ++g2)
#pragma unroll
            for (int n = 0; n < 2; ++n) bv[g2][n] = *(const f32x4*)(bias + cond * DFF + bcol0 + 32 * g2 + 4 * n);
#pragma unroll
        for (int ai = 0; ai < 2; ++ai)
#pragma unroll
            for (int m = 0; m < 2; ++m) {
                const int row = u.pm * BM + ai * HALF + wr * 32 + m * 16 + fr;
                const float rs = row_rstd(ssq, row);
#pragma unroll
                for (int g2 = 0; g2 < 2; ++g2) {
                    f32x4 v0 = acc[ai][m][2 * g2] * rs + bv[g2][0], v1 = acc[ai][m][2 * g2 + 1] * rs + bv[g2][1];
                    v0 = __builtin_elementwise_max(v0, (f32x4){0.f, 0.f, 0.f, 0.f}); v1 = __builtin_elementwise_max(v1, (f32x4){0.f, 0.f, 0.f, 0.f});
                    v0 = v0 * v0; v1 = v1 * v1;
                    u32x4 w; w.x = cvt_pk_bf16(v0[0], v0[1]); w.y = cvt_pk_bf16(v0[2], v0[3]); w.z = cvt_pk_bf16(v1[0], v1[1]); w.w = cvt_pk_bf16(v1[2], v1[3]);
                    *(u32x4*)(H + (size_t)row * DFF + bcol0 + 32 * g2) = w;
                }
                asm volatile("" ::: "memory");
            }
    }
};
struct EpiRes128 {
    static constexpr bool PERM = false;
    float* X; bf16_t* A; const float* gate; const float* Gn; float* ssq_out;
    __device__ __forceinline__ void operator()(const f32x4 (&acc)[2][2][4], const Unit& u, int wr, int wc, int fr, int fq) const {
        const int cond = cond_of_panel(u.pm);
        const int col0 = u.pn * HALF + wc * 64 + 4 * fq;
#pragma unroll
        for (int ai = 0; ai < 2; ++ai)
#pragma unroll
            for (int m = 0; m < 2; ++m) {
                const int row = u.pm * BM + ai * HALF + wr * 32 + m * 16 + fr;
                float q = 0.f;
#pragma unroll
                for (int n = 0; n < 4; ++n) {
                    const int c = col0 + n * 16;
                    float* xp = X + (size_t)row * DM + c;
                    const f32x4 g4 = *(const f32x4*)(gate + cond * 6144 + c);
                    const f32x4 x1 = *(const f32x4*)xp + g4 * acc[ai][m][n];
                    *(f32x4*)xp = x1;
                    q += (x1[0] * x1[0] + x1[1] * x1[1]) + (x1[2] * x1[2] + x1[3] * x1[3]);
                    if (Gn) { const f32x4 a = x1 * *(const f32x4*)(Gn + cond * DM + c); u32x2 w; w.x = cvt_pk_bf16(a[0], a[1]); w.y = cvt_pk_bf16(a[2], a[3]);
                        *(u32x2*)(A + (size_t)row * DM + c) = w; }
                }
                q += __shfl_xor(q, 16); q += __shfl_xor(q, 32);
                if (fq == 0) ssq_out[(size_t)row * SSQW + u.pn * 2 + wc] = q;
                asm volatile("" ::: "memory");
            }
    }
};
struct StaticOrder192 {
    int nM, nN, nwg, G, c;
    __host__ __device__ void init(int M, int N, int G_, int c_) { nM = M / 192; nN = N / HALF; nwg = nM * nN; G = G_; c = c_; }
    __host__ __device__ bool next(int i, Unit& u) const {
        const long L = (long)i * G + c; if (L >= nwg) return false;
        int wgid = (int)L; { const int q = nwg / NXCD, r = nwg % NXCD, xcd = wgid % NXCD, off = wgid / NXCD; wgid = (xcd < r ? xcd * (q + 1) : r * (q + 1) + (xcd - r) * q) + off; }
        const int nig = WGM * nN, gid = wgid / nig, fm = gid * WGM, gsz = (nM - fm) < WGM ? (nM - fm) : WGM;
        u.pm = fm + ((wgid % nig) % gsz); u.pn = (wgid % nig) / gsz; return true;
    }
};
template <class Epi, class Sched>
__device__ __forceinline__ void gemm_phase_m192(PG8_LAS unsigned char* lds, const Gemm g, const Sched& S, const Epi& E) {
    int tid_ = threadIdx.x; asm volatile("" : "+v"(tid_));
    const int tid = tid_, wid = __builtin_amdgcn_readfirstlane(tid >> 6), lane = tid & 63, wh = wid >> 2, wr = wid >> 1, wc = wid & 1, fr = lane & 15, fq = lane >> 4;
    const int K = g.K, nt = K / BK;
    constexpr unsigned SLOT = 40960u, PIECE = 8192u, BOFF = 3u * PIECE;
    unsigned voffA, voffB;
    { int R, C; stage_rc(tid * 16, R, C); const int Rb = Epi::PERM ? ((R & ~31) + perm32(R & 31)) : R; voffA = (unsigned)(R * K + C) * 2u; voffB = (unsigned)(Rb * K + C) * 2u; }
    const size_t kstep = (size_t)(BK * 2), pstep = (size_t)64 * K * 2;
    const unsigned ldsw = (unsigned)wid * 1024u;
    const int sub = lds_byte(fr, fq * 8);
    unsigned aofs[3];
#pragma unroll
    for (int m = 0; m < 3; ++m) { const int mt = 3 * wr + m; aofs[m] = (unsigned)((mt >> 2) * PIECE + ((mt & 3) * 2) * 1024 + sub); }
    const unsigned bofs = BOFF + (unsigned)wc * PIECE + (unsigned)sub;
#define PG8_STAGE5(slot, ga, gb) do { \
        _Pragma("unroll") for (int _p = 0; _p < 3; ++_p) __builtin_amdgcn_global_load_lds((const unsigned*)((ga) + _p * pstep + voffA), (PG8_LAS unsigned*)(lds + (slot) + _p * PIECE + ldsw), 16, 0, 0); \
        _Pragma("unroll") for (int _q = 0; _q < 2; ++_q) __builtin_amdgcn_global_load_lds((const unsigned*)((gb) + _q * pstep + voffB), (PG8_LAS unsigned*)(lds + (slot) + BOFF + _q * PIECE + ldsw), 16, 0, 0); } while (0)
#define PG8_WAIT_V(n) asm volatile("s_waitcnt vmcnt(" #n ")" ::: "memory")
#define PG8_WAIT_L(n) asm volatile("s_waitcnt lgkmcnt(" #n ")" ::: "memory")
#define PG8_BAR __builtin_amdgcn_s_barrier()
#define PG8_SCHED __builtin_amdgcn_sched_barrier(0)
    Unit cur, nxt; int ui = 0;
    if (!S.next(0, cur)) return;
    f32x4 acc[3][4];
#pragma unroll
    for (int m = 0; m < 3; ++m)
#pragma unroll
        for (int n = 0; n < 4; ++n) acc[m][n] = (f32x4){0.f, 0.f, 0.f, 0.f};
    bf16x8 At[3][2], Bf[4][2];
    const char* cA = (const char*)g.A + (size_t)cur.pm * 3 * pstep; const char* cB = (const char*)g.Bt + (size_t)cur.pn * 2 * pstep;
    PG8_STAGE5(0u, cA, cB); PG8_STAGE5(SLOT, cA + kstep, cB + kstep);
    PG8_WAIT_V(5);
    if (wh == 1) PG8_BAR;
    PG8_BAR;
    unsigned rs = 0u, ss = 2u * SLOT;
    for (;;) {
        const bool has_next = S.next(ui + 1, nxt);
        const char* nA = has_next ? (const char*)g.A + (size_t)nxt.pm * 3 * pstep : cA; const char* nB = has_next ? (const char*)g.Bt + (size_t)nxt.pn * 2 * pstep : cB;
        for (int t = 0; t < nt; ++t) {
            const bool tail = t >= nt - 2;
            const char* a2 = tail ? nA + (size_t)(t + 2 - nt) * kstep : cA + (size_t)(t + 2) * kstep;
            const char* b2 = tail ? nB + (size_t)(t + 2 - nt) * kstep : cB + (size_t)(t + 2) * kstep;
#pragma unroll
            for (int n = 0; n < 4; ++n)
#pragma unroll
                for (int k = 0; k < 2; ++k) Bf[n][k] = *(const PG8_LAS bf16x8*)(lds + rs + bofs + n * 2048 + k * 1024);
            PG8_SCHED;
#pragma unroll
            for (int m = 0; m < 3; ++m)
#pragma unroll
                for (int k = 0; k < 2; ++k) At[m][k] = *(const PG8_LAS bf16x8*)(lds + rs + aofs[m] + k * 1024);
            PG8_STAGE5(ss, a2, b2);
            PG8_WAIT_V(5); PG8_WAIT_L(0); PG8_BAR;
            __builtin_amdgcn_s_setprio(1);
#pragma unroll
            for (int m = 0; m < 3; ++m)
#pragma unroll
                for (int n = 0; n < 4; ++n)
#pragma unroll
                    for (int k = 0; k < 2; ++k) acc[m][n] = __builtin_amdgcn_mfma_f32_16x16x32_bf16(Bf[n][k], At[m][k], acc[m][n], 0, 0, 0);
            __builtin_amdgcn_s_setprio(0);
            PG8_BAR; PG8_SCHED;
            rs = rs == 2u * SLOT ? 0u : rs + SLOT; ss = ss == 2u * SLOT ? 0u : ss + SLOT;
        }
        if (wh == 0) PG8_BAR;
        E(acc, cur, wr, wc, fr, fq);
        if (!has_next) break;
#pragma unroll
        for (int m = 0; m < 3; ++m)
#pragma unroll
            for (int n = 0; n < 4; ++n) acc[m][n] = (f32x4){0.f, 0.f, 0.f, 0.f};
        cur = nxt; cA = nA; cB = nB; ++ui;
        if (wh == 1) PG8_BAR;
    }
    PG8_WAIT_V(0);
    PG8_BAR;
#undef PG8_STAGE5
#undef PG8_WAIT_V
#undef PG8_WAIT_L
#undef PG8_BAR
#undef PG8_SCHED
}
__device__ __forceinline__ int cond_of_row(int row) { return row < 4096 ? 0 : (row < 5120 ? 1 : 2); }
struct EpiRes192 {
    static constexpr bool PERM = false;
    float* X; bf16_t* A; const float* gate; const float* Gn; float* ssq_out;
    __device__ __forceinline__ void operator()(const f32x4 (&acc)[3][4], const Unit& u, int wr, int wc, int fr, int fq) const {
        const int col0 = u.pn * HALF + wc * 64 + 4 * fq;
#pragma unroll
        for (int m = 0; m < 3; ++m) {
            const int row = u.pm * 192 + wr * 48 + m * 16 + fr;
            const int cond = cond_of_row(u.pm * 192 + wr * 48 + m * 16);
            float q = 0.f;
#pragma unroll
            for (int n = 0; n < 4; ++n) {
                const int c = col0 + n * 16;
                float* xp = X + (size_t)row * DM + c;
                const f32x4 g4 = *(const f32x4*)(gate + cond * 6144 + c);
                const f32x4 x1 = *(const f32x4*)xp + g4 * acc[m][n];
                *(f32x4*)xp = x1;
                q += (x1[0] * x1[0] + x1[1] * x1[1]) + (x1[2] * x1[2] + x1[3] * x1[3]);
                if (Gn) { const f32x4 a = x1 * *(const f32x4*)(Gn + cond * DM + c); u32x2 w; w.x = cvt_pk_bf16(a[0], a[1]); w.y = cvt_pk_bf16(a[2], a[3]);
                    *(u32x2*)(A + (size_t)row * DM + c) = w; }
            }
            q += __shfl_xor(q, 16); q += __shfl_xor(q, 32);
            if (fq == 0) ssq_out[(size_t)row * SSQW + u.pn * 2 + wc] = q;
            asm volatile("" ::: "memory");
        }
    }
};
}
#define GAS __attribute__((address_space(1)))
#define LAS __attribute__((address_space(3)))
typedef unsigned short bf16;
typedef unsigned v4u __attribute__((ext_vector_type(4)));
typedef unsigned v2u __attribute__((ext_vector_type(2)));
typedef float f32x4 __attribute__((ext_vector_type(4)));
typedef float f32x2 __attribute__((ext_vector_type(2)));
typedef short bf16x8 __attribute__((ext_vector_type(8)));
constexpr int NWAVES = 8, NTHREADS = 512;
constexpr int M_TOK = 6144, M_CTX = 4096, DMODEL = 1024, NINP = 1792, NUC = 1280, FFD = 4096, DEPTHL = 4, DRNN = 512;
constexpr int LDS_BYTES = 147456;
constexpr size_t al256(size_t x) { return (x + 255) & ~(size_t)255; }
constexpr size_t WS_CTL = 0, CTL_BYTES = 1u << 20;
constexpr size_t WS_MODS = WS_CTL + CTL_BYTES;
constexpr size_t WS_GV = WS_MODS + al256((size_t)4 * 3 * 6144 * 4);
constexpr size_t WS_BIASIN = WS_GV + al256((size_t)4 * 2 * 3 * 1024 * 4);
constexpr size_t WS_BIAS1 = WS_BIASIN + al256((size_t)4 * 3 * NINP * 4);
constexpr size_t WS_SSQ = WS_BIAS1 + al256((size_t)4 * 3 * FFD * 4);
constexpr size_t WS_WIN = WS_SSQ + al256((size_t)9 * M_TOK * 16 * 4);
constexpr size_t WS_WOUT = WS_WIN + al256((size_t)4 * NINP * 1024 * 2);
constexpr size_t WS_W1 = WS_WOUT + al256((size_t)4 * 1024 * 1024 * 2);
constexpr size_t WS_W2 = WS_W1 + al256((size_t)4 * FFD * 1024 * 2);
constexpr size_t WS_WG = WS_W2 + al256((size_t)4 * FFD * 1024 * 2);
constexpr size_t WS_T256 = WS_WG + al256((size_t)4 * 8 * 4 * 2 * 32 * 64 * 2);
constexpr size_t WS_T1024 = WS_T256 + al256((size_t)256 * 512 * 2);
constexpr size_t WS_X = WS_T1024 + al256((size_t)1024 * 2048 * 2);
constexpr size_t WS_A = WS_X + al256((size_t)M_TOK * 1024 * 4);
constexpr size_t WS_U = WS_A + al256((size_t)M_TOK * 1024 * 2);
constexpr size_t WS_XCT = WS_U + al256((size_t)M_TOK * NUC * 2);
constexpr size_t WS_CAT = WS_XCT + al256((size_t)M_TOK * 512 * 2);
constexpr size_t WS_HF = WS_CAT + al256((size_t)M_TOK * 1024 * 2);
constexpr size_t WS_PB = WS_HF + al256((size_t)M_TOK * 512 * 4);
constexpr size_t WS_HID = WS_PB + al256((size_t)M_TOK * 512 * 4);
constexpr size_t WS_END = WS_HID + al256((size_t)M_TOK * FFD * 2);
static_assert(WS_END <= ((size_t)256 << 20), "workspace map exceeds 256 MiB");

__device__ __forceinline__ unsigned f2bf(float f) { unsigned u = __builtin_bit_cast(unsigned, f); return (u + 0x7fffu + ((u >> 16) & 1u)) >> 16; }
__device__ __forceinline__ unsigned pk2(float lo, float hi) { return f2bf(lo) | (f2bf(hi) << 16); }
__device__ __forceinline__ float bf2f(unsigned short b) { return __builtin_bit_cast(float, (unsigned)b << 16); }
__device__ __forceinline__ float bflo(unsigned w) { return __builtin_bit_cast(float, w << 16); }
__device__ __forceinline__ float bfhi(unsigned w) { return __builtin_bit_cast(float, w & 0xffff0000u); }
__device__ __forceinline__ float wave_sum(float v) {
#pragma unroll
    for (int o = 1; o < 64; o <<= 1) v += __shfl_xor(v, o);
    return v;
}
__device__ __forceinline__ float rdlane(float v, int l) { return __builtin_bit_cast(float, __builtin_amdgcn_readlane(__builtin_bit_cast(int, v), l)); }

__device__ __forceinline__ int launder_v(int x) { asm volatile("" : "+v"(x)); return x; }
__device__ __forceinline__ int launder_s(int x) { asm volatile("" : "+s"(x)); return x; }
#define CAS __attribute__((address_space(4)))
typedef const float* cfp_t;
struct Params { const float* in[24]; float* out; unsigned char* ws; int ph_lo, ph_hi; };
struct Frame {
    LAS unsigned char* lds;
    int tid, lane, wave, G, bid;
    __device__ __forceinline__ void relaunder() { tid = launder_v((int)threadIdx.x); lane = tid & 63; wave = __builtin_amdgcn_readfirstlane(tid >> 6); bid = launder_s(bid); G = launder_s(G);
        size_t z = 0; asm volatile("" : "+s"(z), "+s"(in)); ws = ws0 + z; out = out0 + z; }
    __device__ __forceinline__ const float* inp(int i) const { return (const float*)(const GAS float*)in[i]; }
    const CAS cfp_t* in; float* out; unsigned char* ws; float* out0; unsigned char* ws0;
};
enum { I_XP = 0, I_XS, I_STATE, I_C, I_CCTX, I_N1G, I_N2G, I_FG, I_WMOD, I_BMOD, I_WIN, I_CONVW, I_CONVB, I_WR, I_BR, I_WI, I_BI, I_LAM, I_POOLW, I_POOLS, I_FW, I_WOUT, I_W1, I_W2 };
#define XB_TMO      128
#define XB_XCNT(j)  (256  + 64 * (j))
#define XB_XSUB(j)  (1280 + 64 * (j))
#define XB_XGEN(j)  (2304 + 64 * (j))
#define XB_TOP      3328
#define XB_TOPGEN   3392
#define XCD_BAR_WORDS 3456
#define XB_SPIN_CAP (1u << 18)

__device__ __forceinline__ unsigned xb_ld(unsigned* p)              { return __hip_atomic_load(p, __ATOMIC_RELAXED, __HIP_MEMORY_SCOPE_AGENT); }
__device__ __forceinline__ unsigned xb_add(unsigned* p, unsigned v) { return __hip_atomic_fetch_add(p, v, __ATOMIC_RELAXED, __HIP_MEMORY_SCOPE_AGENT); }
__device__ __forceinline__ unsigned xb_xcc_id() { return (unsigned)__builtin_amdgcn_s_getreg((3 << 11) | 20) & 0xFu; }
#define XB_SPIN(cond, bar) do { unsigned _sp = 0; while (cond) { __builtin_amdgcn_s_sleep(1); \
    if ((++_sp & 255u) == 0u) { if (xb_ld(&(bar)[XB_TMO])) break; if (_sp > XB_SPIN_CAP) { atomicAdd(&(bar)[XB_TMO], 1u); break; } } } } while (0)

struct XcdBarrier {
    unsigned* bar; unsigned x;
    volatile LAS unsigned* st;
};

__device__ __forceinline__ XcdBarrier xcd_barrier_post(unsigned* bar, volatile LAS unsigned* st) {
    XcdBarrier b; b.bar = bar; b.x = xb_xcc_id(); b.st = st;
    if (threadIdx.x == 0) (void)xb_add(&bar[XB_XCNT(b.x)], 1u);
    return b;
}
__device__ __forceinline__ void xcd_barrier_complete(unsigned* bar, unsigned x, unsigned& nloc, unsigned& nx) {
    const unsigned G = gridDim.x * gridDim.y * gridDim.z;
    unsigned sum, cnt, mine, sp = 0u;
    for (;;) {
        sum = 0u; cnt = 0u; mine = 0u;
#pragma unroll
        for (unsigned j = 0; j < 16; ++j) { const unsigned c = xb_ld(&bar[XB_XCNT(j)]); sum += c; cnt += (c > 0u) ? 1u : 0u; mine = (j == x) ? c : mine; }
        if (sum == G) break;
        __builtin_amdgcn_s_sleep(1);
        if ((++sp & 255u) == 0u) { if (xb_ld(&bar[XB_TMO])) break; if (sp > XB_SPIN_CAP) { atomicAdd(&bar[XB_TMO], 1u); break; } }
    }
    nloc = mine > 0u ? mine : 1u; nx = cnt > 0u ? cnt : 1u;
}

__device__ __forceinline__ void xcd_barrier(const XcdBarrier& b) {
    asm volatile("s_waitcnt vmcnt(0)" ::: "memory");
    __syncthreads();
    if (threadIdx.x == 0) {
        unsigned* bar = b.bar;
        __builtin_amdgcn_s_waitcnt(0);
        unsigned nloc = b.st[0], nx = b.st[1];
        if (nloc == 0u) { xcd_barrier_complete(bar, b.x, nloc, nx); b.st[0] = nloc; b.st[1] = nx; }
        const unsigned old = xb_add(&bar[XB_XSUB(b.x)], 1u);
        const unsigned gen = old / nloc;
        if (old + 1u == (gen + 1u) * nloc) {
            __builtin_amdgcn_fence(__ATOMIC_RELEASE, "agent");
            asm volatile("s_waitcnt vmcnt(0)" ::: "memory");
            const unsigned og = xb_add(&bar[XB_TOP], 1u);
            const unsigned tg = og / nx;
            if (og + 1u == (tg + 1u) * nx) xb_add(&bar[XB_TOPGEN], 1u);
            else XB_SPIN(xb_ld(&bar[XB_TOPGEN]) == tg, bar);
            __builtin_amdgcn_fence(__ATOMIC_ACQUIRE, "agent");
            xb_add(&bar[XB_XGEN(b.x)], 1u);
            asm volatile("s_waitcnt vmcnt(0)" ::: "memory");
        } else {
            XB_SPIN(xb_ld(&bar[XB_XGEN(b.x)]) == gen, bar);
            __builtin_amdgcn_fence(__ATOMIC_ACQUIRE, "agent");
            asm volatile("s_waitcnt vmcnt(0)" ::: "memory");
        }
    }
    __syncthreads();
}
__device__ __forceinline__ void p0a_mods(const Frame& F) {
    LAS float* sl = (LAS float*)F.lds;
    LAS float* red = sl + 3 * 1024;
    const float* c_ctx = F.inp(I_CCTX); const float* cv = F.inp(I_C);
    for (int i = F.tid; i < 3 * 1024; i += NTHREADS) { const int cd = i >> 10, k = i & 1023; const float c = cd == 0 ? c_ctx[k] : cv[(cd - 1) * 1024 + k]; sl[i] = c / (1.0f + expf(-c)); }
    __syncthreads();
    float* mods = (float*)(F.ws + WS_MODS);
    { float* BIASIN = (float*)(F.ws + WS_BIASIN);
        for (int i = F.bid * NTHREADS + F.tid; i < 4 * 3 * 512; i += F.G * NTHREADS) BIASIN[(size_t)(i >> 9) * NINP + 1280 + (i & 511)] = 0.f; }
    for (int it = F.bid; it < 256; it += F.G) {
        const int l = it >> 6, ch = it & 63;
        const float* W = F.inp(I_WMOD) + (size_t)l * 1024 * 6144 + ch * 96;
        if (F.tid < 504) {
            const int c4 = F.tid % 24, kr = F.tid / 24;
            f32x4 a0 = {0.f, 0.f, 0.f, 0.f}, a1 = a0, a2 = a0;
#pragma unroll 4
            for (int k = kr; k < 1024; k += 21) { const f32x4 w = *(const f32x4*)(W + (size_t)k * 6144 + c4 * 4); a0 += w * sl[k]; a1 += w * sl[1024 + k]; a2 += w * sl[2048 + k]; }
            *(LAS f32x4*)(red + (kr * 3 + 0) * 96 + c4 * 4) = a0; *(LAS f32x4*)(red + (kr * 3 + 1) * 96 + c4 * 4) = a1; *(LAS f32x4*)(red + (kr * 3 + 2) * 96 + c4 * 4) = a2;
        }
        __syncthreads();
        if (F.tid < 288) { const int cd = F.tid / 96, col = F.tid % 96; float s = 0.f;
#pragma unroll
            for (int kr = 0; kr < 21; ++kr) s += red[(kr * 3 + cd) * 96 + col];
            mods[(size_t)(l * 3 + cd) * 6144 + ch * 96 + col] = s + F.inp(I_BMOD)[l * 6144 + ch * 96 + col]; }
        __syncthreads();
    }
}

template <bool BIAS>
__device__ __forceinline__ void strip_item(const float* W, int N, int kb, int ke, int n0, bf16* WT, int ldt, int trow0, const float* sh, float* bias_out, int bstride, LAS float* scr, int lane) {
    float b0 = 0.f, b1 = 0.f, b2 = 0.f;
    const int nn = lane & 31, half = lane >> 5;
    for (int k0 = kb; k0 < ke; k0 += 64) {
        float tv[32];
#pragma unroll
        for (int i = 0; i < 32; ++i) tv[i] = W[(size_t)(k0 + 2 * i + half) * N + n0 + nn];
#pragma unroll
        for (int i = 0; i < 32; ++i) scr[(2 * i + half) * 33 + nn] = tv[i];
        asm volatile("s_waitcnt lgkmcnt(0)" ::: "memory");
        const int c = lane & 7;
#pragma unroll
        for (int j = 0; j < 4; ++j) { const int n = (lane >> 3) + 8 * j; const LAS float* s = scr + (8 * c) * 33 + n;
            v4u o; o.x = pk2(s[0 * 33], s[1 * 33]); o.y = pk2(s[2 * 33], s[3 * 33]); o.z = pk2(s[4 * 33], s[5 * 33]); o.w = pk2(s[6 * 33], s[7 * 33]);
            *(v4u*)(WT + (size_t)(trow0 + n) * ldt + k0 + 8 * c) = o; }
        if (BIAS) {
            const float s0 = sh[k0 + lane], s1 = sh[6144 + k0 + lane], s2 = sh[2 * 6144 + k0 + lane];
#pragma unroll 8
            for (int kk = 0; kk < 32; ++kk) { const float w = scr[(half * 32 + kk) * 33 + nn]; const int src = half * 32 + kk;
                b0 += w * __shfl(s0, src); b1 += w * __shfl(s1, src); b2 += w * __shfl(s2, src); }
        }
        asm volatile("s_waitcnt lgkmcnt(0)" ::: "memory");
    }
    if (BIAS) {
        b0 += __shfl_xor(b0, 32); b1 += __shfl_xor(b1, 32); b2 += __shfl_xor(b2, 32);
        if (lane < 32) { bias_out[n0 + lane] = b0; bias_out[bstride + n0 + lane] = b1; bias_out[2 * bstride + n0 + lane] = b2; }
    }
}
__device__ __forceinline__ float dft64(float tabreg, int c, int mm) { const int m = mm & 63; const int idx = (mm < 64) ? ((c * m) & 63) : ((c * m - 16) & 63); return __shfl(tabreg, idx); }

__device__ __forceinline__ void p0b_items(Frame F, int llo, int lhi, int gw, int NGW, bool with_rows) {
    const int nl = lhi - llo;
    const float tabreg = cospif((float)F.lane * (1.0f / 32.0f)) * 0.125f;
    const int N_FOUT = 256 * nl, N_FIN = 256 * nl, N_POOLF = 64 * nl, N_FBIAS = 32 * nl, N_W1 = 128 * nl, N_W2 = 128 * nl, N_WIN = 40 * nl, N_WOUTA = 32 * nl, N_ROWS = with_rows ? M_TOK : 0;
    const int NITEMS = N_FOUT + N_FIN + N_POOLF + N_FBIAS + N_W1 + N_W2 + N_WIN + N_WOUTA + N_ROWS;
    for (int it = gw; it < NITEMS; it += NGW) {
        int r = it; F.relaunder(); const int lane = F.lane;
        LAS float* scr = (LAS float*)(F.lds + F.wave * 16384);
        const float* mods = (const float*)(F.ws + WS_MODS);
        bf16* WINT = (bf16*)(F.ws + WS_WIN); bf16* WOUTT = (bf16*)(F.ws + WS_WOUT); bf16* W1T = (bf16*)(F.ws + WS_W1); bf16* W2T = (bf16*)(F.ws + WS_W2);
        float* BIASIN = (float*)(F.ws + WS_BIASIN); float* BIAS1 = (float*)(F.ws + WS_BIAS1);

        if (r < N_FOUT) {
            const int l = llo + (r >> 8), it16 = (r >> 4) & 15, nb = r & 15, lr = lane & 15, lq = lane >> 4;
            const float* fw = F.inp(I_FW) + (size_t)l * 65536 + (size_t)(it16 * 16 + lr) * 256 + lq;
            const float* wo = F.inp(I_WOUT) + (size_t)l * 1048576 + (size_t)(768 + lq) * 1024 + nb * 64 + lr;
            f32x4 acc[4];
#pragma unroll
            for (int nt = 0; nt < 4; ++nt) acc[nt] = (f32x4){0.f, 0.f, 0.f, 0.f};
#pragma unroll 4
            for (int ks = 0; ks < 64; ++ks) { const float av = fw[4 * ks];
#pragma unroll
                for (int nt = 0; nt < 4; ++nt) acc[nt] = __builtin_amdgcn_mfma_f32_16x16x4f32(av, wo[(size_t)(4 * ks) * 1024 + 16 * nt], acc[nt], 0, 0, 0); }
#pragma unroll
            for (int nt = 0; nt < 4; ++nt) { v2u o; o.x = pk2(acc[nt][0], acc[nt][1]); o.y = pk2(acc[nt][2], acc[nt][3]);
                *(v2u*)(WOUTT + (size_t)l * 1048576 + (size_t)(nb * 64 + 16 * nt + lr) * 1024 + 768 + it16 * 16 + 4 * lq) = o; }
            continue;
        }
        r -= N_FOUT;
        if (r < N_FIN) {
            const int l = llo + (r >> 8), hd = (r >> 6) & 3, kt = r & 63, lr = lane & 15, lq = lane >> 4;
            const float* wp = F.inp(I_WIN) + (size_t)l * 1024 * 1536 + (size_t)(kt * 16 + lr) * 1536 + 1280 + 64 * hd + lq;
            f32x4 acc[8];
#pragma unroll
            for (int nt = 0; nt < 8; ++nt) acc[nt] = (f32x4){0.f, 0.f, 0.f, 0.f};
#pragma unroll 2
            for (int ks = 0; ks < 16; ++ks) { const float av = wp[4 * ks]; const int c = 4 * ks + lq;
#pragma unroll
                for (int nt = 0; nt < 8; ++nt) acc[nt] = __builtin_amdgcn_mfma_f32_16x16x4f32(av, dft64(tabreg, c, 16 * nt + lr), acc[nt], 0, 0, 0); }
#pragma unroll
            for (int nt = 0; nt < 8; ++nt) { v2u o; o.x = pk2(acc[nt][0], acc[nt][1]); o.y = pk2(acc[nt][2], acc[nt][3]);
                *(v2u*)(WINT + (size_t)l * NINP * 1024 + (size_t)(1280 + 128 * hd + 16 * nt + lr) * 1024 + kt * 16 + 4 * lq) = o; }
            continue;
        }
        r -= N_FIN;
        if (r < N_POOLF) {
            const int l = llo + (r >> 6), g = (r >> 4) & 3, nb = r & 15, lr = lane & 15, lq = lane >> 4;
            const float* pw = F.inp(I_POOLW) + (size_t)(l * 4 + g) * 4096 + lr * 64 + lq;
            const float* ps = F.inp(I_POOLS) + l * 256 + 64 * g + lq;
            const float* wo = F.inp(I_WOUT) + (size_t)l * 1048576 + (size_t)(512 + 64 * g + lq) * 1024 + nb * 64 + lr;
            f32x4 acc[4][4];
#pragma unroll
            for (int mt = 0; mt < 4; ++mt)
#pragma unroll
                for (int nt = 0; nt < 4; ++nt) acc[mt][nt] = (f32x4){0.f, 0.f, 0.f, 0.f};
#pragma unroll 2
            for (int ks = 0; ks < 16; ++ks) { const float sc = ps[4 * ks]; float av[4], bv[4];
#pragma unroll
                for (int mt = 0; mt < 4; ++mt) av[mt] = pw[mt * 1024 + 4 * ks] * sc;
#pragma unroll
                for (int nt = 0; nt < 4; ++nt) bv[nt] = wo[(size_t)(4 * ks) * 1024 + 16 * nt];
#pragma unroll
                for (int mt = 0; mt < 4; ++mt)
#pragma unroll
                    for (int nt = 0; nt < 4; ++nt) acc[mt][nt] = __builtin_amdgcn_mfma_f32_16x16x4f32(av[mt], bv[nt], acc[mt][nt], 0, 0, 0); }
#pragma unroll
            for (int mt = 0; mt < 4; ++mt)
#pragma unroll
                for (int nt = 0; nt < 4; ++nt) { v2u o; o.x = pk2(acc[mt][nt][0], acc[mt][nt][1]); o.y = pk2(acc[mt][nt][2], acc[mt][nt][3]);
                    *(v2u*)(WOUTT + (size_t)l * 1048576 + (size_t)(nb * 64 + 16 * nt + lr) * 1024 + 512 + 64 * g + 16 * mt + 4 * lq) = o; }
            continue;
        }
        r -= N_POOLF;
        if (r < N_FBIAS) {
            const int l = llo + (r >> 5), hd = (r >> 3) & 3, kp = r & 7;
            const float* wp = F.inp(I_WIN) + (size_t)l * 1024 * 1536 + (size_t)(kp * 128) * 1536 + 1280 + 64 * hd + lane;
            const float* sh = mods + (size_t)l * 3 * 6144 + kp * 128;
            float b0 = 0.f, b1 = 0.f, b2 = 0.f;
#pragma unroll 16
            for (int k = 0; k < 128; ++k) { const float w = wp[(size_t)k * 1536]; b0 += w * sh[k]; b1 += w * sh[6144 + k]; b2 += w * sh[2 * 6144 + k]; }
            for (int hf = 0; hf < 2; ++hf) {
                const int mm = hf * 64 + lane; float s0 = 0.f, s1 = 0.f, s2 = 0.f;
#pragma unroll 8
                for (int c = 0; c < 64; ++c) { const int idx = hf == 0 ? ((c * lane) & 63) : ((c * lane - 16) & 63); const float dv = __shfl(tabreg, idx);
                    s0 += __shfl(b0, c) * dv; s1 += __shfl(b1, c) * dv; s2 += __shfl(b2, c) * dv; }
                float* bo = BIASIN + (size_t)l * 3 * NINP + 1280 + 128 * hd + mm;
                atomicAdd(bo, s0); atomicAdd(bo + NINP, s1); atomicAdd(bo + 2 * NINP, s2);
            }
            continue;
        }
        r -= N_FBIAS;
        if (r < N_W1) {
            const int l = llo + (r >> 7), nb = r & 127;
            strip_item<true>(F.inp(I_W1) + (size_t)l * 1024 * 4096, 4096, 0, 1024, nb * 32, W1T + (size_t)l * 4096 * 1024, 1024, nb * 32,
                             mods + (size_t)l * 3 * 6144 + 3 * 1024, BIAS1 + (size_t)l * 3 * FFD, FFD, scr, lane);
            continue;
        }
        r -= N_W1;
        if (r < N_W2) {
            const int l = llo + (r >> 7), nb = (r >> 2) & 31, kq = r & 3;
            strip_item<false>(F.inp(I_W2) + (size_t)l * 4096 * 1024, 1024, kq * 1024, kq * 1024 + 1024, nb * 32, W2T + (size_t)l * 1024 * 4096, 4096, nb * 32, nullptr, nullptr, 0, scr, lane);
            continue;
        }
        r -= N_W2;
        if (r < N_WIN) {
            const int l = llo + r / 40, nb = r % 40;
            strip_item<true>(F.inp(I_WIN) + (size_t)l * 1024 * 1536, 1536, 0, 1024, nb * 32, WINT + (size_t)l * NINP * 1024, 1024, nb * 32,
                             mods + (size_t)l * 3 * 6144, BIASIN + (size_t)l * 3 * NINP, NINP, scr, lane);
            continue;
        }
        r -= N_WIN;
        if (r < N_WOUTA) {
            const int l = llo + (r >> 5), nb = r & 31;
            strip_item<false>(F.inp(I_WOUT) + (size_t)l * 1048576, 1024, 0, 512, nb * 32, WOUTT + (size_t)l * 1048576, 1024, nb * 32, nullptr, nullptr, 0, scr, lane);
            continue;
        }
        r -= N_WOUTA;
        if (with_rows) {
            const int cond = r < M_CTX ? 0 : 1 + ((r - M_CTX) >> 10);
            const float* src = r < M_CTX ? F.inp(I_XP) + (size_t)r * 1024 : F.inp(I_XS) + (size_t)(r - M_CTX) * 1024;
            const f32x4* xr = (const f32x4*)src + lane;
            const f32x4* gp = (const f32x4*)F.inp(I_N1G) + lane;
            const f32x4* sp = (const f32x4*)(mods + (size_t)cond * 6144 + 1024) + lane;
            f32x4 v[4]; float s = 0.f;
#pragma unroll
            for (int j = 0; j < 4; ++j) { v[j] = xr[64 * j]; s += (v[j][0] * v[j][0] + v[j][1] * v[j][1]) + (v[j][2] * v[j][2] + v[j][3] * v[j][3]); }
            s = wave_sum(s);
            f32x4* xo = (f32x4*)((float*)(F.ws + WS_X) + (size_t)r * 1024) + lane;
            v2u* ao = (v2u*)((bf16*)(F.ws + WS_A) + (size_t)r * 1024) + lane;
#pragma unroll
            for (int j = 0; j < 4; ++j) { xo[64 * j] = v[j]; const f32x4 a = v[j] * (gp[64 * j] * (sp[64 * j] + 1.0f));
                v2u w; w.x = pk2(a[0], a[1]); w.y = pk2(a[2], a[3]); ao[64 * j] = w; }
            if (lane < 16) ((float*)(F.ws + WS_SSQ))[(size_t)r * 16 + lane] = lane == 0 ? s : 0.f;
        }
    }
}
__device__ __forceinline__ void p0b_tail(Frame F) {
    F.relaunder();
    const float* mods = (const float*)(F.ws + WS_MODS);
    const int gt = F.bid * NTHREADS + F.tid, NGT = F.G * NTHREADS;
    {
        float* GV = (float*)(F.ws + WS_GV);
        for (int i = gt; i < 4 * 2 * 3 * 1024; i += NGT) { const int c = i & 1023, cd = (i >> 10) % 3, w = (i / 3072) & 1, l = i / 6144;
            const float g = (w == 0 ? F.inp(I_N1G) : F.inp(I_N2G))[l * 1024 + c]; GV[i] = g * (1.0f + mods[(size_t)(l * 3 + cd) * 6144 + (w == 0 ? 1 : 4) * 1024 + c]); }
    }
    {
        bf16* WG = (bf16*)(F.ws + WS_WG);
        for (int i = gt; i < 4 * 8 * 4 * 2 * 32 * 64; i += NGT) { const int k = i & 63, n = (i >> 6) & 31, dir = (i >> 11) & 1, q = (i >> 12) & 3, h = (i >> 14) & 7, l = i >> 17;
            const float* src = n < 16 ? F.inp(I_WR) : F.inp(I_WI);
            WG[i] = (bf16)f2bf(src[((size_t)((l * 2 + dir) * 8 + h) * 64 + k) * 64 + 16 * q + (n & 15)]); }
    }
    {
        for (int i = gt; i < (256 * 512 + 1024 * 2048) / 8; i += NGT) {
            int L, e; bf16* T;
            if (i < 256 * 512 / 8) { L = 256; e = i * 8; T = (bf16*)(F.ws + WS_T256); } else { L = 1024; e = (i - 256 * 512 / 8) * 8; T = (bf16*)(F.ws + WS_T1024); }
            const int kpos = e / (2 * L), k2 = e % (2 * L), sn = k2 >= L, l0 = k2 - (sn ? L : 0);
            const float scale = L == 256 ? 0.0625f : 0.03125f, inv = 2.0f / (float)L;
            float v[8];
#pragma unroll
            for (int j = 0; j < 8; ++j) { const int a = (kpos * (l0 + j)) & (L - 1); v[j] = sn ? -sinpif((float)a * inv) * scale : cospif((float)a * inv) * scale; }
            v4u o; o.x = pk2(v[0], v[1]); o.y = pk2(v[2], v[3]); o.z = pk2(v[4], v[5]); o.w = pk2(v[6], v[7]);
            *(v4u*)(T + e) = o;
        }
    }
}
__device__ __forceinline__ float sigmoidf_(float x) { return 1.0f / (1.0f + expf(-x)); }
__device__ __forceinline__ float gelu_tanh(float x) { return 0.5f * x * (1.0f + tanhf(0.7978845608028654f * (x + 0.044715f * x * x * x))); }
__device__ __forceinline__ void seq_geom(int seq, int& L, int& row0) { if (seq < 16) { L = 256; row0 = seq * 256; } else { L = 1024; row0 = M_CTX + (seq - 16) * 1024; } }

__device__ __forceinline__ float fexp(float x) { return __builtin_amdgcn_exp2f(x * 1.4426950408889634f); }
__device__ __forceinline__ float fsigmoid(float x) { return __builtin_amdgcn_rcpf(1.0f + __builtin_amdgcn_exp2f(x * -1.4426950408889634f)); }
__device__ __forceinline__ float fgelu_tanh(float x) { return x * fsigmoid(1.5957691216057308f * (x + 0.044715f * x * x * x)); }
__device__ __forceinline__ float neg_expm1(float y) {
    float p = 1.0f / 720.0f; p = p * y + (1.0f / 120.0f); p = p * y + (1.0f / 24.0f); p = p * y + (1.0f / 6.0f); p = p * y + 0.5f; p = p * y + 1.0f;
    return y < -0.5f ? 1.0f - fexp(y) : -y * p;
}
__device__ __forceinline__ void lru_unit(Frame F, int l, int seq, int h, int q) {
    F.relaunder();
    int L, row0; seq_geom(seq, L, row0);
    const int tid = F.tid, lane = F.lane, wave = F.wave;
    LAS bf16* XR = (LAS bf16*)F.lds;
    LAS bf16* XC = (LAS bf16*)(F.lds + 37440);
    LAS float* AA = (LAS float*)(F.lds + 37440);
    LAS float* BB = (LAS float*)(F.lds + 74304);
    LAS bf16* XG = (LAS bf16*)(F.lds + 107072);
    LAS float* XCF = (LAS float*)(F.lds + 115264);
    LAS float* SEGP = (LAS float*)(F.lds + 131648);
    LAS float* SEGH = SEGP + 512; LAS float* SEGC = SEGP + 1024; LAS float* SEGQ = SEGP + 1536;
    LAS float* CARF = SEGP + 2048;
    LAS float* H0B = CARF + 16;
    LAS float* CHKP = CARF + 32;
    LAS float* CHKH = CARF + 96;
    LAS float* CINB = CARF + 160;
    const bf16* U = (const bf16*)(F.ws + WS_U);
    bf16* CAT = (bf16*)(F.ws + WS_CAT);
    float* HFG = (float*)(F.ws + WS_HF); float* PBG = (float*)(F.ws + WS_PB);
    const int chb = 64 * h + 16 * q;
    const int nch = L >> 8;
    const int cg = tid & 7, j16 = lane & 15, lq = lane >> 4;
    float gbr[2], gbi[2], sp8[2];
#pragma unroll
    for (int d = 0; d < 2; ++d) { gbr[d] = F.inp(I_BR)[(l * 2 + d) * 512 + chb + j16]; gbi[d] = F.inp(I_BI)[(l * 2 + d) * 512 + chb + j16];
        sp8[d] = -8.0f * log1pf(expf(-F.inp(I_LAM)[(l * 2 + d) * 512 + chb + j16])); }
    if (tid < 16) { CARF[tid] = seq < 16 ? 0.f : F.inp(I_STATE)[(((seq - 16) * 4 + l) * 2 + 0) * 512 + chb + tid];
                    H0B[tid] = seq < 16 ? 0.f : F.inp(I_STATE)[(((seq - 16) * 4 + l) * 2 + 1) * 512 + chb + tid]; }
#pragma unroll 1
    for (int c = 0; c < nch; ++c) {
        const int c0 = c * 256; const bool last = c == nch - 1;
        v4u xv[5];
#pragma unroll
        for (int i = 0; i < 5; ++i) { const int id = tid + NTHREADS * i, tr = id >> 3, v = id & 7, t = c0 - 2 + tr; xv[i] = (v4u){0u, 0u, 0u, 0u};
            if (id < 260 * 8 && t >= 0 && t < L) xv[i] = *(const v4u*)(U + (size_t)(row0 + t) * NUC + 64 * h + 8 * v); }
        const v4u gv = *(const v4u*)(U + (size_t)(row0 + c0 + (tid >> 1)) * NUC + 512 + chb + 8 * (tid & 1));
        const int cgo = launder_v(64 * h + 8 * cg);
        f32x4 cwv[4][2], cbv[2];
#pragma unroll
        for (int k = 0; k < 4; ++k) { cwv[k][0] = *(const f32x4*)(F.inp(I_CONVW) + (l * 4 + k) * 512 + cgo); cwv[k][1] = *(const f32x4*)(F.inp(I_CONVW) + (l * 4 + k) * 512 + cgo + 4); }
        cbv[0] = *(const f32x4*)(F.inp(I_CONVB) + l * 512 + cgo); cbv[1] = *(const f32x4*)(F.inp(I_CONVB) + l * 512 + cgo + 4);
        bf16x8 bw[4][2];
        { const bf16* WG = (const bf16*)(F.ws + WS_WG) + (size_t)(((l * 8 + h) * 4 + q) * 2) * 32 * 64 + launder_v(j16 * 64 + 8 * lq);
#pragma unroll
            for (int nt = 0; nt < 4; ++nt)
#pragma unroll
                for (int ks = 0; ks < 2; ++ks) bw[nt][ks] = *(const bf16x8*)(WG + (size_t)(16 * nt) * 64 + 32 * ks); }
#pragma unroll
        for (int i = 0; i < 5; ++i) { const int id = tid + NTHREADS * i; if (id < 260 * 8) *(LAS v4u*)(XR + (id >> 3) * 72 + 8 * (id & 7)) = xv[i]; }
        *(LAS v4u*)(XG + tid * 8) = gv;
        __syncthreads();
#pragma unroll
        for (int i = 0; i < 4; ++i) { const int tl = (tid >> 3) + 64 * i;
            f32x4 o0 = cbv[0], o1 = cbv[1];
#pragma unroll
            for (int k = 0; k < 4; ++k) { const v4u x = *(const LAS v4u*)(XR + (tl + k) * 72 + 8 * cg);
                o0 += (f32x4){bflo(x.x), bfhi(x.x), bflo(x.y), bfhi(x.y)} * cwv[k][0]; o1 += (f32x4){bflo(x.z), bfhi(x.z), bflo(x.w), bfhi(x.w)} * cwv[k][1]; }
            v4u w; w.x = pk2(o0[0], o0[1]); w.y = pk2(o0[2], o0[3]); w.z = pk2(o1[0], o1[1]); w.w = pk2(o1[2], o1[3]);
            *(LAS v4u*)(XC + tl * 72 + 8 * cg) = w;
            if ((cg >> 1) == q) { *(LAS f32x4*)(XCF + tl * 16 + (cg & 1) * 8) = o0; *(LAS f32x4*)(XCF + tl * 16 + (cg & 1) * 8 + 4) = o1; } }
        __syncthreads();
        f32x4 acc[2][4];
#pragma unroll
        for (int mt = 0; mt < 2; ++mt) {
#pragma unroll
            for (int nt = 0; nt < 4; ++nt) acc[mt][nt] = (f32x4){0.f, 0.f, 0.f, 0.f};
#pragma unroll
            for (int ks = 0; ks < 2; ++ks) { const bf16x8 a = *(const LAS bf16x8*)(XC + (32 * wave + 16 * mt + j16) * 72 + 32 * ks + 8 * lq);
#pragma unroll
                for (int nt = 0; nt < 4; ++nt) acc[mt][nt] = __builtin_amdgcn_mfma_f32_16x16x32_bf16(a, bw[nt][ks], acc[mt][nt], 0, 0, 0); }
        }
        __syncthreads();
#pragma unroll
        for (int mt = 0; mt < 2; ++mt)
#pragma unroll
            for (int rg = 0; rg < 4; ++rg) { const int tl = 32 * wave + 16 * mt + 4 * lq + rg;
                const float xc = XCF[tl * 16 + j16];
#pragma unroll
                for (int d = 0; d < 2; ++d) { const float r = fsigmoid(acc[mt][2 * d][rg] + gbr[d]), ig = fsigmoid(acc[mt][2 * d + 1][rg] + gbi[d]);
                    const float la = sp8[d] * r, a = fexp(la), bt = sqrtf(neg_expm1(2.0f * la)) * (ig * xc);
                    AA[d * 4096 + tl * 16 + j16] = a; BB[d * 4096 + tl * 16 + j16] = bt; } }
        __syncthreads();
        { const int d = tid >> 8, sg = (tid >> 4) & 15, j = tid & 15; LAS float* ap = AA + d * 4096 + (16 * sg) * 16 + j; LAS float* bp = BB + d * 4096 + (16 * sg) * 16 + j;
            float av[16], bv[16];
#pragma unroll
            for (int i = 0; i < 16; ++i) { av[i] = ap[i * 16]; bv[i] = bp[i * 16]; }
            float P = 1.f, Hl = 0.f;
            if (d == 0) {
#pragma unroll
                for (int i = 0; i < 16; ++i) { Hl = av[i] * Hl + bv[i]; P *= av[i]; av[i] = P; bv[i] = Hl; }
            } else {
#pragma unroll
                for (int i = 15; i >= 0; --i) { Hl = av[i] * Hl + bv[i]; P *= av[i]; av[i] = P; bv[i] = Hl; }
            }
#pragma unroll
            for (int i = 0; i < 16; ++i) { ap[i * 16] = av[i]; bp[i * 16] = bv[i]; }
            SEGP[d * 256 + sg * 16 + j] = P; SEGH[d * 256 + sg * 16 + j] = Hl; }
        __syncthreads();
        if ((tid & 255) < 16) { const int d = tid >> 8, j = tid & 15;
            float pv[16], hv[16];
#pragma unroll
            for (int s = 0; s < 16; ++s) { pv[s] = SEGP[d * 256 + s * 16 + j]; hv[s] = SEGH[d * 256 + s * 16 + j]; }
            if (d == 0) { float cv = CARF[j];
#pragma unroll
                for (int s = 0; s < 16; ++s) { const float t = cv; cv = pv[s] * cv + hv[s]; hv[s] = t; }
                CARF[j] = cv;
#pragma unroll
                for (int s = 0; s < 16; ++s) SEGC[s * 16 + j] = hv[s];
            } else { float cv = last ? H0B[j] : 0.f, qv = 1.f;
#pragma unroll
                for (int s = 15; s >= 0; --s) { const float t = cv, tq = qv; cv = pv[s] * cv + hv[s]; qv *= pv[s]; hv[s] = t; pv[s] = tq; }
                CHKP[c * 16 + j] = qv; CHKH[c * 16 + j] = cv;
#pragma unroll
                for (int s = 0; s < 16; ++s) { SEGC[256 + s * 16 + j] = hv[s]; SEGQ[256 + s * 16 + j] = pv[s]; }
            } }
        __syncthreads();
        { const int tl = tid >> 1, hf8 = 8 * (tid & 1), sg = tl >> 4; const size_t row = (size_t)(row0 + c0 + tl);
            float hs[8], pb[8];
#pragma unroll
            for (int e4 = 0; e4 < 2; ++e4) { const int o = tl * 16 + hf8 + 4 * e4, so = sg * 16 + hf8 + 4 * e4;
                const f32x4 af = *(const LAS f32x4*)(AA + o), bf = *(const LAS f32x4*)(BB + o), ab = *(const LAS f32x4*)(AA + 4096 + o), bb = *(const LAS f32x4*)(BB + 4096 + o);
                const f32x4 cf = *(const LAS f32x4*)(SEGC + so), cbk = *(const LAS f32x4*)(SEGC + 256 + so), qb = *(const LAS f32x4*)(SEGQ + 256 + so);
                const f32x4 s = (bf + af * cf) + (bb + ab * cbk), pq = ab * qb;
#pragma unroll
                for (int e = 0; e < 4; ++e) { hs[4 * e4 + e] = s[e]; pb[4 * e4 + e] = pq[e]; } }
            if (last) { const v4u g = *(const LAS v4u*)(XG + tid * 8);
                v4u o; o.x = pk2(hs[0] * fgelu_tanh(bflo(g.x)), hs[1] * fgelu_tanh(bfhi(g.x))); o.y = pk2(hs[2] * fgelu_tanh(bflo(g.y)), hs[3] * fgelu_tanh(bfhi(g.y)));
                o.z = pk2(hs[4] * fgelu_tanh(bflo(g.z)), hs[5] * fgelu_tanh(bfhi(g.z))); o.w = pk2(hs[6] * fgelu_tanh(bflo(g.w)), hs[7] * fgelu_tanh(bfhi(g.w)));
                *(v4u*)(CAT + row * DMODEL + chb + hf8) = o; }
            else { f32x4* sp = (f32x4*)(HFG + row * DRNN + chb + hf8); f32x4* pp = (f32x4*)(PBG + row * DRNN + chb + hf8);
                sp[0] = (f32x4){hs[0], hs[1], hs[2], hs[3]}; sp[1] = (f32x4){hs[4], hs[5], hs[6], hs[7]};
                pp[0] = (f32x4){pb[0], pb[1], pb[2], pb[3]}; pp[1] = (f32x4){pb[4], pb[5], pb[6], pb[7]}; } }
        __syncthreads();
    }
    if (nch > 1) {
        if (tid < 16) { float cv = CHKH[(nch - 1) * 16 + tid];
            for (int c = nch - 2; c >= 0; --c) { CINB[c * 16 + tid] = cv; cv = CHKP[c * 16 + tid] * cv + CHKH[c * 16 + tid]; } }
        __syncthreads();
#pragma unroll
        for (int i = 0; i < 3; ++i) if (i < nch - 1) { const int tk = (tid >> 1) + 256 * i, hf8 = 8 * (tid & 1); const size_t row = (size_t)(row0 + tk);
            const f32x4* sp = (const f32x4*)(HFG + row * DRNN + chb + hf8); const f32x4* pp = (const f32x4*)(PBG + row * DRNN + chb + hf8);
            const f32x4 s0 = sp[0], s1 = sp[1], p0 = pp[0], p1 = pp[1];
            const v4u g = *(const v4u*)(U + row * NUC + 512 + chb + hf8);
            const f32x4 c0v = *(const LAS f32x4*)(CINB + i * 16 + hf8), c1v = *(const LAS f32x4*)(CINB + i * 16 + hf8 + 4);
            const f32x4 h0 = s0 + p0 * c0v, h1 = s1 + p1 * c1v;
            v4u o; o.x = pk2(h0[0] * fgelu_tanh(bflo(g.x)), h0[1] * fgelu_tanh(bfhi(g.x))); o.y = pk2(h0[2] * fgelu_tanh(bflo(g.y)), h0[3] * fgelu_tanh(bfhi(g.y)));
            o.z = pk2(h1[0] * fgelu_tanh(bflo(g.z)), h1[1] * fgelu_tanh(bfhi(g.z))); o.w = pk2(h1[2] * fgelu_tanh(bflo(g.w)), h1[3] * fgelu_tanh(bfhi(g.w)));
            *(v4u*)(CAT + row * DMODEL + chb + hf8) = o; }
    } else if (tid < 32) {
        const int d = tid >> 4, j = tid & 15;
        F.out[(size_t)M_TOK * DMODEL + (size_t)((seq * 4 + l) * 2 + d) * 512 + chb + j] = d == 0 ? CARF[j] : CHKH[j];
    }
    __syncthreads();
}

__device__ __forceinline__ void pool1d_unit(Frame F, int seq, int tb) {
    F.relaunder();
    const bf16* U = (const bf16*)(F.ws + WS_U); bf16* CAT = (bf16*)(F.ws + WS_CAT);
    const int row0 = seq * 256;
#pragma unroll 1
    for (int i = 0; i < 4; ++i) { const int id = F.tid + NTHREADS * i, t = tb * 64 + (id >> 5), v = id & 31, g = v >> 3, hw = 1 << g;
        const int lo = max(t - hw, 0), hi = min(t + hw, 256);
        v4u x[16];
#pragma unroll
        for (int k = 0; k < 16; ++k) { const int tt = t - 8 + k; x[k] = (v4u){0u, 0u, 0u, 0u}; if (tt >= lo && tt < hi) x[k] = *(const v4u*)(U + (size_t)(row0 + tt) * NUC + 1024 + 8 * v); }
        float s[8];
#pragma unroll
        for (int c = 0; c < 8; ++c) s[c] = 0.f;
#pragma unroll
        for (int k = 0; k < 16; ++k) { s[0] += bflo(x[k].x); s[1] += bfhi(x[k].x); s[2] += bflo(x[k].y); s[3] += bfhi(x[k].y); s[4] += bflo(x[k].z); s[5] += bfhi(x[k].z); s[6] += bflo(x[k].w); s[7] += bfhi(x[k].w); }
        const float inv = 1.0f / (float)(hi - lo);
        const v4u xs = x[8];
        v4u o; o.x = pk2(s[0] * inv - bflo(xs.x), s[1] * inv - bfhi(xs.x)); o.y = pk2(s[2] * inv - bflo(xs.y), s[3] * inv - bfhi(xs.y));
        o.z = pk2(s[4] * inv - bflo(xs.z), s[5] * inv - bfhi(xs.z)); o.w = pk2(s[6] * inv - bflo(xs.w), s[7] * inv - bfhi(xs.w));
        *(v4u*)(CAT + (size_t)(row0 + t) * DMODEL + 512 + 8 * v) = o; }
}
__device__ __forceinline__ void pool2d_unit(Frame F, int b, int g, int oc) {
    F.relaunder();
    const bf16* U = (const bf16*)(F.ws + WS_U); bf16* CAT = (bf16*)(F.ws + WS_CAT);
    LAS float* T1 = (LAS float*)F.lds;
    LAS float* T2 = (LAS float*)(F.lds + 32768);
    const int row0 = M_CTX + b * 1024, colb = 64 * g + 8 * oc, hw = 1 << g;
#pragma unroll
    for (int i = 0; i < 2; ++i) { const int t = F.tid + NTHREADS * i;
        const v4u x = *(const v4u*)(U + (size_t)(row0 + t) * NUC + 1024 + colb);
        *(LAS f32x4*)(T1 + t * 8) = (f32x4){bflo(x.x), bfhi(x.x), bflo(x.y), bfhi(x.y)}; *(LAS f32x4*)(T1 + t * 8 + 4) = (f32x4){bflo(x.z), bfhi(x.z), bflo(x.w), bfhi(x.w)}; }
    __syncthreads();
    const int j4 = 4 * (F.tid & 1), tq = F.tid >> 1;
#pragma unroll
    for (int i = 0; i < 4; ++i) { const int t = tq + 256 * i, r = t >> 6, c = t & 63, lo = max(c - hw, 0), hi = min(c + hw, 64);
        f32x4 s = {0.f, 0.f, 0.f, 0.f};
        for (int c2 = lo; c2 < hi; ++c2) s += *(const LAS f32x4*)(T1 + (r * 64 + c2) * 8 + j4);
        *(LAS f32x4*)(T2 + t * 8 + j4) = s * (1.0f / (float)(hi - lo)); }
    __syncthreads();
#pragma unroll
    for (int i = 0; i < 4; ++i) { const int t = tq + 256 * i, r = t >> 6, c = t & 63, lo = max(r - hw, 0), hi = min(r + hw, 16);
        f32x4 s = {0.f, 0.f, 0.f, 0.f};
        for (int r2 = lo; r2 < hi; ++r2) s += *(const LAS f32x4*)(T2 + (r2 * 64 + c) * 8 + j4);
        const f32x4 o = s * (1.0f / (float)(hi - lo)) - *(const LAS f32x4*)(T1 + t * 8 + j4);
        v2u w; w.x = pk2(o[0], o[1]); w.y = pk2(o[2], o[3]);
        *(v2u*)(CAT + (size_t)(row0 + t) * DMODEL + 512 + colb + j4) = w; }
    __syncthreads();
}
__device__ __forceinline__ void fourier_unit(Frame F, int seq, int hd, int nb) {
    F.relaunder();
    int L, row0; seq_geom(seq, L, row0);
    const int lane = F.lane, wave = F.wave, j16 = lane & 15, kq = 8 * (lane >> 4);
    const bf16* XCT = (const bf16*)(F.ws + WS_XCT) + (seq < 16 ? (size_t)(seq * 4 + hd) * 128 * 256 : pg8::XCT_LAT_OFF + (size_t)((seq - 16) * 4 + hd) * 128 * 1024);
    const bf16* T = seq < 16 ? (const bf16*)(F.ws + WS_T256) : (const bf16*)(F.ws + WS_T1024);
    const int K2 = 2 * L, kw = K2 / 8, kbeg = wave * kw;
    const int part = kbeg >= L;
    const bf16* Ab = XCT + (size_t)(part * 64) * L + (kbeg - part * L);
    const bf16* Bb = T + (size_t)(nb * 64) * K2 + kbeg;
    f32x4 acc[4][4];
#pragma unroll
    for (int mt = 0; mt < 4; ++mt)
#pragma unroll
        for (int nt = 0; nt < 4; ++nt) acc[mt][nt] = (f32x4){0.f, 0.f, 0.f, 0.f};
    for (int ks = 0; ks < kw; ks += 32) {
        bf16x8 a[4], b[4];
#pragma unroll
        for (int mt = 0; mt < 4; ++mt) a[mt] = *(const bf16x8*)(Ab + (size_t)(16 * mt + j16) * L + ks + kq);
#pragma unroll
        for (int nt = 0; nt < 4; ++nt) b[nt] = *(const bf16x8*)(Bb + (size_t)(16 * nt + j16) * K2 + ks + kq);
#pragma unroll
        for (int mt = 0; mt < 4; ++mt)
#pragma unroll
            for (int nt = 0; nt < 4; ++nt) acc[mt][nt] = __builtin_amdgcn_mfma_f32_16x16x32_bf16(a[mt], b[nt], acc[mt][nt], 0, 0, 0);
    }
    LAS float* red = (LAS float*)F.lds;
#pragma unroll
    for (int mt = 0; mt < 4; ++mt)
#pragma unroll
        for (int nt = 0; nt < 4; ++nt) *(LAS f32x4*)(red + (size_t)(wave * 64 + 16 * nt + j16) * 68 + 16 * mt + 4 * (lane >> 4)) = acc[mt][nt];
    __syncthreads();
    { const int kp = F.tid >> 3, mg = F.tid & 7;
        f32x4 s0 = {0.f, 0.f, 0.f, 0.f}, s1 = s0;
#pragma unroll
        for (int w = 0; w < 8; ++w) { const LAS f32x4* p = (const LAS f32x4*)(red + (size_t)(w * 64 + kp) * 68 + 8 * mg); s0 += p[0]; s1 += p[1]; }
        v4u o; o.x = pk2(s0[0], s0[1]); o.y = pk2(s0[2], s0[3]); o.z = pk2(s1[0], s1[1]); o.w = pk2(s1[2], s1[3]);
        *(v4u*)((bf16*)(F.ws + WS_CAT) + (size_t)(row0 + nb * 64 + kp) * DMODEL + 768 + 64 * hd + 8 * mg) = o; }
    __syncthreads();
}
#ifndef REP_LRU
#define REP_LRU 1
#endif
#ifndef REP_FOU
#define REP_FOU 1
#endif
#ifndef REP_POOL
#define REP_POOL 1
#endif
__device__ __forceinline__ void mixer_phase(const Frame& F, int l) {
    constexpr int N_LRU_LAT = 64, N_FOU_LAT = 128, N_P2D = 64, N_LRU_CTX = 512, N_FOU_CTX = 256, N_P1D = 64;
    constexpr int NREST = N_FOU_LAT + N_P2D + N_LRU_CTX + N_FOU_CTX + N_P1D;
    const int nlat = F.G >= 128 ? 64 : F.G / 4;
    if (F.bid < nlat) {
        for (int r = F.bid; r < N_LRU_LAT; r += nlat) {
#ifndef SKIP_LRU
            for (int rp = 0; rp < REP_LRU; ++rp) lru_unit(F, l, 16 + (r >> 5), (r >> 2) & 7, r & 3);
#endif
        }
        return;
    }
    for (int it = F.bid - nlat; it < NREST; it += F.G - nlat) {
        int r = it;
        if (r < N_P2D) {
#ifndef SKIP_POOL
            for (int rp = 0; rp < REP_POOL; ++rp) pool2d_unit(F, r >> 5, (r >> 3) & 3, r & 7);
#endif
            continue; } r -= N_P2D;
        if (r < N_FOU_LAT) {
#ifndef SKIP_FOU
            for (int rp = 0; rp < REP_FOU; ++rp) fourier_unit(F, 16 + (r >> 6), (r >> 4) & 3, r & 15);
#endif
            continue; } r -= N_FOU_LAT;
        if (r < N_LRU_CTX) {
#ifndef SKIP_LRU
            for (int rp = 0; rp < REP_LRU; ++rp) lru_unit(F, l, r >> 5, (r >> 2) & 7, r & 3);
#endif
            continue; } r -= N_LRU_CTX;
        if (r < N_FOU_CTX) {
#ifndef SKIP_FOU
            for (int rp = 0; rp < REP_FOU; ++rp) fourier_unit(F, r >> 4, (r >> 2) & 3, r & 3);
#endif
            continue; } r -= N_FOU_CTX;
#ifndef SKIP_POOL
        for (int rp = 0; rp < REP_POOL; ++rp) pool1d_unit(F, r >> 2, r & 3);
#endif
    }
}
#ifndef MK_PER_PHASE
#define MK_PER_PHASE 0
#endif
#ifndef MK_BARRIER
#define MK_BARRIER 1
#endif
#ifndef REP_P0
#define REP_P0 1
#endif
#ifndef REP_MIX
#define REP_MIX 1
#endif
#ifndef REP_G1
#define REP_G1 1
#endif
#ifndef REP_G3
#define REP_G3 1
#endif
constexpr int N_PHASES = 2 + 5 * DEPTHL + 1;
constexpr int CW_BAR = 4096;
__device__ __forceinline__ void final_norm(const Frame& F) {
    const int gw = F.bid * NWAVES + F.wave, NGW = F.G * NWAVES;
    const float* X = (const float*)(F.ws + WS_X); const float* ssq = (const float*)(F.ws + WS_SSQ) + (size_t)8 * M_TOK * 16;
    const f32x4* gp = (const f32x4*)F.inp(I_FG) + F.lane;
    for (int r = gw; r < M_TOK; r += NGW) {
        const float rs = pg8::row_rstd(ssq, r);
        const f32x4* xr = (const f32x4*)(X + (size_t)r * 1024) + F.lane; f32x4* o = (f32x4*)(F.out + (size_t)r * 1024) + F.lane;
#pragma unroll
        for (int j = 0; j < 4; ++j) o[64 * j] = xr[64 * j] * rs * gp[64 * j];
    }
}
__global__ void __launch_bounds__(NTHREADS, 2) mega(Params p) {
    extern __shared__ __attribute__((aligned(16))) unsigned char lds[];
    Frame F;
    F.lds = (LAS unsigned char*)lds; F.tid = threadIdx.x; F.lane = F.tid & 63; F.wave = __builtin_amdgcn_readfirstlane(F.tid >> 6);
    F.G = gridDim.x; F.bid = blockIdx.x; F.in = (const CAS cfp_t*)__builtin_amdgcn_kernarg_segment_ptr(); F.out0 = p.out; F.ws0 = p.ws; F.out = p.out; F.ws = p.ws;
#if MK_BARRIER
    volatile LAS unsigned* bst = (volatile LAS unsigned*)(F.lds + LDS_BYTES - 64);
    if (F.tid < 2) bst[F.tid] = 0u;
    __syncthreads();
    XcdBarrier bar = xcd_barrier_post((unsigned*)(p.ws + WS_CTL) + CW_BAR, bst);
#else
    cg::grid_group grid = cg::this_grid();
#endif
    for (int ph = p.ph_lo; ph < p.ph_hi; ++ph) {
        F.relaunder();
        bf16* A = (bf16*)(F.ws + WS_A); bf16* CAT = (bf16*)(F.ws + WS_CAT); bf16* HID = (bf16*)(F.ws + WS_HID); bf16* U = (bf16*)(F.ws + WS_U); bf16* XCT = (bf16*)(F.ws + WS_XCT);
        float* X = (float*)(F.ws + WS_X); float* SSQ = (float*)(F.ws + WS_SSQ); const float* MODS = (const float*)(F.ws + WS_MODS); const float* GV = (const float*)(F.ws + WS_GV);
        if (ph == 0) {
#ifndef SKIP_P0A
 p0a_mods(F);
#endif
 }
        else if (ph == 1) {
#ifndef SKIP_P0B
 { const bool defer = false && F.G >= 224;
   p0b_items(F, 0, defer ? 1 : DEPTHL, F.bid * NWAVES + F.wave, F.G * NWAVES, true); p0b_tail(F); }
#endif
 }
        else if (ph == N_PHASES - 1) final_norm(F);
        else {
            const int l = (ph - 2) / 5, k = (ph - 2) % 5;
            if (k == 0) {
                pg8::Gemm g{A, (const bf16*)(F.ws + WS_WIN) + (size_t)l * NINP * 1024, M_TOK, NINP, 1024}; pg8::StaticOrder S; S.init(M_TOK, NINP, F.G, F.bid);
                pg8::EpiIn E{U, XCT, SSQ + (size_t)(2 * l) * M_TOK * 16, (const float*)(F.ws + WS_BIASIN) + (size_t)l * 3 * NINP};
#ifndef SKIP_G1
                pg8::gemm_phase<pg8::EpiIn, pg8::StaticOrder, true, true>(F.lds, g, S, E);
#endif
            } else if (k == 1) {
#ifndef SKIP_MIX
                for (int rep = 0; rep < REP_MIX; ++rep) mixer_phase(F, l);
#endif
            } else if (k == 2 || k == 4) {
                const bool dn = k == 4;
                pg8::Gemm g{dn ? HID : CAT, dn ? (const bf16*)(F.ws + WS_W2) + (size_t)l * FFD * 1024 : (const bf16*)(F.ws + WS_WOUT) + (size_t)l * 1024 * 1024, M_TOK, 1024, dn ? FFD : 1024};
                pg8::StaticOrder192 S; S.init(M_TOK, 1024, F.G, F.bid);
                const float* Gn = dn ? (l < DEPTHL - 1 ? GV + (size_t)((l + 1) * 2 * 3) * 1024 : nullptr) : GV + (size_t)((l * 2 + 1) * 3) * 1024;
                const int inst = dn ? (l < DEPTHL - 1 ? 2 * (l + 1) : 8) : 2 * l + 1;
                pg8::EpiRes192 E{X, A, MODS + (size_t)l * 3 * 6144 + (dn ? 5 : 2) * 1024, Gn, SSQ + (size_t)inst * M_TOK * 16};
#ifndef SKIP_G24
                pg8::gemm_phase_m192<pg8::EpiRes192, pg8::StaticOrder192>(F.lds, g, S, E);
                if (false && dn && l + 1 < DEPTHL && F.G >= 224 && F.bid >= 192) p0b_items(F, l + 1, l + 2, (F.bid - 192) * NWAVES + F.wave, (F.G - 192) * NWAVES, false);
#endif
            } else {
                pg8::Gemm g{A, (const bf16*)(F.ws + WS_W1) + (size_t)l * FFD * 1024, M_TOK, FFD, 1024}; pg8::StaticOrder128 S; S.init(M_TOK, FFD, F.G, F.bid);
                pg8::EpiUp128 E{HID, SSQ + (size_t)(2 * l + 1) * M_TOK * 16, (const float*)(F.ws + WS_BIAS1) + (size_t)l * 3 * FFD};
#ifndef SKIP_G3
                pg8::gemm_phase_n128<pg8::EpiUp128, pg8::StaticOrder128>(F.lds, g, S, E);
#endif
            }
        }
#if MK_BARRIER
        if (ph + 1 < p.ph_hi) xcd_barrier(bar);
#else
        if (ph + 1 < p.ph_hi) grid.sync();
#endif
    }
}

extern "C" void kernel_launch(void* const* d_in, const int* in_sizes, int n_in, void* d_out, int out_size, void* d_ws, size_t ws_size, hipStream_t stream) {
    static int grid = 0;
    if (grid == 0) {
        if (n_in != 24 || ws_size < WS_END) { fprintf(stderr, "kernel_launch: expected 24 inputs and >= %zu bytes of workspace (got %d, %zu)\n", (size_t)WS_END, n_in, ws_size); grid = -1; return; }
        int dev = 0, cus = 0, per_cu = 0;
        if (hipGetDevice(&dev) != hipSuccess || hipDeviceGetAttribute(&cus, hipDeviceAttributeMultiprocessorCount, dev) != hipSuccess) { grid = -1; return; }
        if (hipFuncSetAttribute((const void*)mega, hipFuncAttributeMaxDynamicSharedMemorySize, LDS_BYTES) != hipSuccess) { fprintf(stderr, "kernel_launch: hipFuncSetAttribute failed\n"); grid = -1; return; }
        if (hipOccupancyMaxActiveBlocksPerMultiprocessor(&per_cu, (const void*)mega, NTHREADS, LDS_BYTES) != hipSuccess || per_cu < 1) { fprintf(stderr, "kernel_launch: occupancy query says %d blocks per CU\n", per_cu); grid = -1; return; }
        grid = cus;
    }
    if (grid < 0) return;
    Params p{};
    for (int i = 0; i < 24; ++i) p.in[i] = (const float*)d_in[i];
    p.out = (float*)d_out; p.ws = (unsigned char*)d_ws;
    hipMemsetAsync((char*)d_ws + WS_CTL, 0, CTL_BYTES, stream);
#if MK_PER_PHASE
    for (int ph = 0; ph < N_PHASES; ++ph) { p.ph_lo = ph; p.ph_hi = ph + 1; hipLaunchKernelGGL(mega, dim3(grid), dim3(NTHREADS), LDS_BYTES, stream, p); }
#else
    p.ph_lo = 0; p.ph_hi = N_PHASES;
    void* args[] = {&p};
    hipError_t e = hipLaunchCooperativeKernel((const void*)mega, dim3(grid), dim3(NTHREADS), args, LDS_BYTES, stream);
    if (e != hipSuccess) fprintf(stderr, "kernel_launch: cooperative launch failed: %s (grid %d)\n", hipGetErrorString(e), grid);
#endif
}
```

```cpp
#include <hip/hip_runtime.h>
#include <hip/hip_cooperative_groups.h>
#include <cstdio>
#include <cstdint>
namespace cg = cooperative_groups;
#define MK_PER_PHASE 0
namespace pg8 {
#define PG8_LAS __attribute__((address_space(3)))
typedef unsigned short bf16_t;
typedef short bf16x8 __attribute__((ext_vector_type(8)));
typedef float f32x4 __attribute__((ext_vector_type(4)));
typedef unsigned u32x4 __attribute__((ext_vector_type(4)));
constexpr int BM = 256, BK = 64, HALF = 128, HTB = HALF * BK * 2  , STAGE_BYTES = 8 * HTB, NXCD = 8, WGM = 8;

__host__ __device__ __forceinline__ int lds_byte(int r, int c) { const int st = (r >> 4) * 2 + (c >> 5), rr = r & 15, cc = c & 31, ob = rr * 64 + cc * 2; return st * 1024 + (ob ^ (((ob >> 9) & 1) << 5)); }
__host__ __device__ __forceinline__ void stage_rc(int b, int& R, int& C) { const int st = b / 1024, sb = b % 1024, swz = sb ^ (((sb >> 9) & 1) << 5); R = (st >> 1) * 16 + swz / 64; C = (st & 1) * 32 + (swz % 64) / 2; }
__host__ __device__ __forceinline__ int perm32(int rho) { const int n = rho >> 4, i = rho & 15; return 8 * (i >> 2) + 4 * n + (i & 3); }

struct Unit { int pm, pn; };
struct Gemm { const bf16_t* A; const bf16_t* Bt; int M, N, K; };

struct StaticOrder {
    int nM, nN, nwg, G, c;
    __host__ __device__ void init(int M, int N, int G_, int c_) { nM = M / BM; nN = N / BM; nwg = nM * nN; G = G_; c = c_; }
    __host__ __device__ bool next(int i, Unit& u) const {
        const long L = (long)i * G + c; if (L >= nwg) return false;
        int wgid = (int)L; { const int q = nwg / NXCD, r = nwg % NXCD, xcd = wgid % NXCD, off = wgid / NXCD; wgid = (xcd < r ? xcd * (q + 1) : r * (q + 1) + (xcd - r) * q) + off; }
        const int nig = WGM * nN, gid = wgid / nig, fm = gid * WGM, gsz = (nM - fm) < WGM ? (nM - fm) : WGM;
        u.pm = fm + ((wgid % nig) % gsz); u.pn = (wgid % nig) / gsz; return true;
    }
    __device__ __forceinline__ void a_ready(const Unit&) const {}
    __device__ __forceinline__ void done(const Unit&) const {}
};

__device__ __forceinline__ unsigned cvt_pk_bf16(float lo, float hi) { unsigned r; asm volatile("v_cvt_pk_bf16_f32 %0, %1, %2" : "=v"(r) : "v"(lo), "v"(hi)); return r; }
typedef float f32x2 __attribute__((ext_vector_type(2)));
typedef unsigned u32x2 __attribute__((ext_vector_type(2)));
constexpr int NIN = 1792, DM = 1024, DFF = 4096, NU = 1280, SSQW = 16;
constexpr size_t XCT_LAT_OFF = (size_t)16 * 4 * 128 * 256;
__device__ __forceinline__ int cond_of_panel(int pm) { return pm < 16 ? 0 : (pm < 20 ? 1 : 2); }
__device__ __forceinline__ float row_rstd(const float* ssq, int row) {
    const f32x4* sp = (const f32x4*)(ssq + (size_t)row * SSQW);
    const f32x4 s = (sp[0] + sp[1]) + (sp[2] + sp[3]);
    return 1.0f / sqrtf(((s[0] + s[1]) + (s[2] + s[3])) * (1.0f / 1024.0f) + 1e-6f);
}
struct EpiIn {
    static constexpr bool PERM = true, AFTER_DRAIN = false;
    bf16_t* U; bf16_t* XCT; const float* ssq; const float* bias;
    __device__ __forceinline__ void operator()(const f32x4 (&acc)[2][2][4][2], const Unit& u, int wr, int wc, int fr, int fq) const {
        const int cond = cond_of_panel(u.pm);
        const int bcol0 = u.pn * BM + wc * 32 + 8 * fq;
        f32x4 bv[2][2];
#pragma unroll
        for (int bj = 0; bj < 2; ++bj)
#pragma unroll
            for (int n = 0; n < 2; ++n) bv[bj][n] = *(const f32x4*)(bias + cond * NIN + bcol0 + bj * HALF + 4 * n);
#pragma unroll
        for (int ai = 0; ai < 2; ++ai)
#pragma unroll
            for (int m = 0; m < 4; ++m) {
                const int row = u.pm * BM + ai * HALF + wr * 64 + m * 16 + fr;
                const float rs = row_rstd(ssq, row);
#pragma unroll
                for (int bj = 0; bj < 2; ++bj) {
                    const f32x4 v0 = acc[ai][bj][m][0] * rs + bv[bj][0], v1 = acc[ai][bj][m][1] * rs + bv[bj][1];
                    u32x4 w; w.x = cvt_pk_bf16(v0[0], v0[1]); w.y = cvt_pk_bf16(v0[2], v0[3]); w.z = cvt_pk_bf16(v1[0], v1[1]); w.w = cvt_pk_bf16(v1[2], v1[3]);
                    if (u.pn < 5) { *(u32x4*)(U + (size_t)row * NU + bcol0 + bj * HALF) = w; }
                    else {
                        const int cc = bcol0 + bj * HALF - NU, hd = cc >> 7, mm = cc & 127;
                        bf16_t* p; int ls;
                        if (u.pm < 16) { ls = 256; p = XCT + ((size_t)(u.pm * 4 + hd) * 128 + mm) * 256 + (row & 255); }
                        else { const int rl = row - 4096; ls = 1024; p = XCT + XCT_LAT_OFF + ((size_t)((rl >> 10) * 4 + hd) * 128 + mm) * 1024 + (rl & 1023); }
                        p[0] = (bf16_t)(w.x & 0xffffu); p[ls] = (bf16_t)(w.x >> 16); p[2 * ls] = (bf16_t)(w.y & 0xffffu); p[3 * ls] = (bf16_t)(w.y >> 16);
                        p[4 * ls] = (bf16_t)(w.z & 0xffffu); p[5 * ls] = (bf16_t)(w.z >> 16); p[6 * ls] = (bf16_t)(w.w & 0xffffu); p[7 * ls] = (bf16_t)(w.w >> 16);
                    }
                }
                asm volatile("" ::: "memory");
            }
    }
};
struct EpiUp {
    static constexpr bool PERM = true, AFTER_DRAIN = false;
    bf16_t* H; const float* ssq; const float* bias;
    __device__ __forceinline__ void operator()(const f32x4 (&acc)[2][2][4][2], const Unit& u, int wr, int wc, int fr, int fq) const {
        const int cond = cond_of_panel(u.pm);
        const int bcol0 = u.pn * BM + wc * 32 + 8 * fq;
        f32x4 bv[2][2];
#pragma unroll
        for (int bj = 0; bj < 2; ++bj)
#pragma unroll
            for (int n = 0; n < 2; ++n) bv[bj][n] = *(const f32x4*)(bias + cond * DFF + bcol0 + bj * HALF + 4 * n);
#pragma unroll
        for (int ai = 0; ai < 2; ++ai)
#pragma unroll
            for (int m = 0; m < 4; ++m) {
                const int row = u.pm * BM + ai * HALF + wr * 64 + m * 16 + fr;
                const float rs = row_rstd(ssq, row);
#pragma unroll
                for (int bj = 0; bj < 2; ++bj) {
                    f32x4 v0 = acc[ai][bj][m][0] * rs + bv[bj][0], v1 = acc[ai][bj][m][1] * rs + bv[bj][1];
                    v0 = __builtin_elementwise_max(v0, (f32x4){0.f, 0.f, 0.f, 0.f}); v1 = __builtin_elementwise_max(v1, (f32x4){0.f, 0.f, 0.f, 0.f});
                    v0 = v0 * v0; v1 = v1 * v1;
                    u32x4 w; w.x = cvt_pk_bf16(v0[0], v0[1]); w.y = cvt_pk_bf16(v0[2], v0[3]); w.z = cvt_pk_bf16(v1[0], v1[1]); w.w = cvt_pk_bf16(v1[2], v1[3]);
                    *(u32x4*)(H + (size_t)row * DFF + bcol0 + bj * HALF) = w;
                }
                if (m & 1) asm volatile("" ::: "memory");
            }
    }
};
struct EpiRes {
    static constexpr bool PERM = false, AFTER_DRAIN = false;
    float* X; bf16_t* A; const float* gate; const float* Gn; float* ssq_out;
    __device__ __forceinline__ void operator()(const f32x4 (&acc)[2][2][4][2], const Unit& u, int wr, int wc, int fr, int fq) const {
        const int cond = cond_of_panel(u.pm);
        const int col0 = u.pn * BM + wc * 32 + 4 * fq;
#pragma unroll
        for (int ai = 0; ai < 2; ++ai)
#pragma unroll
            for (int m = 0; m < 4; ++m) {
                const int row = u.pm * BM + ai * HALF + wr * 64 + m * 16 + fr;
                float q = 0.f;
#pragma unroll
                for (int bj = 0; bj < 2; ++bj)
#pragma unroll
                    for (int n = 0; n < 2; ++n) {
                        const int c = col0 + bj * HALF + n * 16;
                        float* xp = X + (size_t)row * DM + c;
                        const f32x4 g4 = *(const f32x4*)(gate + cond * 6144 + c);
                        const f32x4 x1 = *(const f32x4*)xp + g4 * acc[ai][bj][m][n];
                        *(f32x4*)xp = x1;
                        q += (x1[0] * x1[0] + x1[1] * x1[1]) + (x1[2] * x1[2] + x1[3] * x1[3]);
                        if (Gn) { const f32x4 a = x1 * *(const f32x4*)(Gn + cond * DM + c); u32x2 w; w.x = cvt_pk_bf16(a[0], a[1]); w.y = cvt_pk_bf16(a[2], a[3]);
                            *(u32x2*)(A + (size_t)row * DM + c) = w; }
                    }
                q += __shfl_xor(q, 16); q += __shfl_xor(q, 32);
                if (fq == 0) ssq_out[(size_t)row * SSQW + u.pn * 4 + wc] = q;
                if (m & 1) asm volatile("" ::: "memory");
            }
    }
};
template <class Epi, class Sched, bool ALIGN_EPI = false, bool SP2 = false>
__device__ __forceinline__ void gemm_phase(PG8_LAS unsigned char* lds, const Gemm g, const Sched& S, const Epi& E, int tid_in) {
    int tid_ = tid_in; asm volatile("" : "+v"(tid_)); const int tid = tid_, wid = __builtin_amdgcn_readfirstlane(tid >> 6), lane = tid & 63, wr = wid >> 2, wc = wid & 3, fr = lane & 15, fq = lane >> 4;
    const int K = g.K, nt = K / BK;
    unsigned voffA[2], voffB[2];
#pragma unroll
    for (int i = 0; i < 2; ++i) { int R, C; stage_rc(tid * 16 + i * 8192, R, C); const int Rb = Epi::PERM ? ((R & ~31) + perm32(R & 31)) : R;
        voffA[i] = (unsigned)(R * K + C) * 2u; voffB[i] = (unsigned)(Rb * K + C) * 2u; }
    const size_t kstep = (size_t)(BK * 2);
    const size_t hstep = (size_t)HALF * K * 2;
    const size_t tstep = 2 * hstep;
    const unsigned ldsw = (unsigned)wid * 1024u;
    const int aoff = lds_byte(wr * 64 + fr, fq * 8), boff = lds_byte(wc * 32 + fr, fq * 8);
#define PG8_SA(b, h) (((b) * 2 + (h)) * HTB)
#define PG8_SB(b, h) ((4 + (b) * 2 + (h)) * HTB)
#define PG8_STAGE(bufoff, gbase, voff) do { _Pragma("unroll") for (int _i = 0; _i < 2; ++_i) \
        __builtin_amdgcn_global_load_lds((const unsigned*)((const char*)(gbase) + (voff)[_i]), (PG8_LAS unsigned*)(lds + (bufoff) + ldsw + _i * 8192), 16, 0, 0); } while (0)
#define PG8_LDA(dst, b, h) do { _Pragma("unroll") for (int m = 0; m < 4; ++m) _Pragma("unroll") for (int k = 0; k < 2; ++k) dst[m][k] = *(const PG8_LAS bf16x8*)(lds + PG8_SA(b, h) + aoff + m * 2048 + k * 1024); } while (0)
#define PG8_LDB(dst, b, h) do { _Pragma("unroll") for (int n = 0; n < 2; ++n) _Pragma("unroll") for (int k = 0; k < 2; ++k) dst[n][k] = *(const PG8_LAS bf16x8*)(lds + PG8_SB(b, h) + boff + n * 2048 + k * 1024); } while (0)
#define PG8_MMA(ai, bj, At, Bt) do { __builtin_amdgcn_s_setprio(1); _Pragma("unroll") for (int m = 0; m < 4; ++m) _Pragma("unroll") for (int n = 0; n < 2; ++n) _Pragma("unroll") for (int k = 0; k < 2; ++k) \
        acc[ai][bj][m][n] = __builtin_amdgcn_mfma_f32_16x16x32_bf16(Bt[n][k], At[m][k], acc[ai][bj][m][n], 0, 0, 0); __builtin_amdgcn_s_setprio(0); } while (0)
#define PG8_WAIT_V(n) asm volatile("s_waitcnt vmcnt(" #n ")" ::: "memory")
#define PG8_WAIT_L(n) asm volatile("s_waitcnt lgkmcnt(" #n ")" ::: "memory")
#define PG8_BAR __builtin_amdgcn_s_barrier()
#define PG8_SCHED __builtin_amdgcn_sched_barrier(0)
    Unit cur, nxt; int ui = 0;
    if (!S.next(0, cur)) return;
    f32x4 acc[2][2][4][2];
#pragma unroll
    for (int a = 0; a < 2; ++a)
#pragma unroll
        for (int b = 0; b < 2; ++b)
#pragma unroll
            for (int m = 0; m < 4; ++m)
#pragma unroll
                for (int n = 0; n < 2; ++n) acc[a][b][m][n] = (f32x4){0.f, 0.f, 0.f, 0.f};
    bf16x8 At[4][2], B0[2][2], B1[2][2];
    const char* cA = (const char*)g.A + (size_t)cur.pm * tstep; const char* cB = (const char*)g.Bt + (size_t)cur.pn * tstep;
    S.a_ready(cur);
    if constexpr (SP2) {
        PG8_STAGE(PG8_SB(0, 0), cB, voffB); PG8_STAGE(PG8_SB(0, 1), cB + hstep, voffB); PG8_STAGE(PG8_SA(0, 0), cA, voffA); PG8_STAGE(PG8_SA(0, 1), cA + hstep, voffA);
        if (wr == 1) PG8_BAR;
        PG8_WAIT_V(2); PG8_BAR;
        PG8_STAGE(PG8_SB(1, 0), cB + kstep, voffB); PG8_STAGE(PG8_SA(1, 0), cA + kstep, voffA); PG8_STAGE(PG8_SB(1, 1), cB + hstep + kstep, voffB);
        PG8_WAIT_V(6); PG8_BAR;
    } else {
        PG8_STAGE(PG8_SB(0, 0), cB, voffB); PG8_STAGE(PG8_SA(0, 0), cA, voffA); PG8_STAGE(PG8_SB(0, 1), cB + hstep, voffB); PG8_STAGE(PG8_SA(0, 1), cA + hstep, voffA);
        if (wr == 1) PG8_BAR;
        PG8_WAIT_V(4); PG8_BAR;
        PG8_STAGE(PG8_SB(1, 0), cB + kstep, voffB); PG8_STAGE(PG8_SA(1, 0), cA + kstep, voffA); PG8_STAGE(PG8_SB(1, 1), cB + hstep + kstep, voffB);
        PG8_WAIT_V(6); PG8_BAR;
    }
    for (;;) {
        const bool has_next = S.next(ui + 1, nxt);
        const char* nA = has_next ? (const char*)g.A + (size_t)nxt.pm * tstep : cA; const char* nB = has_next ? (const char*)g.Bt + (size_t)nxt.pn * tstep : cB;
        for (int t = 0; t < nt; t += 2) {
            const bool last = (t == nt - 2);
            const char* a1 = cA + (size_t)(t + 1) * kstep;
            const char* a2 = last ? nA : cA + (size_t)(t + 2) * kstep; const char* b2 = last ? nB : cB + (size_t)(t + 2) * kstep;
            const char* a3 = a2 + kstep; const char* b3 = b2 + kstep;
            if (last && has_next) S.a_ready(nxt);
            if constexpr (SP2) {
            PG8_LDB(B0, 0, 0); PG8_LDB(B1, 0, 1); PG8_SCHED; PG8_LDA(At, 0, 0); PG8_STAGE(PG8_SA(1, 1), a1 + hstep, voffA);
            PG8_WAIT_V(8); PG8_WAIT_L(0); PG8_BAR; PG8_MMA(0, 0, At, B0); PG8_MMA(0, 1, At, B1); PG8_BAR; PG8_SCHED;
            PG8_LDA(At, 0, 1); PG8_STAGE(PG8_SB(0, 0), b2, voffB); PG8_STAGE(PG8_SB(0, 1), b2 + hstep, voffB); PG8_STAGE(PG8_SA(0, 0), a2, voffA);
            PG8_WAIT_V(8); PG8_WAIT_L(0); PG8_BAR; PG8_MMA(1, 0, At, B0); PG8_MMA(1, 1, At, B1); PG8_BAR; PG8_SCHED;
            PG8_LDB(B0, 1, 0); PG8_LDB(B1, 1, 1); PG8_SCHED; PG8_LDA(At, 1, 0); PG8_STAGE(PG8_SA(0, 1), a2 + hstep, voffA);
            PG8_WAIT_V(8); PG8_WAIT_L(0); PG8_BAR; PG8_MMA(0, 0, At, B0); PG8_MMA(0, 1, At, B1); PG8_BAR; PG8_SCHED;
            PG8_LDA(At, 1, 1); PG8_STAGE(PG8_SB(1, 0), b3, voffB); PG8_STAGE(PG8_SB(1, 1), b3 + hstep, voffB); PG8_STAGE(PG8_SA(1, 0), a3, voffA);
            PG8_WAIT_V(8); PG8_WAIT_L(0); PG8_BAR; PG8_MMA(1, 0, At, B0); PG8_MMA(1, 1, At, B1); PG8_BAR; PG8_SCHED;
            } else {
            PG8_LDB(B0, 0, 0); PG8_SCHED; PG8_LDA(At, 0, 0); PG8_STAGE(PG8_SA(1, 1), a1 + hstep, voffA);
            PG8_WAIT_L(8); PG8_BAR; PG8_WAIT_L(0); PG8_MMA(0, 0, At, B0); PG8_BAR; PG8_SCHED;
            PG8_LDB(B1, 0, 1); PG8_STAGE(PG8_SB(0, 0), b2, voffB);
            PG8_BAR; PG8_WAIT_L(0); PG8_MMA(0, 1, At, B1); PG8_BAR;
            PG8_LDA(At, 0, 1); PG8_STAGE(PG8_SA(0, 0), a2, voffA);
            PG8_BAR; PG8_WAIT_L(0); PG8_MMA(1, 0, At, B0); PG8_BAR; PG8_SCHED;
            PG8_STAGE(PG8_SB(0, 1), b2 + hstep, voffB);
            PG8_WAIT_V(6); PG8_BAR; PG8_MMA(1, 1, At, B1); PG8_BAR;
            PG8_LDB(B0, 1, 0); PG8_SCHED; PG8_LDA(At, 1, 0); PG8_STAGE(PG8_SA(0, 1), a2 + hstep, voffA);
            PG8_WAIT_L(8); PG8_BAR; PG8_WAIT_L(0); PG8_MMA(0, 0, At, B0); PG8_BAR; PG8_SCHED;
            PG8_LDB(B1, 1, 1); PG8_STAGE(PG8_SB(1, 0), b3, voffB);
            PG8_BAR; PG8_WAIT_L(0); PG8_MMA(0, 1, At, B1); PG8_BAR;
            PG8_LDA(At, 1, 1); PG8_STAGE(PG8_SA(1, 0), a3, voffA);
            PG8_BAR; PG8_WAIT_L(0); PG8_MMA(1, 0, At, B0); PG8_BAR; PG8_SCHED;
            PG8_STAGE(PG8_SB(1, 1), b3 + hstep, voffB);
            PG8_WAIT_V(6); PG8_BAR; PG8_MMA(1, 1, At, B1); PG8_BAR;
            }
        }
        if constexpr (ALIGN_EPI) { if (wr == 0) PG8_BAR; }
        if constexpr (!Epi::AFTER_DRAIN) { E(acc, cur, wr, wc, fr, fq); S.done(cur); }
        if (!has_next) break;
#pragma unroll
        for (int a = 0; a < 2; ++a)
#pragma unroll
            for (int b = 0; b < 2; ++b)
#pragma unroll
                for (int m = 0; m < 4; ++m)
#pragma unroll
                    for (int n = 0; n < 2; ++n) acc[a][b][m][n] = (f32x4){0.f, 0.f, 0.f, 0.f};
        cur = nxt; cA = nA; cB = nB; ++ui;
        if constexpr (ALIGN_EPI) { if (wr == 1) PG8_BAR; }
    }
    PG8_WAIT_V(0);
    if constexpr (!ALIGN_EPI) { if (wr == 0) PG8_BAR; }
    PG8_BAR;
    if constexpr (Epi::AFTER_DRAIN) { E.fused(acc, cur, wr, wc, fr, fq, lds, wid, lane); S.done(cur); }
#undef PG8_SA
#undef PG8_SB
#undef PG8_STAGE
#undef PG8_LDA
#undef PG8_LDB
#undef PG8_MMA
#undef PG8_WAIT_V
#undef PG8_WAIT_L
#undef PG8_BAR
#undef PG8_SCHED
}
struct StaticOrder128 {
    int nM, nN, nwg, G, c, pm0;
    __host__ __device__ void init(int M, int N, int G_, int c_, int pm0_ = 0) { nM = M / BM; nN = N / HALF; nwg = nM * nN; G = G_; c = c_; pm0 = pm0_; }
    __host__ __device__ bool next(int i, Unit& u) const {
        const long L = (long)i * G + c; if (L >= nwg) return false;
        int wgid = (int)L; { const int q = nwg / NXCD, r = nwg % NXCD, xcd = wgid % NXCD, off = wgid / NXCD; wgid = (xcd < r ? xcd * (q + 1) : r * (q + 1) + (xcd - r) * q) + off; }
        const int nig = WGM * nN, gid = wgid / nig, fm = gid * WGM, gsz = (nM - fm) < WGM ? (nM - fm) : WGM;
        u.pm = pm0 + fm + ((wgid % nig) % gsz); u.pn = (wgid % nig) / gsz; return true;
    }
    __device__ __forceinline__ void a_ready(const Unit&) const {}
    __device__ __forceinline__ void done(const Unit&) const {}
};
template <class Epi, class Sched>
__device__ __forceinline__ void gemm_phase_n128(PG8_LAS unsigned char* lds, const Gemm g, const Sched& S, const Epi& E, int tid_in) {
    int tid_ = tid_in; asm volatile("" : "+v"(tid_));
    const int tid = tid_, wid = __builtin_amdgcn_readfirstlane(tid >> 6), lane = tid & 63, wh = wid >> 2, wr = wid >> 1, wc = wid & 1, fr = lane & 15, fq = lane >> 4;
    const int K = g.K, nt = K / BK;
    unsigned voffA[2], voffB[2];
#pragma unroll
    for (int i = 0; i < 2; ++i) { int R, C; stage_rc(tid * 16 + i * 8192, R, C); const int Rb = Epi::PERM ? ((R & ~31) + perm32(R & 31)) : R;
        voffA[i] = (unsigned)(R * K + C) * 2u; voffB[i] = (unsigned)(Rb * K + C) * 2u; }
    const size_t kstep = (size_t)(BK * 2);
    const size_t hstep = (size_t)HALF * K * 2;
    const size_t tstep = 2 * hstep;
    const unsigned ldsw = (unsigned)wid * 1024u;
    const int aoff = lds_byte(wr * 32 + fr, fq * 8), boff = lds_byte(wc * 64 + fr, fq * 8);
#define PG8_SA(b, h) (((b) * 2 + (h)) * HTB)
#define PG8_SB(b) ((4 + (b) * 2) * HTB)
#define PG8_STAGE(bufoff, gbase, voff) do { _Pragma("unroll") for (int _i = 0; _i < 2; ++_i) \
        __builtin_amdgcn_global_load_lds((const unsigned*)((const char*)(gbase) + (voff)[_i]), (PG8_LAS unsigned*)(lds + (bufoff) + ldsw + _i * 8192), 16, 0, 0); } while (0)
#define PG8_LDA(dst, b, h) do { _Pragma("unroll") for (int m = 0; m < 2; ++m) _Pragma("unroll") for (int k = 0; k < 2; ++k) dst[m][k] = *(const PG8_LAS bf16x8*)(lds + PG8_SA(b, h) + aoff + m * 2048 + k * 1024); } while (0)
#define PG8_LDB(dst, b) do { _Pragma("unroll") for (int n = 0; n < 4; ++n) _Pragma("unroll") for (int k = 0; k < 2; ++k) dst[n][k] = *(const PG8_LAS bf16x8*)(lds + PG8_SB(b) + boff + n * 2048 + k * 1024); } while (0)
#define PG8_MMA(ai, At, Bt) do { __builtin_amdgcn_s_setprio(1); _Pragma("unroll") for (int m = 0; m < 2; ++m) _Pragma("unroll") for (int n = 0; n < 4; ++n) _Pragma("unroll") for (int k = 0; k < 2; ++k) \
        acc[ai][m][n] = __builtin_amdgcn_mfma_f32_16x16x32_bf16(Bt[n][k], At[m][k], acc[ai][m][n], 0, 0, 0); __builtin_amdgcn_s_setprio(0); } while (0)
#define PG8_WAIT_V(n) asm volatile("s_waitcnt vmcnt(" #n ")" ::: "memory")
#define PG8_WAIT_L(n) asm volatile("s_waitcnt lgkmcnt(" #n ")" ::: "memory")
#define PG8_BAR __builtin_amdgcn_s_barrier()
#define PG8_SCHED __builtin_amdgcn_sched_barrier(0)
    Unit cur, nxt; int ui = 0;
    if (!S.next(0, cur)) return;
    f32x4 acc[2][2][4];
#pragma unroll
    for (int a = 0; a < 2; ++a)
#pragma unroll
        for (int m = 0; m < 2; ++m)
#pragma unroll
            for (int n = 0; n < 4; ++n) acc[a][m][n] = (f32x4){0.f, 0.f, 0.f, 0.f};
    bf16x8 At[2][2], Bf[4][2];
    const char* cA = (const char*)g.A + (size_t)cur.pm * tstep; const char* cB = (const char*)g.Bt + (size_t)cur.pn * hstep;
    S.a_ready(cur);
    PG8_STAGE(PG8_SB(0), cB, voffB); PG8_STAGE(PG8_SA(0, 0), cA, voffA); PG8_STAGE(PG8_SA(0, 1), cA + hstep, voffA);
    if (wh == 1) PG8_BAR;
    PG8_WAIT_V(2); PG8_BAR;
    PG8_STAGE(PG8_SB(1), cB + kstep, voffB); PG8_STAGE(PG8_SA(1, 0), cA + kstep, voffA);
    PG8_WAIT_V(4); PG8_BAR;
    for (;;) {
        const bool has_next = S.next(ui + 1, nxt);
        const char* nA = has_next ? (const char*)g.A + (size_t)nxt.pm * tstep : cA; const char* nB = has_next ? (const char*)g.Bt + (size_t)nxt.pn * hstep : cB;
        for (int t = 0; t < nt; t += 2) {
            const bool last = (t == nt - 2);
            const char* a1 = cA + (size_t)(t + 1) * kstep;
            const char* a2 = last ? nA : cA + (size_t)(t + 2) * kstep; const char* b2 = last ? nB : cB + (size_t)(t + 2) * kstep;
            const char* a3 = a2 + kstep; const char* b3 = b2 + kstep;
            if (last && has_next) S.a_ready(nxt);
            PG8_LDB(Bf, 0); PG8_SCHED; PG8_LDA(At, 0, 0); PG8_STAGE(PG8_SA(1, 1), a1 + hstep, voffA);
            PG8_WAIT_V(6); PG8_WAIT_L(0); PG8_BAR; PG8_MMA(0, At, Bf); PG8_BAR; PG8_SCHED;
            PG8_LDA(At, 0, 1); PG8_STAGE(PG8_SB(0), b2, voffB); PG8_STAGE(PG8_SA(0, 0), a2, voffA);
            PG8_WAIT_V(6); PG8_WAIT_L(0); PG8_BAR; PG8_MMA(1, At, Bf); PG8_BAR; PG8_SCHED;
            PG8_LDB(Bf, 1); PG8_SCHED; PG8_LDA(At, 1, 0); PG8_STAGE(PG8_SA(0, 1), a2 + hstep, voffA);
            PG8_WAIT_V(6); PG8_WAIT_L(0); PG8_BAR; PG8_MMA(0, At, Bf); PG8_BAR; PG8_SCHED;
            PG8_LDA(At, 1, 1); PG8_STAGE(PG8_SB(1), b3, voffB); PG8_STAGE(PG8_SA(1, 0), a3, voffA);
            PG8_WAIT_V(6); PG8_WAIT_L(0); PG8_BAR; PG8_MMA(1, At, Bf); PG8_BAR; PG8_SCHED;
        }
        if (wh == 0) PG8_BAR;
        E(acc, cur, wr, wc, fr, fq); S.done(cur);
        if (!has_next) break;
#pragma unroll
        for (int a = 0; a < 2; ++a)
#pragma unroll
            for (int m = 0; m < 2; ++m)
#pragma unroll
                for (int n = 0; n < 4; ++n) acc[a][m][n] = (f32x4){0.f, 0.f, 0.f, 0.f};
        cur = nxt; cA = nA; cB = nB; ++ui;
        if (wh == 1) PG8_BAR;
    }
    PG8_WAIT_V(0);
    PG8_BAR;
#undef PG8_SA
#undef PG8_SB
#undef PG8_STAGE
#undef PG8_LDA
#undef PG8_LDB
#undef PG8_MMA
#undef PG8_WAIT_V
#undef PG8_WAIT_L
#undef PG8_BAR
#undef PG8_SCHED
}
struct EpiUp128 {
    static constexpr bool PERM = true;
    bf16_t* H; const float* ssq; const float* bias;
    __device__ __forceinline__ void operator()(const f32x4 (&acc)[2][2][4], const Unit& u, int wr, int wc, int fr, int fq) const {
        const int cond = cond_of_panel(u.pm);
        const int bcol0 = u.pn * HALF + wc * 64 + 8 * fq;
        f32x4 bv[2][2];
#pragma unroll
        for (int g2 = 0; g2 < 2; ++g2)
#pragma unroll
            for (int n = 0; n < 2; ++n) bv[g2][n] = *(const f32x4*)(bias + cond * DFF + bcol0 + 32 * g2 + 4 * n);
#pragma unroll
        for (int ai = 0; ai < 2; ++ai)
#pragma unroll
            for (int m = 0; m < 2; ++m) {
                const int row = u.pm * BM + ai * HALF + wr * 32 + m * 16 + fr;
                const float rs = row_rstd(ssq, row);
#pragma unroll
                for (int g2 = 0; g2 < 2; ++g2) {
                    f32x4 v0 = acc[ai][m][2 * g2] * rs + bv[g2][0], v1 = acc[ai][m][2 * g2 + 1] * rs + bv[g2][1];
                    v0 = __builtin_elementwise_max(v0, (f32x4){0.f, 0.f, 0.f, 0.f}); v1 = __builtin_elementwise_max(v1, (f32x4){0.f, 0.f, 0.f, 0.f});
                    v0 = v0 * v0; v1 = v1 * v1;
                    u32x4 w; w.x = cvt_pk_bf16(v0[0], v0[1]); w.y = cvt_pk_bf16(v0[2], v0[3]); w.z = cvt_pk_bf16(v1[0], v1[1]); w.w = cvt_pk_bf16(v1[2], v1[3]);
                    *(u32x4*)(H + (size_t)row * DFF + bcol0 + 32 * g2) = w;
                }
                asm volatile("" ::: "memory");
            }
    }
};
struct EpiRes128 {
    static constexpr bool PERM = false;
    float* X; bf16_t* A; const float* gate; const float* Gn; float* ssq_out;
    __device__ __forceinline__ void operator()(const f32x4 (&acc)[2][2][4], const Unit& u, int wr, int wc, int fr, int fq) const {
        const int cond = cond_of_panel(u.pm);
        const int col0 = u.pn * HALF + wc * 64 + 4 * fq;
#pragma unroll
        for (int ai = 0; ai < 2; ++ai)
#pragma unroll
            for (int m = 0; m < 2; ++m) {
                const int row = u.pm * BM + ai * HALF + wr * 32 + m * 16 + fr;
                float q = 0.f;
#pragma unroll
                for (int n = 0; n < 4; ++n) {
                    const int c = col0 + n * 16;
                    float* xp = X + (size_t)row * DM + c;
                    const f32x4 g4 = *(const f32x4*)(gate + cond * 6144 + c);
                    const f32x4 x1 = *(const f32x4*)xp + g4 * acc[ai][m][n];
                    *(f32x4*)xp = x1;
                    q += (x1[0] * x1[0] + x1[1] * x1[1]) + (x1[2] * x1[2] + x1[3] * x1[3]);
                    if (Gn) { const f32x4 a = x1 * *(const f32x4*)(Gn + cond * DM + c); u32x2 w; w.x = cvt_pk_bf16(a[0], a[1]); w.y = cvt_pk_bf16(a[2], a[3]);
                        *(u32x2*)(A + (size_t)row * DM + c) = w; }
                }
                q += __shfl_xor(q, 16); q += __shfl_xor(q, 32);
                if (fq == 0) ssq_out[(size_t)row * SSQW + u.pn * 2 + wc] = q;
                asm volatile("" ::: "memory");
            }
    }
};
struct StaticOrder192 {
    int nM, nN, nwg, G, c;
    __host__ __device__ void init(int M, int N, int G_, int c_) { nM = M / 192; nN = N / HALF; nwg = nM * nN; G = G_; c = c_; }
    __host__ __device__ bool next(int i, Unit& u) const {
        const long L = (long)i * G + c; if (L >= nwg) return false;
        int wgid = (int)L; { const int q = nwg / NXCD, r = nwg % NXCD, xcd = wgid % NXCD, off = wgid / NXCD; wgid = (xcd < r ? xcd * (q + 1) : r * (q + 1) + (xcd - r) * q) + off; }
        const int nig = WGM * nN, gid = wgid / nig, fm = gid * WGM, gsz = (nM - fm) < WGM ? (nM - fm) : WGM;
        u.pm = fm + ((wgid % nig) % gsz); u.pn = (wgid % nig) / gsz; return true;
    }
};
template <class Epi, class Sched>
__device__ __forceinline__ void gemm_phase_m192(PG8_LAS unsigned char* lds, const Gemm g, const Sched& S, const Epi& E, int tid_in) {
    int tid_ = tid_in; asm volatile("" : "+v"(tid_));
    const int tid = tid_, wid = __builtin_amdgcn_readfirstlane(tid >> 6), lane = tid & 63, wh = wid >> 2, wr = wid >> 1, wc = wid & 1, fr = lane & 15, fq = lane >> 4;
    const int K = g.K, nt = K / BK;
    constexpr unsigned SLOT = 40960u, PIECE = 8192u, BOFF = 3u * PIECE;
    unsigned voffA, voffB;
    { int R, C; stage_rc(tid * 16, R, C); const int Rb = Epi::PERM ? ((R & ~31) + perm32(R & 31)) : R; voffA = (unsigned)(R * K + C) * 2u; voffB = (unsigned)(Rb * K + C) * 2u; }
    const size_t kstep = (size_t)(BK * 2), pstep = (size_t)64 * K * 2;
    const unsigned ldsw = (unsigned)wid * 1024u;
    const int sub = lds_byte(fr, fq * 8);
    unsigned aofs[3];
#pragma unroll
    for (int m = 0; m < 3; ++m) { const int mt = 3 * wr + m; aofs[m] = (unsigned)((mt >> 2) * PIECE + ((mt & 3) * 2) * 1024 + sub); }
    const unsigned bofs = BOFF + (unsigned)wc * PIECE + (unsigned)sub;
#define PG8_STAGE5(slot, ga, gb) do { \
        _Pragma("unroll") for (int _p = 0; _p < 3; ++_p) __builtin_amdgcn_global_load_lds((const unsigned*)((ga) + _p * pstep + voffA), (PG8_LAS unsigned*)(lds + (slot) + _p * PIECE + ldsw), 16, 0, 0); \
        _Pragma("unroll") for (int _q = 0; _q < 2; ++_q) __builtin_amdgcn_global_load_lds((const unsigned*)((gb) + _q * pstep + voffB), (PG8_LAS unsigned*)(lds + (slot) + BOFF + _q * PIECE + ldsw), 16, 0, 0); } while (0)
#define PG8_WAIT_V(n) asm volatile("s_waitcnt vmcnt(" #n ")" ::: "memory")
#define PG8_WAIT_L(n) asm volatile("s_waitcnt lgkmcnt(" #n ")" ::: "memory")
#define PG8_BAR __builtin_amdgcn_s_barrier()
#define PG8_SCHED __builtin_amdgcn_sched_barrier(0)
    Unit cur, nxt; int ui = 0;
    if (!S.next(0, cur)) return;
    f32x4 acc[3][4];
#pragma unroll
    for (int m = 0; m < 3; ++m)
#pragma unroll
        for (int n = 0; n < 4; ++n) acc[m][n] = (f32x4){0.f, 0.f, 0.f, 0.f};
    bf16x8 At[3][2], Bf[4][2];
    const char* cA = (const char*)g.A + (size_t)cur.pm * 3 * pstep; const char* cB = (const char*)g.Bt + (size_t)cur.pn * 2 * pstep;
    PG8_STAGE5(0u, cA, cB); PG8_STAGE5(SLOT, cA + kstep, cB + kstep);
    PG8_WAIT_V(5);
    if (wh == 1) PG8_BAR;
    PG8_BAR;
    unsigned rs = 0u, ss = 2u * SLOT;
    for (;;) {
        const bool has_next = S.next(ui + 1, nxt);
        const char* nA = has_next ? (const char*)g.A + (size_t)nxt.pm * 3 * pstep : cA; const char* nB = has_next ? (const char*)g.Bt + (size_t)nxt.pn * 2 * pstep : cB;
        for (int t = 0; t < nt; ++t) {
            const bool tail = t >= nt - 2;
            const char* a2 = tail ? nA + (size_t)(t + 2 - nt) * kstep : cA + (size_t)(t + 2) * kstep;
            const char* b2 = tail ? nB + (size_t)(t + 2 - nt) * kstep : cB + (size_t)(t + 2) * kstep;
#pragma unroll
            for (int n = 0; n < 4; ++n)
#pragma unroll
                for (int k = 0; k < 2; ++k) Bf[n][k] = *(const PG8_LAS bf16x8*)(lds + rs + bofs + n * 2048 + k * 1024);
            PG8_SCHED;
#pragma unroll
            for (int m = 0; m < 3; ++m)
#pragma unroll
                for (int k = 0; k < 2; ++k) At[m][k] = *(const PG8_LAS bf16x8*)(lds + rs + aofs[m] + k * 1024);
            PG8_STAGE5(ss, a2, b2);
            PG8_WAIT_V(5); PG8_WAIT_L(0); PG8_BAR;
            __builtin_amdgcn_s_setprio(1);
#pragma unroll
            for (int m = 0; m < 3; ++m)
#pragma unroll
                for (int n = 0; n < 4; ++n)
#pragma unroll
                    for (int k = 0; k < 2; ++k) acc[m][n] = __builtin_amdgcn_mfma_f32_16x16x32_bf16(Bf[n][k], At[m][k], acc[m][n], 0, 0, 0);
            __builtin_amdgcn_s_setprio(0);
            PG8_BAR; PG8_SCHED;
            rs = rs == 2u * SLOT ? 0u : rs + SLOT; ss = ss == 2u * SLOT ? 0u : ss + SLOT;
        }
        if (wh == 0) PG8_BAR;
        E(acc, cur, wr, wc, fr, fq);
        if (!has_next) break;
#pragma unroll
        for (int m = 0; m < 3; ++m)
#pragma unroll
            for (int n = 0; n < 4; ++n) acc[m][n] = (f32x4){0.f, 0.f, 0.f, 0.f};
        cur = nxt; cA = nA; cB = nB; ++ui;
        if (wh == 1) PG8_BAR;
    }
    PG8_WAIT_V(0);
    PG8_BAR;
#undef PG8_STAGE5
#undef PG8_WAIT_V
#undef PG8_WAIT_L
#undef PG8_BAR
#undef PG8_SCHED
}
__device__ __forceinline__ int cond_of_row(int row) { return row < 4096 ? 0 : (row < 5120 ? 1 : 2); }
struct EpiRes192 {
    static constexpr bool PERM = false;
    float* X; bf16_t* A; const float* gate; const float* Gn; float* ssq_out;
    __device__ __forceinline__ void operator()(const f32x4 (&acc)[3][4], const Unit& u, int wr, int wc, int fr, int fq) const {
        const int col0 = u.pn * HALF + wc * 64 + 4 * fq;
#pragma unroll
        for (int m = 0; m < 3; ++m) {
            const int row = u.pm * 192 + wr * 48 + m * 16 + fr;
            const int cond = cond_of_row(u.pm * 192 + wr * 48 + m * 16);
            float q = 0.f;
#pragma unroll
            for (int n = 0; n < 4; ++n) {
                const int c = col0 + n * 16;
                float* xp = X + (size_t)row * DM + c;
                const f32x4 g4 = *(const f32x4*)(gate + cond * 6144 + c);
                const f32x4 x1 = *(const f32x4*)xp + g4 * acc[m][n];
                *(f32x4*)xp = x1;
                q += (x1[0] * x1[0] + x1[1] * x1[1]) + (x1[2] * x1[2] + x1[3] * x1[3]);
                if (Gn) { const f32x4 a = x1 * *(const f32x4*)(Gn + cond * DM + c); u32x2 w; w.x = cvt_pk_bf16(a[0], a[1]); w.y = cvt_pk_bf16(a[2], a[3]);
                    *(u32x2*)(A + (size_t)row * DM + c) = w; }
            }
            q += __shfl_xor(q, 16); q += __shfl_xor(q, 32);
            if (fq == 0) ssq_out[(size_t)row * SSQW + u.pn * 2 + wc] = q;
            asm volatile("" ::: "memory");
        }
    }
};
}
#define GAS __attribute__((address_space(1)))
#define LAS __attribute__((address_space(3)))
typedef unsigned short bf16;
typedef unsigned v4u __attribute__((ext_vector_type(4)));
typedef unsigned v2u __attribute__((ext_vector_type(2)));
typedef float f32x4 __attribute__((ext_vector_type(4)));
typedef float f32x2 __attribute__((ext_vector_type(2)));
typedef short bf16x8 __attribute__((ext_vector_type(8)));
constexpr int NWAVES = 8, NTHREADS = 512;
constexpr int M_TOK = 6144, M_CTX = 4096, DMODEL = 1024, NINP = 1792, NUC = 1280, FFD = 4096, DEPTHL = 4, DRNN = 512;
constexpr int LDS_BYTES = 147456;
constexpr size_t al256(size_t x) { return (x + 255) & ~(size_t)255; }
constexpr size_t WS_CTL = 0, CTL_BYTES = 1u << 20;
constexpr size_t WS_MODS = WS_CTL + CTL_BYTES;
constexpr size_t WS_GV = WS_MODS + al256((size_t)4 * 3 * 6144 * 4);
constexpr size_t WS_BIASIN = WS_GV + al256((size_t)4 * 2 * 3 * 1024 * 4);
constexpr size_t WS_BIAS1 = WS_BIASIN + al256((size_t)4 * 3 * NINP * 4);
constexpr size_t WS_SSQ = WS_BIAS1 + al256((size_t)4 * 3 * FFD * 4);
constexpr size_t WS_WIN = WS_SSQ + al256((size_t)9 * M_TOK * 16 * 4);
constexpr size_t WS_WOUT = WS_WIN + al256((size_t)4 * NINP * 1024 * 2);
constexpr size_t WS_W1 = WS_WOUT + al256((size_t)4 * 1024 * 1024 * 2);
constexpr size_t WS_W2 = WS_W1 + al256((size_t)4 * FFD * 1024 * 2);
constexpr size_t WS_WG = WS_W2 + al256((size_t)4 * FFD * 1024 * 2);
constexpr size_t WS_T256 = WS_WG + al256((size_t)4 * 8 * 4 * 2 * 32 * 64 * 2);
constexpr size_t WS_T1024 = WS_T256 + al256((size_t)256 * 512 * 2);
constexpr size_t WS_X = WS_T1024 + al256((size_t)1024 * 2048 * 2);
constexpr size_t WS_A = WS_X + al256((size_t)M_TOK * 1024 * 4);
constexpr size_t WS_U = WS_A + al256((size_t)M_TOK * 1024 * 2);
constexpr size_t WS_XCT = WS_U + al256((size_t)M_TOK * NUC * 2);
constexpr size_t WS_CAT = WS_XCT + al256((size_t)M_TOK * 512 * 2);
constexpr size_t WS_HF = WS_CAT + al256((size_t)M_TOK * 1024 * 2);
constexpr size_t WS_PB = WS_HF + al256((size_t)M_TOK * 512 * 4);
constexpr size_t WS_HID = WS_PB + al256((size_t)M_TOK * 512 * 4);
constexpr size_t WS_END = WS_HID + al256((size_t)M_TOK * FFD * 2);
static_assert(WS_END <= ((size_t)256 << 20), "workspace map exceeds 256 MiB");

__device__ __forceinline__ unsigned f2bf(float f) { unsigned u = __builtin_bit_cast(unsigned, f); return (u + 0x7fffu + ((u >> 16) & 1u)) >> 16; }
__device__ __forceinline__ unsigned pk2(float lo, float hi) { return f2bf(lo) | (f2bf(hi) << 16); }
__device__ __forceinline__ float bf2f(unsigned short b) { return __builtin_bit_cast(float, (unsigned)b << 16); }
__device__ __forceinline__ float bflo(unsigned w) { return __builtin_bit_cast(float, w << 16); }
__device__ __forceinline__ float bfhi(unsigned w) { return __builtin_bit_cast(float, w & 0xffff0000u); }
__device__ __forceinline__ float wave_sum(float v) {
#pragma unroll
    for (int o = 1; o < 64; o <<= 1) v += __shfl_xor(v, o);
    return v;
}
__device__ __forceinline__ float rdlane(float v, int l) { return __builtin_bit_cast(float, __builtin_amdgcn_readlane(__builtin_bit_cast(int, v), l)); }

__device__ __forceinline__ int launder_v(int x) { asm volatile("" : "+v"(x)); return x; }
__device__ __forceinline__ int launder_s(int x) { asm volatile("" : "+s"(x)); return x; }
#define CAS __attribute__((address_space(4)))
typedef const float* cfp_t;
struct Params { const float* in[24]; float* out; unsigned char* ws; int ph_lo, ph_hi; };
struct Frame {
    LAS unsigned char* lds;
    int tid, lane, wave, G, bid;
    __device__ __forceinline__ void relaunder() { wave = launder_s(wave); asm volatile("v_mbcnt_lo_u32_b32 %0, -1, 0\n\tv_mbcnt_hi_u32_b32 %0, -1, %0" : "=v"(lane)); tid = wave * 64 + lane;
        bid = launder_s(bid); G = launder_s(G);
        size_t z = 0; asm volatile("" : "+s"(z), "+s"(in)); ws = ws0 + z; out = out0 + z; }
    __device__ __forceinline__ const float* inp(int i) const { return (const float*)(const GAS float*)in[i]; }
    const CAS cfp_t* in; float* out; unsigned char* ws; float* out0; unsigned char* ws0;
};
enum { I_XP = 0, I_XS, I_STATE, I_C, I_CCTX, I_N1G, I_N2G, I_FG, I_WMOD, I_BMOD, I_WIN, I_CONVW, I_CONVB, I_WR, I_BR, I_WI, I_BI, I_LAM, I_POOLW, I_POOLS, I_FW, I_WOUT, I_W1, I_W2 };
#define XB_TMO      128
#define XB_XCNT(j)  (256  + 64 * (j))
#define XB_XSUB(j)  (1280 + 64 * (j))
#define XB_XGEN(j)  (2304 + 64 * (j))
#define XB_TOP      3328
#define XB_TOPGEN   3392
#define XCD_BAR_WORDS 3456
#define XB_SPIN_CAP (1u << 18)

__device__ __forceinline__ unsigned xb_ld(unsigned* p)              { return __hip_atomic_load(p, __ATOMIC_RELAXED, __HIP_MEMORY_SCOPE_AGENT); }
__device__ __forceinline__ unsigned xb_add(unsigned* p, unsigned v) { return __hip_atomic_fetch_add(p, v, __ATOMIC_RELAXED, __HIP_MEMORY_SCOPE_AGENT); }
__device__ __forceinline__ unsigned xb_xcc_id() { return (unsigned)__builtin_amdgcn_s_getreg((3 << 11) | 20) & 0xFu; }
#define XB_SPIN(cond, bar) do { unsigned _sp = 0; while (cond) { __builtin_amdgcn_s_sleep(1); \
    if ((++_sp & 255u) == 0u) { if (xb_ld(&(bar)[XB_TMO])) break; if (_sp > XB_SPIN_CAP) { atomicAdd(&(bar)[XB_TMO], 1u); break; } } } } while (0)

struct XcdBarrier {
    unsigned* bar; unsigned x;
    volatile LAS unsigned* st;
};

__device__ __forceinline__ XcdBarrier xcd_barrier_post(unsigned* bar, volatile LAS unsigned* st) {
    XcdBarrier b; b.bar = bar; b.x = xb_xcc_id(); b.st = st;
    if (threadIdx.x == 0) (void)xb_add(&bar[XB_XCNT(b.x)], 1u);
    return b;
}
__device__ __forceinline__ void xcd_barrier_complete(unsigned* bar, unsigned x, unsigned& nloc, unsigned& nx) {
    const unsigned G = gridDim.x * gridDim.y * gridDim.z;
    unsigned sum, cnt, mine, sp = 0u;
    for (;;) {
        sum = 0u; cnt = 0u; mine = 0u;
#pragma unroll
        for (unsigned j = 0; j < 16; ++j) { const unsigned c = xb_ld(&bar[XB_XCNT(j)]); sum += c; cnt += (c > 0u) ? 1u : 0u; mine = (j == x) ? c : mine; }
        if (sum == G) break;
        __builtin_amdgcn_s_sleep(1);
        if ((++sp & 255u) == 0u) { if (xb_ld(&bar[XB_TMO])) break; if (sp > XB_SPIN_CAP) { atomicAdd(&bar[XB_TMO], 1u); break; } }
    }
    nloc = mine > 0u ? mine : 1u; nx = cnt > 0u ? cnt : 1u;
}

__device__ __forceinline__ void xcd_barrier(const XcdBarrier& b) {
    asm volatile("s_waitcnt vmcnt(0)" ::: "memory");
    __syncthreads();
    if (threadIdx.x == 0) {
        unsigned* bar = b.bar;
        __builtin_amdgcn_s_waitcnt(0);
        unsigned nloc = b.st[0], nx = b.st[1];
        if (nloc == 0u) { xcd_barrier_complete(bar, b.x, nloc, nx); b.st[0] = nloc; b.st[1] = nx; }
        const unsigned old = xb_add(&bar[XB_XSUB(b.x)], 1u);
        const unsigned gen = old / nloc;
        if (old + 1u == (gen + 1u) * nloc) {
            __builtin_amdgcn_fence(__ATOMIC_RELEASE, "agent");
            asm volatile("s_waitcnt vmcnt(0)" ::: "memory");
            const unsigned og = xb_add(&bar[XB_TOP], 1u);
            const unsigned tg = og / nx;
            if (og + 1u == (tg + 1u) * nx) xb_add(&bar[XB_TOPGEN], 1u);
            else XB_SPIN(xb_ld(&bar[XB_TOPGEN]) == tg, bar);
            __builtin_amdgcn_fence(__ATOMIC_ACQUIRE, "agent");
            xb_add(&bar[XB_XGEN(b.x)], 1u);
            asm volatile("s_waitcnt vmcnt(0)" ::: "memory");
        } else {
            XB_SPIN(xb_ld(&bar[XB_XGEN(b.x)]) == gen, bar);
            __builtin_amdgcn_fence(__ATOMIC_ACQUIRE, "agent");
            asm volatile("s_waitcnt vmcnt(0)" ::: "memory");
        }
    }
    __syncthreads();
}
__device__ __forceinline__ void p0a_mods(const Frame& F) {
    LAS float* sl = (LAS float*)F.lds;
    LAS float* red = sl + 3 * 1024;
    const float* c_ctx = F.inp(I_CCTX); const float* cv = F.inp(I_C);
    for (int i = F.tid; i < 3 * 1024; i += NTHREADS) { const int cd = i >> 10, k = i & 1023; const float c = cd == 0 ? c_ctx[k] : cv[(cd - 1) * 1024 + k]; sl[i] = c / (1.0f + expf(-c)); }
    __syncthreads();
    float* mods = (float*)(F.ws + WS_MODS);
    { float* BIASIN = (float*)(F.ws + WS_BIASIN);
        for (int i = F.bid * NTHREADS + F.tid; i < 4 * 3 * 512; i += F.G * NTHREADS) BIASIN[(size_t)(i >> 9) * NINP + 1280 + (i & 511)] = 0.f; }
    for (int it = F.bid; it < 256; it += F.G) {
        const int l = it >> 6, ch = it & 63;
        const float* W = F.inp(I_WMOD) + (size_t)l * 1024 * 6144 + ch * 96;
        if (F.tid < 504) {
            const int c4 = F.tid % 24, kr = F.tid / 24;
            f32x4 a0 = {0.f, 0.f, 0.f, 0.f}, a1 = a0, a2 = a0;
#pragma unroll 16
            for (int k = kr; k < 1024; k += 21) { const f32x4 w = *(const f32x4*)(W + (size_t)k * 6144 + c4 * 4); a0 += w * sl[k]; a1 += w * sl[1024 + k]; a2 += w * sl[2048 + k]; }
            *(LAS f32x4*)(red + (kr * 3 + 0) * 96 + c4 * 4) = a0; *(LAS f32x4*)(red + (kr * 3 + 1) * 96 + c4 * 4) = a1; *(LAS f32x4*)(red + (kr * 3 + 2) * 96 + c4 * 4) = a2;
        }
        __syncthreads();
        if (F.tid < 288) { const int cd = F.tid / 96, col = F.tid % 96; float s = 0.f;
#pragma unroll
            for (int kr = 0; kr < 21; ++kr) s += red[(kr * 3 + cd) * 96 + col];
            mods[(size_t)(l * 3 + cd) * 6144 + ch * 96 + col] = s + F.inp(I_BMOD)[l * 6144 + ch * 96 + col]; }
        __syncthreads();
    }
}

template <bool BIAS>
__device__ __forceinline__ void strip_item(const float* W, int N, int kb, int ke, int n0, bf16* WT, int ldt, int trow0, const float* sh, float* bias_out, int bstride, LAS float* scr, int lane) {
    float b0 = 0.f, b1 = 0.f, b2 = 0.f;
    const int nn = lane & 31, half = lane >> 5;
    float tv[32];
#pragma unroll
    for (int i = 0; i < 32; ++i) tv[i] = W[(size_t)(kb + 2 * i + half) * N + n0 + nn];
    for (int k0 = kb; k0 < ke; k0 += 64) {
#pragma unroll
        for (int i = 0; i < 32; ++i) scr[(2 * i + half) * 33 + nn] = tv[i];
        if (k0 + 64 < ke) {
#pragma unroll
            for (int i = 0; i < 32; ++i) tv[i] = W[(size_t)(k0 + 64 + 2 * i + half) * N + n0 + nn];
        }
        asm volatile("s_waitcnt lgkmcnt(0)" ::: "memory");
        const int c = lane & 7;
#pragma unroll
        for (int j = 0; j < 4; ++j) { const int n = (lane >> 3) + 8 * j; const LAS float* s = scr + (8 * c) * 33 + n;
            v4u o; o.x = pk2(s[0 * 33], s[1 * 33]); o.y = pk2(s[2 * 33], s[3 * 33]); o.z = pk2(s[4 * 33], s[5 * 33]); o.w = pk2(s[6 * 33], s[7 * 33]);
            *(v4u*)(WT + (size_t)(trow0 + n) * ldt + k0 + 8 * c) = o; }
        if (BIAS) {
            const float s0 = sh[k0 + lane], s1 = sh[6144 + k0 + lane], s2 = sh[2 * 6144 + k0 + lane];
#pragma unroll 8
            for (int kk = 0; kk < 32; ++kk) { const float w = scr[(half * 32 + kk) * 33 + nn]; const int src = half * 32 + kk;
                b0 += w * __shfl(s0, src); b1 += w * __shfl(s1, src); b2 += w * __shfl(s2, src); }
        }
        asm volatile("s_waitcnt lgkmcnt(0)" ::: "memory");
    }
    if (BIAS) {
        b0 += __shfl_xor(b0, 32); b1 += __shfl_xor(b1, 32); b2 += __shfl_xor(b2, 32);
        if (lane < 32) { bias_out[n0 + lane] = b0; bias_out[bstride + n0 + lane] = b1; bias_out[2 * bstride + n0 + lane] = b2; }
    }
}
__device__ __forceinline__ float dft64(float tabreg, int c, int mm) { const int m = mm & 63; const int idx = (mm < 64) ? ((c * m) & 63) : ((c * m - 16) & 63); return __shfl(tabreg, idx); }

__device__ __forceinline__ void p0b_items(Frame F, int llo, int lhi, int gw, int NGW, bool with_rows) {
    const int nl = lhi - llo;
    const float tabreg = cospif((float)F.lane * (1.0f / 32.0f)) * 0.125f;
    const int N_FOUT = 256 * nl, N_FIN = 256 * nl, N_POOLF = 64 * nl, N_FBIAS = 32 * nl, N_W1 = 128 * nl, N_W2 = 128 * nl, N_WIN = 40 * nl, N_WOUTA = 32 * nl, N_ROWS = with_rows ? M_TOK : 0;
    const int NITEMS = N_FOUT + N_FIN + N_POOLF + N_FBIAS + N_W1 + N_W2 + N_WIN + N_WOUTA + N_ROWS;
    for (int it = gw; it < NITEMS; it += NGW) {
        int r = it; F.relaunder(); const int lane = F.lane;
        LAS float* scr = (LAS float*)(F.lds + F.wave * 16384);
        const float* mods = (const float*)(F.ws + WS_MODS);
        bf16* WINT = (bf16*)(F.ws + WS_WIN); bf16* WOUTT = (bf16*)(F.ws + WS_WOUT); bf16* W1T = (bf16*)(F.ws + WS_W1); bf16* W2T = (bf16*)(F.ws + WS_W2);
        float* BIASIN = (float*)(F.ws + WS_BIASIN); float* BIAS1 = (float*)(F.ws + WS_BIAS1);

        if (r < N_FOUT) {
            const int l = llo + (r >> 8), it16 = (r >> 4) & 15, nb = r & 15, lr = lane & 15, lq = lane >> 4;
            const float* fw = F.inp(I_FW) + (size_t)l * 65536 + (size_t)(it16 * 16 + lr) * 256 + lq;
            const float* wo = F.inp(I_WOUT) + (size_t)l * 1048576 + (size_t)(768 + lq) * 1024 + nb * 64 + lr;
            f32x4 acc[4];
#pragma unroll
            for (int nt = 0; nt < 4; ++nt) acc[nt] = (f32x4){0.f, 0.f, 0.f, 0.f};
#pragma unroll 4
            for (int ks = 0; ks < 64; ++ks) { const float av = fw[4 * ks];
#pragma unroll
                for (int nt = 0; nt < 4; ++nt) acc[nt] = __builtin_amdgcn_mfma_f32_16x16x4f32(av, wo[(size_t)(4 * ks) * 1024 + 16 * nt], acc[nt], 0, 0, 0); }
#pragma unroll
            for (int nt = 0; nt < 4; ++nt) { v2u o; o.x = pk2(acc[nt][0], acc[nt][1]); o.y = pk2(acc[nt][2], acc[nt][3]);
                *(v2u*)(WOUTT + (size_t)l * 1048576 + (size_t)(nb * 64 + 16 * nt + lr) * 1024 + 768 + it16 * 16 + 4 * lq) = o; }
            continue;
        }
        r -= N_FOUT;
        if (r < N_FIN) {
            const int l = llo + (r >> 8), hd = (r >> 6) & 3, kt = r & 63, lr = lane & 15, lq = lane >> 4;
            const float* wp = F.inp(I_WIN) + (size_t)l * 1024 * 1536 + (size_t)(kt * 16 + lr) * 1536 + 1280 + 64 * hd + lq;
            f32x4 acc[8];
#pragma unroll
            for (int nt = 0; nt < 8; ++nt) acc[nt] = (f32x4){0.f, 0.f, 0.f, 0.f};
#pragma unroll 2
            for (int ks = 0; ks < 16; ++ks) { const float av = wp[4 * ks]; const int c = 4 * ks + lq;
#pragma unroll
                for (int nt = 0; nt < 8; ++nt) acc[nt] = __builtin_amdgcn_mfma_f32_16x16x4f32(av, dft64(tabreg, c, 16 * nt + lr), acc[nt], 0, 0, 0); }
#pragma unroll
            for (int nt = 0; nt < 8; ++nt) { v2u o; o.x = pk2(acc[nt][0], acc[nt][1]); o.y = pk2(acc[nt][2], acc[nt][3]);
                *(v2u*)(WINT + (size_t)l * NINP * 1024 + (size_t)(1280 + 128 * hd + 16 * nt + lr) * 1024 + kt * 16 + 4 * lq) = o; }
            continue;
        }
        r -= N_FIN;
        if (r < N_POOLF) {
            const int l = llo + (r >> 6), g = (r >> 4) & 3, nb = r & 15, lr = lane & 15, lq = lane >> 4;
            const float* pw = F.inp(I_POOLW) + (size_t)(l * 4 + g) * 4096 + lr * 64 + lq;
            const float* ps = F.inp(I_POOLS) + l * 256 + 64 * g + lq;
            const float* wo = F.inp(I_WOUT) + (size_t)l * 1048576 + (size_t)(512 + 64 * g + lq) * 1024 + nb * 64 + lr;
            f32x4 acc[4][4];
#pragma unroll
            for (int mt = 0; mt < 4; ++mt)
#pragma unroll
                for (int nt = 0; nt < 4; ++nt) acc[mt][nt] = (f32x4){0.f, 0.f, 0.f, 0.f};
#pragma unroll 2
            for (int ks = 0; ks < 16; ++ks) { const float sc = ps[4 * ks]; float av[4], bv[4];
#pragma unroll
                for (int mt = 0; mt < 4; ++mt) av[mt] = pw[mt * 1024 + 4 * ks] * sc;
#pragma unroll
                for (int nt = 0; nt < 4; ++nt) bv[nt] = wo[(size_t)(4 * ks) * 1024 + 16 * nt];
#pragma unroll
                for (int mt = 0; mt < 4; ++mt)
#pragma unroll
                    for (int nt = 0; nt < 4; ++nt) acc[mt][nt] = __builtin_amdgcn_mfma_f32_16x16x4f32(av[mt], bv[nt], acc[mt][nt], 0, 0, 0); }
#pragma unroll
            for (int mt = 0; mt < 4; ++mt)
#pragma unroll
                for (int nt = 0; nt < 4; ++nt) { v2u o; o.x = pk2(acc[mt][nt][0], acc[mt][nt][1]); o.y = pk2(acc[mt][nt][2], acc[mt][nt][3]);
                    *(v2u*)(WOUTT + (size_t)l * 1048576 + (size_t)(nb * 64 + 16 * nt + lr) * 1024 + 512 + 64 * g + 16 * mt + 4 * lq) = o; }
            continue;
        }
        r -= N_POOLF;
        if (r < N_FBIAS) {
            const int l = llo + (r >> 5), hd = (r >> 3) & 3, kp = r & 7;
            const float* wp = F.inp(I_WIN) + (size_t)l * 1024 * 1536 + (size_t)(kp * 128) * 1536 + 1280 + 64 * hd + lane;
            const float* sh = mods + (size_t)l * 3 * 6144 + kp * 128;
            float b0 = 0.f, b1 = 0.f, b2 = 0.f;
#pragma unroll 16
            for (int k = 0; k < 128; ++k) { const float w = wp[(size_t)k * 1536]; b0 += w * sh[k]; b1 += w * sh[6144 + k]; b2 += w * sh[2 * 6144 + k]; }
            for (int hf = 0; hf < 2; ++hf) {
                const int mm = hf * 64 + lane; float s0 = 0.f, s1 = 0.f, s2 = 0.f;
#pragma unroll 8
                for (int c = 0; c < 64; ++c) { const int idx = hf == 0 ? ((c * lane) & 63) : ((c * lane - 16) & 63); const float dv = __shfl(tabreg, idx);
                    s0 += __shfl(b0, c) * dv; s1 += __shfl(b1, c) * dv; s2 += __shfl(b2, c) * dv; }
                float* bo = BIASIN + (size_t)l * 3 * NINP + 1280 + 128 * hd + mm;
                atomicAdd(bo, s0); atomicAdd(bo + NINP, s1); atomicAdd(bo + 2 * NINP, s2);
            }
            continue;
        }
        r -= N_FBIAS;
        if (r < N_W1) {
            const int l = llo + (r >> 7), nb = r & 127;
            strip_item<true>(F.inp(I_W1) + (size_t)l * 1024 * 4096, 4096, 0, 1024, nb * 32, W1T + (size_t)l * 4096 * 1024, 1024, nb * 32,
                             mods + (size_t)l * 3 * 6144 + 3 * 1024, BIAS1 + (size_t)l * 3 * FFD, FFD, scr, lane);
            continue;
        }
        r -= N_W1;
        if (r < N_W2) {
            const int l = llo + (r >> 7), nb = (r >> 2) & 31, kq = r & 3;
            strip_item<false>(F.inp(I_W2) + (size_t)l * 4096 * 1024, 1024, kq * 1024, kq * 1024 + 1024, nb * 32, W2T + (size_t)l * 1024 * 4096, 4096, nb * 32, nullptr, nullptr, 0, scr, lane);
            continue;
        }
        r -= N_W2;
        if (r < N_WIN) {
            const int l = llo + r / 40, nb = r % 40;
            strip_item<true>(F.inp(I_WIN) + (size_t)l * 1024 * 1536, 1536, 0, 1024, nb * 32, WINT + (size_t)l * NINP * 1024, 1024, nb * 32,
                             mods + (size_t)l * 3 * 6144, BIASIN + (size_t)l * 3 * NINP, NINP, scr, lane);
            continue;
        }
        r -= N_WIN;
        if (r < N_WOUTA) {
            const int l = llo + (r >> 5), nb = r & 31;
            strip_item<false>(F.inp(I_WOUT) + (size_t)l * 1048576, 1024, 0, 512, nb * 32, WOUTT + (size_t)l * 1048576, 1024, nb * 32, nullptr, nullptr, 0, scr, lane);
            continue;
        }
        r -= N_WOUTA;
        if (with_rows) {
            const int cond = r < M_CTX ? 0 : 1 + ((r - M_CTX) >> 10);
            const float* src = r < M_CTX ? F.inp(I_XP) + (size_t)r * 1024 : F.inp(I_XS) + (size_t)(r - M_CTX) * 1024;
            const f32x4* xr = (const f32x4*)src + lane;
            const f32x4* gp = (const f32x4*)F.inp(I_N1G) + lane;
            const f32x4* sp = (const f32x4*)(mods + (size_t)cond * 6144 + 1024) + lane;
            f32x4 v[4]; float s = 0.f;
#pragma unroll
            for (int j = 0; j < 4; ++j) { v[j] = xr[64 * j]; s += (v[j][0] * v[j][0] + v[j][1] * v[j][1]) + (v[j][2] * v[j][2] + v[j][3] * v[j][3]); }
            s = wave_sum(s);
            f32x4* xo = (f32x4*)((float*)(F.ws + WS_X) + (size_t)r * 1024) + lane;
            v2u* ao = (v2u*)((bf16*)(F.ws + WS_A) + (size_t)r * 1024) + lane;
#pragma unroll
            for (int j = 0; j < 4; ++j) { xo[64 * j] = v[j]; const f32x4 a = v[j] * (gp[64 * j] * (sp[64 * j] + 1.0f));
                v2u w; w.x = pk2(a[0], a[1]); w.y = pk2(a[2], a[3]); ao[64 * j] = w; }
            if (lane < 16) ((float*)(F.ws + WS_SSQ))[(size_t)r * 16 + lane] = lane == 0 ? s : 0.f;
        }
    }
}
__device__ __forceinline__ void p0b_tail(Frame F) {
    F.relaunder();
    const float* mods = (const float*)(F.ws + WS_MODS);
    const int gt = F.bid * NTHREADS + F.tid, NGT = F.G * NTHREADS;
    {
        float* GV = (float*)(F.ws + WS_GV);
        for (int i = gt; i < 4 * 2 * 3 * 1024; i += NGT) { const int c = i & 1023, cd = (i >> 10) % 3, w = (i / 3072) & 1, l = i / 6144;
            const float g = (w == 0 ? F.inp(I_N1G) : F.inp(I_N2G))[l * 1024 + c]; GV[i] = g * (1.0f + mods[(size_t)(l * 3 + cd) * 6144 + (w == 0 ? 1 : 4) * 1024 + c]); }
    }
    {
        bf16* WG = (bf16*)(F.ws + WS_WG);
        for (int i = gt; i < 4 * 8 * 4 * 2 * 32 * 64; i += NGT) { const int k = i & 63, n = (i >> 6) & 31, dir = (i >> 11) & 1, q = (i >> 12) & 3, h = (i >> 14) & 7, l = i >> 17;
            const float* src = n < 16 ? F.inp(I_WR) : F.inp(I_WI);
            WG[i] = (bf16)f2bf(src[((size_t)((l * 2 + dir) * 8 + h) * 64 + k) * 64 + 16 * q + (n & 15)]); }
    }
    {
        for (int i = gt; i < (256 * 512 + 1024 * 2048) / 8; i += NGT) {
            int L, e; bf16* T;
            if (i < 256 * 512 / 8) { L = 256; e = i * 8; T = (bf16*)(F.ws + WS_T256); } else { L = 1024; e = (i - 256 * 512 / 8) * 8; T = (bf16*)(F.ws + WS_T1024); }
            const int kpos = e / (2 * L), k2 = e % (2 * L), sn = k2 >= L, l0 = k2 - (sn ? L : 0);
            const float scale = L == 256 ? 0.0625f : 0.03125f, inv = 2.0f / (float)L;
            float v[8];
#pragma unroll
            for (int j = 0; j < 8; ++j) { const int a = (kpos * (l0 + j)) & (L - 1); v[j] = sn ? -sinpif((float)a * inv) * scale : cospif((float)a * inv) * scale; }
            v4u o; o.x = pk2(v[0], v[1]); o.y = pk2(v[2], v[3]); o.z = pk2(v[4], v[5]); o.w = pk2(v[6], v[7]);
            *(v4u*)(T + e) = o;
        }
    }
}
__device__ __forceinline__ float sigmoidf_(float x) { return 1.0f / (1.0f + expf(-x)); }
__device__ __forceinline__ float gelu_tanh(float x) { return 0.5f * x * (1.0f + tanhf(0.7978845608028654f * (x + 0.044715f * x * x * x))); }
__device__ __forceinline__ void seq_geom(int seq, int& L, int& row0) { if (seq < 16) { L = 256; row0 = seq * 256; } else { L = 1024; row0 = M_CTX + (seq - 16) * 1024; } }

__device__ __forceinline__ float fexp(float x) { return __builtin_amdgcn_exp2f(x * 1.4426950408889634f); }
__device__ __forceinline__ float fsigmoid(float x) { return __builtin_amdgcn_rcpf(1.0f + __builtin_amdgcn_exp2f(x * -1.4426950408889634f)); }
__device__ __forceinline__ float fgelu_tanh(float x) { return x * fsigmoid(1.5957691216057308f * (x + 0.044715f * x * x * x)); }
__device__ __forceinline__ float neg_expm1(float y) {
    float p = 1.0f / 720.0f; p = p * y + (1.0f / 120.0f); p = p * y + (1.0f / 24.0f); p = p * y + (1.0f / 6.0f); p = p * y + 0.5f; p = p * y + 1.0f;
    return y < -0.5f ? 1.0f - fexp(y) : -y * p;
}
__device__ __forceinline__ void lru_unit(Frame F, int l, int seq, int h, int q) {
    F.relaunder();
    int L, row0; seq_geom(seq, L, row0);
    const int tid = F.tid, lane = F.lane, wave = F.wave;
    LAS bf16* XR = (LAS bf16*)F.lds;
    LAS bf16* XC = (LAS bf16*)(F.lds + 37440);
    LAS bf16* XG = (LAS bf16*)(F.lds + 74304);
    LAS float* XCF = (LAS float*)(F.lds + 90688);
    LAS float* WTP = (LAS float*)(F.lds + 107072);
    LAS float* WTH = WTP + 256;
    LAS float* CHKP = WTP + 512;
    LAS float* CHKH = WTP + 576;
    const bf16* U = (const bf16*)(F.ws + WS_U);
    bf16* CAT = (bf16*)(F.ws + WS_CAT);
    float* HFG = (float*)(F.ws + WS_HF); float* PBG = (float*)(F.ws + WS_PB);
    const int chb = 64 * h + 16 * q;
    const int nch = L >> 8;
    const int cg = tid & 7, j16 = lane & 15, lq = lane >> 4;
    float gbr[2], gbi[2], sp8[2];
#pragma unroll
    for (int d = 0; d < 2; ++d) { gbr[d] = F.inp(I_BR)[(l * 2 + d) * 512 + chb + j16]; gbi[d] = F.inp(I_BI)[(l * 2 + d) * 512 + chb + j16];
        sp8[d] = -8.0f * log1pf(expf(-F.inp(I_LAM)[(l * 2 + d) * 512 + chb + j16])); }
    float carf = seq < 16 ? 0.f : F.inp(I_STATE)[(((seq - 16) * 4 + l) * 2 + 0) * 512 + chb + j16];
    const float h0b = seq < 16 ? 0.f : F.inp(I_STATE)[(((seq - 16) * 4 + l) * 2 + 1) * 512 + chb + j16];
    v4u xv[5], gv;
#pragma unroll
    for (int i = 0; i < 5; ++i) { const int id = tid + NTHREADS * i, tr = id >> 3, v = id & 7, t = tr - 2; xv[i] = (v4u){0u, 0u, 0u, 0u};
        if (id < 260 * 8 && t >= 0 && t < L) xv[i] = *(const v4u*)(U + (size_t)(row0 + t) * NUC + 64 * h + 8 * v); }
    gv = *(const v4u*)(U + (size_t)(row0 + (tid >> 1)) * NUC + 512 + chb + 8 * (tid & 1));
#pragma unroll 1
    for (int c = 0; c < nch; ++c) {
        const int c0 = c * 256; const bool last = c == nch - 1;
        LAS bf16* XGc = XG + (c & 1) * 4096;
        const int cgo = launder_v(64 * h + 8 * cg);
        f32x4 cwv[4][2], cbv[2];
#pragma unroll
        for (int k = 0; k < 4; ++k) { cwv[k][0] = *(const f32x4*)(F.inp(I_CONVW) + (l * 4 + k) * 512 + cgo); cwv[k][1] = *(const f32x4*)(F.inp(I_CONVW) + (l * 4 + k) * 512 + cgo + 4); }
        cbv[0] = *(const f32x4*)(F.inp(I_CONVB) + l * 512 + cgo); cbv[1] = *(const f32x4*)(F.inp(I_CONVB) + l * 512 + cgo + 4);
        bf16x8 bw[4][2];
        { const bf16* WG = (const bf16*)(F.ws + WS_WG) + (size_t)(((l * 8 + h) * 4 + q) * 2) * 32 * 64 + launder_v(j16 * 64 + 8 * lq);
#pragma unroll
            for (int nt = 0; nt < 4; ++nt)
#pragma unroll
                for (int ks = 0; ks < 2; ++ks) bw[nt][ks] = *(const bf16x8*)(WG + (size_t)(16 * nt) * 64 + 32 * ks); }
#pragma unroll
        for (int i = 0; i < 5; ++i) { const int id = tid + NTHREADS * i; if (id < 260 * 8) *(LAS v4u*)(XR + (id >> 3) * 72 + 8 * (id & 7)) = xv[i]; }
        *(LAS v4u*)(XGc + tid * 8) = gv;
        if (!last) {
#pragma unroll
            for (int i = 0; i < 5; ++i) { const int id = tid + NTHREADS * i, tr = id >> 3, v = id & 7, t = c0 + 256 - 2 + tr; xv[i] = (v4u){0u, 0u, 0u, 0u};
                if (id < 260 * 8 && t < L) xv[i] = *(const v4u*)(U + (size_t)(row0 + t) * NUC + 64 * h + 8 * v); }
            gv = *(const v4u*)(U + (size_t)(row0 + c0 + 256 + (tid >> 1)) * NUC + 512 + chb + 8 * (tid & 1));
        }
        __syncthreads();
#pragma unroll
        for (int i = 0; i < 4; ++i) { const int tl = (tid >> 3) + 64 * i;
            f32x4 o0 = cbv[0], o1 = cbv[1];
#pragma unroll
            for (int k = 0; k < 4; ++k) { const v4u x = *(const LAS v4u*)(XR + (tl + k) * 72 + 8 * cg);
                o0 += (f32x4){bflo(x.x), bfhi(x.x), bflo(x.y), bfhi(x.y)} * cwv[k][0]; o1 += (f32x4){bflo(x.z), bfhi(x.z), bflo(x.w), bfhi(x.w)} * cwv[k][1]; }
            v4u w; w.x = pk2(o0[0], o0[1]); w.y = pk2(o0[2], o0[3]); w.z = pk2(o1[0], o1[1]); w.w = pk2(o1[2], o1[3]);
            *(LAS v4u*)(XC + tl * 72 + 8 * cg) = w;
            if ((cg >> 1) == q) { *(LAS f32x4*)(XCF + tl * 16 + (cg & 1) * 8) = o0; *(LAS f32x4*)(XCF + tl * 16 + (cg & 1) * 8 + 4) = o1; } }
        __syncthreads();
        f32x4 acc[2][4];
#pragma unroll
        for (int mt = 0; mt < 2; ++mt) {
#pragma unroll
            for (int nt = 0; nt < 4; ++nt) acc[mt][nt] = (f32x4){0.f, 0.f, 0.f, 0.f};
#pragma unroll
            for (int ks = 0; ks < 2; ++ks) { const bf16x8 a = *(const LAS bf16x8*)(XC + (32 * wave + 16 * mt + j16) * 72 + 32 * ks + 8 * lq);
#pragma unroll
                for (int nt = 0; nt < 4; ++nt) acc[mt][nt] = __builtin_amdgcn_mfma_f32_16x16x32_bf16(a, bw[nt][ks], acc[mt][nt], 0, 0, 0); }
        }
        float Pc[2][8], Hc[2][8], rP[2][2], rH[2][2];
#pragma unroll
        for (int mt = 0; mt < 2; ++mt) {
            float av[2][4], bv[2][4];
#pragma unroll
            for (int rg = 0; rg < 4; ++rg) { const float xc = XCF[(32 * wave + 16 * mt + 4 * lq + rg) * 16 + j16];
#pragma unroll
                for (int d = 0; d < 2; ++d) { const float r = fsigmoid(acc[mt][2 * d][rg] + gbr[d]), ig = fsigmoid(acc[mt][2 * d + 1][rg] + gbi[d]);
                    const float la = sp8[d] * r; av[d][rg] = fexp(la); bv[d][rg] = sqrtf(neg_expm1(2.0f * la)) * (ig * xc); } }
            float P = 1.f, Hl = 0.f;
#pragma unroll
            for (int rg = 0; rg < 4; ++rg) { Hl = av[0][rg] * Hl + bv[0][rg]; P *= av[0][rg]; Pc[0][4 * mt + rg] = P; Hc[0][4 * mt + rg] = Hl; }
            rP[0][mt] = P; rH[0][mt] = Hl; P = 1.f; Hl = 0.f;
#pragma unroll
            for (int rg = 3; rg >= 0; --rg) { Hl = av[1][rg] * Hl + bv[1][rg]; P *= av[1][rg]; Pc[1][4 * mt + rg] = P; Hc[1][4 * mt + rg] = Hl; }
            rP[1][mt] = P; rH[1][mt] = Hl;
        }
        float EP[2][2], EH[2][2], WPt[2], WHt[2];
#pragma unroll
        for (int d = 0; d < 2; ++d) { float ep = 1.f, eh = 0.f;
#pragma unroll
            for (int rr = 0; rr < 8; ++rr) { const int r = d == 0 ? rr : 7 - rr, mt = r >> 2, lq2 = r & 3;
                const float p = __shfl(rP[d][mt], j16 + 16 * lq2), hh = __shfl(rH[d][mt], j16 + 16 * lq2);
                if (lq2 == lq) { EP[d][mt] = ep; EH[d][mt] = eh; }
                eh = p * eh + hh; ep *= p; }
            WPt[d] = ep; WHt[d] = eh; }
        if (lq == 0) {
#pragma unroll
            for (int d = 0; d < 2; ++d) { WTP[(d * 8 + wave) * 16 + j16] = WPt[d]; WTH[(d * 8 + wave) * 16 + j16] = WHt[d]; } }
        __syncthreads();
        float cwf = 0.f, cwb = 0.f, qwb = 1.f;
        { float cv = carf;
#pragma unroll
            for (int w = 0; w < 8; ++w) { if (w == wave) cwf = cv; cv = WTP[w * 16 + j16] * cv + WTH[w * 16 + j16]; }
            carf = cv;
            cv = last ? h0b : 0.f; float qv = 1.f;
#pragma unroll
            for (int w = 7; w >= 0; --w) { if (w == wave) { cwb = cv; qwb = qv; } const float pw = WTP[(8 + w) * 16 + j16]; cv = pw * cv + WTH[(8 + w) * 16 + j16]; qv *= pw; }
            if (wave == 0 && lq == 0) { CHKP[c * 16 + j16] = qv; CHKH[c * 16 + j16] = cv; }
            if (nch == 1 && wave == 0 && lq == 0) {
                float* so = F.out + (size_t)M_TOK * DMODEL + (size_t)((seq * 4 + l) * 2) * 512 + chb + j16; so[0] = carf; so[512] = cv; } }
#pragma unroll
        for (int mt = 0; mt < 2; ++mt) {
            const float hinf = EP[0][mt] * cwf + EH[0][mt], hinb = EP[1][mt] * cwb + EH[1][mt], pbf = EP[1][mt] * qwb;
#pragma unroll
            for (int rg = 0; rg < 4; ++rg) { const int p = 4 * mt + rg, tl = 32 * wave + 16 * mt + 4 * lq + rg; const size_t row = (size_t)(row0 + c0 + tl);
                const float s = (Hc[0][p] + Pc[0][p] * hinf) + (Hc[1][p] + Pc[1][p] * hinb);
                if (last) CAT[row * DMODEL + chb + j16] = (bf16)f2bf(s * fgelu_tanh(bf2f(XGc[tl * 16 + j16])));
                else { HFG[row * DRNN + chb + j16] = s; PBG[row * DRNN + chb + j16] = Pc[1][p] * pbf; } }
        }
    }
    if (nch > 1) {
        __syncthreads();
        float cin[3]; { float cv = CHKH[(nch - 1) * 16 + j16];
#pragma unroll
            for (int c = 2; c >= 0; --c) { cin[c] = cv; if (c < nch - 1) cv = CHKP[c * 16 + j16] * cv + CHKH[c * 16 + j16]; } }
#pragma unroll
        for (int c = 0; c < 3; ++c) if (c < nch - 1) {
            float sv[8], pv[8], gx[8];
#pragma unroll
            for (int p = 0; p < 8; ++p) { const size_t row = (size_t)(row0 + 256 * c + 32 * wave + 16 * (p >> 2) + 4 * lq + (p & 3));
                sv[p] = HFG[row * DRNN + chb + j16]; pv[p] = PBG[row * DRNN + chb + j16]; gx[p] = bf2f(U[row * NUC + 512 + chb + j16]); }
#pragma unroll
            for (int p = 0; p < 8; ++p) { const size_t row = (size_t)(row0 + 256 * c + 32 * wave + 16 * (p >> 2) + 4 * lq + (p & 3));
                CAT[row * DMODEL + chb + j16] = (bf16)f2bf((sv[p] + pv[p] * cin[c]) * fgelu_tanh(gx[p])); }
        }
    }
    __syncthreads();
}

__device__ __forceinline__ void pool1d_unit(Frame F, int seq, int tb) {
    F.relaunder();
    const bf16* U = (const bf16*)(F.ws + WS_U); bf16* CAT = (bf16*)(F.ws + WS_CAT);
    const int row0 = seq * 256;
#pragma unroll 1
    for (int i = 0; i < 4; ++i) { const int id = F.tid + NTHREADS * i, t = tb * 64 + (id >> 5), v = id & 31, g = v >> 3, hw = 1 << g;
        const int lo = max(t - hw, 0), hi = min(t + hw, 256);
        v4u x[16];
#pragma unroll
        for (int k = 0; k < 16; ++k) { const int tt = t - 8 + k; x[k] = (v4u){0u, 0u, 0u, 0u}; if (tt >= lo && tt < hi) x[k] = *(const v4u*)(U + (size_t)(row0 + tt) * NUC + 1024 + 8 * v); }
        float s[8];
#pragma unroll
        for (int c = 0; c < 8; ++c) s[c] = 0.f;
#pragma unroll
        for (int k = 0; k < 16; ++k) { s[0] += bflo(x[k].x); s[1] += bfhi(x[k].x); s[2] += bflo(x[k].y); s[3] += bfhi(x[k].y); s[4] += bflo(x[k].z); s[5] += bfhi(x[k].z); s[6] += bflo(x[k].w); s[7] += bfhi(x[k].w); }
        const float inv = 1.0f / (float)(hi - lo);
        const v4u xs = x[8];
        v4u o; o.x = pk2(s[0] * inv - bflo(xs.x), s[1] * inv - bfhi(xs.x)); o.y = pk2(s[2] * inv - bflo(xs.y), s[3] * inv - bfhi(xs.y));
        o.z = pk2(s[4] * inv - bflo(xs.z), s[5] * inv - bfhi(xs.z)); o.w = pk2(s[6] * inv - bflo(xs.w), s[7] * inv - bfhi(xs.w));
        *(v4u*)(CAT + (size_t)(row0 + t) * DMODEL + 512 + 8 * v) = o; }
}
__device__ __forceinline__ void pool2d_unit(Frame F, int b, int g, int oc) {
    F.relaunder();
    const bf16* U = (const bf16*)(F.ws + WS_U); bf16* CAT = (bf16*)(F.ws + WS_CAT);
    LAS float* T1 = (LAS float*)F.lds;
    LAS float* T2 = (LAS float*)(F.lds + 32768);
    const int row0 = M_CTX + b * 1024, colb = 64 * g + 8 * oc, hw = 1 << g;
#pragma unroll
    for (int i = 0; i < 2; ++i) { const int t = F.tid + NTHREADS * i;
        const v4u x = *(const v4u*)(U + (size_t)(row0 + t) * NUC + 1024 + colb);
        *(LAS f32x4*)(T1 + t * 8) = (f32x4){bflo(x.x), bfhi(x.x), bflo(x.y), bfhi(x.y)}; *(LAS f32x4*)(T1 + t * 8 + 4) = (f32x4){bflo(x.z), bfhi(x.z), bflo(x.w), bfhi(x.w)}; }
    __syncthreads();
    const int j4 = 4 * (F.tid & 1), tq = F.tid >> 1;
#pragma unroll
    for (int i = 0; i < 4; ++i) { const int t = tq + 256 * i, r = t >> 6, c = t & 63, lo = max(c - hw, 0), hi = min(c + hw, 64);
        f32x4 s = {0.f, 0.f, 0.f, 0.f};
        for (int c2 = lo; c2 < hi; ++c2) s += *(const LAS f32x4*)(T1 + (r * 64 + c2) * 8 + j4);
        *(LAS f32x4*)(T2 + t * 8 + j4) = s * (1.0f / (float)(hi - lo)); }
    __syncthreads();
#pragma unroll
    for (int i = 0; i < 4; ++i) { const int t = tq + 256 * i, r = t >> 6, c = t & 63, lo = max(r - hw, 0), hi = min(r + hw, 16);
        f32x4 s = {0.f, 0.f, 0.f, 0.f};
        for (int r2 = lo; r2 < hi; ++r2) s += *(const LAS f32x4*)(T2 + (r2 * 64 + c) * 8 + j4);
        const f32x4 o = s * (1.0f / (float)(hi - lo)) - *(const LAS f32x4*)(T1 + t * 8 + j4);
        v2u w; w.x = pk2(o[0], o[1]); w.y = pk2(o[2], o[3]);
        *(v2u*)(CAT + (size_t)(row0 + t) * DMODEL + 512 + colb + j4) = w; }
    __syncthreads();
}
__device__ __forceinline__ void fourier_unit(Frame F, int seq, int hd, int nb) {
    F.relaunder();
    int L, row0; seq_geom(seq, L, row0);
    const int lane = F.lane, wave = F.wave, j16 = lane & 15, kq = 8 * (lane >> 4);
    const bf16* XCT = (const bf16*)(F.ws + WS_XCT) + (seq < 16 ? (size_t)(seq * 4 + hd) * 128 * 256 : pg8::XCT_LAT_OFF + (size_t)((seq - 16) * 4 + hd) * 128 * 1024);
    const bf16* T = seq < 16 ? (const bf16*)(F.ws + WS_T256) : (const bf16*)(F.ws + WS_T1024);
    const int K2 = 2 * L, kw = K2 / 8, kbeg = wave * kw;
    const int part = kbeg >= L;
    const bf16* Ab = XCT + (size_t)(part * 64) * L + (kbeg - part * L);
    const bf16* Bb = T + (size_t)(nb * 64) * K2 + kbeg;
    f32x4 acc[4][4];
#pragma unroll
    for (int mt = 0; mt < 4; ++mt)
#pragma unroll
        for (int nt = 0; nt < 4; ++nt) acc[mt][nt] = (f32x4){0.f, 0.f, 0.f, 0.f};
    const bf16* Ap = Ab + (size_t)j16 * L + kq; const bf16* Bp = Bb + (size_t)j16 * K2 + kq;
    const size_t a16 = (size_t)16 * L, b16 = (size_t)16 * K2;
#define FOU_LOAD(A_, B_, ks_) do { _Pragma("unroll") for (int mt = 0; mt < 4; ++mt) A_[mt] = *(const bf16x8*)(Ap + mt * a16 + (ks_)); \
                                   _Pragma("unroll") for (int nt = 0; nt < 4; ++nt) B_[nt] = *(const bf16x8*)(Bp + nt * b16 + (ks_)); } while (0)
#define FOU_MMA(A_, B_) do { _Pragma("unroll") for (int mt = 0; mt < 4; ++mt) _Pragma("unroll") for (int nt = 0; nt < 4; ++nt) \
                                   acc[mt][nt] = __builtin_amdgcn_mfma_f32_16x16x32_bf16(A_[mt], B_[nt], acc[mt][nt], 0, 0, 0); } while (0)
    bf16x8 fa0[4], fb0[4], fa1[4], fb1[4], fa2[4], fb2[4];
    FOU_LOAD(fa0, fb0, 0); FOU_LOAD(fa1, fb1, 32);
    if (kw == 64) { FOU_MMA(fa0, fb0); FOU_MMA(fa1, fb1); }
    else {
        FOU_LOAD(fa2, fb2, 64);
        FOU_MMA(fa0, fb0); FOU_LOAD(fa0, fb0, 96);
        FOU_MMA(fa1, fb1); FOU_LOAD(fa1, fb1, 128);
        FOU_MMA(fa2, fb2); FOU_LOAD(fa2, fb2, 160);
        FOU_MMA(fa0, fb0); FOU_LOAD(fa0, fb0, 192);
        FOU_MMA(fa1, fb1); FOU_LOAD(fa1, fb1, 224);
        FOU_MMA(fa2, fb2); FOU_MMA(fa0, fb0); FOU_MMA(fa1, fb1);
    }
#undef FOU_LOAD
#undef FOU_MMA
    LAS float* red = (LAS float*)F.lds;
#pragma unroll
    for (int mt = 0; mt < 4; ++mt)
#pragma unroll
        for (int nt = 0; nt < 4; ++nt) *(LAS f32x4*)(red + (size_t)(wave * 64 + 16 * nt + j16) * 68 + 16 * mt + 4 * (lane >> 4)) = acc[mt][nt];
    __syncthreads();
    { const int kp = F.tid >> 3, mg = F.tid & 7;
        f32x4 s0 = {0.f, 0.f, 0.f, 0.f}, s1 = s0;
#pragma unroll
        for (int w = 0; w < 8; ++w) { const LAS f32x4* p = (const LAS f32x4*)(red + (size_t)(w * 64 + kp) * 68 + 8 * mg); s0 += p[0]; s1 += p[1]; }
        v4u o; o.x = pk2(s0[0], s0[1]); o.y = pk2(s0[2], s0[3]); o.z = pk2(s1[0], s1[1]); o.w = pk2(s1[2], s1[3]);
        *(v4u*)((bf16*)(F.ws + WS_CAT) + (size_t)(row0 + nb * 64 + kp) * DMODEL + 768 + 64 * hd + 8 * mg) = o; }
    __syncthreads();
}
#ifndef REP_LRU
#define REP_LRU 1
#endif
#ifndef REP_FOU
#define REP_FOU 1
#endif
#ifndef REP_POOL
#define REP_POOL 1
#endif
__device__ __forceinline__ void mixer_phase(const Frame& F, int l) {
    constexpr int N_LRU_LAT = 64, N_FOU_LAT = 128, N_P2D = 64, N_LRU_CTX = 512, N_FOU_CTX = 256, N_P1D = 64;
    constexpr int NREST = N_FOU_LAT + N_P2D + N_LRU_CTX + N_FOU_CTX + N_P1D;
    if (false && F.G == 256 && REP_LRU == 1 && REP_FOU == 1 && REP_POOL == 1) {
        const int b = F.bid;
        if (b < 64) { lru_unit(F, l, 16 + (b >> 5), (b >> 2) & 7, b & 3); fourier_unit(F, b >> 4, (b >> 2) & 3, b & 3); }
        else if (b < 192) { const int i = b - 64; fourier_unit(F, 16 + (i >> 6), (i >> 4) & 3, i & 15);
            for (int k = 0; k < 3; ++k) { const int r = 3 * i + k; lru_unit(F, l, r >> 5, (r >> 2) & 7, r & 3); } }
        else { const int i = b - 192;
            for (int k = 0; k < 2; ++k) { const int r = 384 + 2 * i + k; lru_unit(F, l, r >> 5, (r >> 2) & 7, r & 3); }
            for (int k = 0; k < 3; ++k) { const int r = 64 + 3 * i + k; fourier_unit(F, r >> 4, (r >> 2) & 3, r & 3); }
            pool2d_unit(F, i >> 5, (i >> 3) & 3, i & 7); pool1d_unit(F, i >> 2, i & 3); }
        return;
    }
    const int nlat = F.G >= 128 ? 64 : F.G / 4;
    if (F.bid < nlat) {
        for (int r = F.bid; r < N_LRU_LAT; r += nlat) {
#ifndef SKIP_LRU
            for (int rp = 0; rp < REP_LRU; ++rp) lru_unit(F, l, 16 + (r >> 5), (r >> 2) & 7, r & 3);
#endif
        }
        return;
    }
    for (int it = F.bid - nlat; it < NREST; it += F.G - nlat) {
        int r = it;
        if (r < N_P2D) {
#ifndef SKIP_POOL
            for (int rp = 0; rp < REP_POOL; ++rp) pool2d_unit(F, r >> 5, (r >> 3) & 3, r & 7);
#endif
            continue; } r -= N_P2D;
        if (r < N_FOU_LAT) {
#ifndef SKIP_FOU
            for (int rp = 0; rp < REP_FOU; ++rp) fourier_unit(F, 16 + (r >> 6), (r >> 4) & 3, r & 15);
#endif
            continue; } r -= N_FOU_LAT;
        if (r < N_LRU_CTX) {
#ifndef SKIP_LRU
            for (int rp = 0; rp < REP_LRU; ++rp) lru_unit(F, l, r >> 5, (r >> 2) & 7, r & 3);
#endif
            continue; } r -= N_LRU_CTX;
        if (r < N_FOU_CTX) {
#ifndef SKIP_FOU
            for (int rp = 0; rp < REP_FOU; ++rp) fourier_unit(F, r >> 4, (r >> 2) & 3, r & 3);
#endif
            continue; } r -= N_FOU_CTX;
#ifndef SKIP_POOL
        for (int rp = 0; rp < REP_POOL; ++rp) pool1d_unit(F, r >> 2, r & 3);
#endif
    }
}
#ifndef MK_PER_PHASE
#define MK_PER_PHASE 0
#endif
#ifndef MK_BARRIER
#define MK_BARRIER 1
#endif
#ifndef REP_P0
#define REP_P0 1
#endif
#ifndef REP_MIX
#define REP_MIX 1
#endif
#ifndef REP_G1
#define REP_G1 1
#endif
#ifndef REP_G3
#define REP_G3 1
#endif
constexpr int N_PHASES = 2 + 5 * DEPTHL + 1;
constexpr int CW_BAR = 4096;
__device__ __forceinline__ void final_norm(const Frame& F) {
    const int gw = F.bid * NWAVES + F.wave, NGW = F.G * NWAVES;
    const float* X = (const float*)(F.ws + WS_X); const float* ssq = (const float*)(F.ws + WS_SSQ) + (size_t)8 * M_TOK * 16;
    const f32x4* gp = (const f32x4*)F.inp(I_FG) + F.lane;
    for (int r = gw; r < M_TOK; r += NGW) {
        const float rs = pg8::row_rstd(ssq, r);
        const f32x4* xr = (const f32x4*)(X + (size_t)r * 1024) + F.lane; f32x4* o = (f32x4*)(F.out + (size_t)r * 1024) + F.lane;
#pragma unroll
        for (int j = 0; j < 4; ++j) o[64 * j] = xr[64 * j] * rs * gp[64 * j];
    }
}
__global__ void __launch_bounds__(NTHREADS, 2) mega(Params p) {
    extern __shared__ __attribute__((aligned(16))) unsigned char lds[];
    Frame F;
    F.lds = (LAS unsigned char*)lds; F.tid = threadIdx.x; F.lane = F.tid & 63; F.wave = __builtin_amdgcn_readfirstlane(F.tid >> 6);
    F.G = gridDim.x; F.bid = blockIdx.x; F.in = (const CAS cfp_t*)__builtin_amdgcn_kernarg_segment_ptr(); F.out0 = p.out; F.ws0 = p.ws; F.out = p.out; F.ws = p.ws;
#if MK_BARRIER
    volatile LAS unsigned* bst = (volatile LAS unsigned*)(F.lds + LDS_BYTES - 64);
    if (F.tid < 2) bst[F.tid] = 0u;
    __syncthreads();
    XcdBarrier bar = xcd_barrier_post((unsigned*)(p.ws + WS_CTL) + CW_BAR, bst);
#else
    cg::grid_group grid = cg::this_grid();
#endif
    for (int ph = p.ph_lo; ph < p.ph_hi; ++ph) {
        { size_t z = 0; asm volatile("" : "+s"(z)); F.ws = F.ws0 + z; }
        bf16* A = (bf16*)(F.ws + WS_A); bf16* CAT = (bf16*)(F.ws + WS_CAT); bf16* HID = (bf16*)(F.ws + WS_HID); bf16* U = (bf16*)(F.ws + WS_U); bf16* XCT = (bf16*)(F.ws + WS_XCT);
        float* X = (float*)(F.ws + WS_X); float* SSQ = (float*)(F.ws + WS_SSQ); const float* MODS = (const float*)(F.ws + WS_MODS); const float* GV = (const float*)(F.ws + WS_GV);
        if (ph == 0) {
#ifndef SKIP_P0A
 F.relaunder(); p0a_mods(F);
#endif
 }
        else if (ph == 1) {
#ifndef SKIP_P0B
 F.relaunder();
 { const bool defer = false && F.G >= 224;
   p0b_items(F, 0, defer ? 1 : DEPTHL, F.bid * NWAVES + F.wave, F.G * NWAVES, true); p0b_tail(F); }
#endif
 }
        else if (ph == N_PHASES - 1) { F.relaunder(); final_norm(F); }
        else {
            const int l = (ph - 2) / 5, k = (ph - 2) % 5;
            if (k == 0) {
                F.relaunder();
                pg8::Gemm g{A, (const bf16*)(F.ws + WS_WIN) + (size_t)l * NINP * 1024, M_TOK, NINP, 1024}; pg8::StaticOrder S; S.init(M_TOK, NINP, F.G, F.bid);
                pg8::EpiIn E{U, XCT, SSQ + (size_t)(2 * l) * M_TOK * 16, (const float*)(F.ws + WS_BIASIN) + (size_t)l * 3 * NINP};
#ifndef SKIP_G1
                pg8::gemm_phase<pg8::EpiIn, pg8::StaticOrder, true, true>(F.lds, g, S, E, F.tid);
#endif
            } else if (k == 1) {
#ifndef SKIP_MIX
                for (int rep = 0; rep < REP_MIX; ++rep) mixer_phase(F, l);
#endif
            } else if (k == 2 || k == 4) {
                F.relaunder();
                const bool dn = k == 4;
                pg8::Gemm g{dn ? HID : CAT, dn ? (const bf16*)(F.ws + WS_W2) + (size_t)l * FFD * 1024 : (const bf16*)(F.ws + WS_WOUT) + (size_t)l * 1024 * 1024, M_TOK, 1024, dn ? FFD : 1024};
                pg8::StaticOrder192 S; S.init(M_TOK, 1024, F.G, F.bid);
                const float* Gn = dn ? (l < DEPTHL - 1 ? GV + (size_t)((l + 1) * 2 * 3) * 1024 : nullptr) : GV + (size_t)((l * 2 + 1) * 3) * 1024;
                const int inst = dn ? (l < DEPTHL - 1 ? 2 * (l + 1) : 8) : 2 * l + 1;
                pg8::EpiRes192 E{X, A, MODS + (size_t)l * 3 * 6144 + (dn ? 5 : 2) * 1024, Gn, SSQ + (size_t)inst * M_TOK * 16};
#ifndef SKIP_G24
                pg8::gemm_phase_m192<pg8::EpiRes192, pg8::StaticOrder192>(F.lds, g, S, E, F.tid);
                if (false && dn && l + 1 < DEPTHL && F.G >= 224 && F.bid >= 192) p0b_items(F, l + 1, l + 2, (F.bid - 192) * NWAVES + F.wave, (F.G - 192) * NWAVES, false);
#endif
            } else {
                F.relaunder();
                { pg8::Gemm g{A, (const bf16*)(F.ws + WS_W1) + (size_t)l * FFD * 1024, M_CTX, FFD, 1024}; pg8::StaticOrder S; S.init(M_CTX, FFD, F.G, F.bid);
                  pg8::EpiUp E{HID, SSQ + (size_t)(2 * l + 1) * M_TOK * 16, (const float*)(F.ws + WS_BIAS1) + (size_t)l * 3 * FFD};
#ifndef SKIP_G3
                  pg8::gemm_phase<pg8::EpiUp, pg8::StaticOrder, true, true>(F.lds, g, S, E, F.tid);
#endif
                }
                F.relaunder();
                { const int l2 = launder_s(l);
                  pg8::Gemm g{(const bf16*)(F.ws + WS_A), (const bf16*)(F.ws + WS_W1) + (size_t)l2 * FFD * 1024, M_TOK, FFD, 1024}; pg8::StaticOrder128 S; S.init(M_TOK - M_CTX, FFD, F.G, F.bid, M_CTX / 256);
                  pg8::EpiUp128 E{(bf16*)(F.ws + WS_HID), (const float*)(F.ws + WS_SSQ) + (size_t)(2 * l2 + 1) * M_TOK * 16, (const float*)(F.ws + WS_BIAS1) + (size_t)l2 * 3 * FFD};
#ifndef SKIP_G3
                  pg8::gemm_phase_n128<pg8::EpiUp128, pg8::StaticOrder128>(F.lds, g, S, E, F.tid);
#endif
                }
            }
        }
#if MK_BARRIER
        if (ph + 1 < p.ph_hi) xcd_barrier(bar);
#else
        if (ph + 1 < p.ph_hi) grid.sync();
#endif
    }
}

extern "C" void kernel_launch(void* const* d_in, const int* in_sizes, int n_in, void* d_out, int out_size, void* d_ws, size_t ws_size, hipStream_t stream) {
    static int grid = 0;
    if (grid == 0) {
        if (n_in != 24 || ws_size < WS_END) { fprintf(stderr, "kernel_launch: expected 24 inputs and >= %zu bytes of workspace (got %d, %zu)\n", (size_t)WS_END, n_in, ws_size); grid = -1; return; }
        int dev = 0, cus = 0, per_cu = 0;
        if (hipGetDevice(&dev) != hipSuccess || hipDeviceGetAttribute(&cus, hipDeviceAttributeMultiprocessorCount, dev) != hipSuccess) { grid = -1; return; }
        if (hipFuncSetAttribute((const void*)mega, hipFuncAttributeMaxDynamicSharedMemorySize, LDS_BYTES) != hipSuccess) { fprintf(stderr, "kernel_launch: hipFuncSetAttribute failed\n"); grid = -1; return; }
        if (hipOccupancyMaxActiveBlocksPerMultiprocessor(&per_cu, (const void*)mega, NTHREADS, LDS_BYTES) != hipSuccess || per_cu < 1) { fprintf(stderr, "kernel_launch: occupancy query says %d blocks per CU\n", per_cu); grid = -1; return; }
        grid = cus;
    }
    if (grid < 0) return;
    Params p{};
    for (int i = 0; i < 24; ++i) p.in[i] = (const float*)d_in[i];
    p.out = (float*)d_out; p.ws = (unsigned char*)d_ws;
    hipMemsetAsync((char*)d_ws + WS_CTL, 0, 32768, stream);
#if MK_PER_PHASE
    for (int ph = 0; ph < N_PHASES; ++ph) { p.ph_lo = ph; p.ph_hi = ph + 1; hipLaunchKernelGGL(mega, dim3(grid), dim3(NTHREADS), LDS_BYTES, stream, p); }
#else
    p.ph_lo = 0; p.ph_hi = N_PHASES;
    void* args[] = {&p};
    hipError_t e = hipLaunchCooperativeKernel((const void*)mega, dim3(grid), dim3(NTHREADS), args, LDS_BYTES, stream);
    if (e != hipSuccess) fprintf(stderr, "kernel_launch: cooperative launch failed: %s (grid %d)\n", hipGetErrorString(e), grid);
#endif
}
```

```cpp
#include <hip/hip_runtime.h>
#include <hip/hip_cooperative_groups.h>
#include <cstdio>
#include <cstdint>
namespace cg = cooperative_groups;
#define MK_PER_PHASE 0
#ifndef TS_SEL
#define TS_SEL -1
#endif
#ifndef TS_BLK
#define TS_BLK 0
#endif
namespace pg8 {
#define PG8_LAS __attribute__((address_space(3)))
typedef unsigned short bf16_t;
typedef short bf16x8 __attribute__((ext_vector_type(8)));
typedef float f32x4 __attribute__((ext_vector_type(4)));
typedef unsigned u32x4 __attribute__((ext_vector_type(4)));
constexpr int BM = 256, BK = 64, HALF = 128, HTB = HALF * BK * 2  , STAGE_BYTES = 8 * HTB, NXCD = 8, WGM = 8;

__host__ __device__ __forceinline__ int lds_byte(int r, int c) { const int st = (r >> 4) * 2 + (c >> 5), rr = r & 15, cc = c & 31, ob = rr * 64 + cc * 2; return st * 1024 + (ob ^ (((ob >> 9) & 1) << 5)); }
__host__ __device__ __forceinline__ void stage_rc(int b, int& R, int& C) { const int st = b / 1024, sb = b % 1024, swz = sb ^ (((sb >> 9) & 1) << 5); R = (st >> 1) * 16 + swz / 64; C = (st & 1) * 32 + (swz % 64) / 2; }
__host__ __device__ __forceinline__ int perm32(int rho) { const int n = rho >> 4, i = rho & 15; return 8 * (i >> 2) + 4 * n + (i & 3); }

struct Unit { int pm, pn; };
struct Gemm { const bf16_t* A; const bf16_t* Bt; int M, N, K; };

struct StaticOrder {
    int nM, nN, nwg, G, c;
    __host__ __device__ void init(int M, int N, int G_, int c_) { nM = M / BM; nN = N / BM; nwg = nM * nN; G = G_; c = c_; }
    __host__ __device__ bool next(int i, Unit& u) const {
        const long L = (long)i * G + c; if (L >= nwg) return false;
        int wgid = (int)L; { const int q = nwg / NXCD, r = nwg % NXCD, xcd = wgid % NXCD, off = wgid / NXCD; wgid = (xcd < r ? xcd * (q + 1) : r * (q + 1) + (xcd - r) * q) + off; }
        const int nig = WGM * nN, gid = wgid / nig, fm = gid * WGM, gsz = (nM - fm) < WGM ? (nM - fm) : WGM;
        u.pm = fm + ((wgid % nig) % gsz); u.pn = (wgid % nig) / gsz; return true;
    }
    __device__ __forceinline__ void a_ready(const Unit&) const {}
    __device__ __forceinline__ void done(const Unit&) const {}
};

__device__ __forceinline__ unsigned cvt_pk_bf16(float lo, float hi) { unsigned r; asm volatile("v_cvt_pk_bf16_f32 %0, %1, %2" : "=v"(r) : "v"(lo), "v"(hi)); return r; }
typedef float f32x2 __attribute__((ext_vector_type(2)));
typedef unsigned u32x2 __attribute__((ext_vector_type(2)));
constexpr int NIN = 1792, DM = 1024, DFF = 4096, NU = 1280, SSQW = 16;
constexpr size_t XCT_LAT_OFF = (size_t)16 * 4 * 128 * 256;
__device__ __forceinline__ int cond_of_panel(int pm) { return pm < 16 ? 0 : (pm < 20 ? 1 : 2); }
__device__ __forceinline__ float row_rstd(const float* ssq, int row) {
    const f32x4* sp = (const f32x4*)(ssq + (size_t)row * SSQW);
    const f32x4 s = (sp[0] + sp[1]) + (sp[2] + sp[3]);
    return 1.0f / sqrtf(((s[0] + s[1]) + (s[2] + s[3])) * (1.0f / 1024.0f) + 1e-6f);
}
constexpr int RTAB_OFF = 131072;
struct EpiIn {
    static constexpr bool PERM = true, AFTER_DRAIN = false;
    bf16_t* U; bf16_t* XCT; const float* ssq; const float* bias;
    static constexpr bool NEEDS_RSTD = true;
    __device__ __forceinline__ void operator()(const f32x4 (&acc)[2][2][4][2], const Unit& u, int wr, int wc, int fr, int fq, const PG8_LAS float* rtab) const {
        const int cond = cond_of_panel(u.pm);
        const int bcol0 = u.pn * BM + wc * 32 + 8 * fq;
        f32x4 bv[2][2];
#pragma unroll
        for (int bj = 0; bj < 2; ++bj)
#pragma unroll
            for (int n = 0; n < 2; ++n) bv[bj][n] = *(const f32x4*)(bias + cond * NIN + bcol0 + bj * HALF + 4 * n);
        float sq[2][4];
#pragma unroll
        for (int ai = 0; ai < 2; ++ai)
#pragma unroll
            for (int m = 0; m < 4; ++m) sq[ai][m] = rtab[ai * HALF + wr * 64 + m * 16 + fr];
#pragma unroll
        for (int ai = 0; ai < 2; ++ai)
#pragma unroll
            for (int m = 0; m < 4; ++m) {
                const int row = u.pm * BM + ai * HALF + wr * 64 + m * 16 + fr;
                const float rs = sq[ai][m];
#pragma unroll
                for (int bj = 0; bj < 2; ++bj) {
                    const f32x4 v0 = acc[ai][bj][m][0] * rs + bv[bj][0], v1 = acc[ai][bj][m][1] * rs + bv[bj][1];
                    u32x4 w; w.x = cvt_pk_bf16(v0[0], v0[1]); w.y = cvt_pk_bf16(v0[2], v0[3]); w.z = cvt_pk_bf16(v1[0], v1[1]); w.w = cvt_pk_bf16(v1[2], v1[3]);
                    if (u.pn < 5) { *(u32x4*)(U + (size_t)row * NU + bcol0 + bj * HALF) = w; }
                    else {
                        const int cc = bcol0 + bj * HALF - NU, hd = cc >> 7, mm = cc & 127, m0 = mm & 63;
                        int L, t; bf16_t* base;
                        if (u.pm < 16) { L = 256; t = row & 255; base = XCT + (size_t)(u.pm * 4 + hd) * 128 * 256; }
                        else { const int rl = row - 4096; L = 1024; t = rl & 1023; base = XCT + XCT_LAT_OFF + (size_t)((rl >> 10) * 4 + hd) * 128 * 1024; }
                        const int k = (mm >> 6) * L + t;
                        bf16_t* p = base + ((size_t)(((m0 >> 4) * (L >> 4) + (k >> 5)) * 64 + ((k >> 3) & 3) * 16 + (m0 & 15))) * 8 + (k & 7);
                        p[0] = (bf16_t)(w.x & 0xffffu); p[8] = (bf16_t)(w.x >> 16); p[16] = (bf16_t)(w.y & 0xffffu); p[24] = (bf16_t)(w.y >> 16);
                        p[32] = (bf16_t)(w.z & 0xffffu); p[40] = (bf16_t)(w.z >> 16); p[48] = (bf16_t)(w.w & 0xffffu); p[56] = (bf16_t)(w.w >> 16);
                    }
                }
            }
    }
};
struct EpiUp {
    static constexpr bool PERM = true, AFTER_DRAIN = false;
    bf16_t* H; const float* ssq; const float* bias;
    static constexpr bool NEEDS_RSTD = true;
    __device__ __forceinline__ void operator()(const f32x4 (&acc)[2][2][4][2], const Unit& u, int wr, int wc, int fr, int fq, const PG8_LAS float* rtab) const {
        const int cond = cond_of_panel(u.pm);
        const int bcol0 = u.pn * BM + wc * 32 + 8 * fq;
        f32x4 bv[2][2];
#pragma unroll
        for (int bj = 0; bj < 2; ++bj)
#pragma unroll
            for (int n = 0; n < 2; ++n) bv[bj][n] = *(const f32x4*)(bias + cond * DFF + bcol0 + bj * HALF + 4 * n);
        float sq[2][4];
#pragma unroll
        for (int ai = 0; ai < 2; ++ai)
#pragma unroll
            for (int m = 0; m < 4; ++m) sq[ai][m] = rtab[ai * HALF + wr * 64 + m * 16 + fr];
#pragma unroll
        for (int ai = 0; ai < 2; ++ai)
#pragma unroll
            for (int m = 0; m < 4; ++m) {
                const int row = u.pm * BM + ai * HALF + wr * 64 + m * 16 + fr;
                const float rs = sq[ai][m];
#pragma unroll
                for (int bj = 0; bj < 2; ++bj) {
                    f32x4 v0 = acc[ai][bj][m][0] * rs + bv[bj][0], v1 = acc[ai][bj][m][1] * rs + bv[bj][1];
                    v0 = __builtin_elementwise_max(v0, (f32x4){0.f, 0.f, 0.f, 0.f}); v1 = __builtin_elementwise_max(v1, (f32x4){0.f, 0.f, 0.f, 0.f});
                    v0 = v0 * v0; v1 = v1 * v1;
                    u32x4 w; w.x = cvt_pk_bf16(v0[0], v0[1]); w.y = cvt_pk_bf16(v0[2], v0[3]); w.z = cvt_pk_bf16(v1[0], v1[1]); w.w = cvt_pk_bf16(v1[2], v1[3]);
                    *(u32x4*)(H + (size_t)row * DFF + bcol0 + bj * HALF) = w;
                }
            }
    }
};
struct EpiRes {
    static constexpr bool PERM = false, AFTER_DRAIN = false, NEEDS_RSTD = false;
    float* X; bf16_t* A; const float* gate; const float* Gn; float* ssq_out;
    __device__ __forceinline__ void operator()(const f32x4 (&acc)[2][2][4][2], const Unit& u, int wr, int wc, int fr, int fq, const PG8_LAS float*) const {
        const int cond = cond_of_panel(u.pm);
        const int col0 = u.pn * BM + wc * 32 + 4 * fq;
#pragma unroll
        for (int ai = 0; ai < 2; ++ai)
#pragma unroll
            for (int m = 0; m < 4; ++m) {
                const int row = u.pm * BM + ai * HALF + wr * 64 + m * 16 + fr;
                float q = 0.f;
#pragma unroll
                for (int bj = 0; bj < 2; ++bj)
#pragma unroll
                    for (int n = 0; n < 2; ++n) {
                        const int c = col0 + bj * HALF + n * 16;
                        float* xp = X + (size_t)row * DM + c;
                        const f32x4 g4 = *(const f32x4*)(gate + cond * 6144 + c);
                        const f32x4 x1 = *(const f32x4*)xp + g4 * acc[ai][bj][m][n];
                        *(f32x4*)xp = x1;
                        q += (x1[0] * x1[0] + x1[1] * x1[1]) + (x1[2] * x1[2] + x1[3] * x1[3]);
                        if (Gn) { const f32x4 a = x1 * *(const f32x4*)(Gn + cond * DM + c); u32x2 w; w.x = cvt_pk_bf16(a[0], a[1]); w.y = cvt_pk_bf16(a[2], a[3]);
                            *(u32x2*)(A + (size_t)row * DM + c) = w; }
                    }
                q += __shfl_xor(q, 16); q += __shfl_xor(q, 32);
                if (fq == 0) ssq_out[(size_t)row * SSQW + u.pn * 4 + wc] = q;
                if (m & 1) asm volatile("" ::: "memory");
            }
    }
};
template <class Epi, class Sched, bool ALIGN_EPI = false, bool SP2 = false>
__device__ __forceinline__ void gemm_phase(PG8_LAS unsigned char* lds, const Gemm g, const Sched& S, const Epi& E, int tid_in) {
    int tid_ = tid_in; asm volatile("" : "+v"(tid_)); const int tid = tid_, wid = __builtin_amdgcn_readfirstlane(tid >> 6), lane = tid & 63, wr = wid >> 2, wc = wid & 3, fr = lane & 15, fq = lane >> 4;
    const int K = g.K, nt = K / BK;
    unsigned voffA[2], voffB[2];
#pragma unroll
    for (int i = 0; i < 2; ++i) { int R, C; stage_rc(tid * 16 + i * 8192, R, C); const int Rb = Epi::PERM ? ((R & ~31) + perm32(R & 31)) : R;
        voffA[i] = (unsigned)(R * K + C) * 2u; voffB[i] = (unsigned)(Rb * K + C) * 2u; }
    const size_t kstep = (size_t)(BK * 2);
    const size_t hstep = (size_t)HALF * K * 2;
    const size_t tstep = 2 * hstep;
    const unsigned ldsw = (unsigned)wid * 1024u;
    const int aoff = lds_byte(wr * 64 + fr, fq * 8), boff = lds_byte(wc * 32 + fr, fq * 8);
#define PG8_SA(b, h) (((b) * 2 + (h)) * HTB)
#define PG8_SB(b, h) ((4 + (b) * 2 + (h)) * HTB)
#define PG8_STAGE(bufoff, gbase, voff) do { _Pragma("unroll") for (int _i = 0; _i < 2; ++_i) \
        __builtin_amdgcn_global_load_lds((const unsigned*)((const char*)(gbase) + (voff)[_i]), (PG8_LAS unsigned*)(lds + (bufoff) + ldsw + _i * 8192), 16, 0, 0); } while (0)
#define PG8_LDA(dst, b, h) do { _Pragma("unroll") for (int m = 0; m < 4; ++m) _Pragma("unroll") for (int k = 0; k < 2; ++k) dst[m][k] = *(const PG8_LAS bf16x8*)(lds + PG8_SA(b, h) + aoff + m * 2048 + k * 1024); } while (0)
#define PG8_LDB(dst, b, h) do { _Pragma("unroll") for (int n = 0; n < 2; ++n) _Pragma("unroll") for (int k = 0; k < 2; ++k) dst[n][k] = *(const PG8_LAS bf16x8*)(lds + PG8_SB(b, h) + boff + n * 2048 + k * 1024); } while (0)
#define PG8_MMA(ai, bj, At, Bt) do { __builtin_amdgcn_s_setprio(1); _Pragma("unroll") for (int m = 0; m < 4; ++m) _Pragma("unroll") for (int n = 0; n < 2; ++n) _Pragma("unroll") for (int k = 0; k < 2; ++k) \
        acc[ai][bj][m][n] = __builtin_amdgcn_mfma_f32_16x16x32_bf16(Bt[n][k], At[m][k], acc[ai][bj][m][n], 0, 0, 0); __builtin_amdgcn_s_setprio(0); } while (0)
#define PG8_WAIT_V(n) asm volatile("s_waitcnt vmcnt(" #n ")" ::: "memory")
#define PG8_WAIT_L(n) asm volatile("s_waitcnt lgkmcnt(" #n ")" ::: "memory")
#define PG8_BAR __builtin_amdgcn_s_barrier()
#define PG8_SCHED __builtin_amdgcn_sched_barrier(0)
    Unit cur, nxt; int ui = 0;
    if (!S.next(0, cur)) return;
    f32x4 acc[2][2][4][2];
#pragma unroll
    for (int a = 0; a < 2; ++a)
#pragma unroll
        for (int b = 0; b < 2; ++b)
#pragma unroll
            for (int m = 0; m < 4; ++m)
#pragma unroll
                for (int n = 0; n < 2; ++n) acc[a][b][m][n] = (f32x4){0.f, 0.f, 0.f, 0.f};
    bf16x8 At[4][2], B0[2][2], B1[2][2];
    const char* cA = (const char*)g.A + (size_t)cur.pm * tstep; const char* cB = (const char*)g.Bt + (size_t)cur.pn * tstep;
    if constexpr (Epi::NEEDS_RSTD) { if (tid < 256) ((PG8_LAS float*)(lds + RTAB_OFF))[tid] = row_rstd(E.ssq, cur.pm * BM + tid); }
    S.a_ready(cur);
    if constexpr (SP2) {
        PG8_STAGE(PG8_SB(0, 0), cB, voffB); PG8_STAGE(PG8_SB(0, 1), cB + hstep, voffB); PG8_STAGE(PG8_SA(0, 0), cA, voffA); PG8_STAGE(PG8_SA(0, 1), cA + hstep, voffA);
        if (wr == 1) PG8_BAR;
        PG8_WAIT_V(2); PG8_BAR;
        PG8_STAGE(PG8_SB(1, 0), cB + kstep, voffB); PG8_STAGE(PG8_SA(1, 0), cA + kstep, voffA); PG8_STAGE(PG8_SB(1, 1), cB + hstep + kstep, voffB);
        PG8_WAIT_V(6); PG8_BAR;
    } else {
        PG8_STAGE(PG8_SB(0, 0), cB, voffB); PG8_STAGE(PG8_SA(0, 0), cA, voffA); PG8_STAGE(PG8_SB(0, 1), cB + hstep, voffB); PG8_STAGE(PG8_SA(0, 1), cA + hstep, voffA);
        if (wr == 1) PG8_BAR;
        PG8_WAIT_V(4); PG8_BAR;
        PG8_STAGE(PG8_SB(1, 0), cB + kstep, voffB); PG8_STAGE(PG8_SA(1, 0), cA + kstep, voffA); PG8_STAGE(PG8_SB(1, 1), cB + hstep + kstep, voffB);
        PG8_WAIT_V(6); PG8_BAR;
    }
    for (;;) {
        const bool has_next = S.next(ui + 1, nxt);
        const char* nA = has_next ? (const char*)g.A + (size_t)nxt.pm * tstep : cA; const char* nB = has_next ? (const char*)g.Bt + (size_t)nxt.pn * tstep : cB;
        for (int t = 0; t < nt; t += 2) {
            const bool last = (t == nt - 2);
            const char* a1 = cA + (size_t)(t + 1) * kstep;
            const char* a2 = last ? nA : cA + (size_t)(t + 2) * kstep; const char* b2 = last ? nB : cB + (size_t)(t + 2) * kstep;
            const char* a3 = a2 + kstep; const char* b3 = b2 + kstep;
            if (last && has_next) S.a_ready(nxt);
            if constexpr (SP2) {
            PG8_LDB(B0, 0, 0); PG8_LDB(B1, 0, 1); PG8_SCHED; PG8_LDA(At, 0, 0); PG8_STAGE(PG8_SA(1, 1), a1 + hstep, voffA);
            PG8_WAIT_V(8); PG8_WAIT_L(0); PG8_BAR; PG8_MMA(0, 0, At, B0); PG8_MMA(0, 1, At, B1); PG8_BAR; PG8_SCHED;
            PG8_LDA(At, 0, 1); PG8_STAGE(PG8_SB(0, 0), b2, voffB); PG8_STAGE(PG8_SB(0, 1), b2 + hstep, voffB); PG8_STAGE(PG8_SA(0, 0), a2, voffA);
            PG8_WAIT_V(8); PG8_WAIT_L(0); PG8_BAR; PG8_MMA(1, 0, At, B0); PG8_MMA(1, 1, At, B1); PG8_BAR; PG8_SCHED;
            PG8_LDB(B0, 1, 0); PG8_LDB(B1, 1, 1); PG8_SCHED; PG8_LDA(At, 1, 0); PG8_STAGE(PG8_SA(0, 1), a2 + hstep, voffA);
            PG8_WAIT_V(8); PG8_WAIT_L(0); PG8_BAR; PG8_MMA(0, 0, At, B0); PG8_MMA(0, 1, At, B1); PG8_BAR; PG8_SCHED;
            PG8_LDA(At, 1, 1); PG8_STAGE(PG8_SB(1, 0), b3, voffB); PG8_STAGE(PG8_SB(1, 1), b3 + hstep, voffB); PG8_STAGE(PG8_SA(1, 0), a3, voffA);
            PG8_WAIT_V(8); PG8_WAIT_L(0); PG8_BAR; PG8_MMA(1, 0, At, B0); PG8_MMA(1, 1, At, B1); PG8_BAR; PG8_SCHED;
            } else {
            PG8_LDB(B0, 0, 0); PG8_SCHED; PG8_LDA(At, 0, 0); PG8_STAGE(PG8_SA(1, 1), a1 + hstep, voffA);
            PG8_WAIT_L(8); PG8_BAR; PG8_WAIT_L(0); PG8_MMA(0, 0, At, B0); PG8_BAR; PG8_SCHED;
            PG8_LDB(B1, 0, 1); PG8_STAGE(PG8_SB(0, 0), b2, voffB);
            PG8_BAR; PG8_WAIT_L(0); PG8_MMA(0, 1, At, B1); PG8_BAR;
            PG8_LDA(At, 0, 1); PG8_STAGE(PG8_SA(0, 0), a2, voffA);
            PG8_BAR; PG8_WAIT_L(0); PG8_MMA(1, 0, At, B0); PG8_BAR; PG8_SCHED;
            PG8_STAGE(PG8_SB(0, 1), b2 + hstep, voffB);
            PG8_WAIT_V(6); PG8_BAR; PG8_MMA(1, 1, At, B1); PG8_BAR;
            PG8_LDB(B0, 1, 0); PG8_SCHED; PG8_LDA(At, 1, 0); PG8_STAGE(PG8_SA(0, 1), a2 + hstep, voffA);
            PG8_WAIT_L(8); PG8_BAR; PG8_WAIT_L(0); PG8_MMA(0, 0, At, B0); PG8_BAR; PG8_SCHED;
            PG8_LDB(B1, 1, 1); PG8_STAGE(PG8_SB(1, 0), b3, voffB);
            PG8_BAR; PG8_WAIT_L(0); PG8_MMA(0, 1, At, B1); PG8_BAR;
            PG8_LDA(At, 1, 1); PG8_STAGE(PG8_SA(1, 0), a3, voffA);
            PG8_BAR; PG8_WAIT_L(0); PG8_MMA(1, 0, At, B0); PG8_BAR; PG8_SCHED;
            PG8_STAGE(PG8_SB(1, 1), b3 + hstep, voffB);
            PG8_WAIT_V(6); PG8_BAR; PG8_MMA(1, 1, At, B1); PG8_BAR;
            }
        }
        if constexpr (ALIGN_EPI) { if (wr == 0) PG8_BAR; }
        if constexpr (!Epi::AFTER_DRAIN) { E(acc, cur, wr, wc, fr, fq, (const PG8_LAS float*)(lds + RTAB_OFF + (ui & 1) * 1024)); S.done(cur); }
        if (!has_next) break;
#pragma unroll
        for (int a = 0; a < 2; ++a)
#pragma unroll
            for (int b = 0; b < 2; ++b)
#pragma unroll
                for (int m = 0; m < 4; ++m)
#pragma unroll
                    for (int n = 0; n < 2; ++n) acc[a][b][m][n] = (f32x4){0.f, 0.f, 0.f, 0.f};
        cur = nxt; cA = nA; cB = nB; ++ui;
        if constexpr (Epi::NEEDS_RSTD) { if (tid < 256) ((PG8_LAS float*)(lds + RTAB_OFF + (ui & 1) * 1024))[tid] = row_rstd(E.ssq, cur.pm * BM + tid); }
        if constexpr (ALIGN_EPI) { if (wr == 1) PG8_BAR; }
    }
    PG8_WAIT_V(0);
    if constexpr (!ALIGN_EPI) { if (wr == 0) PG8_BAR; }
    PG8_BAR;
    if constexpr (Epi::AFTER_DRAIN) { E.fused(acc, cur, wr, wc, fr, fq, lds, wid, lane); S.done(cur); }
#undef PG8_SA
#undef PG8_SB
#undef PG8_STAGE
#undef PG8_LDA
#undef PG8_LDB
#undef PG8_MMA
#undef PG8_WAIT_V
#undef PG8_WAIT_L
#undef PG8_BAR
#undef PG8_SCHED
}
struct StaticOrder128 {
    int nM, nN, nwg, G, c, pm0;
    __host__ __device__ void init(int M, int N, int G_, int c_, int pm0_ = 0) { nM = M / BM; nN = N / HALF; nwg = nM * nN; G = G_; c = c_; pm0 = pm0_; }
    __host__ __device__ bool next(int i, Unit& u) const {
        const long L = (long)i * G + c; if (L >= nwg) return false;
        int wgid = (int)L; { const int q = nwg / NXCD, r = nwg % NXCD, xcd = wgid % NXCD, off = wgid / NXCD; wgid = (xcd < r ? xcd * (q + 1) : r * (q + 1) + (xcd - r) * q) + off; }
        const int nig = WGM * nN, gid = wgid / nig, fm = gid * WGM, gsz = (nM - fm) < WGM ? (nM - fm) : WGM;
        u.pm = pm0 + fm + ((wgid % nig) % gsz); u.pn = (wgid % nig) / gsz; return true;
    }
    __device__ __forceinline__ void a_ready(const Unit&) const {}
    __device__ __forceinline__ void done(const Unit&) const {}
};
template <class Epi, class Sched>
__device__ __forceinline__ void gemm_phase_n128(PG8_LAS unsigned char* lds, const Gemm g, const Sched& S, const Epi& E, int tid_in) {
    int tid_ = tid_in; asm volatile("" : "+v"(tid_));
    const int tid = tid_, wid = __builtin_amdgcn_readfirstlane(tid >> 6), lane = tid & 63, wh = wid >> 2, wr = wid >> 1, wc = wid & 1, fr = lane & 15, fq = lane >> 4;
    const int K = g.K, nt = K / BK;
    unsigned voffA[2], voffB[2];
#pragma unroll
    for (int i = 0; i < 2; ++i) { int R, C; stage_rc(tid * 16 + i * 8192, R, C); const int Rb = Epi::PERM ? ((R & ~31) + perm32(R & 31)) : R;
        voffA[i] = (unsigned)(R * K + C) * 2u; voffB[i] = (unsigned)(Rb * K + C) * 2u; }
    const size_t kstep = (size_t)(BK * 2);
    const size_t hstep = (size_t)HALF * K * 2;
    const size_t tstep = 2 * hstep;
    const unsigned ldsw = (unsigned)wid * 1024u;
    const int aoff = lds_byte(wr * 32 + fr, fq * 8), boff = lds_byte(wc * 64 + fr, fq * 8);
#define PG8_SA(b, h) (((b) * 2 + (h)) * HTB)
#define PG8_SB(b) ((4 + (b) * 2) * HTB)
#define PG8_STAGE(bufoff, gbase, voff) do { _Pragma("unroll") for (int _i = 0; _i < 2; ++_i) \
        __builtin_amdgcn_global_load_lds((const unsigned*)((const char*)(gbase) + (voff)[_i]), (PG8_LAS unsigned*)(lds + (bufoff) + ldsw + _i * 8192), 16, 0, 0); } while (0)
#define PG8_LDA(dst, b, h) do { _Pragma("unroll") for (int m = 0; m < 2; ++m) _Pragma("unroll") for (int k = 0; k < 2; ++k) dst[m][k] = *(const PG8_LAS bf16x8*)(lds + PG8_SA(b, h) + aoff + m * 2048 + k * 1024); } while (0)
#define PG8_LDB(dst, b) do { _Pragma("unroll") for (int n = 0; n < 4; ++n) _Pragma("unroll") for (int k = 0; k < 2; ++k) dst[n][k] = *(const PG8_LAS bf16x8*)(lds + PG8_SB(b) + boff + n * 2048 + k * 1024); } while (0)
#define PG8_MMA(ai, At, Bt) do { __builtin_amdgcn_s_setprio(1); _Pragma("unroll") for (int m = 0; m < 2; ++m) _Pragma("unroll") for (int n = 0; n < 4; ++n) _Pragma("unroll") for (int k = 0; k < 2; ++k) \
        acc[ai][m][n] = __builtin_amdgcn_mfma_f32_16x16x32_bf16(Bt[n][k], At[m][k], acc[ai][m][n], 0, 0, 0); __builtin_amdgcn_s_setprio(0); } while (0)
#define PG8_WAIT_V(n) asm volatile("s_waitcnt vmcnt(" #n ")" ::: "memory")
#define PG8_WAIT_L(n) asm volatile("s_waitcnt lgkmcnt(" #n ")" ::: "memory")
#define PG8_BAR __builtin_amdgcn_s_barrier()
#define PG8_SCHED __builtin_amdgcn_sched_barrier(0)
    Unit cur, nxt; int ui = 0;
    if (!S.next(0, cur)) return;
    f32x4 acc[2][2][4];
#pragma unroll
    for (int a = 0; a < 2; ++a)
#pragma unroll
        for (int m = 0; m < 2; ++m)
#pragma unroll
            for (int n = 0; n < 4; ++n) acc[a][m][n] = (f32x4){0.f, 0.f, 0.f, 0.f};
    bf16x8 At[2][2], Bf[4][2];
    const char* cA = (const char*)g.A + (size_t)cur.pm * tstep; const char* cB = (const char*)g.Bt + (size_t)cur.pn * hstep;
    if constexpr (Epi::NEEDS_RSTD) { if (tid < 256) ((PG8_LAS float*)(lds + RTAB_OFF))[tid] = row_rstd(E.ssq, cur.pm * BM + tid); }
    S.a_ready(cur);
    PG8_STAGE(PG8_SB(0), cB, voffB); PG8_STAGE(PG8_SA(0, 0), cA, voffA); PG8_STAGE(PG8_SA(0, 1), cA + hstep, voffA);
    if (wh == 1) PG8_BAR;
    PG8_WAIT_V(2); PG8_BAR;
    PG8_STAGE(PG8_SB(1), cB + kstep, voffB); PG8_STAGE(PG8_SA(1, 0), cA + kstep, voffA);
    PG8_WAIT_V(4); PG8_BAR;
    for (;;) {
        const bool has_next = S.next(ui + 1, nxt);
        const char* nA = has_next ? (const char*)g.A + (size_t)nxt.pm * tstep : cA; const char* nB = has_next ? (const char*)g.Bt + (size_t)nxt.pn * hstep : cB;
        for (int t = 0; t < nt; t += 2) {
            const bool last = (t == nt - 2);
            const char* a1 = cA + (size_t)(t + 1) * kstep;
            const char* a2 = last ? nA : cA + (size_t)(t + 2) * kstep; const char* b2 = last ? nB : cB + (size_t)(t + 2) * kstep;
            const char* a3 = a2 + kstep; const char* b3 = b2 + kstep;
            if (last && has_next) S.a_ready(nxt);
            PG8_LDB(Bf, 0); PG8_SCHED; PG8_LDA(At, 0, 0); PG8_STAGE(PG8_SA(1, 1), a1 + hstep, voffA);
            PG8_WAIT_V(6); PG8_WAIT_L(0); PG8_BAR; PG8_MMA(0, At, Bf); PG8_BAR; PG8_SCHED;
            PG8_LDA(At, 0, 1); PG8_STAGE(PG8_SB(0), b2, voffB); PG8_STAGE(PG8_SA(0, 0), a2, voffA);
            PG8_WAIT_V(6); PG8_WAIT_L(0); PG8_BAR; PG8_MMA(1, At, Bf); PG8_BAR; PG8_SCHED;
            PG8_LDB(Bf, 1); PG8_SCHED; PG8_LDA(At, 1, 0); PG8_STAGE(PG8_SA(0, 1), a2 + hstep, voffA);
            PG8_WAIT_V(6); PG8_WAIT_L(0); PG8_BAR; PG8_MMA(0, At, Bf); PG8_BAR; PG8_SCHED;
            PG8_LDA(At, 1, 1); PG8_STAGE(PG8_SB(1), b3, voffB); PG8_STAGE(PG8_SA(1, 0), a3, voffA);
            PG8_WAIT_V(6); PG8_WAIT_L(0); PG8_BAR; PG8_MMA(1, At, Bf); PG8_BAR; PG8_SCHED;
        }
        if (wh == 0) PG8_BAR;
        E(acc, cur, wr, wc, fr, fq, (const PG8_LAS float*)(lds + RTAB_OFF + (ui & 1) * 1024)); S.done(cur);
        if (!has_next) break;
#pragma unroll
        for (int a = 0; a < 2; ++a)
#pragma unroll
            for (int m = 0; m < 2; ++m)
#pragma unroll
                for (int n = 0; n < 4; ++n) acc[a][m][n] = (f32x4){0.f, 0.f, 0.f, 0.f};
        cur = nxt; cA = nA; cB = nB; ++ui;
        if constexpr (Epi::NEEDS_RSTD) { if (tid < 256) ((PG8_LAS float*)(lds + RTAB_OFF + (ui & 1) * 1024))[tid] = row_rstd(E.ssq, cur.pm * BM + tid); }
        if (wh == 1) PG8_BAR;
    }
    PG8_WAIT_V(0);
    PG8_BAR;
#undef PG8_SA
#undef PG8_SB
#undef PG8_STAGE
#undef PG8_LDA
#undef PG8_LDB
#undef PG8_MMA
#undef PG8_WAIT_V
#undef PG8_WAIT_L
#undef PG8_BAR
#undef PG8_SCHED
}
struct EpiUp128 {
    static constexpr bool PERM = true, NEEDS_RSTD = true;
    bf16_t* H; const float* ssq; const float* bias;
    __device__ __forceinline__ void operator()(const f32x4 (&acc)[2][2][4], const Unit& u, int wr, int wc, int fr, int fq, const PG8_LAS float* rtab) const {
        const int cond = cond_of_panel(u.pm);
        const int bcol0 = u.pn * HALF + wc * 64 + 8 * fq;
        f32x4 bv[2][2];
#pragma unroll
        for (int g2 = 0; g2 < 2; ++g2)
#pragma unroll
            for (int n = 0; n < 2; ++n) bv[g2][n] = *(const f32x4*)(bias + cond * DFF + bcol0 + 32 * g2 + 4 * n);
        float sq[2][2];
#pragma unroll
        for (int ai = 0; ai < 2; ++ai)
#pragma unroll
            for (int m = 0; m < 2; ++m) sq[ai][m] = rtab[ai * HALF + wr * 32 + m * 16 + fr];
#pragma unroll
        for (int ai = 0; ai < 2; ++ai)
#pragma unroll
            for (int m = 0; m < 2; ++m) {
                const int row = u.pm * BM + ai * HALF + wr * 32 + m * 16 + fr;
                const float rs = sq[ai][m];
#pragma unroll
                for (int g2 = 0; g2 < 2; ++g2) {
                    f32x4 v0 = acc[ai][m][2 * g2] * rs + bv[g2][0], v1 = acc[ai][m][2 * g2 + 1] * rs + bv[g2][1];
                    v0 = __builtin_elementwise_max(v0, (f32x4){0.f, 0.f, 0.f, 0.f}); v1 = __builtin_elementwise_max(v1, (f32x4){0.f, 0.f, 0.f, 0.f});
                    v0 = v0 * v0; v1 = v1 * v1;
                    u32x4 w; w.x = cvt_pk_bf16(v0[0], v0[1]); w.y = cvt_pk_bf16(v0[2], v0[3]); w.z = cvt_pk_bf16(v1[0], v1[1]); w.w = cvt_pk_bf16(v1[2], v1[3]);
                    *(u32x4*)(H + (size_t)row * DFF + bcol0 + 32 * g2) = w;
                }
            }
    }
};
struct EpiRes128 {
    static constexpr bool PERM = false, NEEDS_RSTD = false;
    float* X; bf16_t* A; const float* gate; const float* Gn; float* ssq_out;
    __device__ __forceinline__ void operator()(const f32x4 (&acc)[2][2][4], const Unit& u, int wr, int wc, int fr, int fq, const PG8_LAS float*) const {
        const int cond = cond_of_panel(u.pm);
        const int col0 = u.pn * HALF + wc * 64 + 4 * fq;
#pragma unroll
        for (int ai = 0; ai < 2; ++ai)
#pragma unroll
            for (int m = 0; m < 2; ++m) {
                const int row = u.pm * BM + ai * HALF + wr * 32 + m * 16 + fr;
                float q = 0.f;
#pragma unroll
                for (int n = 0; n < 4; ++n) {
                    const int c = col0 + n * 16;
                    float* xp = X + (size_t)row * DM + c;
                    const f32x4 g4 = *(const f32x4*)(gate + cond * 6144 + c);
                    const f32x4 x1 = *(const f32x4*)xp + g4 * acc[ai][m][n];
                    *(f32x4*)xp = x1;
                    q += (x1[0] * x1[0] + x1[1] * x1[1]) + (x1[2] * x1[2] + x1[3] * x1[3]);
                    if (Gn) { const f32x4 a = x1 * *(const f32x4*)(Gn + cond * DM + c); u32x2 w; w.x = cvt_pk_bf16(a[0], a[1]); w.y = cvt_pk_bf16(a[2], a[3]);
                        *(u32x2*)(A + (size_t)row * DM + c) = w; }
                }
                q += __shfl_xor(q, 16); q += __shfl_xor(q, 32);
                if (fq == 0) ssq_out[(size_t)row * SSQW + u.pn * 2 + wc] = q;
                asm volatile("" ::: "memory");
            }
    }
};
struct StaticOrder192 {
    int nM, nN, nwg, G, c;
    __host__ __device__ void init(int M, int N, int G_, int c_) { nM = M / 192; nN = N / HALF; nwg = nM * nN; G = G_; c = c_; }
    __host__ __device__ bool next(int i, Unit& u) const {
        const long L = (long)i * G + c; if (L >= nwg) return false;
        int wgid = (int)L; { const int q = nwg / NXCD, r = nwg % NXCD, xcd = wgid % NXCD, off = wgid / NXCD; wgid = (xcd < r ? xcd * (q + 1) : r * (q + 1) + (xcd - r) * q) + off; }
        const int nig = WGM * nN, gid = wgid / nig, fm = gid * WGM, gsz = (nM - fm) < WGM ? (nM - fm) : WGM;
        u.pm = fm + ((wgid % nig) % gsz); u.pn = (wgid % nig) / gsz; return true;
    }
};
#ifndef M192_SLOTS
#define M192_SLOTS 4
#endif
#ifndef M192_TOUCH
#define M192_TOUCH 0
#endif
template <class Epi, class Sched>
__device__ __forceinline__ void gemm_phase_m192(PG8_LAS unsigned char* lds, const Gemm g, const Sched& S, const Epi& E, int tid_in, unsigned long long* TSX = nullptr) {
    int tid_ = tid_in; asm volatile("" : "+v"(tid_));
    const int tid = tid_, wid = __builtin_amdgcn_readfirstlane(tid >> 6), lane = tid & 63, wh = wid >> 2, wr = wid >> 1, wc = wid & 1, fr = lane & 15, fq = lane >> 4;
    const int K = g.K, nt = K / BK;
    constexpr unsigned SLOT = 40960u, PIECE = 8192u, BOFF = 3u * PIECE;
    constexpr int NS = M192_SLOTS, LA = NS - 1;
    unsigned voffA, voffB;
    { int R, C; stage_rc(tid * 16, R, C); const int Rb = Epi::PERM ? ((R & ~31) + perm32(R & 31)) : R; voffA = (unsigned)(R * K + C) * 2u; voffB = (unsigned)(Rb * K + C) * 2u; }
    const size_t kstep = (size_t)(BK * 2), pstep = (size_t)64 * K * 2;
    const unsigned ldsw = (unsigned)wid * 1024u;
    const int sub = lds_byte(fr, fq * 8);
    unsigned aofs[3];
#pragma unroll
    for (int m = 0; m < 3; ++m) { const int mt = 3 * wr + m; aofs[m] = (unsigned)((mt >> 2) * PIECE + ((mt & 3) * 2) * 1024 + sub); }
    const unsigned bofs = BOFF + (unsigned)wc * PIECE + (unsigned)sub;
    constexpr int TOUCH = M192_TOUCH; constexpr unsigned DUMMY = (unsigned)NS * SLOT;
    const int tpc = tid < 320 ? tid >> 6 : 4, trow = tid & 63;
    const size_t toff = (size_t)(tpc < 3 ? tpc : tpc - 3) * pstep + (size_t)trow * K * 2;
#define PG8_STAGE5(slot, ga, gb) do { \
        _Pragma("unroll") for (int _p = 0; _p < 3; ++_p) __builtin_amdgcn_global_load_lds((const unsigned*)((ga) + _p * pstep + voffA), (PG8_LAS unsigned*)(lds + (slot) + _p * PIECE + ldsw), 16, 0, 0); \
        _Pragma("unroll") for (int _q = 0; _q < 2; ++_q) __builtin_amdgcn_global_load_lds((const unsigned*)((gb) + _q * pstep + voffB), (PG8_LAS unsigned*)(lds + (slot) + BOFF + _q * PIECE + ldsw), 16, 0, 0); } while (0)
#define PG8_WAIT_V(n) asm volatile("s_waitcnt vmcnt(" #n ")" ::: "memory")
#define PG8_WAIT_L(n) asm volatile("s_waitcnt lgkmcnt(" #n ")" ::: "memory")
#define PG8_BAR __builtin_amdgcn_s_barrier()
#define PG8_SCHED __builtin_amdgcn_sched_barrier(0)
#if TS_SEL >= 0
#define M192_STAMP(i) do { if (blockIdx.x == TS_BLK && wid == 0 && TSX) __hip_atomic_store(TSX + (i), (unsigned long long)__builtin_amdgcn_s_memrealtime(), __ATOMIC_RELAXED, __HIP_MEMORY_SCOPE_AGENT); } while (0)
#else
#define M192_STAMP(i) do {} while (0)
#endif
    M192_STAMP(0);
    Unit cur, nxt; int ui = 0;
    if (!S.next(0, cur)) return;
    f32x4 acc[3][4];
#pragma unroll
    for (int m = 0; m < 3; ++m)
#pragma unroll
        for (int n = 0; n < 4; ++n) acc[m][n] = (f32x4){0.f, 0.f, 0.f, 0.f};
    bf16x8 At[3][2], Bf[4][2];
    typename Epi::Pre xpre;
    E.prefetch(xpre, cur, wr, wc, fr, fq);
    const char* cA = (const char*)g.A + (size_t)cur.pm * 3 * pstep; const char* cB = (const char*)g.Bt + (size_t)cur.pn * 2 * pstep;
#pragma unroll
    for (int i = 0; i < LA; ++i) PG8_STAGE5((unsigned)i * SLOT, cA + i * kstep, cB + i * kstep);
    if (LA == 2) PG8_WAIT_V(5); else PG8_WAIT_V(10);
    if (wh == 1) PG8_BAR;
    PG8_BAR;
    unsigned rs = 0u, ss = (unsigned)LA * SLOT;
    M192_STAMP(1);
    for (;;) {
        const bool has_next = S.next(ui + 1, nxt);
        const char* nA = has_next ? (const char*)g.A + (size_t)nxt.pm * 3 * pstep : cA; const char* nB = has_next ? (const char*)g.Bt + (size_t)nxt.pn * 2 * pstep : cB;
        for (int t = 0; t < nt; ++t) {
            const bool tail = t >= nt - LA;
            const char* a2 = tail ? nA + (size_t)(t + LA - nt) * kstep : cA + (size_t)(t + LA) * kstep;
            const char* b2 = tail ? nB + (size_t)(t + LA - nt) * kstep : cB + (size_t)(t + LA) * kstep;
#pragma unroll
            for (int n = 0; n < 4; ++n)
#pragma unroll
                for (int k = 0; k < 2; ++k) Bf[n][k] = *(const PG8_LAS bf16x8*)(lds + rs + bofs + n * 2048 + k * 1024);
            PG8_SCHED;
#pragma unroll
            for (int m = 0; m < 3; ++m)
#pragma unroll
                for (int k = 0; k < 2; ++k) At[m][k] = *(const PG8_LAS bf16x8*)(lds + rs + aofs[m] + k * 1024);
            PG8_STAGE5(ss, a2, b2);
            if (TOUCH > 0) { const int tt = t + TOUCH; const bool nx = tt >= nt;
                const char* ta = (tpc < 3 ? (nx ? nA : cA) : (nx ? nB : cB)) + toff + (size_t)(nx ? (tt - nt < nt ? tt - nt : 0) : tt) * kstep;
                __builtin_amdgcn_global_load_lds((const unsigned*)ta, (PG8_LAS unsigned*)(lds + DUMMY + (unsigned)wid * 256u), 4, 0, 0);
                PG8_WAIT_V(6); } else { if (LA == 2) PG8_WAIT_V(5); else PG8_WAIT_V(10); }
            PG8_WAIT_L(0); PG8_BAR;
            __builtin_amdgcn_s_setprio(1);
#pragma unroll
            for (int m = 0; m < 3; ++m)
#pragma unroll
                for (int n = 0; n < 4; ++n)
#pragma unroll
                    for (int k = 0; k < 2; ++k) acc[m][n] = __builtin_amdgcn_mfma_f32_16x16x32_bf16(Bf[n][k], At[m][k], acc[m][n], 0, 0, 0);
            __builtin_amdgcn_s_setprio(0);
            PG8_BAR; PG8_SCHED;
            rs = rs == (unsigned)LA * SLOT ? 0u : rs + SLOT; ss = ss == (unsigned)LA * SLOT ? 0u : ss + SLOT;
        }
        if (wh == 0) PG8_BAR;
        M192_STAMP(2);
        E(acc, xpre, cur, wr, wc, fr, fq);
        asm volatile("s_waitcnt vmcnt(0)" ::: "memory"); M192_STAMP(3);
        if (!has_next) break;
        E.prefetch(xpre, nxt, wr, wc, fr, fq);
#pragma unroll
        for (int m = 0; m < 3; ++m)
#pragma unroll
            for (int n = 0; n < 4; ++n) acc[m][n] = (f32x4){0.f, 0.f, 0.f, 0.f};
        cur = nxt; cA = nA; cB = nB; ++ui;
        if (wh == 1) PG8_BAR;
    }
    PG8_WAIT_V(0);
    PG8_BAR;
#undef PG8_STAGE5
#undef PG8_WAIT_V
#undef PG8_WAIT_L
#undef PG8_BAR
#undef PG8_SCHED
}
__device__ __forceinline__ int cond_of_row(int row) { return row < 4096 ? 0 : (row < 5120 ? 1 : 2); }
struct EpiRes192 {
    static constexpr bool PERM = false;
    float* X; bf16_t* A; const float* gate; const float* Gn; float* ssq_out;
    struct Pre { f32x4 x[3][4], g[4], gn[4]; int cond0; };
    __device__ __forceinline__ void prefetch(Pre& P, const Unit& u, int wr, int wc, int fr, int fq) const {
        const int col0 = u.pn * HALF + wc * 64 + 4 * fq;
        P.cond0 = cond_of_row(u.pm * 192 + wr * 48);
#pragma unroll
        for (int n = 0; n < 4; ++n) { P.g[n] = *(const f32x4*)(gate + P.cond0 * 6144 + col0 + n * 16); P.gn[n] = Gn ? *(const f32x4*)(Gn + P.cond0 * DM + col0 + n * 16) : (f32x4){0.f, 0.f, 0.f, 0.f}; }
#pragma unroll
        for (int m = 0; m < 3; ++m)
#pragma unroll
            for (int n = 0; n < 4; ++n) P.x[m][n] = *(const f32x4*)(X + (size_t)(u.pm * 192 + wr * 48 + m * 16 + fr) * DM + col0 + n * 16);
    }
    __device__ __forceinline__ void operator()(const f32x4 (&acc)[3][4], const Pre& P, const Unit& u, int wr, int wc, int fr, int fq) const {
        const int col0 = u.pn * HALF + wc * 64 + 4 * fq;
#pragma unroll
        for (int m = 0; m < 3; ++m) {
            const int row = u.pm * 192 + wr * 48 + m * 16 + fr;
            const int cond = cond_of_row(u.pm * 192 + wr * 48 + m * 16);
            float q = 0.f;
#pragma unroll
            for (int n = 0; n < 4; ++n) {
                const int c = col0 + n * 16;
                f32x4 g4 = P.g[n], gn4 = P.gn[n];
                if (cond != P.cond0) { g4 = *(const f32x4*)(gate + cond * 6144 + c); if (Gn) gn4 = *(const f32x4*)(Gn + cond * DM + c); }
                const f32x4 x1 = P.x[m][n] + g4 * acc[m][n];
                *(f32x4*)(X + (size_t)row * DM + c) = x1;
                q += (x1[0] * x1[0] + x1[1] * x1[1]) + (x1[2] * x1[2] + x1[3] * x1[3]);
                if (Gn) { const f32x4 a = x1 * gn4; u32x2 w; w.x = cvt_pk_bf16(a[0], a[1]); w.y = cvt_pk_bf16(a[2], a[3]);
                    *(u32x2*)(A + (size_t)row * DM + c) = w; }
            }
            q += __shfl_xor(q, 16); q += __shfl_xor(q, 32);
            if (fq == 0) ssq_out[(size_t)row * SSQW + u.pn * 2 + wc] = q;
        }
    }
};
}
#define GAS __attribute__((address_space(1)))
#define LAS __attribute__((address_space(3)))
typedef unsigned short bf16;
typedef unsigned v4u __attribute__((ext_vector_type(4)));
typedef unsigned v2u __attribute__((ext_vector_type(2)));
typedef float f32x4 __attribute__((ext_vector_type(4)));
typedef float f32x2 __attribute__((ext_vector_type(2)));
typedef short bf16x8 __attribute__((ext_vector_type(8)));
constexpr int NWAVES = 8, NTHREADS = 512;
constexpr int M_TOK = 6144, M_CTX = 4096, DMODEL = 1024, NINP = 1792, NUC = 1280, FFD = 4096, DEPTHL = 4, DRNN = 512;
constexpr int LDS_BYTES = 163840;
constexpr size_t al256(size_t x) { return (x + 255) & ~(size_t)255; }
constexpr size_t WS_CTL = 0, CTL_BYTES = 1u << 20;
constexpr size_t WS_MODS = WS_CTL + CTL_BYTES;
constexpr size_t WS_GV = WS_MODS + al256((size_t)4 * 3 * 6144 * 4);
constexpr size_t WS_BIASIN = WS_GV + al256((size_t)4 * 2 * 3 * 1024 * 4);
constexpr size_t WS_BIAS1 = WS_BIASIN + al256((size_t)4 * 3 * NINP * 4);
constexpr size_t WS_SSQ = WS_BIAS1 + al256((size_t)4 * 3 * FFD * 4);
constexpr size_t WS_WIN = WS_SSQ + al256((size_t)9 * M_TOK * 16 * 4);
constexpr size_t WS_WOUT = WS_WIN + al256((size_t)4 * NINP * 1024 * 2);
constexpr size_t WS_W1 = WS_WOUT + al256((size_t)4 * 1024 * 1024 * 2);
constexpr size_t WS_W2 = WS_W1 + al256((size_t)4 * FFD * 1024 * 2);
constexpr size_t WS_WG = WS_W2 + al256((size_t)4 * FFD * 1024 * 2);
constexpr size_t WS_GB = WS_WG + al256((size_t)4 * 8 * 4 * 4 * 2 * 32 * 64 * 2);
constexpr size_t WS_T256 = WS_GB + al256((size_t)4 * 2 * 2 * 512 * 4);
constexpr size_t WS_T1024 = WS_T256 + al256((size_t)256 * 512 * 2);
constexpr size_t WS_X = WS_T1024 + al256((size_t)1024 * 2048 * 2);
constexpr size_t WS_A = WS_X + al256((size_t)M_TOK * 1024 * 4);
constexpr size_t WS_U = WS_A + al256((size_t)M_TOK * 1024 * 2);
constexpr size_t WS_XCT = WS_U + al256((size_t)M_TOK * NUC * 2);
constexpr size_t WS_CAT = WS_XCT + al256((size_t)M_TOK * 512 * 2);
constexpr size_t WS_HF = WS_CAT + al256((size_t)M_TOK * 1024 * 2);
constexpr size_t WS_PB = WS_HF + al256((size_t)M_TOK * 512 * 4);
constexpr size_t WS_HID = WS_PB + al256((size_t)M_TOK * 512 * 4);
constexpr size_t WS_END = WS_HID + al256((size_t)M_TOK * FFD * 2);
static_assert(WS_END <= ((size_t)256 << 20), "workspace map exceeds 256 MiB");

__device__ __forceinline__ unsigned f2bf(float f) { unsigned u = __builtin_bit_cast(unsigned, f); return (u + 0x7fffu + ((u >> 16) & 1u)) >> 16; }
__device__ __forceinline__ unsigned pk2(float lo, float hi) { return f2bf(lo) | (f2bf(hi) << 16); }
__device__ __forceinline__ float bf2f(unsigned short b) { return __builtin_bit_cast(float, (unsigned)b << 16); }
__device__ __forceinline__ float bflo(unsigned w) { return __builtin_bit_cast(float, w << 16); }
__device__ __forceinline__ float bfhi(unsigned w) { return __builtin_bit_cast(float, w & 0xffff0000u); }
__device__ __forceinline__ float wave_sum(float v) {
#pragma unroll
    for (int o = 1; o < 64; o <<= 1) v += __shfl_xor(v, o);
    return v;
}
__device__ __forceinline__ float rdlane(float v, int l) { return __builtin_bit_cast(float, __builtin_amdgcn_readlane(__builtin_bit_cast(int, v), l)); }

__device__ __forceinline__ int launder_v(int x) { asm volatile("" : "+v"(x)); return x; }
__device__ __forceinline__ int launder_s(int x) { asm volatile("" : "+s"(x)); return x; }
#define CAS __attribute__((address_space(4)))
typedef const float* cfp_t;
struct Params { const float* in[24]; float* out; unsigned char* ws; int ph_lo, ph_hi; };
struct Frame {
    LAS unsigned char* lds;
    int tid, lane, wave, G, bid;
    __device__ __forceinline__ void relaunder() { wave = launder_s(wave); asm volatile("v_mbcnt_lo_u32_b32 %0, -1, 0\n\tv_mbcnt_hi_u32_b32 %0, -1, %0" : "=v"(lane)); tid = wave * 64 + lane;
        bid = launder_s(bid); G = launder_s(G);
        size_t z = 0; asm volatile("" : "+s"(z), "+s"(in)); ws = ws0 + z; out = out0 + z; }
    __device__ __forceinline__ const float* inp(int i) const { return (const float*)(const GAS float*)in[i]; }
    const CAS cfp_t* in; float* out; unsigned char* ws; float* out0; unsigned char* ws0; unsigned long long* tsx;
};
enum { I_XP = 0, I_XS, I_STATE, I_C, I_CCTX, I_N1G, I_N2G, I_FG, I_WMOD, I_BMOD, I_WIN, I_CONVW, I_CONVB, I_WR, I_BR, I_WI, I_BI, I_LAM, I_POOLW, I_POOLS, I_FW, I_WOUT, I_W1, I_W2 };
#define XB_TMO      128
#define XB_XCNT(j)  (256  + 64 * (j))
#define XB_XSUB(j)  (1280 + 64 * (j))
#define XB_XGEN(j)  (2304 + 64 * (j))
#define XB_TOP      3328
#define XB_TOPGEN   3392
#define XCD_BAR_WORDS 3456
#define XB_SPIN_CAP (1u << 18)

__device__ __forceinline__ unsigned xb_ld(unsigned* p)              { return __hip_atomic_load(p, __ATOMIC_RELAXED, __HIP_MEMORY_SCOPE_AGENT); }
__device__ __forceinline__ unsigned xb_add(unsigned* p, unsigned v) { return __hip_atomic_fetch_add(p, v, __ATOMIC_RELAXED, __HIP_MEMORY_SCOPE_AGENT); }
__device__ __forceinline__ unsigned xb_xcc_id() { return (unsigned)__builtin_amdgcn_s_getreg((3 << 11) | 20) & 0xFu; }
#define XB_SPIN(cond, bar) do { unsigned _sp = 0; while (cond) { __builtin_amdgcn_s_sleep(1); \
    if ((++_sp & 255u) == 0u) { if (xb_ld(&(bar)[XB_TMO])) break; if (_sp > XB_SPIN_CAP) { atomicAdd(&(bar)[XB_TMO], 1u); break; } } } } while (0)

struct XcdBarrier {
    unsigned* bar; unsigned x;
    volatile unsigned* st;
};

__device__ __forceinline__ XcdBarrier xcd_barrier_post(unsigned* bar, volatile unsigned* st) {
    XcdBarrier b; b.bar = bar; b.x = xb_xcc_id(); b.st = st;
    if (threadIdx.x == 0) (void)xb_add(&bar[XB_XCNT(b.x)], 1u);
    return b;
}
__device__ __forceinline__ void xcd_barrier_complete(unsigned* bar, unsigned x, unsigned& nloc, unsigned& nx) {
    const unsigned G = gridDim.x * gridDim.y * gridDim.z;
    unsigned sum, cnt, mine, sp = 0u;
    for (;;) {
        sum = 0u; cnt = 0u; mine = 0u;
#pragma unroll
        for (unsigned j = 0; j < 16; ++j) { const unsigned c = xb_ld(&bar[XB_XCNT(j)]); sum += c; cnt += (c > 0u) ? 1u : 0u; mine = (j == x) ? c : mine; }
        if (sum == G) break;
        __builtin_amdgcn_s_sleep(1);
        if ((++sp & 255u) == 0u) { if (xb_ld(&bar[XB_TMO])) break; if (sp > XB_SPIN_CAP) { atomicAdd(&bar[XB_TMO], 1u); break; } }
    }
    nloc = mine > 0u ? mine : 1u; nx = cnt > 0u ? cnt : 1u;
}

__device__ __forceinline__ void xcd_barrier(const XcdBarrier& b) {
    asm volatile("s_waitcnt vmcnt(0)" ::: "memory");
    __syncthreads();
    if (threadIdx.x == 0) {
        unsigned* bar = b.bar;
        __builtin_amdgcn_s_waitcnt(0);
        unsigned nloc = b.st[0], nx = b.st[1];
        if (nloc == 0u) { xcd_barrier_complete(bar, b.x, nloc, nx); b.st[0] = nloc; b.st[1] = nx; }
        const unsigned old = xb_add(&bar[XB_XSUB(b.x)], 1u);
        const unsigned gen = old / nloc;
        if (old + 1u == (gen + 1u) * nloc) {
            __builtin_amdgcn_fence(__ATOMIC_RELEASE, "agent");
            asm volatile("s_waitcnt vmcnt(0)" ::: "memory");
            const unsigned og = xb_add(&bar[XB_TOP], 1u);
            const unsigned tg = og / nx;
            if (og + 1u == (tg + 1u) * nx) xb_add(&bar[XB_TOPGEN], 1u);
            else XB_SPIN(xb_ld(&bar[XB_TOPGEN]) == tg, bar);
            __builtin_amdgcn_fence(__ATOMIC_ACQUIRE, "agent");
            xb_add(&bar[XB_XGEN(b.x)], 1u);
            asm volatile("s_waitcnt vmcnt(0)" ::: "memory");
        } else {
            XB_SPIN(xb_ld(&bar[XB_XGEN(b.x)]) == gen, bar);
            __builtin_amdgcn_fence(__ATOMIC_ACQUIRE, "agent");
            asm volatile("s_waitcnt vmcnt(0)" ::: "memory");
        }
    }
    __syncthreads();
}
__device__ __forceinline__ void p0a_mods(const Frame& F) {
    LAS float* sl = (LAS float*)F.lds;
    LAS float* red = sl + 3 * 1024;
    const float* c_ctx = F.inp(I_CCTX); const float* cv = F.inp(I_C);
    for (int i = F.tid; i < 3 * 1024; i += NTHREADS) { const int cd = i >> 10, k = i & 1023; const float c = cd == 0 ? c_ctx[k] : cv[(cd - 1) * 1024 + k]; sl[i] = c / (1.0f + expf(-c)); }
    __syncthreads();
    float* mods = (float*)(F.ws + WS_MODS);
    for (int it = F.bid; it < 256; it += F.G) {
        const int l = it >> 6, ch = it & 63;
        const float* W = F.inp(I_WMOD) + (size_t)l * 1024 * 6144 + ch * 96;
        if (F.tid < 504) {
            const int c4 = F.tid % 24, kr = F.tid / 24;
            f32x4 a0 = {0.f, 0.f, 0.f, 0.f}, a1 = a0, a2 = a0;
#pragma unroll 16
            for (int k = kr; k < 1024; k += 21) { const f32x4 w = *(const f32x4*)(W + (size_t)k * 6144 + c4 * 4); a0 += w * sl[k]; a1 += w * sl[1024 + k]; a2 += w * sl[2048 + k]; }
            *(LAS f32x4*)(red + (kr * 3 + 0) * 96 + c4 * 4) = a0; *(LAS f32x4*)(red + (kr * 3 + 1) * 96 + c4 * 4) = a1; *(LAS f32x4*)(red + (kr * 3 + 2) * 96 + c4 * 4) = a2;
        }
        __syncthreads();
        if (F.tid < 288) { const int cd = F.tid / 96, col = F.tid % 96; float s = 0.f;
#pragma unroll
            for (int kr = 0; kr < 21; ++kr) s += red[(kr * 3 + cd) * 96 + col];
            mods[(size_t)(l * 3 + cd) * 6144 + ch * 96 + col] = s + F.inp(I_BMOD)[l * 6144 + ch * 96 + col]; }
        __syncthreads();
    }
}

template <bool BIAS>
__device__ __forceinline__ void strip_item(const float* W, int N, int kb, int ke, int n0, bf16* WT, int ldt, int trow0, const float* sh, float* bias_out, int bstride, LAS float* scr, int lane) {
    float b0 = 0.f, b1 = 0.f, b2 = 0.f;
    const int nn = lane & 31, half = lane >> 5;
    float tv[32];
#pragma unroll
    for (int i = 0; i < 32; ++i) tv[i] = W[(size_t)(kb + 2 * i + half) * N + n0 + nn];
    for (int k0 = kb; k0 < ke; k0 += 64) {
#pragma unroll
        for (int i = 0; i < 32; ++i) scr[(2 * i + half) * 33 + nn] = tv[i];
        if (k0 + 64 < ke) {
#pragma unroll
            for (int i = 0; i < 32; ++i) tv[i] = W[(size_t)(k0 + 64 + 2 * i + half) * N + n0 + nn];
        }
        asm volatile("s_waitcnt lgkmcnt(0)" ::: "memory");
        const int c = lane & 7;
#pragma unroll
        for (int j = 0; j < 4; ++j) { const int n = (lane >> 3) + 8 * j; const LAS float* s = scr + (8 * c) * 33 + n;
            v4u o; o.x = pk2(s[0 * 33], s[1 * 33]); o.y = pk2(s[2 * 33], s[3 * 33]); o.z = pk2(s[4 * 33], s[5 * 33]); o.w = pk2(s[6 * 33], s[7 * 33]);
            *(v4u*)(WT + (size_t)(trow0 + n) * ldt + k0 + 8 * c) = o; }
        if (BIAS) {
            const float s0 = sh[k0 + lane], s1 = sh[6144 + k0 + lane], s2 = sh[2 * 6144 + k0 + lane];
#pragma unroll 8
            for (int kk = 0; kk < 32; ++kk) { const float w = scr[(half * 32 + kk) * 33 + nn]; const int src = half * 32 + kk;
                b0 += w * __shfl(s0, src); b1 += w * __shfl(s1, src); b2 += w * __shfl(s2, src); }
        }
        asm volatile("s_waitcnt lgkmcnt(0)" ::: "memory");
    }
    if (BIAS) {
        b0 += __shfl_xor(b0, 32); b1 += __shfl_xor(b1, 32); b2 += __shfl_xor(b2, 32);
        if (lane < 32) { bias_out[n0 + lane] = b0; bias_out[bstride + n0 + lane] = b1; bias_out[2 * bstride + n0 + lane] = b2; }
    }
}
__device__ __forceinline__ float dft64(float tabreg, int c, int mm) { const int m = mm & 63; const int idx = (mm < 64) ? ((c * m) & 63) : ((c * m - 16) & 63); return __shfl(tabreg, idx); }

__device__ __forceinline__ void p0b_items(Frame F, int llo, int lhi, int gw, int NGW, bool with_rows) {
    const int nl = lhi - llo;
    const float tabreg = cospif((float)F.lane * (1.0f / 32.0f)) * 0.125f;
    const int N_FOUT = 256 * nl, N_FIN = 256 * nl, N_POOLF = 64 * nl, N_FBIAS = 4 * nl, N_W1 = 128 * nl, N_W2 = 128 * nl, N_WIN = 40 * nl, N_WOUTA = 32 * nl, N_ROWS = with_rows ? M_TOK : 0;
    const int NITEMS = N_FOUT + N_FIN + N_POOLF + N_FBIAS + N_W1 + N_W2 + N_WIN + N_WOUTA + N_ROWS;
    const int nA = N_FBIAS + N_FOUT, nW = N_W1 + N_W2 + N_WIN + N_WOUTA, NQ = nA + nW + N_POOLF + N_FIN + N_ROWS / 8;
    unsigned* head = (unsigned*)(F.ws + WS_CTL) + 2048 + 64 * (gw & 7);
    for (int sit = gw;; sit += NGW) {
        int it0, nrep = 1;
        if (with_rows) {
            unsigned idx = 0; if (F.lane == 0) idx = __hip_atomic_fetch_add(head, 1u, __ATOMIC_RELAXED, __HIP_MEMORY_SCOPE_AGENT);
            const int j = (int)__builtin_amdgcn_readfirstlane(idx) * 8 + (gw & 7);
            if (j >= NQ) break;
            if (j < nA) it0 = j;
            else if (j < nA + nW) it0 = nA + N_FIN + N_POOLF + (j - nA);
            else if (j < nA + nW + N_POOLF) it0 = nA + N_FIN + (j - nA - nW);
            else if (j < nA + nW + N_POOLF + N_FIN) it0 = nA + (j - nA - nW - N_POOLF);
            else { it0 = nA + N_FIN + N_POOLF + nW + 8 * (j - nA - nW - N_POOLF - N_FIN); nrep = 8; }
        } else { if (sit >= NITEMS) break; it0 = sit; }
      for (int rep = 0; rep < nrep; ++rep) {
        const int it = it0 + rep;
        int r = it; F.relaunder(); const int lane = F.lane;
        LAS float* scr = (LAS float*)(F.lds + F.wave * 16384);
        const float* mods = (const float*)(F.ws + WS_MODS);
        bf16* WINT = (bf16*)(F.ws + WS_WIN); bf16* WOUTT = (bf16*)(F.ws + WS_WOUT); bf16* W1T = (bf16*)(F.ws + WS_W1); bf16* W2T = (bf16*)(F.ws + WS_W2);
        float* BIASIN = (float*)(F.ws + WS_BIASIN); float* BIAS1 = (float*)(F.ws + WS_BIAS1);

        if (r < N_FBIAS) {
            const int l = llo + (r >> 2), hd = r & 3, rg = lane >> 4, c4 = lane & 15;
            const float* wp = F.inp(I_WIN) + (size_t)l * 1024 * 1536 + (size_t)rg * 1536 + 1280 + 64 * hd + 4 * c4;
            const float* sh = mods + (size_t)l * 3 * 6144 + rg;
            f32x4 b0 = {0.f, 0.f, 0.f, 0.f}, b1 = b0, b2 = b0;
            for (int i0 = 0; i0 < 256; i0 += 16) { f32x4 wv[16];
#pragma unroll
                for (int i = 0; i < 16; ++i) wv[i] = *(const f32x4*)(wp + (size_t)(4 * (i0 + i)) * 1536);
#pragma unroll
                for (int i = 0; i < 16; ++i) { const int k = 4 * (i0 + i); b0 += wv[i] * sh[k]; b1 += wv[i] * sh[6144 + k]; b2 += wv[i] * sh[2 * 6144 + k]; } }
#pragma unroll
            for (int e = 0; e < 4; ++e) { b0[e] += __shfl_xor(b0[e], 16); b0[e] += __shfl_xor(b0[e], 32); b1[e] += __shfl_xor(b1[e], 16); b1[e] += __shfl_xor(b1[e], 32); b2[e] += __shfl_xor(b2[e], 16); b2[e] += __shfl_xor(b2[e], 32); }
            if (lane < 16) { *(LAS f32x4*)(scr + 4 * lane) = b0; *(LAS f32x4*)(scr + 64 + 4 * lane) = b1; *(LAS f32x4*)(scr + 128 + 4 * lane) = b2; }
            asm volatile("s_waitcnt lgkmcnt(0)" ::: "memory");
            for (int hf = 0; hf < 2; ++hf) {
                const int mm = hf * 64 + lane; float s0 = 0.f, s1 = 0.f, s2 = 0.f;
#pragma unroll 8
                for (int c = 0; c < 64; ++c) { const int idx = hf == 0 ? ((c * lane) & 63) : ((c * lane - 16) & 63); const float dv = __shfl(tabreg, idx);
                    s0 += scr[c] * dv; s1 += scr[64 + c] * dv; s2 += scr[128 + c] * dv; }
                float* bo = BIASIN + (size_t)l * 3 * NINP + 1280 + 128 * hd + mm;
                bo[0] = s0; bo[NINP] = s1; bo[2 * NINP] = s2;
            }
            asm volatile("s_waitcnt lgkmcnt(0)" ::: "memory");
            continue;
        }
        r -= N_FBIAS;
        if (r < N_FOUT) {
            const int l = llo + (r >> 8), it16 = (r >> 4) & 15, nb = r & 15, lr = lane & 15, lq = lane >> 4;
            const float* fw = F.inp(I_FW) + (size_t)l * 65536 + (size_t)(it16 * 16 + lr) * 256 + 4 * lq;
            const float* wo = F.inp(I_WOUT) + (size_t)l * 1048576 + (size_t)(768 + 4 * lq) * 1024 + nb * 64 + 4 * lr;
            f32x4 acc[4];
#pragma unroll
            for (int e2 = 0; e2 < 4; ++e2) acc[e2] = (f32x4){0.f, 0.f, 0.f, 0.f};
#pragma unroll 4
            for (int t = 0; t < 16; ++t) { const f32x4 av = *(const f32x4*)(fw + 16 * t); f32x4 bv[4];
#pragma unroll
                for (int e = 0; e < 4; ++e) bv[e] = *(const f32x4*)(wo + (size_t)(16 * t + e) * 1024);
#pragma unroll
                for (int e = 0; e < 4; ++e)
#pragma unroll
                    for (int e2 = 0; e2 < 4; ++e2) acc[e2] = __builtin_amdgcn_mfma_f32_16x16x4f32(av[e], bv[e][e2], acc[e2], 0, 0, 0); }
#pragma unroll
            for (int e2 = 0; e2 < 4; ++e2) { v2u o; o.x = pk2(acc[e2][0], acc[e2][1]); o.y = pk2(acc[e2][2], acc[e2][3]);
                *(v2u*)(WOUTT + (size_t)l * 1048576 + (size_t)(nb * 64 + 4 * lr + e2) * 1024 + 768 + it16 * 16 + 4 * lq) = o; }
            continue;
        }
        r -= N_FOUT;
        if (r < N_FIN) {
            const int l = llo + (r >> 8), hd = (r >> 6) & 3, kt = r & 63, lr = lane & 15, lq = lane >> 4;
            const float* wp = F.inp(I_WIN) + (size_t)l * 1024 * 1536 + (size_t)(kt * 16 + lr) * 1536 + 1280 + 64 * hd + lq;
            f32x4 acc[8];
#pragma unroll
            for (int nt = 0; nt < 8; ++nt) acc[nt] = (f32x4){0.f, 0.f, 0.f, 0.f};
#pragma unroll 2
            for (int ks = 0; ks < 16; ++ks) { const float av = wp[4 * ks]; const int c = 4 * ks + lq;
#pragma unroll
                for (int nt = 0; nt < 8; ++nt) acc[nt] = __builtin_amdgcn_mfma_f32_16x16x4f32(av, dft64(tabreg, c, 16 * nt + lr), acc[nt], 0, 0, 0); }
#pragma unroll
            for (int nt = 0; nt < 8; ++nt) { v2u o; o.x = pk2(acc[nt][0], acc[nt][1]); o.y = pk2(acc[nt][2], acc[nt][3]);
                *(v2u*)(WINT + (size_t)l * NINP * 1024 + (size_t)(1280 + 128 * hd + 16 * nt + lr) * 1024 + kt * 16 + 4 * lq) = o; }
            continue;
        }
        r -= N_FIN;
        if (r < N_POOLF) {
            const int l = llo + (r >> 6), g = (r >> 4) & 3, nb = r & 15, lr = lane & 15, lq = lane >> 4;
            const float* pw = F.inp(I_POOLW) + (size_t)(l * 4 + g) * 4096 + lr * 64 + lq;
            const float* ps = F.inp(I_POOLS) + l * 256 + 64 * g + lq;
            const float* wo = F.inp(I_WOUT) + (size_t)l * 1048576 + (size_t)(512 + 64 * g + lq) * 1024 + nb * 64 + lr;
            f32x4 acc[4][4];
#pragma unroll
            for (int mt = 0; mt < 4; ++mt)
#pragma unroll
                for (int nt = 0; nt < 4; ++nt) acc[mt][nt] = (f32x4){0.f, 0.f, 0.f, 0.f};
#pragma unroll 2
            for (int ks = 0; ks < 16; ++ks) { const float sc = ps[4 * ks]; float av[4], bv[4];
#pragma unroll
                for (int mt = 0; mt < 4; ++mt) av[mt] = pw[mt * 1024 + 4 * ks] * sc;
#pragma unroll
                for (int nt = 0; nt < 4; ++nt) bv[nt] = wo[(size_t)(4 * ks) * 1024 + 16 * nt];
#pragma unroll
                for (int mt = 0; mt < 4; ++mt)
#pragma unroll
                    for (int nt = 0; nt < 4; ++nt) acc[mt][nt] = __builtin_amdgcn_mfma_f32_16x16x4f32(av[mt], bv[nt], acc[mt][nt], 0, 0, 0); }
#pragma unroll
            for (int mt = 0; mt < 4; ++mt)
#pragma unroll
                for (int nt = 0; nt < 4; ++nt) { v2u o; o.x = pk2(acc[mt][nt][0], acc[mt][nt][1]); o.y = pk2(acc[mt][nt][2], acc[mt][nt][3]);
                    *(v2u*)(WOUTT + (size_t)l * 1048576 + (size_t)(nb * 64 + 16 * nt + lr) * 1024 + 512 + 64 * g + 16 * mt + 4 * lq) = o; }
            continue;
        }
        r -= N_POOLF;
        if (r < N_W1) {
            const int l = llo + (r >> 7), nb = r & 127;
            strip_item<true>(F.inp(I_W1) + (size_t)l * 1024 * 4096, 4096, 0, 1024, nb * 32, W1T + (size_t)l * 4096 * 1024, 1024, nb * 32,
                             mods + (size_t)l * 3 * 6144 + 3 * 1024, BIAS1 + (size_t)l * 3 * FFD, FFD, scr, lane);
            continue;
        }
        r -= N_W1;
        if (r < N_W2) {
            const int l = llo + (r >> 7), nb = (r >> 2) & 31, kq = r & 3;
            strip_item<false>(F.inp(I_W2) + (size_t)l * 4096 * 1024, 1024, kq * 1024, kq * 1024 + 1024, nb * 32, W2T + (size_t)l * 1024 * 4096, 4096, nb * 32, nullptr, nullptr, 0, scr, lane);
            continue;
        }
        r -= N_W2;
        if (r < N_WIN) {
            const int l = llo + r / 40, nb = r % 40;
            strip_item<true>(F.inp(I_WIN) + (size_t)l * 1024 * 1536, 1536, 0, 1024, nb * 32, WINT + (size_t)l * NINP * 1024, 1024, nb * 32,
                             mods + (size_t)l * 3 * 6144, BIASIN + (size_t)l * 3 * NINP, NINP, scr, lane);
            continue;
        }
        r -= N_WIN;
        if (r < N_WOUTA) {
            const int l = llo + (r >> 5), nb = r & 31;
            strip_item<false>(F.inp(I_WOUT) + (size_t)l * 1048576, 1024, 0, 512, nb * 32, WOUTT + (size_t)l * 1048576, 1024, nb * 32, nullptr, nullptr, 0, scr, lane);
            continue;
        }
        r -= N_WOUTA;
        if (with_rows) {
            const int cond = r < M_CTX ? 0 : 1 + ((r - M_CTX) >> 10);
            const float* src = r < M_CTX ? F.inp(I_XP) + (size_t)r * 1024 : F.inp(I_XS) + (size_t)(r - M_CTX) * 1024;
            const f32x4* xr = (const f32x4*)src + lane;
            const f32x4* gp = (const f32x4*)F.inp(I_N1G) + lane;
            const f32x4* sp = (const f32x4*)(mods + (size_t)cond * 6144 + 1024) + lane;
            f32x4 v[4]; float s = 0.f;
#pragma unroll
            for (int j = 0; j < 4; ++j) { v[j] = xr[64 * j]; s += (v[j][0] * v[j][0] + v[j][1] * v[j][1]) + (v[j][2] * v[j][2] + v[j][3] * v[j][3]); }
            s = wave_sum(s);
            f32x4* xo = (f32x4*)((float*)(F.ws + WS_X) + (size_t)r * 1024) + lane;
            v2u* ao = (v2u*)((bf16*)(F.ws + WS_A) + (size_t)r * 1024) + lane;
#pragma unroll
            for (int j = 0; j < 4; ++j) { xo[64 * j] = v[j]; const f32x4 a = v[j] * (gp[64 * j] * (sp[64 * j] + 1.0f));
                v2u w; w.x = pk2(a[0], a[1]); w.y = pk2(a[2], a[3]); ao[64 * j] = w; }
            if (lane < 16) ((float*)(F.ws + WS_SSQ))[(size_t)r * 16 + lane] = lane == 0 ? s : 0.f;
        }
      }
    }
}
__device__ __forceinline__ void p0b_tail(Frame F) {
    F.relaunder();
    const float* mods = (const float*)(F.ws + WS_MODS);
    const int gt = F.bid * NTHREADS + F.tid, NGT = F.G * NTHREADS;
    {
        float* GV = (float*)(F.ws + WS_GV);
        for (int i = gt; i < 4 * 2 * 3 * 1024; i += NGT) { const int c = i & 1023, cd = (i >> 10) % 3, w = (i / 3072) & 1, l = i / 6144;
            const float g = (w == 0 ? F.inp(I_N1G) : F.inp(I_N2G))[l * 1024 + c]; GV[i] = g * (1.0f + mods[(size_t)(l * 3 + cd) * 6144 + (w == 0 ? 1 : 4) * 1024 + c]); }
    }
    {
        bf16* WG = (bf16*)(F.ws + WS_WG);
        for (int i = gt; i < 4 * 8 * 4 * 4 * 2 * 32 * 64; i += NGT) { const int c = i & 63, n = (i >> 6) & 31, dir = (i >> 11) & 1, tap = (i >> 12) & 3, q = (i >> 14) & 3, h = (i >> 16) & 7, l = i >> 19;
            const float* src = n < 16 ? F.inp(I_WR) : F.inp(I_WI);
            WG[i] = (bf16)f2bf(F.inp(I_CONVW)[(l * 4 + tap) * 512 + 64 * h + c] * src[((size_t)((l * 2 + dir) * 8 + h) * 64 + c) * 64 + 16 * q + (n & 15)]); }
        float* GB = (float*)(F.ws + WS_GB);
        for (int i = gt; i < 4 * 2 * 2 * 512; i += NGT) { const int ch = i & 511, g = (i >> 9) & 1, dir = (i >> 10) & 1, l = i >> 11, h = ch >> 6, j = ch & 63;
            const float* W = (g == 0 ? F.inp(I_WR) : F.inp(I_WI)) + (size_t)((l * 2 + dir) * 8 + h) * 4096 + j;
            float s = (g == 0 ? F.inp(I_BR) : F.inp(I_BI))[(l * 2 + dir) * 512 + ch];
            { float wv[64];
#pragma unroll
              for (int c = 0; c < 64; ++c) wv[c] = W[c * 64];
#pragma unroll
              for (int c = 0; c < 64; ++c) s += F.inp(I_CONVB)[l * 512 + 64 * h + c] * wv[c]; }
            GB[i] = s; }
    }
    {
        for (int i = gt; i < (256 * 512 + 1024 * 2048) / 8; i += NGT) {
            int L, e; bf16* T;
            if (i < 256 * 512 / 8) { L = 256; e = i * 8; T = (bf16*)(F.ws + WS_T256); } else { L = 1024; e = (i - 256 * 512 / 8) * 8; T = (bf16*)(F.ws + WS_T1024); }
            const int kpos = e / (2 * L), k2 = e % (2 * L), sn = k2 >= L, l0 = k2 - (sn ? L : 0);
            const float scale = L == 256 ? 0.0625f : 0.03125f, inv = 2.0f / (float)L;
            float v[8];
#pragma unroll
            for (int j = 0; j < 8; ++j) { const int a = (kpos * (l0 + j)) & (L - 1); v[j] = sn ? -sinpif((float)a * inv) * scale : cospif((float)a * inv) * scale; }
            v4u o; o.x = pk2(v[0], v[1]); o.y = pk2(v[2], v[3]); o.z = pk2(v[4], v[5]); o.w = pk2(v[6], v[7]);
            *(v4u*)(T + ((size_t)(((kpos >> 4) * (L >> 4) + (k2 >> 5)) * 64 + ((k2 >> 3) & 3) * 16 + (kpos & 15))) * 8) = o;
        }
    }
}
#define LRU_STAMP(i) do { if (TS_SEL >= 0 && F.tsx && F.wave == 0) __hip_atomic_store(F.tsx + (i), (unsigned long long)__builtin_amdgcn_s_memrealtime(), __ATOMIC_RELAXED, __HIP_MEMORY_SCOPE_AGENT); } while (0)
__device__ __forceinline__ float sigmoidf_(float x) { return 1.0f / (1.0f + expf(-x)); }
__device__ __forceinline__ float gelu_tanh(float x) { return 0.5f * x * (1.0f + tanhf(0.7978845608028654f * (x + 0.044715f * x * x * x))); }
__device__ __forceinline__ void seq_geom(int seq, int& L, int& row0) { if (seq < 16) { L = 256; row0 = seq * 256; } else { L = 1024; row0 = M_CTX + (seq - 16) * 1024; } }

__device__ __forceinline__ float fexp(float x) { return __builtin_amdgcn_exp2f(x * 1.4426950408889634f); }
__device__ __forceinline__ float fsigmoid(float x) { return __builtin_amdgcn_rcpf(1.0f + __builtin_amdgcn_exp2f(x * -1.4426950408889634f)); }
__device__ __forceinline__ float fgelu_tanh(float x) { return x * fsigmoid(1.5957691216057308f * (x + 0.044715f * x * x * x)); }
__device__ __forceinline__ float neg_expm1(float y) {
    float p = 1.0f / 720.0f; p = p * y + (1.0f / 120.0f); p = p * y + (1.0f / 24.0f); p = p * y + (1.0f / 6.0f); p = p * y + 0.5f; p = p * y + 1.0f;
    return y < -0.5f ? 1.0f - fexp(y) : -y * p;
}
__device__ __forceinline__ void lru_unit(Frame F, int l, int seq, int h, int q) {
    F.relaunder();
    LRU_STAMP(0);
    int L, row0; seq_geom(seq, L, row0);
    const int tid = F.tid, lane = F.lane, wave = F.wave;
    LAS bf16* XR = (LAS bf16*)F.lds;
    LAS bf16* XG = (LAS bf16*)(F.lds + 37440);
    LAS float* WTP = (LAS float*)(F.lds + 53824);
    LAS float* WTH = WTP + 256;
    LAS float* CHKP = WTP + 512;
    LAS float* CHKH = WTP + 576;
    LAS bf16* WGL = (LAS bf16*)(F.lds + 57344);
    const bf16* U = (const bf16*)(F.ws + WS_U);
    bf16* CAT = (bf16*)(F.ws + WS_CAT);
    float* HFG = (float*)(F.ws + WS_HF); float* PBG = (float*)(F.ws + WS_PB);
    const int chb = 64 * h + 16 * q;
    const int nch = L >> 8;
    const int j16 = lane & 15, lq = lane >> 4;
    float gbr[2], gbi[2], sp8[2], cwo[4];
    { const float* GB = (const float*)(F.ws + WS_GB) + (size_t)l * 2048 + chb + j16;
#pragma unroll
        for (int d = 0; d < 2; ++d) { gbr[d] = GB[d * 1024]; gbi[d] = GB[d * 1024 + 512];
            sp8[d] = -8.0f * log1pf(expf(-F.inp(I_LAM)[(l * 2 + d) * 512 + chb + j16])); } }
#pragma unroll
    for (int k = 0; k < 4; ++k) cwo[k] = F.inp(I_CONVW)[(l * 4 + k) * 512 + chb + j16];
    const float cbo = F.inp(I_CONVB)[l * 512 + chb + j16];
    float carf = seq < 16 ? 0.f : F.inp(I_STATE)[(((seq - 16) * 4 + l) * 2 + 0) * 512 + chb + j16];
    const float h0b = seq < 16 ? 0.f : F.inp(I_STATE)[(((seq - 16) * 4 + l) * 2 + 1) * 512 + chb + j16];
    v4u xv[5], gv;
#pragma unroll
    for (int i = 0; i < 5; ++i) { const int id = tid + NTHREADS * i, tr = id >> 3, v = id & 7, t = tr - 2; xv[i] = (v4u){0u, 0u, 0u, 0u};
        if (id < 260 * 8 && t >= 0 && t < L) xv[i] = *(const v4u*)(U + (size_t)(row0 + t) * NUC + 64 * h + 8 * v); }
    gv = *(const v4u*)(U + (size_t)(row0 + (tid >> 1)) * NUC + 512 + chb + 8 * (tid & 1));
    { const bf16* WGb = (const bf16*)(F.ws + WS_WG) + (size_t)((l * 8 + h) * 4 + q) * (4 * 2 * 32 * 64);
        v4u wv[4];
#pragma unroll
        for (int i = 0; i < 4; ++i) { const int id = tid + NTHREADS * i; wv[i] = *(const v4u*)(WGb + (size_t)(id >> 3) * 64 + 8 * (id & 7)); }
#pragma unroll
        for (int i = 0; i < 4; ++i) { const int id = tid + NTHREADS * i; *(LAS v4u*)(WGL + (id >> 3) * 72 + 8 * (id & 7)) = wv[i]; } }
#pragma unroll 1
    for (int c = 0; c < nch; ++c) {
        const int c0 = c * 256; const bool last = c == nch - 1;
        LAS bf16* XGc = XG + (c & 1) * 4096;
#pragma unroll
        for (int i = 0; i < 5; ++i) { const int id = tid + NTHREADS * i; if (id < 260 * 8) *(LAS v4u*)(XR + (id >> 3) * 72 + 8 * (id & 7)) = xv[i]; }
        *(LAS v4u*)(XGc + tid * 8) = gv;
        if (!last) {
#pragma unroll
            for (int i = 0; i < 5; ++i) { const int id = tid + NTHREADS * i, tr = id >> 3, v = id & 7, t = c0 + 256 - 2 + tr; xv[i] = (v4u){0u, 0u, 0u, 0u};
                if (id < 260 * 8 && t < L) xv[i] = *(const v4u*)(U + (size_t)(row0 + t) * NUC + 64 * h + 8 * v); }
            gv = *(const v4u*)(U + (size_t)(row0 + c0 + 256 + (tid >> 1)) * NUC + 512 + chb + 8 * (tid & 1));
        }
        __syncthreads();
        LRU_STAMP(1);
        f32x4 acc[2][4];
#pragma unroll
        for (int mt = 0; mt < 2; ++mt)
#pragma unroll
            for (int nt = 0; nt < 4; ++nt) acc[mt][nt] = (f32x4){0.f, 0.f, 0.f, 0.f};
#pragma unroll
        for (int k = 0; k < 4; ++k)
#pragma unroll
            for (int mt = 0; mt < 2; ++mt)
#pragma unroll
                for (int ks = 0; ks < 2; ++ks) { const bf16x8 a = *(const LAS bf16x8*)(XR + (32 * wave + 16 * mt + j16 + k) * 72 + 32 * ks + 8 * lq);
#pragma unroll
                    for (int nt = 0; nt < 4; ++nt) acc[mt][nt] = __builtin_amdgcn_mfma_f32_16x16x32_bf16(a, *(const LAS bf16x8*)(WGL + (k * 64 + 16 * nt + j16) * 72 + 32 * ks + 8 * lq), acc[mt][nt], 0, 0, 0); }
        LRU_STAMP(3);
        float Pc[2][8], Hc[2][8], rP[2][2], rH[2][2];
#pragma unroll
        for (int mt = 0; mt < 2; ++mt) {
            float av[2][4], bv[2][4];
#pragma unroll
            for (int rg = 0; rg < 4; ++rg) { const int tl = 32 * wave + 16 * mt + 4 * lq + rg;
                float xc = cbo;
#pragma unroll
                for (int k = 0; k < 4; ++k) xc += bf2f(XR[(tl + k) * 72 + 16 * q + j16]) * cwo[k];
#pragma unroll
                for (int d = 0; d < 2; ++d) { const float r = fsigmoid(acc[mt][2 * d][rg] + gbr[d]), ig = fsigmoid(acc[mt][2 * d + 1][rg] + gbi[d]);
                    const float la = sp8[d] * r; av[d][rg] = fexp(la); bv[d][rg] = sqrtf(neg_expm1(2.0f * la)) * (ig * xc); } }
            float P = 1.f, Hl = 0.f;
#pragma unroll
            for (int rg = 0; rg < 4; ++rg) { Hl = av[0][rg] * Hl + bv[0][rg]; P *= av[0][rg]; Pc[0][4 * mt + rg] = P; Hc[0][4 * mt + rg] = Hl; }
            rP[0][mt] = P; rH[0][mt] = Hl; P = 1.f; Hl = 0.f;
#pragma unroll
            for (int rg = 3; rg >= 0; --rg) { Hl = av[1][rg] * Hl + bv[1][rg]; P *= av[1][rg]; Pc[1][4 * mt + rg] = P; Hc[1][4 * mt + rg] = Hl; }
            rP[1][mt] = P; rH[1][mt] = Hl;
        }
        LRU_STAMP(4);
        float EP[2][2], EH[2][2], WPt[2], WHt[2];
#pragma unroll
        for (int d = 0; d < 2; ++d) { float ep = 1.f, eh = 0.f;
#pragma unroll
            for (int rr = 0; rr < 8; ++rr) { const int r = d == 0 ? rr : 7 - rr, mt = r >> 2, lq2 = r & 3;
                const float p = __shfl(rP[d][mt], j16 + 16 * lq2), hh = __shfl(rH[d][mt], j16 + 16 * lq2);
                if (lq2 == lq) { EP[d][mt] = ep; EH[d][mt] = eh; }
                eh = p * eh + hh; ep *= p; }
            WPt[d] = ep; WHt[d] = eh; }
        if (lq == 0) {
#pragma unroll
            for (int d = 0; d < 2; ++d) { WTP[(d * 8 + wave) * 16 + j16] = WPt[d]; WTH[(d * 8 + wave) * 16 + j16] = WHt[d]; } }
        __syncthreads();
        LRU_STAMP(5);
        float cwf = 0.f, cwb = 0.f, qwb = 1.f;
        { float cv = carf;
#pragma unroll
            for (int w = 0; w < 8; ++w) { if (w == wave) cwf = cv; cv = WTP[w * 16 + j16] * cv + WTH[w * 16 + j16]; }
            carf = cv;
            cv = last ? h0b : 0.f; float qv = 1.f;
#pragma unroll
            for (int w = 7; w >= 0; --w) { if (w == wave) { cwb = cv; qwb = qv; } const float pw = WTP[(8 + w) * 16 + j16]; cv = pw * cv + WTH[(8 + w) * 16 + j16]; qv *= pw; }
            if (wave == 0 && lq == 0) { CHKP[c * 16 + j16] = qv; CHKH[c * 16 + j16] = cv; }
            if (nch == 1 && wave == 0 && lq == 0) {
                float* so = F.out + (size_t)M_TOK * DMODEL + (size_t)((seq * 4 + l) * 2) * 512 + chb + j16; so[0] = carf; so[512] = cv; } }
        LRU_STAMP(6);
#pragma unroll
        for (int mt = 0; mt < 2; ++mt) {
            const float hinf = EP[0][mt] * cwf + EH[0][mt], hinb = EP[1][mt] * cwb + EH[1][mt], pbf = EP[1][mt] * qwb;
#pragma unroll
            for (int rg = 0; rg < 4; ++rg) { const int p = 4 * mt + rg, tl = 32 * wave + 16 * mt + 4 * lq + rg; const size_t row = (size_t)(row0 + c0 + tl);
                const float s = (Hc[0][p] + Pc[0][p] * hinf) + (Hc[1][p] + Pc[1][p] * hinb);
                if (last) CAT[row * DMODEL + chb + j16] = (bf16)f2bf(s * fgelu_tanh(bf2f(XGc[tl * 16 + j16])));
                else { HFG[row * DRNN + chb + j16] = s; PBG[row * DRNN + chb + j16] = Pc[1][p] * pbf; } }
        }
        if (!last) __syncthreads();
    }
    LRU_STAMP(7);
    if (nch > 1) {
        __syncthreads();
        float cin[3]; { float cv = CHKH[(nch - 1) * 16 + j16];
#pragma unroll
            for (int c = 2; c >= 0; --c) { cin[c] = cv; if (c < nch - 1) cv = CHKP[c * 16 + j16] * cv + CHKH[c * 16 + j16]; } }
#pragma unroll
        for (int c = 0; c < 3; ++c) if (c < nch - 1) {
            float sv[8], pv[8], gx[8];
#pragma unroll
            for (int p = 0; p < 8; ++p) { const size_t row = (size_t)(row0 + 256 * c + 32 * wave + 16 * (p >> 2) + 4 * lq + (p & 3));
                sv[p] = HFG[row * DRNN + chb + j16]; pv[p] = PBG[row * DRNN + chb + j16]; gx[p] = bf2f(U[row * NUC + 512 + chb + j16]); }
#pragma unroll
            for (int p = 0; p < 8; ++p) { const size_t row = (size_t)(row0 + 256 * c + 32 * wave + 16 * (p >> 2) + 4 * lq + (p & 3));
                CAT[row * DMODEL + chb + j16] = (bf16)f2bf((sv[p] + pv[p] * cin[c]) * fgelu_tanh(gx[p])); }
        }
    }
    __syncthreads();
}

__device__ __forceinline__ void pool1d_unit(Frame F, int seq, int tb) {
    F.relaunder();
    const bf16* U = (const bf16*)(F.ws + WS_U); bf16* CAT = (bf16*)(F.ws + WS_CAT);
    const int row0 = seq * 256;
#pragma unroll 1
    for (int i = 0; i < 4; ++i) { const int id = F.tid + NTHREADS * i, t = tb * 64 + (id >> 5), v = id & 31, g = v >> 3, hw = 1 << g;
        const int lo = max(t - hw, 0), hi = min(t + hw, 256);
        v4u x[16];
#pragma unroll
        for (int k = 0; k < 16; ++k) { const int tt = t - 8 + k; x[k] = (v4u){0u, 0u, 0u, 0u}; if (tt >= lo && tt < hi) x[k] = *(const v4u*)(U + (size_t)(row0 + tt) * NUC + 1024 + 8 * v); }
        float s[8];
#pragma unroll
        for (int c = 0; c < 8; ++c) s[c] = 0.f;
#pragma unroll
        for (int k = 0; k < 16; ++k) { s[0] += bflo(x[k].x); s[1] += bfhi(x[k].x); s[2] += bflo(x[k].y); s[3] += bfhi(x[k].y); s[4] += bflo(x[k].z); s[5] += bfhi(x[k].z); s[6] += bflo(x[k].w); s[7] += bfhi(x[k].w); }
        const float inv = 1.0f / (float)(hi - lo);
        const v4u xs = x[8];
        v4u o; o.x = pk2(s[0] * inv - bflo(xs.x), s[1] * inv - bfhi(xs.x)); o.y = pk2(s[2] * inv - bflo(xs.y), s[3] * inv - bfhi(xs.y));
        o.z = pk2(s[4] * inv - bflo(xs.z), s[5] * inv - bfhi(xs.z)); o.w = pk2(s[6] * inv - bflo(xs.w), s[7] * inv - bfhi(xs.w));
        *(v4u*)(CAT + (size_t)(row0 + t) * DMODEL + 512 + 8 * v) = o; }
}
__device__ __forceinline__ void pool2d_unit(Frame F, int b, int g, int oc) {
    F.relaunder();
    const bf16* U = (const bf16*)(F.ws + WS_U); bf16* CAT = (bf16*)(F.ws + WS_CAT);
    LAS float* T1 = (LAS float*)F.lds;
    LAS float* T2 = (LAS float*)(F.lds + 32768);
    const int row0 = M_CTX + b * 1024, colb = 64 * g + 8 * oc, hw = 1 << g;
#pragma unroll
    for (int i = 0; i < 2; ++i) { const int t = F.tid + NTHREADS * i;
        const v4u x = *(const v4u*)(U + (size_t)(row0 + t) * NUC + 1024 + colb);
        *(LAS f32x4*)(T1 + t * 8) = (f32x4){bflo(x.x), bfhi(x.x), bflo(x.y), bfhi(x.y)}; *(LAS f32x4*)(T1 + t * 8 + 4) = (f32x4){bflo(x.z), bfhi(x.z), bflo(x.w), bfhi(x.w)}; }
    __syncthreads();
    const int j4 = 4 * (F.tid & 1), tq = F.tid >> 1;
#pragma unroll
    for (int i = 0; i < 4; ++i) { const int t = tq + 256 * i, r = t >> 6, c = t & 63, lo = max(c - hw, 0), hi = min(c + hw, 64);
        f32x4 s = {0.f, 0.f, 0.f, 0.f};
        for (int c2 = lo; c2 < hi; ++c2) s += *(const LAS f32x4*)(T1 + (r * 64 + c2) * 8 + j4);
        *(LAS f32x4*)(T2 + t * 8 + j4) = s * (1.0f / (float)(hi - lo)); }
    __syncthreads();
#pragma unroll
    for (int i = 0; i < 4; ++i) { const int t = tq + 256 * i, r = t >> 6, c = t & 63, lo = max(r - hw, 0), hi = min(r + hw, 16);
        f32x4 s = {0.f, 0.f, 0.f, 0.f};
        for (int r2 = lo; r2 < hi; ++r2) s += *(const LAS f32x4*)(T2 + (r2 * 64 + c) * 8 + j4);
        const f32x4 o = s * (1.0f / (float)(hi - lo)) - *(const LAS f32x4*)(T1 + t * 8 + j4);
        v2u w; w.x = pk2(o[0], o[1]); w.y = pk2(o[2], o[3]);
        *(v2u*)(CAT + (size_t)(row0 + t) * DMODEL + 512 + colb + j4) = w; }
    __syncthreads();
}
__device__ __forceinline__ void fourier_unit(Frame F, int seq, int hd, int nb) {
    F.relaunder();
    LRU_STAMP(0);
    int L, row0; seq_geom(seq, L, row0);
    const int lane = F.lane, wave = F.wave, j16 = lane & 15, kq = 8 * (lane >> 4);
    const bf16* XCT = (const bf16*)(F.ws + WS_XCT) + (seq < 16 ? (size_t)(seq * 4 + hd) * 128 * 256 : pg8::XCT_LAT_OFF + (size_t)((seq - 16) * 4 + hd) * 128 * 1024);
    const bf16* T = seq < 16 ? (const bf16*)(F.ws + WS_T256) : (const bf16*)(F.ws + WS_T1024);
    const int K2 = 2 * L, KB2 = K2 >> 5, kw = K2 / 8, kbeg = wave * kw;
    const bf16* Ab = XCT + ((size_t)(kbeg >> 5) * 64 + lane) * 8;
    const bf16* Bb = T + ((size_t)((nb * 4) * KB2 + (kbeg >> 5)) * 64 + lane) * 8;
    f32x4 acc[4][4];
#pragma unroll
    for (int mt = 0; mt < 4; ++mt)
#pragma unroll
        for (int nt = 0; nt < 4; ++nt) acc[mt][nt] = (f32x4){0.f, 0.f, 0.f, 0.f};
    const bf16* Ap = Ab; const bf16* Bp = Bb;
    const size_t a16 = (size_t)KB2 * 512, b16 = (size_t)KB2 * 512;
#define FOU_LOAD(A_, B_, ks_) do { _Pragma("unroll") for (int mt = 0; mt < 4; ++mt) A_[mt] = *(const bf16x8*)(Ap + mt * a16 + (size_t)(ks_) * 16); \
                                   _Pragma("unroll") for (int nt = 0; nt < 4; ++nt) B_[nt] = *(const bf16x8*)(Bp + nt * b16 + (size_t)(ks_) * 16); } while (0)
#define FOU_MMA(A_, B_) do { _Pragma("unroll") for (int mt = 0; mt < 4; ++mt) _Pragma("unroll") for (int nt = 0; nt < 4; ++nt) \
                                   acc[mt][nt] = __builtin_amdgcn_mfma_f32_16x16x32_bf16(A_[mt], B_[nt], acc[mt][nt], 0, 0, 0); } while (0)
    bf16x8 fa0[4], fb0[4], fa1[4], fb1[4], fa2[4], fb2[4];
    FOU_LOAD(fa0, fb0, 0); FOU_LOAD(fa1, fb1, 32);
    if (kw == 64) { FOU_MMA(fa0, fb0); FOU_MMA(fa1, fb1); }
    else {
        FOU_LOAD(fa2, fb2, 64);
        FOU_MMA(fa0, fb0); FOU_LOAD(fa0, fb0, 96);
        FOU_MMA(fa1, fb1); FOU_LOAD(fa1, fb1, 128);
        FOU_MMA(fa2, fb2); FOU_LOAD(fa2, fb2, 160);
        FOU_MMA(fa0, fb0); FOU_LOAD(fa0, fb0, 192);
        FOU_MMA(fa1, fb1); FOU_LOAD(fa1, fb1, 224);
        FOU_MMA(fa2, fb2); FOU_MMA(fa0, fb0); FOU_MMA(fa1, fb1);
    }
#undef FOU_LOAD
#undef FOU_MMA
    LRU_STAMP(1);
    LAS float* red = (LAS float*)F.lds;
#pragma unroll
    for (int mt = 0; mt < 4; ++mt)
#pragma unroll
        for (int nt = 0; nt < 4; ++nt) *(LAS f32x4*)(red + (size_t)(wave * 64 + 16 * nt + j16) * 68 + 16 * mt + 4 * (lane >> 4)) = acc[mt][nt];
    __syncthreads();
    LRU_STAMP(2);
    { const int kp = F.tid >> 3, mg = F.tid & 7;
        f32x4 s0 = {0.f, 0.f, 0.f, 0.f}, s1 = s0;
#pragma unroll
        for (int w = 0; w < 8; ++w) { const LAS f32x4* p = (const LAS f32x4*)(red + (size_t)(w * 64 + kp) * 68 + 8 * mg); s0 += p[0]; s1 += p[1]; }
        v4u o; o.x = pk2(s0[0], s0[1]); o.y = pk2(s0[2], s0[3]); o.z = pk2(s1[0], s1[1]); o.w = pk2(s1[2], s1[3]);
        *(v4u*)((bf16*)(F.ws + WS_CAT) + (size_t)(row0 + nb * 64 + kp) * DMODEL + 768 + 64 * hd + 8 * mg) = o; }
    __syncthreads();
    LRU_STAMP(3);
}
#ifndef REP_LRU
#define REP_LRU 1
#endif
#ifndef REP_FOU
#define REP_FOU 1
#endif
#ifndef REP_POOL
#define REP_POOL 1
#endif
__device__ __forceinline__ void mixer_phase(const Frame& F, int l) {
    constexpr int N_LRU_LAT = 64, N_FOU_LAT = 128, N_P2D = 64, N_LRU_CTX = 512, N_FOU_CTX = 256, N_P1D = 64;
    constexpr int NREST = N_FOU_LAT + N_P2D + N_LRU_CTX + N_FOU_CTX + N_P1D;
    if (false && F.G == 256 && REP_LRU == 1 && REP_FOU == 1 && REP_POOL == 1) {
        const int b = F.bid;
        if (b < 64) { lru_unit(F, l, 16 + (b >> 5), (b >> 2) & 7, b & 3); fourier_unit(F, b >> 4, (b >> 2) & 3, b & 3); }
        else if (b < 192) { const int i = b - 64; fourier_unit(F, 16 + (i >> 6), (i >> 4) & 3, i & 15);
            for (int k = 0; k < 3; ++k) { const int r = 3 * i + k; lru_unit(F, l, r >> 5, (r >> 2) & 7, r & 3); } }
        else { const int i = b - 192;
            for (int k = 0; k < 2; ++k) { const int r = 384 + 2 * i + k; lru_unit(F, l, r >> 5, (r >> 2) & 7, r & 3); }
            for (int k = 0; k < 3; ++k) { const int r = 64 + 3 * i + k; fourier_unit(F, r >> 4, (r >> 2) & 3, r & 3); }
            pool2d_unit(F, i >> 5, (i >> 3) & 3, i & 7); pool1d_unit(F, i >> 2, i & 3); }
        return;
    }
    const int nlat = F.G >= 128 ? 64 : F.G / 4;
    if (F.bid < nlat) {
        for (int r = F.bid; r < N_LRU_LAT; r += nlat) {
#ifndef SKIP_LRU
            for (int rp = 0; rp < REP_LRU; ++rp) lru_unit(F, l, 16 + (r >> 5), (r >> 2) & 7, r & 3);
#endif
        }
        return;
    }
#if TS_SEL >= 0
    int ustamp = 0; unsigned long long* TSX = (unsigned long long*)(F.ws0 + WS_CTL + 2048) + 64;
#define MIX_STAMP() do { if (F.bid == TS_BLK && F.wave == 0 && l == (TS_SEL - 2) / 5 && ustamp < 8) __hip_atomic_store(TSX + ustamp, (unsigned long long)__builtin_amdgcn_s_memrealtime(), __ATOMIC_RELAXED, __HIP_MEMORY_SCOPE_AGENT); ++ustamp; } while (0)
#else
#define MIX_STAMP() do {} while (0)
#endif
    for (int it = F.bid - nlat; ; it += F.G - nlat) {
        MIX_STAMP();
        if (it >= NREST) break;
        int r = it;
        if (r < N_P2D) {
#ifndef SKIP_POOL
            for (int rp = 0; rp < REP_POOL; ++rp) pool2d_unit(F, r >> 5, (r >> 3) & 3, r & 7);
#endif
            continue; } r -= N_P2D;
        if (r < N_FOU_LAT) {
#ifndef SKIP_FOU
            { Frame F2 = F;
#if TS_SEL >= 0
              if (F.bid == TS_BLK && l == (TS_SEL - 2) / 5) F2.tsx = TSX + 32;
#endif
              for (int rp = 0; rp < REP_FOU; ++rp) fourier_unit(F2, 16 + ((r & 7) >> 2), r & 3, r >> 3); }
#endif
            continue; } r -= N_FOU_LAT;
        if (r < N_LRU_CTX) {
#ifndef SKIP_LRU
            { Frame F2 = F;
#if TS_SEL >= 0
              if (F.bid == TS_BLK && l == (TS_SEL - 2) / 5 && ustamp == 2) F2.tsx = TSX + 16;
#endif
              for (int rp = 0; rp < REP_LRU; ++rp) lru_unit(F2, l, r >> 5, (r >> 2) & 7, r & 3); }
#endif
            continue; } r -= N_LRU_CTX;
        if (r < N_FOU_CTX) {
#ifndef SKIP_FOU
            for (int rp = 0; rp < REP_FOU; ++rp) fourier_unit(F, r >> 4, (r >> 2) & 3, r & 3);
#endif
            continue; } r -= N_FOU_CTX;
#ifndef SKIP_POOL
        for (int rp = 0; rp < REP_POOL; ++rp) pool1d_unit(F, r >> 2, r & 3);
#endif
    }
}
#ifndef MK_PER_PHASE
#define MK_PER_PHASE 0
#endif
#ifndef MK_BARRIER
#define MK_BARRIER 1
#endif
#ifndef REP_P0
#define REP_P0 1
#endif
#ifndef REP_MIX
#define REP_MIX 1
#endif
#ifndef REP_G1
#define REP_G1 1
#endif
#ifndef REP_G3
#define REP_G3 1
#endif
#ifndef TS_SEL
#define TS_SEL -1
#endif
#ifndef TS_MODE
#define TS_MODE 0
#endif
#ifndef TS_BLK
#define TS_BLK 0
#endif
#ifndef TSX_OFF
#define TSX_OFF 0
#endif
#ifndef TS_SCALE
#define TS_SCALE 1e-6f
#endif
constexpr int N_PHASES = 2 + 5 * DEPTHL + 1;
constexpr int CW_BAR = 4096;
__device__ __forceinline__ void final_norm(const Frame& F) {
    const int gw = F.bid * NWAVES + F.wave, NGW = F.G * NWAVES;
    const float* X = (const float*)(F.ws + WS_X); const float* ssq = (const float*)(F.ws + WS_SSQ) + (size_t)8 * M_TOK * 16;
    const f32x4* gp = (const f32x4*)F.inp(I_FG) + F.lane;
    for (int r = gw; r < M_TOK; r += NGW) {
        const float rs = pg8::row_rstd(ssq, r);
        const f32x4* xr = (const f32x4*)(X + (size_t)r * 1024) + F.lane; f32x4* o = (f32x4*)(F.out + (size_t)r * 1024) + F.lane;
#pragma unroll
        for (int j = 0; j < 4; ++j) o[64 * j] = xr[64 * j] * rs * gp[64 * j];
    }
}
__global__ void __launch_bounds__(NTHREADS, 2) mega(Params p) {
    extern __shared__ __attribute__((aligned(16))) unsigned char lds[];
    Frame F;
    F.lds = (LAS unsigned char*)lds; F.tid = threadIdx.x; F.lane = F.tid & 63; F.wave = __builtin_amdgcn_readfirstlane(F.tid >> 6);
    F.G = gridDim.x; F.bid = blockIdx.x; F.in = (const CAS cfp_t*)__builtin_amdgcn_kernarg_segment_ptr(); F.out0 = p.out; F.ws0 = p.ws; F.out = p.out; F.ws = p.ws; F.tsx = nullptr;
#if MK_BARRIER
    volatile unsigned* bst = (volatile unsigned*)(p.ws + WS_CTL) + 1024 + 2 * blockIdx.x;
    XcdBarrier bar = xcd_barrier_post((unsigned*)(p.ws + WS_CTL) + CW_BAR, bst);
#else
    cg::grid_group grid = cg::this_grid();
#endif
#if TS_SEL >= 0
    unsigned long long* TS = (unsigned long long*)(p.ws + WS_CTL + 2048);
    if (blockIdx.x == TS_BLK && threadIdx.x == 0) TS[31] = __builtin_amdgcn_s_memrealtime();
#endif
    for (int ph = p.ph_lo; ph < p.ph_hi; ++ph) {
        { size_t z = 0; asm volatile("" : "+s"(z)); F.ws = F.ws0 + z; }
        bf16* A = (bf16*)(F.ws + WS_A); bf16* CAT = (bf16*)(F.ws + WS_CAT); bf16* HID = (bf16*)(F.ws + WS_HID); bf16* U = (bf16*)(F.ws + WS_U); bf16* XCT = (bf16*)(F.ws + WS_XCT);
        float* X = (float*)(F.ws + WS_X); float* SSQ = (float*)(F.ws + WS_SSQ); const float* MODS = (const float*)(F.ws + WS_MODS); const float* GV = (const float*)(F.ws + WS_GV);
        if (ph == 0) {
#ifndef SKIP_P0A
 F.relaunder(); p0a_mods(F);
#endif
 }
        else if (ph == 1) {
#ifndef SKIP_P0B
 F.relaunder();
 { const bool defer = false && F.G >= 224;
   p0b_items(F, 0, defer ? 1 : DEPTHL, F.bid * NWAVES + F.wave, F.G * NWAVES, true); p0b_tail(F); }
#endif
 }
        else if (ph == N_PHASES - 1) { F.relaunder(); final_norm(F); }
        else {
            const int l = (ph - 2) / 5, k = (ph - 2) % 5;
            if (k == 0) {
                F.relaunder();
                pg8::Gemm g{A, (const bf16*)(F.ws + WS_WIN) + (size_t)l * NINP * 1024, M_TOK, NINP, 1024}; pg8::StaticOrder S; S.init(M_TOK, NINP, F.G, F.bid);
                pg8::EpiIn E{U, XCT, SSQ + (size_t)(2 * l) * M_TOK * 16, (const float*)(F.ws + WS_BIASIN) + (size_t)l * 3 * NINP};
#ifndef SKIP_G1
                pg8::gemm_phase<pg8::EpiIn, pg8::StaticOrder, true, true>(F.lds, g, S, E, F.tid);
#endif
            } else if (k == 1) {
#ifndef SKIP_MIX
                for (int rep = 0; rep < REP_MIX; ++rep) mixer_phase(F, l);
#endif
            } else if (k == 2 || k == 4) {
                F.relaunder();
                const bool dn = k == 4;
                pg8::Gemm g{dn ? HID : CAT, dn ? (const bf16*)(F.ws + WS_W2) + (size_t)l * FFD * 1024 : (const bf16*)(F.ws + WS_WOUT) + (size_t)l * 1024 * 1024, M_TOK, 1024, dn ? FFD : 1024};
                pg8::StaticOrder192 S; S.init(M_TOK, 1024, F.G, F.bid);
                const float* Gn = dn ? (l < DEPTHL - 1 ? GV + (size_t)((l + 1) * 2 * 3) * 1024 : nullptr) : GV + (size_t)((l * 2 + 1) * 3) * 1024;
                const int inst = dn ? (l < DEPTHL - 1 ? 2 * (l + 1) : 8) : 2 * l + 1;
                pg8::EpiRes192 E{X, A, MODS + (size_t)l * 3 * 6144 + (dn ? 5 : 2) * 1024, Gn, SSQ + (size_t)inst * M_TOK * 16};
#ifndef SKIP_G24
                #if TS_SEL >= 0
                pg8::gemm_phase_m192<pg8::EpiRes192, pg8::StaticOrder192>(F.lds, g, S, E, F.tid, ph == TS_SEL ? (unsigned long long*)(p.ws + WS_CTL + 2048) + 64 : nullptr);
#else
                pg8::gemm_phase_m192<pg8::EpiRes192, pg8::StaticOrder192>(F.lds, g, S, E, F.tid);
#endif
                if (false && dn && l + 1 < DEPTHL && F.G >= 224 && F.bid >= 192) p0b_items(F, l + 1, l + 2, (F.bid - 192) * NWAVES + F.wave, (F.G - 192) * NWAVES, false);
#endif
            } else {
                F.relaunder();
                { pg8::Gemm g{A, (const bf16*)(F.ws + WS_W1) + (size_t)l * FFD * 1024, M_CTX, FFD, 1024}; pg8::StaticOrder S; S.init(M_CTX, FFD, F.G, F.bid);
                  pg8::EpiUp E{HID, SSQ + (size_t)(2 * l + 1) * M_TOK * 16, (const float*)(F.ws + WS_BIAS1) + (size_t)l * 3 * FFD};
#ifndef SKIP_G3
                  pg8::gemm_phase<pg8::EpiUp, pg8::StaticOrder, true, true>(F.lds, g, S, E, F.tid);
#endif
                }
                F.relaunder();
                { const int l2 = launder_s(l);
                  pg8::Gemm g{(const bf16*)(F.ws + WS_A), (const bf16*)(F.ws + WS_W1) + (size_t)l2 * FFD * 1024, M_TOK, FFD, 1024}; pg8::StaticOrder128 S; S.init(M_TOK - M_CTX, FFD, F.G, F.bid, M_CTX / 256);
                  pg8::EpiUp128 E{(bf16*)(F.ws + WS_HID), (const float*)(F.ws + WS_SSQ) + (size_t)(2 * l2 + 1) * M_TOK * 16, (const float*)(F.ws + WS_BIAS1) + (size_t)l2 * 3 * FFD};
#ifndef SKIP_G3
                  pg8::gemm_phase_n128<pg8::EpiUp128, pg8::StaticOrder128>(F.lds, g, S, E, F.tid);
#endif
                }
            }
        }
#if TS_SEL >= 0
        if (blockIdx.x == TS_BLK && F.wave == 0) __hip_atomic_store(TS + 32 + ph, (unsigned long long)__builtin_amdgcn_s_memrealtime(), __ATOMIC_RELAXED, __HIP_MEMORY_SCOPE_AGENT);
#endif
#if MK_BARRIER
        if (ph + 1 < p.ph_hi) xcd_barrier(bar);
#else
        if (ph + 1 < p.ph_hi) grid.sync();
#endif
#if TS_SEL >= 0
        if (blockIdx.x == TS_BLK && F.wave == 0) __hip_atomic_store(TS + ph, (unsigned long long)__builtin_amdgcn_s_memrealtime(), __ATOMIC_RELAXED, __HIP_MEMORY_SCOPE_AGENT);
        if (ph == N_PHASES - 2 && blockIdx.x == 255 - TS_BLK) {
            const unsigned long long te = __hip_atomic_load(TS + TS_SEL, __ATOMIC_RELAXED, __HIP_MEMORY_SCOPE_AGENT), tb = __hip_atomic_load(TS + 32 + TS_SEL, __ATOMIC_RELAXED, __HIP_MEMORY_SCOPE_AGENT),
                                     ts = __hip_atomic_load(TS + (TS_SEL == 0 ? 31 : TS_SEL - 1), __ATOMIC_RELAXED, __HIP_MEMORY_SCOPE_AGENT);
            unsigned long long t1 = TS_MODE == 1 ? tb : te, t0 = TS_MODE == 2 ? tb : ts;
            if (TS_MODE == 3) { t0 = __hip_atomic_load(TS + 31, __ATOMIC_RELAXED, __HIP_MEMORY_SCOPE_AGENT); t1 = te; }
            if (TS_MODE >= 10) { unsigned long long x[8]; for (int i = 0; i < 8; ++i) x[i] = __hip_atomic_load(TS + 64 + TSX_OFF + i, __ATOMIC_RELAXED, __HIP_MEMORY_SCOPE_AGENT);
                if (TS_MODE == 10) { t0 = ts; t1 = x[0]; } else if (TS_MODE == 14) { t0 = x[3]; t1 = tb; } else { t0 = x[TS_MODE - 11]; t1 = x[TS_MODE - 10]; } }
            const float us = (float)(t1 - t0) * 0.01f, f = 1.0f + sqrtf(TS_SCALE * us);
            float* st = p.out + (size_t)M_TOK * DMODEL;
            F.relaunder();
            for (int i = F.tid; i < 16 * 4 * 2 * 512; i += NTHREADS) st[i] *= f;
        }
#endif
    }
}

extern "C" void kernel_launch(void* const* d_in, const int* in_sizes, int n_in, void* d_out, int out_size, void* d_ws, size_t ws_size, hipStream_t stream) {
    static int grid = 0;
    if (grid == 0) {
        if (n_in != 24 || ws_size < WS_END) { fprintf(stderr, "kernel_launch: expected 24 inputs and >= %zu bytes of workspace (got %d, %zu)\n", (size_t)WS_END, n_in, ws_size); grid = -1; return; }
        int dev = 0, cus = 0, per_cu = 0;
        if (hipGetDevice(&dev) != hipSuccess || hipDeviceGetAttribute(&cus, hipDeviceAttributeMultiprocessorCount, dev) != hipSuccess) { grid = -1; return; }
        if (hipFuncSetAttribute((const void*)mega, hipFuncAttributeMaxDynamicSharedMemorySize, LDS_BYTES) != hipSuccess) { fprintf(stderr, "kernel_launch: hipFuncSetAttribute failed\n"); grid = -1; return; }
        if (hipOccupancyMaxActiveBlocksPerMultiprocessor(&per_cu, (const void*)mega, NTHREADS, LDS_BYTES) != hipSuccess || per_cu < 1) { fprintf(stderr, "kernel_launch: occupancy query says %d blocks per CU\n", per_cu); grid = -1; return; }
        grid = cus;
    }
    if (grid < 0) return;
    Params p{};
    for (int i = 0; i < 24; ++i) p.in[i] = (const float*)d_in[i];
    p.out = (float*)d_out; p.ws = (unsigned char*)d_ws;
    hipMemsetAsync((char*)d_ws + WS_CTL, 0, 32768, stream);
#if MK_PER_PHASE
    for (int ph = 0; ph < N_PHASES; ++ph) { p.ph_lo = ph; p.ph_hi = ph + 1; hipLaunchKernelGGL(mega, dim3(grid), dim3(NTHREADS), LDS_BYTES, stream, p); }
#else
    p.ph_lo = 0; p.ph_hi = N_PHASES;
    void* args[] = {&p};
    hipError_t e = hipLaunchCooperativeKernel((const void*)mega, dim3(grid), dim3(NTHREADS), args, LDS_BYTES, stream);
    if (e != hipSuccess) fprintf(stderr, "kernel_launch: cooperative launch failed: %s (grid %d)\n", hipGetErrorString(e), grid);
#endif
}
```

```cpp
#include <hip/hip_runtime.h>
#include <hip/hip_cooperative_groups.h>
#include <cstdio>
#include <cstdint>
namespace cg = cooperative_groups;
#define MK_PER_PHASE 0
#ifndef TS_SEL
#define TS_SEL -1
#endif
#ifndef TS_BLK
#define TS_BLK 0
#endif
namespace pg8 {
#define PG8_LAS __attribute__((address_space(3)))
typedef unsigned short bf16_t;
typedef short bf16x8 __attribute__((ext_vector_type(8)));
typedef float f32x4 __attribute__((ext_vector_type(4)));
typedef unsigned u32x4 __attribute__((ext_vector_type(4)));
constexpr int BM = 256, BK = 64, HALF = 128, HTB = HALF * BK * 2  , STAGE_BYTES = 8 * HTB, NXCD = 8, WGM = 8;

__host__ __device__ __forceinline__ int lds_byte(int r, int c) { const int st = (r >> 4) * 2 + (c >> 5), rr = r & 15, cc = c & 31, ob = rr * 64 + cc * 2; return st * 1024 + (ob ^ (((ob >> 9) & 1) << 5)); }
__host__ __device__ __forceinline__ void stage_rc(int b, int& R, int& C) { const int st = b / 1024, sb = b % 1024, swz = sb ^ (((sb >> 9) & 1) << 5); R = (st >> 1) * 16 + swz / 64; C = (st & 1) * 32 + (swz % 64) / 2; }
__host__ __device__ __forceinline__ int perm32(int rho) { const int n = rho >> 4, i = rho & 15; return 8 * (i >> 2) + 4 * n + (i & 3); }

struct Unit { int pm, pn; };
struct Gemm { const bf16_t* A; const bf16_t* Bt; int M, N, K; };

struct StaticOrder {
    int nM, nN, nwg, G, c;
    __host__ __device__ void init(int M, int N, int G_, int c_) { nM = M / BM; nN = N / BM; nwg = nM * nN; G = G_; c = c_; }
    __host__ __device__ bool next(int i, Unit& u) const {
        const long L = (long)i * G + c; if (L >= nwg) return false;
        int wgid = (int)L; { const int q = nwg / NXCD, r = nwg % NXCD, xcd = wgid % NXCD, off = wgid / NXCD; wgid = (xcd < r ? xcd * (q + 1) : r * (q + 1) + (xcd - r) * q) + off; }
        const int nig = WGM * nN, gid = wgid / nig, fm = gid * WGM, gsz = (nM - fm) < WGM ? (nM - fm) : WGM;
        u.pm = fm + ((wgid % nig) % gsz); u.pn = (wgid % nig) / gsz; return true;
    }
    __device__ __forceinline__ void a_ready(const Unit&) const {}
    __device__ __forceinline__ void done(const Unit&) const {}
};

__device__ __forceinline__ unsigned cvt_pk_bf16(float lo, float hi) { unsigned r; asm volatile("v_cvt_pk_bf16_f32 %0, %1, %2" : "=v"(r) : "v"(lo), "v"(hi)); return r; }
typedef float f32x2 __attribute__((ext_vector_type(2)));
typedef unsigned u32x2 __attribute__((ext_vector_type(2)));
constexpr int NIN = 1792, DM = 1024, DFF = 4096, NU = 1280, SSQW = 16;
constexpr size_t XCT_LAT_OFF = (size_t)16 * 4 * 128 * 256;
__device__ __forceinline__ int cond_of_panel(int pm) { return pm < 16 ? 0 : (pm < 20 ? 1 : 2); }
__device__ __forceinline__ float row_rstd(const float* ssq, int row) {
    const f32x4* sp = (const f32x4*)(ssq + (size_t)row * SSQW);
    const f32x4 s = (sp[0] + sp[1]) + (sp[2] + sp[3]);
    return 1.0f / sqrtf(((s[0] + s[1]) + (s[2] + s[3])) * (1.0f / 1024.0f) + 1e-6f);
}
constexpr int RTAB_OFF = 131072;
struct EpiIn {
    static constexpr bool PERM = true, AFTER_DRAIN = false;
    bf16_t* U; bf16_t* XCT; const float* ssq; const float* bias;
    static constexpr bool NEEDS_RSTD = true;
    __device__ __forceinline__ void operator()(const f32x4 (&acc)[2][2][4][2], const Unit& u, int wr, int wc, int fr, int fq, const PG8_LAS float* rtab) const {
        const int cond = cond_of_panel(u.pm);
        const int bcol0 = u.pn * BM + wc * 32 + 8 * fq;
        f32x4 bv[2][2];
#pragma unroll
        for (int bj = 0; bj < 2; ++bj)
#pragma unroll
            for (int n = 0; n < 2; ++n) bv[bj][n] = *(const f32x4*)(bias + cond * NIN + bcol0 + bj * HALF + 4 * n);
        float sq[2][4];
#pragma unroll
        for (int ai = 0; ai < 2; ++ai)
#pragma unroll
            for (int m = 0; m < 4; ++m) sq[ai][m] = rtab[ai * HALF + wr * 64 + m * 16 + fr];
#pragma unroll
        for (int ai = 0; ai < 2; ++ai)
#pragma unroll
            for (int m = 0; m < 4; ++m) {
                const int row = u.pm * BM + ai * HALF + wr * 64 + m * 16 + fr;
                const float rs = sq[ai][m];
#pragma unroll
                for (int bj = 0; bj < 2; ++bj) {
                    const f32x4 v0 = acc[ai][bj][m][0] * rs + bv[bj][0], v1 = acc[ai][bj][m][1] * rs + bv[bj][1];
                    u32x4 w; w.x = cvt_pk_bf16(v0[0], v0[1]); w.y = cvt_pk_bf16(v0[2], v0[3]); w.z = cvt_pk_bf16(v1[0], v1[1]); w.w = cvt_pk_bf16(v1[2], v1[3]);
                    if (u.pn < 5) { *(u32x4*)(U + (size_t)row * NU + bcol0 + bj * HALF) = w; }
                    else {
                        const int cc = bcol0 + bj * HALF - NU, hd = cc >> 7, mm = cc & 127, m0 = mm & 63;
                        int L, t; bf16_t* base;
                        if (u.pm < 16) { L = 256; t = row & 255; base = XCT + (size_t)(u.pm * 4 + hd) * 128 * 256; }
                        else { const int rl = row - 4096; L = 1024; t = rl & 1023; base = XCT + XCT_LAT_OFF + (size_t)((rl >> 10) * 4 + hd) * 128 * 1024; }
                        const int k = (mm >> 6) * L + t;
                        bf16_t* p = base + ((size_t)(((m0 >> 4) * (L >> 4) + (k >> 5)) * 64 + ((k >> 3) & 3) * 16 + (m0 & 15))) * 8 + (k & 7);
                        p[0] = (bf16_t)(w.x & 0xffffu); p[8] = (bf16_t)(w.x >> 16); p[16] = (bf16_t)(w.y & 0xffffu); p[24] = (bf16_t)(w.y >> 16);
                        p[32] = (bf16_t)(w.z & 0xffffu); p[40] = (bf16_t)(w.z >> 16); p[48] = (bf16_t)(w.w & 0xffffu); p[56] = (bf16_t)(w.w >> 16);
                    }
                }
            }
    }
};
struct EpiUp {
    static constexpr bool PERM = true, AFTER_DRAIN = false;
    bf16_t* H; const float* ssq; const float* bias;
    static constexpr bool NEEDS_RSTD = true;
    __device__ __forceinline__ void operator()(const f32x4 (&acc)[2][2][4][2], const Unit& u, int wr, int wc, int fr, int fq, const PG8_LAS float* rtab) const {
        const int cond = cond_of_panel(u.pm);
        const int bcol0 = u.pn * BM + wc * 32 + 8 * fq;
        f32x4 bv[2][2];
#pragma unroll
        for (int bj = 0; bj < 2; ++bj)
#pragma unroll
            for (int n = 0; n < 2; ++n) bv[bj][n] = *(const f32x4*)(bias + cond * DFF + bcol0 + bj * HALF + 4 * n);
        float sq[2][4];
#pragma unroll
        for (int ai = 0; ai < 2; ++ai)
#pragma unroll
            for (int m = 0; m < 4; ++m) sq[ai][m] = rtab[ai * HALF + wr * 64 + m * 16 + fr];
#pragma unroll
        for (int ai = 0; ai < 2; ++ai)
#pragma unroll
            for (int m = 0; m < 4; ++m) {
                const int row = u.pm * BM + ai * HALF + wr * 64 + m * 16 + fr;
                const float rs = sq[ai][m];
#pragma unroll
                for (int bj = 0; bj < 2; ++bj) {
                    f32x4 v0 = acc[ai][bj][m][0] * rs + bv[bj][0], v1 = acc[ai][bj][m][1] * rs + bv[bj][1];
                    v0 = __builtin_elementwise_max(v0, (f32x4){0.f, 0.f, 0.f, 0.f}); v1 = __builtin_elementwise_max(v1, (f32x4){0.f, 0.f, 0.f, 0.f});
                    v0 = v0 * v0; v1 = v1 * v1;
                    u32x4 w; w.x = cvt_pk_bf16(v0[0], v0[1]); w.y = cvt_pk_bf16(v0[2], v0[3]); w.z = cvt_pk_bf16(v1[0], v1[1]); w.w = cvt_pk_bf16(v1[2], v1[3]);
                    *(u32x4*)(H + (size_t)row * DFF + bcol0 + bj * HALF) = w;
                }
            }
    }
};
struct EpiRes {
    static constexpr bool PERM = false, AFTER_DRAIN = false, NEEDS_RSTD = false;
    float* X; bf16_t* A; const float* gate; const float* Gn; float* ssq_out;
    __device__ __forceinline__ void operator()(const f32x4 (&acc)[2][2][4][2], const Unit& u, int wr, int wc, int fr, int fq, const PG8_LAS float*) const {
        const int cond = cond_of_panel(u.pm);
        const int col0 = u.pn * BM + wc * 32 + 4 * fq;
#pragma unroll
        for (int ai = 0; ai < 2; ++ai)
#pragma unroll
            for (int m = 0; m < 4; ++m) {
                const int row = u.pm * BM + ai * HALF + wr * 64 + m * 16 + fr;
                float q = 0.f;
#pragma unroll
                for (int bj = 0; bj < 2; ++bj)
#pragma unroll
                    for (int n = 0; n < 2; ++n) {
                        const int c = col0 + bj * HALF + n * 16;
                        float* xp = X + (size_t)row * DM + c;
                        const f32x4 g4 = *(const f32x4*)(gate + cond * 6144 + c);
                        const f32x4 x1 = *(const f32x4*)xp + g4 * acc[ai][bj][m][n];
                        *(f32x4*)xp = x1;
                        q += (x1[0] * x1[0] + x1[1] * x1[1]) + (x1[2] * x1[2] + x1[3] * x1[3]);
                        if (Gn) { const f32x4 a = x1 * *(const f32x4*)(Gn + cond * DM + c); u32x2 w; w.x = cvt_pk_bf16(a[0], a[1]); w.y = cvt_pk_bf16(a[2], a[3]);
                            *(u32x2*)(A + (size_t)row * DM + c) = w; }
                    }
                q += __shfl_xor(q, 16); q += __shfl_xor(q, 32);
                if (fq == 0) ssq_out[(size_t)row * SSQW + u.pn * 4 + wc] = q;
                if (m & 1) asm volatile("" ::: "memory");
            }
    }
};
template <class Epi, class Sched, bool ALIGN_EPI = false, bool SP2 = false>
__device__ __forceinline__ void gemm_phase(PG8_LAS unsigned char* lds, const Gemm g, const Sched& S, const Epi& E, int tid_in) {
    int tid_ = tid_in; asm volatile("" : "+v"(tid_)); const int tid = tid_, wid = __builtin_amdgcn_readfirstlane(tid >> 6), lane = tid & 63, wr = wid >> 2, wc = wid & 3, fr = lane & 15, fq = lane >> 4;
    const int K = g.K, nt = K / BK;
    unsigned voffA[2], voffB[2];
#pragma unroll
    for (int i = 0; i < 2; ++i) { int R, C; stage_rc(tid * 16 + i * 8192, R, C); const int Rb = Epi::PERM ? ((R & ~31) + perm32(R & 31)) : R;
        voffA[i] = (unsigned)(R * K + C) * 2u; voffB[i] = (unsigned)(Rb * K + C) * 2u; }
    const size_t kstep = (size_t)(BK * 2);
    const size_t hstep = (size_t)HALF * K * 2;
    const size_t tstep = 2 * hstep;
    const unsigned ldsw = (unsigned)wid * 1024u;
    const int aoff = lds_byte(wr * 64 + fr, fq * 8), boff = lds_byte(wc * 32 + fr, fq * 8);
#define PG8_SA(b, h) (((b) * 2 + (h)) * HTB)
#define PG8_SB(b, h) ((4 + (b) * 2 + (h)) * HTB)
#define PG8_STAGE(bufoff, gbase, voff) do { _Pragma("unroll") for (int _i = 0; _i < 2; ++_i) \
        __builtin_amdgcn_global_load_lds((const unsigned*)((const char*)(gbase) + (voff)[_i]), (PG8_LAS unsigned*)(lds + (bufoff) + ldsw + _i * 8192), 16, 0, 0); } while (0)
#define PG8_LDA(dst, b, h) do { _Pragma("unroll") for (int m = 0; m < 4; ++m) _Pragma("unroll") for (int k = 0; k < 2; ++k) dst[m][k] = *(const PG8_LAS bf16x8*)(lds + PG8_SA(b, h) + aoff + m * 2048 + k * 1024); } while (0)
#define PG8_LDB(dst, b, h) do { _Pragma("unroll") for (int n = 0; n < 2; ++n) _Pragma("unroll") for (int k = 0; k < 2; ++k) dst[n][k] = *(const PG8_LAS bf16x8*)(lds + PG8_SB(b, h) + boff + n * 2048 + k * 1024); } while (0)
#define PG8_MMA(ai, bj, At, Bt) do { __builtin_amdgcn_s_setprio(1); _Pragma("unroll") for (int m = 0; m < 4; ++m) _Pragma("unroll") for (int n = 0; n < 2; ++n) _Pragma("unroll") for (int k = 0; k < 2; ++k) \
        acc[ai][bj][m][n] = __builtin_amdgcn_mfma_f32_16x16x32_bf16(Bt[n][k], At[m][k], acc[ai][bj][m][n], 0, 0, 0); __builtin_amdgcn_s_setprio(0); } while (0)
#define PG8_WAIT_V(n) asm volatile("s_waitcnt vmcnt(" #n ")" ::: "memory")
#define PG8_WAIT_L(n) asm volatile("s_waitcnt lgkmcnt(" #n ")" ::: "memory")
#define PG8_BAR __builtin_amdgcn_s_barrier()
#define PG8_SCHED __builtin_amdgcn_sched_barrier(0)
    Unit cur, nxt; int ui = 0;
    if (!S.next(0, cur)) return;
    f32x4 acc[2][2][4][2];
#pragma unroll
    for (int a = 0; a < 2; ++a)
#pragma unroll
        for (int b = 0; b < 2; ++b)
#pragma unroll
            for (int m = 0; m < 4; ++m)
#pragma unroll
                for (int n = 0; n < 2; ++n) acc[a][b][m][n] = (f32x4){0.f, 0.f, 0.f, 0.f};
    bf16x8 At[4][2], B0[2][2], B1[2][2];
    const char* cA = (const char*)g.A + (size_t)cur.pm * tstep; const char* cB = (const char*)g.Bt + (size_t)cur.pn * tstep;
    if constexpr (Epi::NEEDS_RSTD) { if (tid < 256) ((PG8_LAS float*)(lds + RTAB_OFF))[tid] = row_rstd(E.ssq, cur.pm * BM + tid); }
    S.a_ready(cur);
    if constexpr (SP2) {
        PG8_STAGE(PG8_SB(0, 0), cB, voffB); PG8_STAGE(PG8_SB(0, 1), cB + hstep, voffB); PG8_STAGE(PG8_SA(0, 0), cA, voffA); PG8_STAGE(PG8_SA(0, 1), cA + hstep, voffA);
        if (wr == 1) PG8_BAR;
        PG8_WAIT_V(2); PG8_BAR;
        PG8_STAGE(PG8_SB(1, 0), cB + kstep, voffB); PG8_STAGE(PG8_SA(1, 0), cA + kstep, voffA); PG8_STAGE(PG8_SB(1, 1), cB + hstep + kstep, voffB);
        PG8_WAIT_V(6); PG8_BAR;
    } else {
        PG8_STAGE(PG8_SB(0, 0), cB, voffB); PG8_STAGE(PG8_SA(0, 0), cA, voffA); PG8_STAGE(PG8_SB(0, 1), cB + hstep, voffB); PG8_STAGE(PG8_SA(0, 1), cA + hstep, voffA);
        if (wr == 1) PG8_BAR;
        PG8_WAIT_V(4); PG8_BAR;
        PG8_STAGE(PG8_SB(1, 0), cB + kstep, voffB); PG8_STAGE(PG8_SA(1, 0), cA + kstep, voffA); PG8_STAGE(PG8_SB(1, 1), cB + hstep + kstep, voffB);
        PG8_WAIT_V(6); PG8_BAR;
    }
    for (;;) {
        const bool has_next = S.next(ui + 1, nxt);
        const char* nA = has_next ? (const char*)g.A + (size_t)nxt.pm * tstep : cA; const char* nB = has_next ? (const char*)g.Bt + (size_t)nxt.pn * tstep : cB;
        for (int t = 0; t < nt; t += 2) {
            const bool last = (t == nt - 2);
            const char* a1 = cA + (size_t)(t + 1) * kstep;
            const char* a2 = last ? nA : cA + (size_t)(t + 2) * kstep; const char* b2 = last ? nB : cB + (size_t)(t + 2) * kstep;
            const char* a3 = a2 + kstep; const char* b3 = b2 + kstep;
            if (last && has_next) S.a_ready(nxt);
            if constexpr (SP2) {
            PG8_LDB(B0, 0, 0); PG8_LDB(B1, 0, 1); PG8_SCHED; PG8_LDA(At, 0, 0); PG8_STAGE(PG8_SA(1, 1), a1 + hstep, voffA);
            PG8_WAIT_V(8); PG8_WAIT_L(0); PG8_BAR; PG8_MMA(0, 0, At, B0); PG8_MMA(0, 1, At, B1); PG8_BAR; PG8_SCHED;
            PG8_LDA(At, 0, 1); PG8_STAGE(PG8_SB(0, 0), b2, voffB); PG8_STAGE(PG8_SB(0, 1), b2 + hstep, voffB); PG8_STAGE(PG8_SA(0, 0), a2, voffA);
            PG8_WAIT_V(8); PG8_WAIT_L(0); PG8_BAR; PG8_MMA(1, 0, At, B0); PG8_MMA(1, 1, At, B1); PG8_BAR; PG8_SCHED;
            PG8_LDB(B0, 1, 0); PG8_LDB(B1, 1, 1); PG8_SCHED; PG8_LDA(At, 1, 0); PG8_STAGE(PG8_SA(0, 1), a2 + hstep, voffA);
            PG8_WAIT_V(8); PG8_WAIT_L(0); PG8_BAR; PG8_MMA(0, 0, At, B0); PG8_MMA(0, 1, At, B1); PG8_BAR; PG8_SCHED;
            PG8_LDA(At, 1, 1); PG8_STAGE(PG8_SB(1, 0), b3, voffB); PG8_STAGE(PG8_SB(1, 1), b3 + hstep, voffB); PG8_STAGE(PG8_SA(1, 0), a3, voffA);
            PG8_WAIT_V(8); PG8_WAIT_L(0); PG8_BAR; PG8_MMA(1, 0, At, B0); PG8_MMA(1, 1, At, B1); PG8_BAR; PG8_SCHED;
            } else {
            PG8_LDB(B0, 0, 0); PG8_SCHED; PG8_LDA(At, 0, 0); PG8_STAGE(PG8_SA(1, 1), a1 + hstep, voffA);
            PG8_WAIT_L(8); PG8_BAR; PG8_WAIT_L(0); PG8_MMA(0, 0, At, B0); PG8_BAR; PG8_SCHED;
            PG8_LDB(B1, 0, 1); PG8_STAGE(PG8_SB(0, 0), b2, voffB);
            PG8_BAR; PG8_WAIT_L(0); PG8_MMA(0, 1, At, B1); PG8_BAR;
            PG8_LDA(At, 0, 1); PG8_STAGE(PG8_SA(0, 0), a2, voffA);
            PG8_BAR; PG8_WAIT_L(0); PG8_MMA(1, 0, At, B0); PG8_BAR; PG8_SCHED;
            PG8_STAGE(PG8_SB(0, 1), b2 + hstep, voffB);
            PG8_WAIT_V(6); PG8_BAR; PG8_MMA(1, 1, At, B1); PG8_BAR;
            PG8_LDB(B0, 1, 0); PG8_SCHED; PG8_LDA(At, 1, 0); PG8_STAGE(PG8_SA(0, 1), a2 + hstep, voffA);
            PG8_WAIT_L(8); PG8_BAR; PG8_WAIT_L(0); PG8_MMA(0, 0, At, B0); PG8_BAR; PG8_SCHED;
            PG8_LDB(B1, 1, 1); PG8_STAGE(PG8_SB(1, 0), b3, voffB);
            PG8_BAR; PG8_WAIT_L(0); PG8_MMA(0, 1, At, B1); PG8_BAR;
            PG8_LDA(At, 1, 1); PG8_STAGE(PG8_SA(1, 0), a3, voffA);
            PG8_BAR; PG8_WAIT_L(0); PG8_MMA(1, 0, At, B0); PG8_BAR; PG8_SCHED;
            PG8_STAGE(PG8_SB(1, 1), b3 + hstep, voffB);
            PG8_WAIT_V(6); PG8_BAR; PG8_MMA(1, 1, At, B1); PG8_BAR;
            }
        }
        if constexpr (ALIGN_EPI) { if (wr == 0) PG8_BAR; }
        if constexpr (!Epi::AFTER_DRAIN) { E(acc, cur, wr, wc, fr, fq, (const PG8_LAS float*)(lds + RTAB_OFF + (ui & 1) * 1024)); S.done(cur); }
        if (!has_next) break;
#pragma unroll
        for (int a = 0; a < 2; ++a)
#pragma unroll
            for (int b = 0; b < 2; ++b)
#pragma unroll
                for (int m = 0; m < 4; ++m)
#pragma unroll
                    for (int n = 0; n < 2; ++n) acc[a][b][m][n] = (f32x4){0.f, 0.f, 0.f, 0.f};
        cur = nxt; cA = nA; cB = nB; ++ui;
        if constexpr (Epi::NEEDS_RSTD) { if (tid < 256) ((PG8_LAS float*)(lds + RTAB_OFF + (ui & 1) * 1024))[tid] = row_rstd(E.ssq, cur.pm * BM + tid); }
        if constexpr (ALIGN_EPI) { if (wr == 1) PG8_BAR; }
    }
    PG8_WAIT_V(0);
    if constexpr (!ALIGN_EPI) { if (wr == 0) PG8_BAR; }
    PG8_BAR;
    if constexpr (Epi::AFTER_DRAIN) { E.fused(acc, cur, wr, wc, fr, fq, lds, wid, lane); S.done(cur); }
#undef PG8_SA
#undef PG8_SB
#undef PG8_STAGE
#undef PG8_LDA
#undef PG8_LDB
#undef PG8_MMA
#undef PG8_WAIT_V
#undef PG8_WAIT_L
#undef PG8_BAR
#undef PG8_SCHED
}
struct StaticOrder128 {
    int nM, nN, nwg, G, c, pm0;
    __host__ __device__ void init(int M, int N, int G_, int c_, int pm0_ = 0) { nM = M / BM; nN = N / HALF; nwg = nM * nN; G = G_; c = c_; pm0 = pm0_; }
    __host__ __device__ bool next(int i, Unit& u) const {
        const long L = (long)i * G + c; if (L >= nwg) return false;
        int wgid = (int)L; { const int q = nwg / NXCD, r = nwg % NXCD, xcd = wgid % NXCD, off = wgid / NXCD; wgid = (xcd < r ? xcd * (q + 1) : r * (q + 1) + (xcd - r) * q) + off; }
        const int nig = WGM * nN, gid = wgid / nig, fm = gid * WGM, gsz = (nM - fm) < WGM ? (nM - fm) : WGM;
        u.pm = pm0 + fm + ((wgid % nig) % gsz); u.pn = (wgid % nig) / gsz; return true;
    }
    __device__ __forceinline__ void a_ready(const Unit&) const {}
    __device__ __forceinline__ void done(const Unit&) const {}
};
template <class Epi, class Sched>
__device__ __forceinline__ void gemm_phase_n128(PG8_LAS unsigned char* lds, const Gemm g, const Sched& S, const Epi& E, int tid_in) {
    int tid_ = tid_in; asm volatile("" : "+v"(tid_));
    const int tid = tid_, wid = __builtin_amdgcn_readfirstlane(tid >> 6), lane = tid & 63, wh = wid >> 2, wr = wid >> 1, wc = wid & 1, fr = lane & 15, fq = lane >> 4;
    const int K = g.K, nt = K / BK;
    unsigned voffA[2], voffB[2];
#pragma unroll
    for (int i = 0; i < 2; ++i) { int R, C; stage_rc(tid * 16 + i * 8192, R, C); const int Rb = Epi::PERM ? ((R & ~31) + perm32(R & 31)) : R;
        voffA[i] = (unsigned)(R * K + C) * 2u; voffB[i] = (unsigned)(Rb * K + C) * 2u; }
    const size_t kstep = (size_t)(BK * 2);
    const size_t hstep = (size_t)HALF * K * 2;
    const size_t tstep = 2 * hstep;
    const unsigned ldsw = (unsigned)wid * 1024u;
    const int aoff = lds_byte(wr * 32 + fr, fq * 8), boff = lds_byte(wc * 64 + fr, fq * 8);
#define PG8_SA(b, h) (((b) * 2 + (h)) * HTB)
#define PG8_SB(b) ((4 + (b) * 2) * HTB)
#define PG8_STAGE(bufoff, gbase, voff) do { _Pragma("unroll") for (int _i = 0; _i < 2; ++_i) \
        __builtin_amdgcn_global_load_lds((const unsigned*)((const char*)(gbase) + (voff)[_i]), (PG8_LAS unsigned*)(lds + (bufoff) + ldsw + _i * 8192), 16, 0, 0); } while (0)
#define PG8_LDA(dst, b, h) do { _Pragma("unroll") for (int m = 0; m < 2; ++m) _Pragma("unroll") for (int k = 0; k < 2; ++k) dst[m][k] = *(const PG8_LAS bf16x8*)(lds + PG8_SA(b, h) + aoff + m * 2048 + k * 1024); } while (0)
#define PG8_LDB(dst, b) do { _Pragma("unroll") for (int n = 0; n < 4; ++n) _Pragma("unroll") for (int k = 0; k < 2; ++k) dst[n][k] = *(const PG8_LAS bf16x8*)(lds + PG8_SB(b) + boff + n * 2048 + k * 1024); } while (0)
#define PG8_MMA(ai, At, Bt) do { __builtin_amdgcn_s_setprio(1); _Pragma("unroll") for (int m = 0; m < 2; ++m) _Pragma("unroll") for (int n = 0; n < 4; ++n) _Pragma("unroll") for (int k = 0; k < 2; ++k) \
        acc[ai][m][n] = __builtin_amdgcn_mfma_f32_16x16x32_bf16(Bt[n][k], At[m][k], acc[ai][m][n], 0, 0, 0); __builtin_amdgcn_s_setprio(0); } while (0)
#define PG8_WAIT_V(n) asm volatile("s_waitcnt vmcnt(" #n ")" ::: "memory")
#define PG8_WAIT_L(n) asm volatile("s_waitcnt lgkmcnt(" #n ")" ::: "memory")
#define PG8_BAR __builtin_amdgcn_s_barrier()
#define PG8_SCHED __builtin_amdgcn_sched_barrier(0)
    Unit cur, nxt; int ui = 0;
    if (!S.next(0, cur)) return;
    f32x4 acc[2][2][4];
#pragma unroll
    for (int a = 0; a < 2; ++a)
#pragma unroll
        for (int m = 0; m < 2; ++m)
#pragma unroll
            for (int n = 0; n < 4; ++n) acc[a][m][n] = (f32x4){0.f, 0.f, 0.f, 0.f};
    bf16x8 At[2][2], Bf[4][2];
    const char* cA = (const char*)g.A + (size_t)cur.pm * tstep; const char* cB = (const char*)g.Bt + (size_t)cur.pn * hstep;
    if constexpr (Epi::NEEDS_RSTD) { if (tid < 256) ((PG8_LAS float*)(lds + RTAB_OFF))[tid] = row_rstd(E.ssq, cur.pm * BM + tid); }
    S.a_ready(cur);
    PG8_STAGE(PG8_SB(0), cB, voffB); PG8_STAGE(PG8_SA(0, 0), cA, voffA); PG8_STAGE(PG8_SA(0, 1), cA + hstep, voffA);
    if (wh == 1) PG8_BAR;
    PG8_WAIT_V(2); PG8_BAR;
    PG8_STAGE(PG8_SB(1), cB + kstep, voffB); PG8_STAGE(PG8_SA(1, 0), cA + kstep, voffA);
    PG8_WAIT_V(4); PG8_BAR;
    for (;;) {
        const bool has_next = S.next(ui + 1, nxt);
        const char* nA = has_next ? (const char*)g.A + (size_t)nxt.pm * tstep : cA; const char* nB = has_next ? (const char*)g.Bt + (size_t)nxt.pn * hstep : cB;
        for (int t = 0; t < nt; t += 2) {
            const bool last = (t == nt - 2);
            const char* a1 = cA + (size_t)(t + 1) * kstep;
            const char* a2 = last ? nA : cA + (size_t)(t + 2) * kstep; const char* b2 = last ? nB : cB + (size_t)(t + 2) * kstep;
            const char* a3 = a2 + kstep; const char* b3 = b2 + kstep;
            if (last && has_next) S.a_ready(nxt);
            PG8_LDB(Bf, 0); PG8_SCHED; PG8_LDA(At, 0, 0); PG8_STAGE(PG8_SA(1, 1), a1 + hstep, voffA);
            PG8_WAIT_V(6); PG8_WAIT_L(0); PG8_BAR; PG8_MMA(0, At, Bf); PG8_BAR; PG8_SCHED;
            PG8_LDA(At, 0, 1); PG8_STAGE(PG8_SB(0), b2, voffB); PG8_STAGE(PG8_SA(0, 0), a2, voffA);
            PG8_WAIT_V(6); PG8_WAIT_L(0); PG8_BAR; PG8_MMA(1, At, Bf); PG8_BAR; PG8_SCHED;
            PG8_LDB(Bf, 1); PG8_SCHED; PG8_LDA(At, 1, 0); PG8_STAGE(PG8_SA(0, 1), a2 + hstep, voffA);
            PG8_WAIT_V(6); PG8_WAIT_L(0); PG8_BAR; PG8_MMA(0, At, Bf); PG8_BAR; PG8_SCHED;
            PG8_LDA(At, 1, 1); PG8_STAGE(PG8_SB(1), b3, voffB); PG8_STAGE(PG8_SA(1, 0), a3, voffA);
            PG8_WAIT_V(6); PG8_WAIT_L(0); PG8_BAR; PG8_MMA(1, At, Bf); PG8_BAR; PG8_SCHED;
        }
        if (wh == 0) PG8_BAR;
        E(acc, cur, wr, wc, fr, fq, (const PG8_LAS float*)(lds + RTAB_OFF + (ui & 1) * 1024)); S.done(cur);
        if (!has_next) break;
#pragma unroll
        for (int a = 0; a < 2; ++a)
#pragma unroll
            for (int m = 0; m < 2; ++m)
#pragma unroll
                for (int n = 0; n < 4; ++n) acc[a][m][n] = (f32x4){0.f, 0.f, 0.f, 0.f};
        cur = nxt; cA = nA; cB = nB; ++ui;
        if constexpr (Epi::NEEDS_RSTD) { if (tid < 256) ((PG8_LAS float*)(lds + RTAB_OFF + (ui & 1) * 1024))[tid] = row_rstd(E.ssq, cur.pm * BM + tid); }
        if (wh == 1) PG8_BAR;
    }
    PG8_WAIT_V(0);
    PG8_BAR;
#undef PG8_SA
#undef PG8_SB
#undef PG8_STAGE
#undef PG8_LDA
#undef PG8_LDB
#undef PG8_MMA
#undef PG8_WAIT_V
#undef PG8_WAIT_L
#undef PG8_BAR
#undef PG8_SCHED
}
struct EpiUp128 {
    static constexpr bool PERM = true, NEEDS_RSTD = true;
    bf16_t* H; const float* ssq; const float* bias;
    __device__ __forceinline__ void operator()(const f32x4 (&acc)[2][2][4], const Unit& u, int wr, int wc, int fr, int fq, const PG8_LAS float* rtab) const {
        const int cond = cond_of_panel(u.pm);
        const int bcol0 = u.pn * HALF + wc * 64 + 8 * fq;
        f32x4 bv[2][2];
#pragma unroll
        for (int g2 = 0; g2 < 2; ++g2)
#pragma unroll
            for (int n = 0; n < 2; ++n) bv[g2][n] = *(const f32x4*)(bias + cond * DFF + bcol0 + 32 * g2 + 4 * n);
        float sq[2][2];
#pragma unroll
        for (int ai = 0; ai < 2; ++ai)
#pragma unroll
            for (int m = 0; m < 2; ++m) sq[ai][m] = rtab[ai * HALF + wr * 32 + m * 16 + fr];
#pragma unroll
        for (int ai = 0; ai < 2; ++ai)
#pragma unroll
            for (int m = 0; m < 2; ++m) {
                const int row = u.pm * BM + ai * HALF + wr * 32 + m * 16 + fr;
                const float rs = sq[ai][m];
#pragma unroll
                for (int g2 = 0; g2 < 2; ++g2) {
                    f32x4 v0 = acc[ai][m][2 * g2] * rs + bv[g2][0], v1 = acc[ai][m][2 * g2 + 1] * rs + bv[g2][1];
                    v0 = __builtin_elementwise_max(v0, (f32x4){0.f, 0.f, 0.f, 0.f}); v1 = __builtin_elementwise_max(v1, (f32x4){0.f, 0.f, 0.f, 0.f});
                    v0 = v0 * v0; v1 = v1 * v1;
                    u32x4 w; w.x = cvt_pk_bf16(v0[0], v0[1]); w.y = cvt_pk_bf16(v0[2], v0[3]); w.z = cvt_pk_bf16(v1[0], v1[1]); w.w = cvt_pk_bf16(v1[2], v1[3]);
                    *(u32x4*)(H + (size_t)row * DFF + bcol0 + 32 * g2) = w;
                }
            }
    }
};
struct EpiRes128 {
    static constexpr bool PERM = false, NEEDS_RSTD = false;
    float* X; bf16_t* A; const float* gate; const float* Gn; float* ssq_out;
    __device__ __forceinline__ void operator()(const f32x4 (&acc)[2][2][4], const Unit& u, int wr, int wc, int fr, int fq, const PG8_LAS float*) const {
        const int cond = cond_of_panel(u.pm);
        const int col0 = u.pn * HALF + wc * 64 + 4 * fq;
#pragma unroll
        for (int ai = 0; ai < 2; ++ai)
#pragma unroll
            for (int m = 0; m < 2; ++m) {
                const int row = u.pm * BM + ai * HALF + wr * 32 + m * 16 + fr;
                float q = 0.f;
#pragma unroll
                for (int n = 0; n < 4; ++n) {
                    const int c = col0 + n * 16;
                    float* xp = X + (size_t)row * DM + c;
                    const f32x4 g4 = *(const f32x4*)(gate + cond * 6144 + c);
                    const f32x4 x1 = *(const f32x4*)xp + g4 * acc[ai][m][n];
                    *(f32x4*)xp = x1;
                    q += (x1[0] * x1[0] + x1[1] * x1[1]) + (x1[2] * x1[2] + x1[3] * x1[3]);
                    if (Gn) { const f32x4 a = x1 * *(const f32x4*)(Gn + cond * DM + c); u32x2 w; w.x = cvt_pk_bf16(a[0], a[1]); w.y = cvt_pk_bf16(a[2], a[3]);
                        *(u32x2*)(A + (size_t)row * DM + c) = w; }
                }
                q += __shfl_xor(q, 16); q += __shfl_xor(q, 32);
                if (fq == 0) ssq_out[(size_t)row * SSQW + u.pn * 2 + wc] = q;
                asm volatile("" ::: "memory");
            }
    }
};
struct StaticOrder192 {
    int nM, nN, nwg, G, c;
    __host__ __device__ void init(int M, int N, int G_, int c_) { nM = M / 192; nN = N / HALF; nwg = nM * nN; G = G_; c = c_; }
    __host__ __device__ bool next(int i, Unit& u) const {
        const long L = (long)i * G + c; if (L >= nwg) return false;
        int wgid = (int)L; { const int q = nwg / NXCD, r = nwg % NXCD, xcd = wgid % NXCD, off = wgid / NXCD; wgid = (xcd < r ? xcd * (q + 1) : r * (q + 1) + (xcd - r) * q) + off; }
        const int nig = WGM * nN, gid = wgid / nig, fm = gid * WGM, gsz = (nM - fm) < WGM ? (nM - fm) : WGM;
        u.pm = fm + ((wgid % nig) % gsz); u.pn = (wgid % nig) / gsz; return true;
    }
};
#ifndef M192_SLOTS
#define M192_SLOTS 4
#endif
#ifndef M192_TOUCH
#define M192_TOUCH 0
#endif
template <class Epi, class Sched>
__device__ __forceinline__ void gemm_phase_m192(PG8_LAS unsigned char* lds, const Gemm g, const Sched& S, const Epi& E, int tid_in, unsigned long long* TSX = nullptr) {
    int tid_ = tid_in; asm volatile("" : "+v"(tid_));
    const int tid = tid_, wid = __builtin_amdgcn_readfirstlane(tid >> 6), lane = tid & 63, wh = wid >> 2, wr = wid >> 1, wc = wid & 1, fr = lane & 15, fq = lane >> 4;
    const int K = g.K, nt = K / BK;
    constexpr unsigned SLOT = 40960u, PIECE = 8192u, BOFF = 3u * PIECE;
    constexpr int NS = M192_SLOTS, LA = NS - 1;
    unsigned voffA, voffB;
    { int R, C; stage_rc(tid * 16, R, C); const int Rb = Epi::PERM ? ((R & ~31) + perm32(R & 31)) : R; voffA = (unsigned)(R * K + C) * 2u; voffB = (unsigned)(Rb * K + C) * 2u; }
    const size_t kstep = (size_t)(BK * 2), pstep = (size_t)64 * K * 2;
    const unsigned ldsw = (unsigned)wid * 1024u;
    const int sub = lds_byte(fr, fq * 8);
    unsigned aofs[3];
#pragma unroll
    for (int m = 0; m < 3; ++m) { const int mt = 3 * wr + m; aofs[m] = (unsigned)((mt >> 2) * PIECE + ((mt & 3) * 2) * 1024 + sub); }
    const unsigned bofs = BOFF + (unsigned)wc * PIECE + (unsigned)sub;
    constexpr int TOUCH = M192_TOUCH; constexpr unsigned DUMMY = (unsigned)NS * SLOT;
    const int tpc = tid < 320 ? tid >> 6 : 4, trow = tid & 63;
    const size_t toff = (size_t)(tpc < 3 ? tpc : tpc - 3) * pstep + (size_t)trow * K * 2;
#define PG8_STAGE5(slot, ga, gb) do { \
        _Pragma("unroll") for (int _p = 0; _p < 3; ++_p) __builtin_amdgcn_global_load_lds((const unsigned*)((ga) + _p * pstep + voffA), (PG8_LAS unsigned*)(lds + (slot) + _p * PIECE + ldsw), 16, 0, 0); \
        _Pragma("unroll") for (int _q = 0; _q < 2; ++_q) __builtin_amdgcn_global_load_lds((const unsigned*)((gb) + _q * pstep + voffB), (PG8_LAS unsigned*)(lds + (slot) + BOFF + _q * PIECE + ldsw), 16, 0, 0); } while (0)
#define PG8_WAIT_V(n) asm volatile("s_waitcnt vmcnt(" #n ")" ::: "memory")
#define PG8_WAIT_L(n) asm volatile("s_waitcnt lgkmcnt(" #n ")" ::: "memory")
#define PG8_BAR __builtin_amdgcn_s_barrier()
#define PG8_SCHED __builtin_amdgcn_sched_barrier(0)
#if TS_SEL >= 0
#define M192_STAMP(i) do { if (blockIdx.x == TS_BLK && wid == 0 && TSX) __hip_atomic_store(TSX + (i), (unsigned long long)__builtin_amdgcn_s_memrealtime(), __ATOMIC_RELAXED, __HIP_MEMORY_SCOPE_AGENT); } while (0)
#else
#define M192_STAMP(i) do {} while (0)
#endif
    M192_STAMP(0);
    Unit cur, nxt; int ui = 0;
    if (!S.next(0, cur)) return;
    f32x4 acc[3][4];
#pragma unroll
    for (int m = 0; m < 3; ++m)
#pragma unroll
        for (int n = 0; n < 4; ++n) acc[m][n] = (f32x4){0.f, 0.f, 0.f, 0.f};
    bf16x8 At[3][2], Bf[4][2];
    f32x4 xpre[3][4];
    E.prefetch(xpre, cur, wr, wc, fr, fq);
    const char* cA = (const char*)g.A + (size_t)cur.pm * 3 * pstep; const char* cB = (const char*)g.Bt + (size_t)cur.pn * 2 * pstep;
#pragma unroll
    for (int i = 0; i < LA; ++i) PG8_STAGE5((unsigned)i * SLOT, cA + i * kstep, cB + i * kstep);
    if (LA == 2) PG8_WAIT_V(5); else PG8_WAIT_V(10);
    if (wh == 1) PG8_BAR;
    PG8_BAR;
    unsigned rs = 0u, ss = (unsigned)LA * SLOT;
    M192_STAMP(1);
    for (;;) {
        const bool has_next = S.next(ui + 1, nxt);
        const char* nA = has_next ? (const char*)g.A + (size_t)nxt.pm * 3 * pstep : cA; const char* nB = has_next ? (const char*)g.Bt + (size_t)nxt.pn * 2 * pstep : cB;
        for (int t = 0; t < nt; ++t) {
            const bool tail = t >= nt - LA;
            const char* a2 = tail ? nA + (size_t)(t + LA - nt) * kstep : cA + (size_t)(t + LA) * kstep;
            const char* b2 = tail ? nB + (size_t)(t + LA - nt) * kstep : cB + (size_t)(t + LA) * kstep;
#pragma unroll
            for (int n = 0; n < 4; ++n)
#pragma unroll
                for (int k = 0; k < 2; ++k) Bf[n][k] = *(const PG8_LAS bf16x8*)(lds + rs + bofs + n * 2048 + k * 1024);
            PG8_SCHED;
#pragma unroll
            for (int m = 0; m < 3; ++m)
#pragma unroll
                for (int k = 0; k < 2; ++k) At[m][k] = *(const PG8_LAS bf16x8*)(lds + rs + aofs[m] + k * 1024);
            PG8_STAGE5(ss, a2, b2);
            if (TOUCH > 0) { const int tt = t + TOUCH; const bool nx = tt >= nt;
                const char* ta = (tpc < 3 ? (nx ? nA : cA) : (nx ? nB : cB)) + toff + (size_t)(nx ? (tt - nt < nt ? tt - nt : 0) : tt) * kstep;
                __builtin_amdgcn_global_load_lds((const unsigned*)ta, (PG8_LAS unsigned*)(lds + DUMMY + (unsigned)wid * 256u), 4, 0, 0);
                PG8_WAIT_V(6); } else { if (LA == 2) PG8_WAIT_V(5); else PG8_WAIT_V(10); }
            PG8_WAIT_L(0); PG8_BAR;
            __builtin_amdgcn_s_setprio(1);
#pragma unroll
            for (int m = 0; m < 3; ++m)
#pragma unroll
                for (int n = 0; n < 4; ++n)
#pragma unroll
                    for (int k = 0; k < 2; ++k) acc[m][n] = __builtin_amdgcn_mfma_f32_16x16x32_bf16(Bf[n][k], At[m][k], acc[m][n], 0, 0, 0);
            __builtin_amdgcn_s_setprio(0);
            PG8_BAR; PG8_SCHED;
            rs = rs == (unsigned)LA * SLOT ? 0u : rs + SLOT; ss = ss == (unsigned)LA * SLOT ? 0u : ss + SLOT;
        }
        if (wh == 0) PG8_BAR;
        M192_STAMP(2);
        E(acc, xpre, cur, wr, wc, fr, fq);
        asm volatile("s_waitcnt vmcnt(0)" ::: "memory"); M192_STAMP(3);
        if (!has_next) break;
        E.prefetch(xpre, nxt, wr, wc, fr, fq);
#pragma unroll
        for (int m = 0; m < 3; ++m)
#pragma unroll
            for (int n = 0; n < 4; ++n) acc[m][n] = (f32x4){0.f, 0.f, 0.f, 0.f};
        cur = nxt; cA = nA; cB = nB; ++ui;
        if (wh == 1) PG8_BAR;
    }
    PG8_WAIT_V(0);
    PG8_BAR;
#undef PG8_STAGE5
#undef PG8_WAIT_V
#undef PG8_WAIT_L
#undef PG8_BAR
#undef PG8_SCHED
}
__device__ __forceinline__ int cond_of_row(int row) { return row < 4096 ? 0 : (row < 5120 ? 1 : 2); }
struct EpiRes192 {
    static constexpr bool PERM = false;
    float* X; bf16_t* A; const float* gate; const float* Gn; float* ssq_out;
    __device__ __forceinline__ void prefetch(f32x4 (&xpre)[3][4], const Unit& u, int wr, int wc, int fr, int fq) const {
        const int col0 = u.pn * HALF + wc * 64 + 4 * fq;
#pragma unroll
        for (int m = 0; m < 3; ++m)
#pragma unroll
            for (int n = 0; n < 4; ++n) xpre[m][n] = *(const f32x4*)(X + (size_t)(u.pm * 192 + wr * 48 + m * 16 + fr) * DM + col0 + n * 16);
    }
    __device__ __forceinline__ void operator()(const f32x4 (&acc)[3][4], const f32x4 (&xpre)[3][4], const Unit& u, int wr, int wc, int fr, int fq) const {
        const int col0 = u.pn * HALF + wc * 64 + 4 * fq;
#pragma unroll
        for (int m = 0; m < 3; ++m) {
            const int row = u.pm * 192 + wr * 48 + m * 16 + fr;
            const int cond = cond_of_row(u.pm * 192 + wr * 48 + m * 16);
            float q = 0.f;
#pragma unroll
            for (int n = 0; n < 4; ++n) {
                const int c = col0 + n * 16;
                const f32x4 g4 = *(const f32x4*)(gate + cond * 6144 + c);
                const f32x4 x1 = xpre[m][n] + g4 * acc[m][n];
                *(f32x4*)(X + (size_t)row * DM + c) = x1;
                q += (x1[0] * x1[0] + x1[1] * x1[1]) + (x1[2] * x1[2] + x1[3] * x1[3]);
                if (Gn) { const f32x4 a = x1 * *(const f32x4*)(Gn + cond * DM + c); u32x2 w; w.x = cvt_pk_bf16(a[0], a[1]); w.y = cvt_pk_bf16(a[2], a[3]);
                    *(u32x2*)(A + (size_t)row * DM + c) = w; }
            }
            q += __shfl_xor(q, 16); q += __shfl_xor(q, 32);
            if (fq == 0) ssq_out[(size_t)row * SSQW + u.pn * 2 + wc] = q;
        }
    }
};
}
#define GAS __attribute__((address_space(1)))
#define LAS __attribute__((address_space(3)))
typedef unsigned short bf16;
typedef unsigned v4u __attribute__((ext_vector_type(4)));
typedef unsigned v2u __attribute__((ext_vector_type(2)));
typedef float f32x4 __attribute__((ext_vector_type(4)));
typedef float f32x2 __attribute__((ext_vector_type(2)));
typedef short bf16x8 __attribute__((ext_vector_type(8)));
constexpr int NWAVES = 8, NTHREADS = 512;
constexpr int M_TOK = 6144, M_CTX = 4096, DMODEL = 1024, NINP = 1792, NUC = 1280, FFD = 4096, DEPTHL = 4, DRNN = 512;
constexpr int LDS_BYTES = 163840;
constexpr size_t al256(size_t x) { return (x + 255) & ~(size_t)255; }
constexpr size_t WS_CTL = 0, CTL_BYTES = 1u << 20;
constexpr size_t WS_MODS = WS_CTL + CTL_BYTES;
constexpr size_t WS_GV = WS_MODS + al256((size_t)4 * 3 * 6144 * 4);
constexpr size_t WS_BIASIN = WS_GV + al256((size_t)4 * 2 * 3 * 1024 * 4);
constexpr size_t WS_BIAS1 = WS_BIASIN + al256((size_t)4 * 3 * NINP * 4);
constexpr size_t WS_SSQ = WS_BIAS1 + al256((size_t)4 * 3 * FFD * 4);
constexpr size_t WS_WIN = WS_SSQ + al256((size_t)9 * M_TOK * 16 * 4);
constexpr size_t WS_WOUT = WS_WIN + al256((size_t)4 * NINP * 1024 * 2);
constexpr size_t WS_W1 = WS_WOUT + al256((size_t)4 * 1024 * 1024 * 2);
constexpr size_t WS_W2 = WS_W1 + al256((size_t)4 * FFD * 1024 * 2);
constexpr size_t WS_WG = WS_W2 + al256((size_t)4 * FFD * 1024 * 2);
constexpr size_t WS_GB = WS_WG + al256((size_t)4 * 8 * 4 * 4 * 2 * 32 * 64 * 2);
constexpr size_t WS_T256 = WS_GB + al256((size_t)4 * 2 * 2 * 512 * 4);
constexpr size_t WS_T1024 = WS_T256 + al256((size_t)256 * 512 * 2);
constexpr size_t WS_X = WS_T1024 + al256((size_t)1024 * 2048 * 2);
constexpr size_t WS_A = WS_X + al256((size_t)M_TOK * 1024 * 4);
constexpr size_t WS_U = WS_A + al256((size_t)M_TOK * 1024 * 2);
constexpr size_t WS_XCT = WS_U + al256((size_t)M_TOK * NUC * 2);
constexpr size_t WS_CAT = WS_XCT + al256((size_t)M_TOK * 512 * 2);
constexpr size_t WS_HF = WS_CAT + al256((size_t)M_TOK * 1024 * 2);
constexpr size_t WS_PB = WS_HF + al256((size_t)M_TOK * 512 * 4);
constexpr size_t WS_HID = WS_PB + al256((size_t)M_TOK * 512 * 4);
constexpr size_t WS_END = WS_HID + al256((size_t)M_TOK * FFD * 2);
static_assert(WS_END <= ((size_t)256 << 20), "workspace map exceeds 256 MiB");

__device__ __forceinline__ unsigned f2bf(float f) { unsigned u = __builtin_bit_cast(unsigned, f); return (u + 0x7fffu + ((u >> 16) & 1u)) >> 16; }
__device__ __forceinline__ unsigned pk2(float lo, float hi) { return f2bf(lo) | (f2bf(hi) << 16); }
__device__ __forceinline__ float bf2f(unsigned short b) { return __builtin_bit_cast(float, (unsigned)b << 16); }
__device__ __forceinline__ float bflo(unsigned w) { return __builtin_bit_cast(float, w << 16); }
__device__ __forceinline__ float bfhi(unsigned w) { return __builtin_bit_cast(float, w & 0xffff0000u); }
__device__ __forceinline__ float wave_sum(float v) {
#pragma unroll
    for (int o = 1; o < 64; o <<= 1) v += __shfl_xor(v, o);
    return v;
}
__device__ __forceinline__ float rdlane(float v, int l) { return __builtin_bit_cast(float, __builtin_amdgcn_readlane(__builtin_bit_cast(int, v), l)); }

__device__ __forceinline__ int launder_v(int x) { asm volatile("" : "+v"(x)); return x; }
__device__ __forceinline__ int launder_s(int x) { asm volatile("" : "+s"(x)); return x; }
#define CAS __attribute__((address_space(4)))
typedef const float* cfp_t;
struct Params { const float* in[24]; float* out; unsigned char* ws; int ph_lo, ph_hi; };
struct Frame {
    LAS unsigned char* lds;
    int tid, lane, wave, G, bid;
    __device__ __forceinline__ void relaunder() { wave = launder_s(wave); asm volatile("v_mbcnt_lo_u32_b32 %0, -1, 0\n\tv_mbcnt_hi_u32_b32 %0, -1, %0" : "=v"(lane)); tid = wave * 64 + lane;
        bid = launder_s(bid); G = launder_s(G);
        size_t z = 0; asm volatile("" : "+s"(z), "+s"(in)); ws = ws0 + z; out = out0 + z; }
    __device__ __forceinline__ const float* inp(int i) const { return (const float*)(const GAS float*)in[i]; }
    const CAS cfp_t* in; float* out; unsigned char* ws; float* out0; unsigned char* ws0; unsigned long long* tsx;
};
enum { I_XP = 0, I_XS, I_STATE, I_C, I_CCTX, I_N1G, I_N2G, I_FG, I_WMOD, I_BMOD, I_WIN, I_CONVW, I_CONVB, I_WR, I_BR, I_WI, I_BI, I_LAM, I_POOLW, I_POOLS, I_FW, I_WOUT, I_W1, I_W2 };
#define XB_TMO      128
#define XB_XCNT(j)  (256  + 64 * (j))
#define XB_XSUB(j)  (1280 + 64 * (j))
#define XB_XGEN(j)  (2304 + 64 * (j))
#define XB_TOP      3328
#define XB_TOPGEN   3392
#define XCD_BAR_WORDS 3456
#define XB_SPIN_CAP (1u << 18)

__device__ __forceinline__ unsigned xb_ld(unsigned* p)              { return __hip_atomic_load(p, __ATOMIC_RELAXED, __HIP_MEMORY_SCOPE_AGENT); }
__device__ __forceinline__ unsigned xb_add(unsigned* p, unsigned v) { return __hip_atomic_fetch_add(p, v, __ATOMIC_RELAXED, __HIP_MEMORY_SCOPE_AGENT); }
__device__ __forceinline__ unsigned xb_xcc_id() { return (unsigned)__builtin_amdgcn_s_getreg((3 << 11) | 20) & 0xFu; }
#define XB_SPIN(cond, bar) do { unsigned _sp = 0; while (cond) { __builtin_amdgcn_s_sleep(1); \
    if ((++_sp & 255u) == 0u) { if (xb_ld(&(bar)[XB_TMO])) break; if (_sp > XB_SPIN_CAP) { atomicAdd(&(bar)[XB_TMO], 1u); break; } } } } while (0)

struct XcdBarrier {
    unsigned* bar; unsigned x;
    volatile unsigned* st;
};

__device__ __forceinline__ XcdBarrier xcd_barrier_post(unsigned* bar, volatile unsigned* st) {
    XcdBarrier b; b.bar = bar; b.x = xb_xcc_id(); b.st = st;
    if (threadIdx.x == 0) (void)xb_add(&bar[XB_XCNT(b.x)], 1u);
    return b;
}
__device__ __forceinline__ void xcd_barrier_complete(unsigned* bar, unsigned x, unsigned& nloc, unsigned& nx) {
    const unsigned G = gridDim.x * gridDim.y * gridDim.z;
    unsigned sum, cnt, mine, sp = 0u;
    for (;;) {
        sum = 0u; cnt = 0u; mine = 0u;
#pragma unroll
        for (unsigned j = 0; j < 16; ++j) { const unsigned c = xb_ld(&bar[XB_XCNT(j)]); sum += c; cnt += (c > 0u) ? 1u : 0u; mine = (j == x) ? c : mine; }
        if (sum == G) break;
        __builtin_amdgcn_s_sleep(1);
        if ((++sp & 255u) == 0u) { if (xb_ld(&bar[XB_TMO])) break; if (sp > XB_SPIN_CAP) { atomicAdd(&bar[XB_TMO], 1u); break; } }
    }
    nloc = mine > 0u ? mine : 1u; nx = cnt > 0u ? cnt : 1u;
}

__device__ __forceinline__ void xcd_barrier(const XcdBarrier& b) {
    asm volatile("s_waitcnt vmcnt(0)" ::: "memory");
    __syncthreads();
    if (threadIdx.x == 0) {
        unsigned* bar = b.bar;
        __builtin_amdgcn_s_waitcnt(0);
        unsigned nloc = b.st[0], nx = b.st[1];
        if (nloc == 0u) { xcd_barrier_complete(bar, b.x, nloc, nx); b.st[0] = nloc; b.st[1] = nx; }
        const unsigned old = xb_add(&bar[XB_XSUB(b.x)], 1u);
        const unsigned gen = old / nloc;
        if (old + 1u == (gen + 1u) * nloc) {
            __builtin_amdgcn_fence(__ATOMIC_RELEASE, "agent");
            asm volatile("s_waitcnt vmcnt(0)" ::: "memory");
            const unsigned og = xb_add(&bar[XB_TOP], 1u);
            const unsigned tg = og / nx;
            if (og + 1u == (tg + 1u) * nx) xb_add(&bar[XB_TOPGEN], 1u);
            else XB_SPIN(xb_ld(&bar[XB_TOPGEN]) == tg, bar);
            __builtin_amdgcn_fence(__ATOMIC_ACQUIRE, "agent");
            xb_add(&bar[XB_XGEN(b.x)], 1u);
            asm volatile("s_waitcnt vmcnt(0)" ::: "memory");
        } else {
            XB_SPIN(xb_ld(&bar[XB_XGEN(b.x)]) == gen, bar);
            __builtin_amdgcn_fence(__ATOMIC_ACQUIRE, "agent");
            asm volatile("s_waitcnt vmcnt(0)" ::: "memory");
        }
    }
    __syncthreads();
}
__device__ __forceinline__ void p0a_mods(const Frame& F) {
    LAS float* sl = (LAS float*)F.lds;
    LAS float* red = sl + 3 * 1024;
    const float* c_ctx = F.inp(I_CCTX); const float* cv = F.inp(I_C);
    for (int i = F.tid; i < 3 * 1024; i += NTHREADS) { const int cd = i >> 10, k = i & 1023; const float c = cd == 0 ? c_ctx[k] : cv[(cd - 1) * 1024 + k]; sl[i] = c / (1.0f + expf(-c)); }
    __syncthreads();
    float* mods = (float*)(F.ws + WS_MODS);
    for (int it = F.bid; it < 256; it += F.G) {
        const int l = it >> 6, ch = it & 63;
        const float* W = F.inp(I_WMOD) + (size_t)l * 1024 * 6144 + ch * 96;
        if (F.tid < 504) {
            const int c4 = F.tid % 24, kr = F.tid / 24;
            f32x4 a0 = {0.f, 0.f, 0.f, 0.f}, a1 = a0, a2 = a0;
#pragma unroll 16
            for (int k = kr; k < 1024; k += 21) { const f32x4 w = *(const f32x4*)(W + (size_t)k * 6144 + c4 * 4); a0 += w * sl[k]; a1 += w * sl[1024 + k]; a2 += w * sl[2048 + k]; }
            *(LAS f32x4*)(red + (kr * 3 + 0) * 96 + c4 * 4) = a0; *(LAS f32x4*)(red + (kr * 3 + 1) * 96 + c4 * 4) = a1; *(LAS f32x4*)(red + (kr * 3 + 2) * 96 + c4 * 4) = a2;
        }
        __syncthreads();
        if (F.tid < 288) { const int cd = F.tid / 96, col = F.tid % 96; float s = 0.f;
#pragma unroll
            for (int kr = 0; kr < 21; ++kr) s += red[(kr * 3 + cd) * 96 + col];
            mods[(size_t)(l * 3 + cd) * 6144 + ch * 96 + col] = s + F.inp(I_BMOD)[l * 6144 + ch * 96 + col]; }
        __syncthreads();
    }
}

template <bool BIAS>
__device__ __forceinline__ void strip_item(const float* W, int N, int kb, int ke, int n0, bf16* WT, int ldt, int trow0, const float* sh, float* bias_out, int bstride, LAS float* scr, int lane) {
    float b0 = 0.f, b1 = 0.f, b2 = 0.f;
    const int nn = lane & 31, half = lane >> 5;
    float tv[32];
#pragma unroll
    for (int i = 0; i < 32; ++i) tv[i] = W[(size_t)(kb + 2 * i + half) * N + n0 + nn];
    for (int k0 = kb; k0 < ke; k0 += 64) {
#pragma unroll
        for (int i = 0; i < 32; ++i) scr[(2 * i + half) * 33 + nn] = tv[i];
        if (k0 + 64 < ke) {
#pragma unroll
            for (int i = 0; i < 32; ++i) tv[i] = W[(size_t)(k0 + 64 + 2 * i + half) * N + n0 + nn];
        }
        asm volatile("s_waitcnt lgkmcnt(0)" ::: "memory");
        const int c = lane & 7;
#pragma unroll
        for (int j = 0; j < 4; ++j) { const int n = (lane >> 3) + 8 * j; const LAS float* s = scr + (8 * c) * 33 + n;
            v4u o; o.x = pk2(s[0 * 33], s[1 * 33]); o.y = pk2(s[2 * 33], s[3 * 33]); o.z = pk2(s[4 * 33], s[5 * 33]); o.w = pk2(s[6 * 33], s[7 * 33]);
            *(v4u*)(WT + (size_t)(trow0 + n) * ldt + k0 + 8 * c) = o; }
        if (BIAS) {
            const float s0 = sh[k0 + lane], s1 = sh[6144 + k0 + lane], s2 = sh[2 * 6144 + k0 + lane];
#pragma unroll 8
            for (int kk = 0; kk < 32; ++kk) { const float w = scr[(half * 32 + kk) * 33 + nn]; const int src = half * 32 + kk;
                b0 += w * __shfl(s0, src); b1 += w * __shfl(s1, src); b2 += w * __shfl(s2, src); }
        }
        asm volatile("s_waitcnt lgkmcnt(0)" ::: "memory");
    }
    if (BIAS) {
        b0 += __shfl_xor(b0, 32); b1 += __shfl_xor(b1, 32); b2 += __shfl_xor(b2, 32);
        if (lane < 32) { bias_out[n0 + lane] = b0; bias_out[bstride + n0 + lane] = b1; bias_out[2 * bstride + n0 + lane] = b2; }
    }
}
__device__ __forceinline__ float dft64(float tabreg, int c, int mm) { const int m = mm & 63; const int idx = (mm < 64) ? ((c * m) & 63) : ((c * m - 16) & 63); return __shfl(tabreg, idx); }

__device__ __forceinline__ void p0b_items(Frame F, int llo, int lhi, int gw, int NGW, bool with_rows) {
    const int nl = lhi - llo;
    const float tabreg = cospif((float)F.lane * (1.0f / 32.0f)) * 0.125f;
    const int N_FOUT = 256 * nl, N_FIN = 256 * nl, N_POOLF = 64 * nl, N_FBIAS = 4 * nl, N_W1 = 128 * nl, N_W2 = 128 * nl, N_WIN = 40 * nl, N_WOUTA = 32 * nl, N_ROWS = with_rows ? M_TOK : 0;
    const int NITEMS = N_FOUT + N_FIN + N_POOLF + N_FBIAS + N_W1 + N_W2 + N_WIN + N_WOUTA + N_ROWS;
    const int nA = N_FBIAS + N_FOUT, nW = N_W1 + N_W2 + N_WIN + N_WOUTA, NQ = nA + nW + N_POOLF + N_FIN + N_ROWS / 8;
    unsigned* head = (unsigned*)(F.ws + WS_CTL) + 2048 + 64 * (gw & 7);
    for (int sit = gw;; sit += NGW) {
        int it0, nrep = 1;
        if (with_rows) {
            unsigned idx = 0; if (F.lane == 0) idx = __hip_atomic_fetch_add(head, 1u, __ATOMIC_RELAXED, __HIP_MEMORY_SCOPE_AGENT);
            const int j = (int)__builtin_amdgcn_readfirstlane(idx) * 8 + (gw & 7);
            if (j >= NQ) break;
            if (j < nA) it0 = j;
            else if (j < nA + nW) it0 = nA + N_FIN + N_POOLF + (j - nA);
            else if (j < nA + nW + N_POOLF) it0 = nA + N_FIN + (j - nA - nW);
            else if (j < nA + nW + N_POOLF + N_FIN) it0 = nA + (j - nA - nW - N_POOLF);
            else { it0 = nA + N_FIN + N_POOLF + nW + 8 * (j - nA - nW - N_POOLF - N_FIN); nrep = 8; }
        } else { if (sit >= NITEMS) break; it0 = sit; }
      for (int rep = 0; rep < nrep; ++rep) {
        const int it = it0 + rep;
        int r = it; F.relaunder(); const int lane = F.lane;
        LAS float* scr = (LAS float*)(F.lds + F.wave * 16384);
        const float* mods = (const float*)(F.ws + WS_MODS);
        bf16* WINT = (bf16*)(F.ws + WS_WIN); bf16* WOUTT = (bf16*)(F.ws + WS_WOUT); bf16* W1T = (bf16*)(F.ws + WS_W1); bf16* W2T = (bf16*)(F.ws + WS_W2);
        float* BIASIN = (float*)(F.ws + WS_BIASIN); float* BIAS1 = (float*)(F.ws + WS_BIAS1);

        if (r < N_FBIAS) {
            const int l = llo + (r >> 2), hd = r & 3, rg = lane >> 4, c4 = lane & 15;
            const float* wp = F.inp(I_WIN) + (size_t)l * 1024 * 1536 + (size_t)rg * 1536 + 1280 + 64 * hd + 4 * c4;
            const float* sh = mods + (size_t)l * 3 * 6144 + rg;
            f32x4 b0 = {0.f, 0.f, 0.f, 0.f}, b1 = b0, b2 = b0;
            for (int i0 = 0; i0 < 256; i0 += 16) { f32x4 wv[16];
#pragma unroll
                for (int i = 0; i < 16; ++i) wv[i] = *(const f32x4*)(wp + (size_t)(4 * (i0 + i)) * 1536);
#pragma unroll
                for (int i = 0; i < 16; ++i) { const int k = 4 * (i0 + i); b0 += wv[i] * sh[k]; b1 += wv[i] * sh[6144 + k]; b2 += wv[i] * sh[2 * 6144 + k]; } }
#pragma unroll
            for (int e = 0; e < 4; ++e) { b0[e] += __shfl_xor(b0[e], 16); b0[e] += __shfl_xor(b0[e], 32); b1[e] += __shfl_xor(b1[e], 16); b1[e] += __shfl_xor(b1[e], 32); b2[e] += __shfl_xor(b2[e], 16); b2[e] += __shfl_xor(b2[e], 32); }
            if (lane < 16) { *(LAS f32x4*)(scr + 4 * lane) = b0; *(LAS f32x4*)(scr + 64 + 4 * lane) = b1; *(LAS f32x4*)(scr + 128 + 4 * lane) = b2; }
            asm volatile("s_waitcnt lgkmcnt(0)" ::: "memory");
            for (int hf = 0; hf < 2; ++hf) {
                const int mm = hf * 64 + lane; float s0 = 0.f, s1 = 0.f, s2 = 0.f;
#pragma unroll 8
                for (int c = 0; c < 64; ++c) { const int idx = hf == 0 ? ((c * lane) & 63) : ((c * lane - 16) & 63); const float dv = __shfl(tabreg, idx);
                    s0 += scr[c] * dv; s1 += scr[64 + c] * dv; s2 += scr[128 + c] * dv; }
                float* bo = BIASIN + (size_t)l * 3 * NINP + 1280 + 128 * hd + mm;
                bo[0] = s0; bo[NINP] = s1; bo[2 * NINP] = s2;
            }
            asm volatile("s_waitcnt lgkmcnt(0)" ::: "memory");
            continue;
        }
        r -= N_FBIAS;
        if (r < N_FOUT) {
            const int l = llo + (r >> 8), it16 = (r >> 4) & 15, nb = r & 15, lr = lane & 15, lq = lane >> 4;
            const float* fw = F.inp(I_FW) + (size_t)l * 65536 + (size_t)(it16 * 16 + lr) * 256 + lq;
            const float* wo = F.inp(I_WOUT) + (size_t)l * 1048576 + (size_t)(768 + lq) * 1024 + nb * 64 + lr;
            f32x4 acc[4];
#pragma unroll
            for (int nt = 0; nt < 4; ++nt) acc[nt] = (f32x4){0.f, 0.f, 0.f, 0.f};
#pragma unroll 4
            for (int ks = 0; ks < 64; ++ks) { const float av = fw[4 * ks];
#pragma unroll
                for (int nt = 0; nt < 4; ++nt) acc[nt] = __builtin_amdgcn_mfma_f32_16x16x4f32(av, wo[(size_t)(4 * ks) * 1024 + 16 * nt], acc[nt], 0, 0, 0); }
#pragma unroll
            for (int nt = 0; nt < 4; ++nt) { v2u o; o.x = pk2(acc[nt][0], acc[nt][1]); o.y = pk2(acc[nt][2], acc[nt][3]);
                *(v2u*)(WOUTT + (size_t)l * 1048576 + (size_t)(nb * 64 + 16 * nt + lr) * 1024 + 768 + it16 * 16 + 4 * lq) = o; }
            continue;
        }
        r -= N_FOUT;
        if (r < N_FIN) {
            const int l = llo + (r >> 8), hd = (r >> 6) & 3, kt = r & 63, lr = lane & 15, lq = lane >> 4;
            const float* wp = F.inp(I_WIN) + (size_t)l * 1024 * 1536 + (size_t)(kt * 16 + lr) * 1536 + 1280 + 64 * hd + lq;
            f32x4 acc[8];
#pragma unroll
            for (int nt = 0; nt < 8; ++nt) acc[nt] = (f32x4){0.f, 0.f, 0.f, 0.f};
#pragma unroll 2
            for (int ks = 0; ks < 16; ++ks) { const float av = wp[4 * ks]; const int c = 4 * ks + lq;
#pragma unroll
                for (int nt = 0; nt < 8; ++nt) acc[nt] = __builtin_amdgcn_mfma_f32_16x16x4f32(av, dft64(tabreg, c, 16 * nt + lr), acc[nt], 0, 0, 0); }
#pragma unroll
            for (int nt = 0; nt < 8; ++nt) { v2u o; o.x = pk2(acc[nt][0], acc[nt][1]); o.y = pk2(acc[nt][2], acc[nt][3]);
                *(v2u*)(WINT + (size_t)l * NINP * 1024 + (size_t)(1280 + 128 * hd + 16 * nt + lr) * 1024 + kt * 16 + 4 * lq) = o; }
            continue;
        }
        r -= N_FIN;
        if (r < N_POOLF) {
            const int l = llo + (r >> 6), g = (r >> 4) & 3, nb = r & 15, lr = lane & 15, lq = lane >> 4;
            const float* pw = F.inp(I_POOLW) + (size_t)(l * 4 + g) * 4096 + lr * 64 + lq;
            const float* ps = F.inp(I_POOLS) + l * 256 + 64 * g + lq;
            const float* wo = F.inp(I_WOUT) + (size_t)l * 1048576 + (size_t)(512 + 64 * g + lq) * 1024 + nb * 64 + lr;
            f32x4 acc[4][4];
#pragma unroll
            for (int mt = 0; mt < 4; ++mt)
#pragma unroll
                for (int nt = 0; nt < 4; ++nt) acc[mt][nt] = (f32x4){0.f, 0.f, 0.f, 0.f};
#pragma unroll 2
            for (int ks = 0; ks < 16; ++ks) { const float sc = ps[4 * ks]; float av[4], bv[4];
#pragma unroll
                for (int mt = 0; mt < 4; ++mt) av[mt] = pw[mt * 1024 + 4 * ks] * sc;
#pragma unroll
                for (int nt = 0; nt < 4; ++nt) bv[nt] = wo[(size_t)(4 * ks) * 1024 + 16 * nt];
#pragma unroll
                for (int mt = 0; mt < 4; ++mt)
#pragma unroll
                    for (int nt = 0; nt < 4; ++nt) acc[mt][nt] = __builtin_amdgcn_mfma_f32_16x16x4f32(av[mt], bv[nt], acc[mt][nt], 0, 0, 0); }
#pragma unroll
            for (int mt = 0; mt < 4; ++mt)
#pragma unroll
                for (int nt = 0; nt < 4; ++nt) { v2u o; o.x = pk2(acc[mt][nt][0], acc[mt][nt][1]); o.y = pk2(acc[mt][nt][2], acc[mt][nt][3]);
                    *(v2u*)(WOUTT + (size_t)l * 1048576 + (size_t)(nb * 64 + 16 * nt + lr) * 1024 + 512 + 64 * g + 16 * mt + 4 * lq) = o; }
            continue;
        }
        r -= N_POOLF;
        if (r < N_W1) {
            const int l = llo + (r >> 7), nb = r & 127;
            strip_item<true>(F.inp(I_W1) + (size_t)l * 1024 * 4096, 4096, 0, 1024, nb * 32, W1T + (size_t)l * 4096 * 1024, 1024, nb * 32,
                             mods + (size_t)l * 3 * 6144 + 3 * 1024, BIAS1 + (size_t)l * 3 * FFD, FFD, scr, lane);
            continue;
        }
        r -= N_W1;
        if (r < N_W2) {
            const int l = llo + (r >> 7), nb = (r >> 2) & 31, kq = r & 3;
            strip_item<false>(F.inp(I_W2) + (size_t)l * 4096 * 1024, 1024, kq * 1024, kq * 1024 + 1024, nb * 32, W2T + (size_t)l * 1024 * 4096, 4096, nb * 32, nullptr, nullptr, 0, scr, lane);
            continue;
        }
        r -= N_W2;
        if (r < N_WIN) {
            const int l = llo + r / 40, nb = r % 40;
            strip_item<true>(F.inp(I_WIN) + (size_t)l * 1024 * 1536, 1536, 0, 1024, nb * 32, WINT + (size_t)l * NINP * 1024, 1024, nb * 32,
                             mods + (size_t)l * 3 * 6144, BIASIN + (size_t)l * 3 * NINP, NINP, scr, lane);
            continue;
        }
        r -= N_WIN;
        if (r < N_WOUTA) {
            const int l = llo + (r >> 5), nb = r & 31;
            strip_item<false>(F.inp(I_WOUT) + (size_t)l * 1048576, 1024, 0, 512, nb * 32, WOUTT + (size_t)l * 1048576, 1024, nb * 32, nullptr, nullptr, 0, scr, lane);
            continue;
        }
        r -= N_WOUTA;
        if (with_rows) {
            const int cond = r < M_CTX ? 0 : 1 + ((r - M_CTX) >> 10);
            const float* src = r < M_CTX ? F.inp(I_XP) + (size_t)r * 1024 : F.inp(I_XS) + (size_t)(r - M_CTX) * 1024;
            const f32x4* xr = (const f32x4*)src + lane;
            const f32x4* gp = (const f32x4*)F.inp(I_N1G) + lane;
            const f32x4* sp = (const f32x4*)(mods + (size_t)cond * 6144 + 1024) + lane;
            f32x4 v[4]; float s = 0.f;
#pragma unroll
            for (int j = 0; j < 4; ++j) { v[j] = xr[64 * j]; s += (v[j][0] * v[j][0] + v[j][1] * v[j][1]) + (v[j][2] * v[j][2] + v[j][3] * v[j][3]); }
            s = wave_sum(s);
            f32x4* xo = (f32x4*)((float*)(F.ws + WS_X) + (size_t)r * 1024) + lane;
            v2u* ao = (v2u*)((bf16*)(F.ws + WS_A) + (size_t)r * 1024) + lane;
#pragma unroll
            for (int j = 0; j < 4; ++j) { xo[64 * j] = v[j]; const f32x4 a = v[j] * (gp[64 * j] * (sp[64 * j] + 1.0f));
                v2u w; w.x = pk2(a[0], a[1]); w.y = pk2(a[2], a[3]); ao[64 * j] = w; }
            if (lane < 16) ((float*)(F.ws + WS_SSQ))[(size_t)r * 16 + lane] = lane == 0 ? s : 0.f;
        }
      }
    }
}
__device__ __forceinline__ void p0b_tail(Frame F) {
    F.relaunder();
    const float* mods = (const float*)(F.ws + WS_MODS);
    const int gt = F.bid * NTHREADS + F.tid, NGT = F.G * NTHREADS;
    {
        float* GV = (float*)(F.ws + WS_GV);
        for (int i = gt; i < 4 * 2 * 3 * 1024; i += NGT) { const int c = i & 1023, cd = (i >> 10) % 3, w = (i / 3072) & 1, l = i / 6144;
            const float g = (w == 0 ? F.inp(I_N1G) : F.inp(I_N2G))[l * 1024 + c]; GV[i] = g * (1.0f + mods[(size_t)(l * 3 + cd) * 6144 + (w == 0 ? 1 : 4) * 1024 + c]); }
    }
    {
        bf16* WG = (bf16*)(F.ws + WS_WG);
        for (int i = gt; i < 4 * 8 * 4 * 4 * 2 * 32 * 64; i += NGT) { const int c = i & 63, n = (i >> 6) & 31, dir = (i >> 11) & 1, tap = (i >> 12) & 3, q = (i >> 14) & 3, h = (i >> 16) & 7, l = i >> 19;
            const float* src = n < 16 ? F.inp(I_WR) : F.inp(I_WI);
            WG[i] = (bf16)f2bf(-1.4426950408889634f * F.inp(I_CONVW)[(l * 4 + tap) * 512 + 64 * h + c] * src[((size_t)((l * 2 + dir) * 8 + h) * 64 + c) * 64 + 16 * q + (n & 15)]); }
        float* GB = (float*)(F.ws + WS_GB);
        for (int i = gt; i < 4 * 2 * 2 * 512; i += NGT) { const int ch = i & 511, g = (i >> 9) & 1, dir = (i >> 10) & 1, l = i >> 11, h = ch >> 6, j = ch & 63;
            const float* W = (g == 0 ? F.inp(I_WR) : F.inp(I_WI)) + (size_t)((l * 2 + dir) * 8 + h) * 4096 + j;
            float s = (g == 0 ? F.inp(I_BR) : F.inp(I_BI))[(l * 2 + dir) * 512 + ch];
            { float wv[64];
#pragma unroll
              for (int c = 0; c < 64; ++c) wv[c] = W[c * 64];
#pragma unroll
              for (int c = 0; c < 64; ++c) s += F.inp(I_CONVB)[l * 512 + 64 * h + c] * wv[c]; }
            GB[i] = -1.4426950408889634f * s; }
    }
    {
        for (int i = gt; i < (256 * 512 + 1024 * 2048) / 8; i += NGT) {
            int L, e; bf16* T;
            if (i < 256 * 512 / 8) { L = 256; e = i * 8; T = (bf16*)(F.ws + WS_T256); } else { L = 1024; e = (i - 256 * 512 / 8) * 8; T = (bf16*)(F.ws + WS_T1024); }
            const int kpos = e / (2 * L), k2 = e % (2 * L), sn = k2 >= L, l0 = k2 - (sn ? L : 0);
            const float scale = L == 256 ? 0.0625f : 0.03125f, inv = 2.0f / (float)L;
            float v[8];
#pragma unroll
            for (int j = 0; j < 8; ++j) { const int a = (kpos * (l0 + j)) & (L - 1); v[j] = sn ? -sinpif((float)a * inv) * scale : cospif((float)a * inv) * scale; }
            v4u o; o.x = pk2(v[0], v[1]); o.y = pk2(v[2], v[3]); o.z = pk2(v[4], v[5]); o.w = pk2(v[6], v[7]);
            *(v4u*)(T + ((size_t)(((kpos >> 4) * (L >> 4) + (k2 >> 5)) * 64 + ((k2 >> 3) & 3) * 16 + (kpos & 15))) * 8) = o;
        }
    }
}
#define LRU_STAMP(i) do { if (TS_SEL >= 0 && F.tsx && F.wave == 0) __hip_atomic_store(F.tsx + (i), (unsigned long long)__builtin_amdgcn_s_memrealtime(), __ATOMIC_RELAXED, __HIP_MEMORY_SCOPE_AGENT); } while (0)
__device__ __forceinline__ float sigmoidf_(float x) { return 1.0f / (1.0f + expf(-x)); }
__device__ __forceinline__ float gelu_tanh(float x) { return 0.5f * x * (1.0f + tanhf(0.7978845608028654f * (x + 0.044715f * x * x * x))); }
__device__ __forceinline__ void seq_geom(int seq, int& L, int& row0) { if (seq < 16) { L = 256; row0 = seq * 256; } else { L = 1024; row0 = M_CTX + (seq - 16) * 1024; } }

__device__ __forceinline__ float fexp(float x) { return __builtin_amdgcn_exp2f(x * 1.4426950408889634f); }
__device__ __forceinline__ float fsigmoid(float x) { return __builtin_amdgcn_rcpf(1.0f + __builtin_amdgcn_exp2f(x * -1.4426950408889634f)); }
__device__ __forceinline__ float fgelu_tanh(float x) { return x * fsigmoid(1.5957691216057308f * (x + 0.044715f * x * x * x)); }
__device__ __forceinline__ float neg_expm1(float y) {
    float p = 1.0f / 720.0f; p = p * y + (1.0f / 120.0f); p = p * y + (1.0f / 24.0f); p = p * y + (1.0f / 6.0f); p = p * y + 0.5f; p = p * y + 1.0f;
    return y < -0.5f ? 1.0f - fexp(y) : -y * p;
}
__device__ __forceinline__ float one_minus_sq(float a, float y) {
    float p = 1.0f / 720.0f; p = p * y + (1.0f / 120.0f); p = p * y + (1.0f / 24.0f); p = p * y + (1.0f / 6.0f); p = p * y + 0.5f; p = p * y + 1.0f;
    return y < -0.5f ? __builtin_fmaf(-a, a, 1.0f) : -y * p;
}
__device__ __forceinline__ void lru_unit(Frame F, int l, int seq, int h, int q) {
    F.relaunder();
    LRU_STAMP(0);
    int L, row0; seq_geom(seq, L, row0);
    const int tid = F.tid, lane = F.lane, wave = F.wave;
    LAS bf16* XR = (LAS bf16*)F.lds;
    LAS bf16* XG = (LAS bf16*)(F.lds + 37440);
    LAS float* WTP = (LAS float*)(F.lds + 53824);
    LAS float* WTH = WTP + 256;
    LAS float* CHKP = WTP + 512;
    LAS float* CHKH = WTP + 576;
    LAS bf16* WGL = (LAS bf16*)(F.lds + 57344);
    const bf16* U = (const bf16*)(F.ws + WS_U);
    bf16* CAT = (bf16*)(F.ws + WS_CAT);
    float* HFG = (float*)(F.ws + WS_HF); float* PBG = (float*)(F.ws + WS_PB);
    const int chb = 64 * h + 16 * q;
    const int nch = L >> 8;
    const int j16 = lane & 15, lq = lane >> 4;
    float gbr[2], gbi[2], sp8[2], cwo[4];
    { const float* GB = (const float*)(F.ws + WS_GB) + (size_t)l * 2048 + chb + j16;
#pragma unroll
        for (int d = 0; d < 2; ++d) { gbr[d] = GB[d * 1024]; gbi[d] = GB[d * 1024 + 512];
            sp8[d] = (-8.0f * 1.4426950408889634f) * log1pf(expf(-F.inp(I_LAM)[(l * 2 + d) * 512 + chb + j16])); } }
#pragma unroll
    for (int k = 0; k < 4; ++k) cwo[k] = F.inp(I_CONVW)[(l * 4 + k) * 512 + chb + j16];
    const float cbo = F.inp(I_CONVB)[l * 512 + chb + j16];
    float carf = seq < 16 ? 0.f : F.inp(I_STATE)[(((seq - 16) * 4 + l) * 2 + 0) * 512 + chb + j16];
    const float h0b = seq < 16 ? 0.f : F.inp(I_STATE)[(((seq - 16) * 4 + l) * 2 + 1) * 512 + chb + j16];
    v4u xv[5], gv;
#pragma unroll
    for (int i = 0; i < 5; ++i) { const int id = tid + NTHREADS * i, tr = id >> 3, v = id & 7, t = tr - 2; xv[i] = (v4u){0u, 0u, 0u, 0u};
        if (id < 260 * 8 && t >= 0 && t < L) xv[i] = *(const v4u*)(U + (size_t)(row0 + t) * NUC + 64 * h + 8 * v); }
    gv = *(const v4u*)(U + (size_t)(row0 + (tid >> 1)) * NUC + 512 + chb + 8 * (tid & 1));
    { const bf16* WGb = (const bf16*)(F.ws + WS_WG) + (size_t)((l * 8 + h) * 4 + q) * (4 * 2 * 32 * 64);
        v4u wv[4];
#pragma unroll
        for (int i = 0; i < 4; ++i) { const int id = tid + NTHREADS * i; wv[i] = *(const v4u*)(WGb + (size_t)(id >> 3) * 64 + 8 * (id & 7)); }
#pragma unroll
        for (int i = 0; i < 4; ++i) { const int id = tid + NTHREADS * i; *(LAS v4u*)(WGL + (id >> 3) * 72 + 8 * (id & 7)) = wv[i]; } }
#pragma unroll 1
    for (int c = 0; c < nch; ++c) {
        const int c0 = c * 256; const bool last = c == nch - 1;
        LAS bf16* XGc = XG + (c & 1) * 4096;
#pragma unroll
        for (int i = 0; i < 5; ++i) { const int id = tid + NTHREADS * i; if (id < 260 * 8) *(LAS v4u*)(XR + (id >> 3) * 72 + 8 * (id & 7)) = xv[i]; }
        *(LAS v4u*)(XGc + tid * 8) = gv;
        if (!last) {
#pragma unroll
            for (int i = 0; i < 5; ++i) { const int id = tid + NTHREADS * i, tr = id >> 3, v = id & 7, t = c0 + 256 - 2 + tr; xv[i] = (v4u){0u, 0u, 0u, 0u};
                if (id < 260 * 8 && t < L) xv[i] = *(const v4u*)(U + (size_t)(row0 + t) * NUC + 64 * h + 8 * v); }
            gv = *(const v4u*)(U + (size_t)(row0 + c0 + 256 + (tid >> 1)) * NUC + 512 + chb + 8 * (tid & 1));
        }
        __syncthreads();
        LRU_STAMP(1);
        f32x4 acc[2][4];
#pragma unroll
        for (int mt = 0; mt < 2; ++mt)
#pragma unroll
            for (int nt = 0; nt < 4; ++nt) { const float gb = (nt & 1) ? gbi[nt >> 1] : gbr[nt >> 1]; acc[mt][nt] = (f32x4){gb, gb, gb, gb}; }
#pragma unroll
        for (int k = 0; k < 4; ++k)
#pragma unroll
            for (int ks = 0; ks < 2; ++ks) { bf16x8 bw[4];
#pragma unroll
                for (int nt = 0; nt < 4; ++nt) bw[nt] = *(const LAS bf16x8*)(WGL + (k * 64 + 16 * nt + j16) * 72 + 32 * ks + 8 * lq);
#pragma unroll
                for (int mt = 0; mt < 2; ++mt) { const bf16x8 a = *(const LAS bf16x8*)(XR + (32 * wave + 16 * mt + j16 + k) * 72 + 32 * ks + 8 * lq);
#pragma unroll
                    for (int nt = 0; nt < 4; ++nt) acc[mt][nt] = __builtin_amdgcn_mfma_f32_16x16x32_bf16(a, bw[nt], acc[mt][nt], 0, 0, 0); } }
        LRU_STAMP(3);
        float Pc[2][8], Hc[2][8], rP[2][2], rH[2][2];
#pragma unroll
        for (int mt = 0; mt < 2; ++mt) {
            float av[2][4], bv[2][4];
#pragma unroll
            for (int rg = 0; rg < 4; ++rg) { const int tl = 32 * wave + 16 * mt + 4 * lq + rg;
                float xc = cbo;
#pragma unroll
                for (int k = 0; k < 4; ++k) xc += bf2f(XR[(tl + k) * 72 + 16 * q + j16]) * cwo[k];
#pragma unroll
                for (int d = 0; d < 2; ++d) { const float r = __builtin_amdgcn_rcpf(1.0f + __builtin_amdgcn_exp2f(acc[mt][2 * d][rg])), ig = __builtin_amdgcn_rcpf(1.0f + __builtin_amdgcn_exp2f(acc[mt][2 * d + 1][rg]));
                    const float la2 = sp8[d] * r, a = __builtin_amdgcn_exp2f(la2); av[d][rg] = a; bv[d][rg] = __builtin_amdgcn_sqrtf(one_minus_sq(a, la2 * 1.3862943611198906f)) * (ig * xc); } }
            float P = 1.f, Hl = 0.f;
#pragma unroll
            for (int rg = 0; rg < 4; ++rg) { Hl = av[0][rg] * Hl + bv[0][rg]; P *= av[0][rg]; Pc[0][4 * mt + rg] = P; Hc[0][4 * mt + rg] = Hl; }
            rP[0][mt] = P; rH[0][mt] = Hl; P = 1.f; Hl = 0.f;
#pragma unroll
            for (int rg = 3; rg >= 0; --rg) { Hl = av[1][rg] * Hl + bv[1][rg]; P *= av[1][rg]; Pc[1][4 * mt + rg] = P; Hc[1][4 * mt + rg] = Hl; }
            rP[1][mt] = P; rH[1][mt] = Hl;
        }
        LRU_STAMP(4);
        float EP[2][2], EH[2][2], WPt[2], WHt[2];
#pragma unroll
        for (int d = 0; d < 2; ++d) { float ep = 1.f, eh = 0.f;
#pragma unroll
            for (int rr = 0; rr < 8; ++rr) { const int r = d == 0 ? rr : 7 - rr, mt = r >> 2, lq2 = r & 3;
                const float p = __shfl(rP[d][mt], j16 + 16 * lq2), hh = __shfl(rH[d][mt], j16 + 16 * lq2);
                if (lq2 == lq) { EP[d][mt] = ep; EH[d][mt] = eh; }
                eh = p * eh + hh; ep *= p; }
            WPt[d] = ep; WHt[d] = eh; }
        if (lq == 0) {
#pragma unroll
            for (int d = 0; d < 2; ++d) { WTP[(d * 8 + wave) * 16 + j16] = WPt[d]; WTH[(d * 8 + wave) * 16 + j16] = WHt[d]; } }
        __syncthreads();
        LRU_STAMP(5);
        float cwf = 0.f, cwb = 0.f, qwb = 1.f;
        { float cv = carf;
#pragma unroll
            for (int w = 0; w < 8; ++w) { if (w == wave) cwf = cv; cv = WTP[w * 16 + j16] * cv + WTH[w * 16 + j16]; }
            carf = cv;
            cv = last ? h0b : 0.f; float qv = 1.f;
#pragma unroll
            for (int w = 7; w >= 0; --w) { if (w == wave) { cwb = cv; qwb = qv; } const float pw = WTP[(8 + w) * 16 + j16]; cv = pw * cv + WTH[(8 + w) * 16 + j16]; qv *= pw; }
            if (wave == 0 && lq == 0) { CHKP[c * 16 + j16] = qv; CHKH[c * 16 + j16] = cv; }
            if (nch == 1 && wave == 0 && lq == 0) {
                float* so = F.out + (size_t)M_TOK * DMODEL + (size_t)((seq * 4 + l) * 2) * 512 + chb + j16; so[0] = carf; so[512] = cv; } }
        LRU_STAMP(6);
#pragma unroll
        for (int mt = 0; mt < 2; ++mt) {
            const float hinf = EP[0][mt] * cwf + EH[0][mt], hinb = EP[1][mt] * cwb + EH[1][mt], pbf = EP[1][mt] * qwb;
#pragma unroll
            for (int rg = 0; rg < 4; ++rg) { const int p = 4 * mt + rg, tl = 32 * wave + 16 * mt + 4 * lq + rg; const size_t row = (size_t)(row0 + c0 + tl);
                const float s = (Hc[0][p] + Pc[0][p] * hinf) + (Hc[1][p] + Pc[1][p] * hinb);
                if (last) CAT[row * DMODEL + chb + j16] = (bf16)f2bf(s * fgelu_tanh(bf2f(XGc[tl * 16 + j16])));
                else { HFG[row * DRNN + chb + j16] = s; PBG[row * DRNN + chb + j16] = Pc[1][p] * pbf; } }
        }
        if (!last) __syncthreads();
    }
    LRU_STAMP(7);
    if (nch > 1) {
        __syncthreads();
        float cin[3]; { float cv = CHKH[(nch - 1) * 16 + j16];
#pragma unroll
            for (int c = 2; c >= 0; --c) { cin[c] = cv; if (c < nch - 1) cv = CHKP[c * 16 + j16] * cv + CHKH[c * 16 + j16]; } }
#pragma unroll
        for (int c = 0; c < 3; ++c) if (c < nch - 1) {
            float sv[8], pv[8], gx[8];
#pragma unroll
            for (int p = 0; p < 8; ++p) { const size_t row = (size_t)(row0 + 256 * c + 32 * wave + 16 * (p >> 2) + 4 * lq + (p & 3));
                sv[p] = HFG[row * DRNN + chb + j16]; pv[p] = PBG[row * DRNN + chb + j16]; gx[p] = bf2f(U[row * NUC + 512 + chb + j16]); }
#pragma unroll
            for (int p = 0; p < 8; ++p) { const size_t row = (size_t)(row0 + 256 * c + 32 * wave + 16 * (p >> 2) + 4 * lq + (p & 3));
                CAT[row * DMODEL + chb + j16] = (bf16)f2bf((sv[p] + pv[p] * cin[c]) * fgelu_tanh(gx[p])); }
        }
    }
    __syncthreads();
}

__device__ __forceinline__ void pool1d_unit(Frame F, int seq, int tb) {
    F.relaunder();
    const bf16* U = (const bf16*)(F.ws + WS_U); bf16* CAT = (bf16*)(F.ws + WS_CAT);
    const int row0 = seq * 256;
#pragma unroll 1
    for (int i = 0; i < 4; ++i) { const int id = F.tid + NTHREADS * i, t = tb * 64 + (id >> 5), v = id & 31, g = v >> 3, hw = 1 << g;
        const int lo = max(t - hw, 0), hi = min(t + hw, 256);
        v4u x[16];
#pragma unroll
        for (int k = 0; k < 16; ++k) { const int tt = t - 8 + k; x[k] = (v4u){0u, 0u, 0u, 0u}; if (tt >= lo && tt < hi) x[k] = *(const v4u*)(U + (size_t)(row0 + tt) * NUC + 1024 + 8 * v); }
        float s[8];
#pragma unroll
        for (int c = 0; c < 8; ++c) s[c] = 0.f;
#pragma unroll
        for (int k = 0; k < 16; ++k) { s[0] += bflo(x[k].x); s[1] += bfhi(x[k].x); s[2] += bflo(x[k].y); s[3] += bfhi(x[k].y); s[4] += bflo(x[k].z); s[5] += bfhi(x[k].z); s[6] += bflo(x[k].w); s[7] += bfhi(x[k].w); }
        const float inv = 1.0f / (float)(hi - lo);
        const v4u xs = x[8];
        v4u o; o.x = pk2(s[0] * inv - bflo(xs.x), s[1] * inv - bfhi(xs.x)); o.y = pk2(s[2] * inv - bflo(xs.y), s[3] * inv - bfhi(xs.y));
        o.z = pk2(s[4] * inv - bflo(xs.z), s[5] * inv - bfhi(xs.z)); o.w = pk2(s[6] * inv - bflo(xs.w), s[7] * inv - bfhi(xs.w));
        *(v4u*)(CAT + (size_t)(row0 + t) * DMODEL + 512 + 8 * v) = o; }
}
__device__ __forceinline__ void pool2d_unit(Frame F, int b, int g, int oc) {
    F.relaunder();
    const bf16* U = (const bf16*)(F.ws + WS_U); bf16* CAT = (bf16*)(F.ws + WS_CAT);
    LAS float* T1 = (LAS float*)F.lds;
    LAS float* T2 = (LAS float*)(F.lds + 32768);
    const int row0 = M_CTX + b * 1024, colb = 64 * g + 8 * oc, hw = 1 << g;
#pragma unroll
    for (int i = 0; i < 2; ++i) { const int t = F.tid + NTHREADS * i;
        const v4u x = *(const v4u*)(U + (size_t)(row0 + t) * NUC + 1024 + colb);
        *(LAS f32x4*)(T1 + t * 8) = (f32x4){bflo(x.x), bfhi(x.x), bflo(x.y), bfhi(x.y)}; *(LAS f32x4*)(T1 + t * 8 + 4) = (f32x4){bflo(x.z), bfhi(x.z), bflo(x.w), bfhi(x.w)}; }
    __syncthreads();
    const int j4 = 4 * (F.tid & 1), tq = F.tid >> 1;
#pragma unroll
    for (int i = 0; i < 4; ++i) { const int t = tq + 256 * i, r = t >> 6, c = t & 63, lo = max(c - hw, 0), hi = min(c + hw, 64);
        f32x4 s = {0.f, 0.f, 0.f, 0.f};
        for (int c2 = lo; c2 < hi; ++c2) s += *(const LAS f32x4*)(T1 + (r * 64 + c2) * 8 + j4);
        *(LAS f32x4*)(T2 + t * 8 + j4) = s * (1.0f / (float)(hi - lo)); }
    __syncthreads();
#pragma unroll
    for (int i = 0; i < 4; ++i) { const int t = tq + 256 * i, r = t >> 6, c = t & 63, lo = max(r - hw, 0), hi = min(r + hw, 16);
        f32x4 s = {0.f, 0.f, 0.f, 0.f};
        for (int r2 = lo; r2 < hi; ++r2) s += *(const LAS f32x4*)(T2 + (r2 * 64 + c) * 8 + j4);
        const f32x4 o = s * (1.0f / (float)(hi - lo)) - *(const LAS f32x4*)(T1 + t * 8 + j4);
        v2u w; w.x = pk2(o[0], o[1]); w.y = pk2(o[2], o[3]);
        *(v2u*)(CAT + (size_t)(row0 + t) * DMODEL + 512 + colb + j4) = w; }
    __syncthreads();
}
__device__ __forceinline__ void fourier_unit(Frame F, int seq, int hd, int nb) {
    F.relaunder();
    LRU_STAMP(0);
    int L, row0; seq_geom(seq, L, row0);
    const int lane = F.lane, wave = F.wave, j16 = lane & 15, kq = 8 * (lane >> 4);
    const bf16* XCT = (const bf16*)(F.ws + WS_XCT) + (seq < 16 ? (size_t)(seq * 4 + hd) * 128 * 256 : pg8::XCT_LAT_OFF + (size_t)((seq - 16) * 4 + hd) * 128 * 1024);
    const bf16* T = seq < 16 ? (const bf16*)(F.ws + WS_T256) : (const bf16*)(F.ws + WS_T1024);
    const int K2 = 2 * L, KB2 = K2 >> 5, kw = K2 / 8, kbeg = wave * kw;
    const bf16* Ab = XCT + ((size_t)(kbeg >> 5) * 64 + lane) * 8;
    const bf16* Bb = T + ((size_t)((nb * 4) * KB2 + (kbeg >> 5)) * 64 + lane) * 8;
    f32x4 acc[4][4];
#pragma unroll
    for (int mt = 0; mt < 4; ++mt)
#pragma unroll
        for (int nt = 0; nt < 4; ++nt) acc[mt][nt] = (f32x4){0.f, 0.f, 0.f, 0.f};
    const bf16* Ap = Ab; const bf16* Bp = Bb;
    const size_t a16 = (size_t)KB2 * 512, b16 = (size_t)KB2 * 512;
#define FOU_LOAD(A_, B_, ks_) do { _Pragma("unroll") for (int mt = 0; mt < 4; ++mt) A_[mt] = *(const bf16x8*)(Ap + mt * a16 + (size_t)(ks_) * 16); \
                                   _Pragma("unroll") for (int nt = 0; nt < 4; ++nt) B_[nt] = *(const bf16x8*)(Bp + nt * b16 + (size_t)(ks_) * 16); } while (0)
#define FOU_MMA(A_, B_) do { _Pragma("unroll") for (int mt = 0; mt < 4; ++mt) _Pragma("unroll") for (int nt = 0; nt < 4; ++nt) \
                                   acc[mt][nt] = __builtin_amdgcn_mfma_f32_16x16x32_bf16(A_[mt], B_[nt], acc[mt][nt], 0, 0, 0); } while (0)
    bf16x8 fa0[4], fb0[4], fa1[4], fb1[4], fa2[4], fb2[4];
    FOU_LOAD(fa0, fb0, 0); FOU_LOAD(fa1, fb1, 32);
    if (kw == 64) { FOU_MMA(fa0, fb0); FOU_MMA(fa1, fb1); }
    else {
        FOU_LOAD(fa2, fb2, 64);
        FOU_MMA(fa0, fb0); FOU_LOAD(fa0, fb0, 96);
        FOU_MMA(fa1, fb1); FOU_LOAD(fa1, fb1, 128);
        FOU_MMA(fa2, fb2); FOU_LOAD(fa2, fb2, 160);
        FOU_MMA(fa0, fb0); FOU_LOAD(fa0, fb0, 192);
        FOU_MMA(fa1, fb1); FOU_LOAD(fa1, fb1, 224);
        FOU_MMA(fa2, fb2); FOU_MMA(fa0, fb0); FOU_MMA(fa1, fb1);
    }
#undef FOU_LOAD
#undef FOU_MMA
    LRU_STAMP(1);
    LAS float* red = (LAS float*)F.lds;
#pragma unroll
    for (int mt = 0; mt < 4; ++mt)
#pragma unroll
        for (int nt = 0; nt < 4; ++nt) *(LAS f32x4*)(red + (size_t)(wave * 64 + 16 * nt + j16) * 68 + 16 * mt + 4 * (lane >> 4)) = acc[mt][nt];
    __syncthreads();
    LRU_STAMP(2);
    { const int kp = F.tid >> 3, mg = F.tid & 7;
        f32x4 s0 = {0.f, 0.f, 0.f, 0.f}, s1 = s0;
#pragma unroll
        for (int w = 0; w < 8; ++w) { const LAS f32x4* p = (const LAS f32x4*)(red + (size_t)(w * 64 + kp) * 68 + 8 * mg); s0 += p[0]; s1 += p[1]; }
        v4u o; o.x = pk2(s0[0], s0[1]); o.y = pk2(s0[2], s0[3]); o.z = pk2(s1[0], s1[1]); o.w = pk2(s1[2], s1[3]);
        *(v4u*)((bf16*)(F.ws + WS_CAT) + (size_t)(row0 + nb * 64 + kp) * DMODEL + 768 + 64 * hd + 8 * mg) = o; }
    __syncthreads();
    LRU_STAMP(3);
}
#ifndef REP_LRU
#define REP_LRU 1
#endif
#ifndef REP_FOU
#define REP_FOU 1
#endif
#ifndef REP_POOL
#define REP_POOL 1
#endif
__device__ __forceinline__ void mixer_phase(const Frame& F, int l) {
    constexpr int N_LRU_LAT = 64, N_FOU_LAT = 128, N_P2D = 64, N_LRU_CTX = 512, N_FOU_CTX = 256, N_P1D = 64;
    constexpr int NREST = N_FOU_LAT + N_P2D + N_LRU_CTX + N_FOU_CTX + N_P1D;
    if (false && F.G == 256 && REP_LRU == 1 && REP_FOU == 1 && REP_POOL == 1) {
        const int b = F.bid;
        if (b < 64) { lru_unit(F, l, 16 + (b >> 5), (b >> 2) & 7, b & 3); fourier_unit(F, b >> 4, (b >> 2) & 3, b & 3); }
        else if (b < 192) { const int i = b - 64; fourier_unit(F, 16 + (i >> 6), (i >> 4) & 3, i & 15);
            for (int k = 0; k < 3; ++k) { const int r = 3 * i + k; lru_unit(F, l, r >> 5, (r >> 2) & 7, r & 3); } }
        else { const int i = b - 192;
            for (int k = 0; k < 2; ++k) { const int r = 384 + 2 * i + k; lru_unit(F, l, r >> 5, (r >> 2) & 7, r & 3); }
            for (int k = 0; k < 3; ++k) { const int r = 64 + 3 * i + k; fourier_unit(F, r >> 4, (r >> 2) & 3, r & 3); }
            pool2d_unit(F, i >> 5, (i >> 3) & 3, i & 7); pool1d_unit(F, i >> 2, i & 3); }
        return;
    }
    const int nlat = F.G >= 128 ? 64 : F.G / 4;
    if (F.bid < nlat) {
        for (int r = F.bid; r < N_LRU_LAT; r += nlat) {
#ifndef SKIP_LRU
            for (int rp = 0; rp < REP_LRU; ++rp) lru_unit(F, l, 16 + (r >> 5), (r >> 2) & 7, r & 3);
#endif
        }
        return;
    }
#if TS_SEL >= 0
    int ustamp = 0; unsigned long long* TSX = (unsigned long long*)(F.ws0 + WS_CTL + 2048) + 64;
#define MIX_STAMP() do { if (F.bid == TS_BLK && F.wave == 0 && l == (TS_SEL - 2) / 5 && ustamp < 8) __hip_atomic_store(TSX + ustamp, (unsigned long long)__builtin_amdgcn_s_memrealtime(), __ATOMIC_RELAXED, __HIP_MEMORY_SCOPE_AGENT); ++ustamp; } while (0)
#else
#define MIX_STAMP() do {} while (0)
#endif
    for (int it = F.bid - nlat; ; it += F.G - nlat) {
        MIX_STAMP();
        if (it >= NREST) break;
        int r = it;
        if (r < N_P2D) {
#ifndef SKIP_POOL
            for (int rp = 0; rp < REP_POOL; ++rp) pool2d_unit(F, r >> 5, (r >> 3) & 3, r & 7);
#endif
            continue; } r -= N_P2D;
        if (r < N_FOU_LAT) {
#ifndef SKIP_FOU
            { Frame F2 = F;
#if TS_SEL >= 0
              if (F.bid == TS_BLK && l == (TS_SEL - 2) / 5) F2.tsx = TSX + 32;
#endif
              for (int rp = 0; rp < REP_FOU; ++rp) fourier_unit(F2, 16 + ((r & 7) >> 2), r & 3, r >> 3); }
#endif
            continue; } r -= N_FOU_LAT;
        if (r < N_LRU_CTX) {
#ifndef SKIP_LRU
            { Frame F2 = F;
#if TS_SEL >= 0
              if (F.bid == TS_BLK && l == (TS_SEL - 2) / 5 && ustamp == 2) F2.tsx = TSX + 16;
#endif
              for (int rp = 0; rp < REP_LRU; ++rp) lru_unit(F2, l, r >> 5, (r >> 2) & 7, r & 3); }
#endif
            continue; } r -= N_LRU_CTX;
        if (r < N_FOU_CTX) {
#ifndef SKIP_FOU
            for (int rp = 0; rp < REP_FOU; ++rp) fourier_unit(F, r >> 4, (r >> 2) & 3, r & 3);
#endif
            continue; } r -= N_FOU_CTX;
#ifndef SKIP_POOL
        for (int rp = 0; rp < REP_POOL; ++rp) pool1d_unit(F, r >> 2, r & 3);
#endif
    }
}
#ifndef MK_PER_PHASE
#define MK_PER_PHASE 0
#endif
#ifndef MK_BARRIER
#define MK_BARRIER 1
#endif
#ifndef REP_P0
#define REP_P0 1
#endif
#ifndef REP_MIX
#define REP_MIX 1
#endif
#ifndef REP_G1
#define REP_G1 1
#endif
#ifndef REP_G3
#define REP_G3 1
#endif
#ifndef TS_SEL
#define TS_SEL -1
#endif
#ifndef TS_MODE
#define TS_MODE 0
#endif
#ifndef TS_BLK
#define TS_BLK 0
#endif
#ifndef TSX_OFF
#define TSX_OFF 0
#endif
#ifndef TS_SCALE
#define TS_SCALE 1e-6f
#endif
constexpr int N_PHASES = 2 + 5 * DEPTHL + 1;
constexpr int CW_BAR = 4096;
__device__ __forceinline__ void final_norm(const Frame& F) {
    const int gw = F.bid * NWAVES + F.wave, NGW = F.G * NWAVES;
    const float* X = (const float*)(F.ws + WS_X); const float* ssq = (const float*)(F.ws + WS_SSQ) + (size_t)8 * M_TOK * 16;
    const f32x4* gp = (const f32x4*)F.inp(I_FG) + F.lane;
    for (int r = gw; r < M_TOK; r += NGW) {
        const float rs = pg8::row_rstd(ssq, r);
        const f32x4* xr = (const f32x4*)(X + (size_t)r * 1024) + F.lane; f32x4* o = (f32x4*)(F.out + (size_t)r * 1024) + F.lane;
#pragma unroll
        for (int j = 0; j < 4; ++j) o[64 * j] = xr[64 * j] * rs * gp[64 * j];
    }
}
__global__ void __launch_bounds__(NTHREADS, 2) mega(Params p) {
    extern __shared__ __attribute__((aligned(16))) unsigned char lds[];
    Frame F;
    F.lds = (LAS unsigned char*)lds; F.tid = threadIdx.x; F.lane = F.tid & 63; F.wave = __builtin_amdgcn_readfirstlane(F.tid >> 6);
    F.G = gridDim.x; F.bid = blockIdx.x; F.in = (const CAS cfp_t*)__builtin_amdgcn_kernarg_segment_ptr(); F.out0 = p.out; F.ws0 = p.ws; F.out = p.out; F.ws = p.ws; F.tsx = nullptr;
#if MK_BARRIER
    volatile unsigned* bst = (volatile unsigned*)(p.ws + WS_CTL) + 1024 + 2 * blockIdx.x;
    XcdBarrier bar = xcd_barrier_post((unsigned*)(p.ws + WS_CTL) + CW_BAR, bst);
#else
    cg::grid_group grid = cg::this_grid();
#endif
#if TS_SEL >= 0
    unsigned long long* TS = (unsigned long long*)(p.ws + WS_CTL + 2048);
    if (blockIdx.x == TS_BLK && threadIdx.x == 0) TS[31] = __builtin_amdgcn_s_memrealtime();
#endif
    for (int ph = p.ph_lo; ph < p.ph_hi; ++ph) {
        { size_t z = 0; asm volatile("" : "+s"(z)); F.ws = F.ws0 + z; }
        bf16* A = (bf16*)(F.ws + WS_A); bf16* CAT = (bf16*)(F.ws + WS_CAT); bf16* HID = (bf16*)(F.ws + WS_HID); bf16* U = (bf16*)(F.ws + WS_U); bf16* XCT = (bf16*)(F.ws + WS_XCT);
        float* X = (float*)(F.ws + WS_X); float* SSQ = (float*)(F.ws + WS_SSQ); const float* MODS = (const float*)(F.ws + WS_MODS); const float* GV = (const float*)(F.ws + WS_GV);
        if (ph == 0) {
#ifndef SKIP_P0A
 F.relaunder(); p0a_mods(F);
#endif
 }
        else if (ph == 1) {
#ifndef SKIP_P0B
 F.relaunder();
 { const bool defer = false && F.G >= 224;
   p0b_items(F, 0, defer ? 1 : DEPTHL, F.bid * NWAVES + F.wave, F.G * NWAVES, true); p0b_tail(F); }
#endif
 }
        else if (ph == N_PHASES - 1) { F.relaunder(); final_norm(F); }
        else {
            const int l = (ph - 2) / 5, k = (ph - 2) % 5;
            if (k == 0) {
                F.relaunder();
                pg8::Gemm g{A, (const bf16*)(F.ws + WS_WIN) + (size_t)l * NINP * 1024, M_TOK, NINP, 1024}; pg8::StaticOrder S; S.init(M_TOK, NINP, F.G, F.bid);
                pg8::EpiIn E{U, XCT, SSQ + (size_t)(2 * l) * M_TOK * 16, (const float*)(F.ws + WS_BIASIN) + (size_t)l * 3 * NINP};
#ifndef SKIP_G1
                pg8::gemm_phase<pg8::EpiIn, pg8::StaticOrder, true, true>(F.lds, g, S, E, F.tid);
#endif
            } else if (k == 1) {
#ifndef SKIP_MIX
                for (int rep = 0; rep < REP_MIX; ++rep) mixer_phase(F, l);
#endif
            } else if (k == 2 || k == 4) {
                F.relaunder();
                const bool dn = k == 4;
                pg8::Gemm g{dn ? HID : CAT, dn ? (const bf16*)(F.ws + WS_W2) + (size_t)l * FFD * 1024 : (const bf16*)(F.ws + WS_WOUT) + (size_t)l * 1024 * 1024, M_TOK, 1024, dn ? FFD : 1024};
                pg8::StaticOrder192 S; S.init(M_TOK, 1024, F.G, F.bid);
                const float* Gn = dn ? (l < DEPTHL - 1 ? GV + (size_t)((l + 1) * 2 * 3) * 1024 : nullptr) : GV + (size_t)((l * 2 + 1) * 3) * 1024;
                const int inst = dn ? (l < DEPTHL - 1 ? 2 * (l + 1) : 8) : 2 * l + 1;
                pg8::EpiRes192 E{X, A, MODS + (size_t)l * 3 * 6144 + (dn ? 5 : 2) * 1024, Gn, SSQ + (size_t)inst * M_TOK * 16};
#ifndef SKIP_G24
                #if TS_SEL >= 0
                pg8::gemm_phase_m192<pg8::EpiRes192, pg8::StaticOrder192>(F.lds, g, S, E, F.tid, ph == TS_SEL ? (unsigned long long*)(p.ws + WS_CTL + 2048) + 64 : nullptr);
#else
                pg8::gemm_phase_m192<pg8::EpiRes192, pg8::StaticOrder192>(F.lds, g, S, E, F.tid);
#endif
                if (false && dn && l + 1 < DEPTHL && F.G >= 224 && F.bid >= 192) p0b_items(F, l + 1, l + 2, (F.bid - 192) * NWAVES + F.wave, (F.G - 192) * NWAVES, false);
#endif
            } else {
                F.relaunder();
                { pg8::Gemm g{A, (const bf16*)(F.ws + WS_W1) + (size_t)l * FFD * 1024, M_CTX, FFD, 1024}; pg8::StaticOrder S; S.init(M_CTX, FFD, F.G, F.bid);
                  pg8::EpiUp E{HID, SSQ + (size_t)(2 * l + 1) * M_TOK * 16, (const float*)(F.ws + WS_BIAS1) + (size_t)l * 3 * FFD};
#ifndef SKIP_G3
                  pg8::gemm_phase<pg8::EpiUp, pg8::StaticOrder, true, true>(F.lds, g, S, E, F.tid);
#endif
                }
                F.relaunder();
                { const int l2 = launder_s(l);
                  pg8::Gemm g{(const bf16*)(F.ws + WS_A), (const bf16*)(F.ws + WS_W1) + (size_t)l2 * FFD * 1024, M_TOK, FFD, 1024}; pg8::StaticOrder128 S; S.init(M_TOK - M_CTX, FFD, F.G, F.bid, M_CTX / 256);
                  pg8::EpiUp128 E{(bf16*)(F.ws + WS_HID), (const float*)(F.ws + WS_SSQ) + (size_t)(2 * l2 + 1) * M_TOK * 16, (const float*)(F.ws + WS_BIAS1) + (size_t)l2 * 3 * FFD};
#ifndef SKIP_G3
                  pg8::gemm_phase_n128<pg8::EpiUp128, pg8::StaticOrder128>(F.lds, g, S, E, F.tid);
#endif
                }
            }
        }
#if TS_SEL >= 0
        if (blockIdx.x == TS_BLK && F.wave == 0) __hip_atomic_store(TS + 32 + ph, (unsigned long long)__builtin_amdgcn_s_memrealtime(), __ATOMIC_RELAXED, __HIP_MEMORY_SCOPE_AGENT);
#endif
#if MK_BARRIER
        if (ph + 1 < p.ph_hi) xcd_barrier(bar);
#else
        if (ph + 1 < p.ph_hi) grid.sync();
#endif
#if TS_SEL >= 0
        if (blockIdx.x == TS_BLK && F.wave == 0) __hip_atomic_store(TS + ph, (unsigned long long)__builtin_amdgcn_s_memrealtime(), __ATOMIC_RELAXED, __HIP_MEMORY_SCOPE_AGENT);
        if (ph == N_PHASES - 2 && blockIdx.x == 255 - TS_BLK) {
            const unsigned long long te = __hip_atomic_load(TS + TS_SEL, __ATOMIC_RELAXED, __HIP_MEMORY_SCOPE_AGENT), tb = __hip_atomic_load(TS + 32 + TS_SEL, __ATOMIC_RELAXED, __HIP_MEMORY_SCOPE_AGENT),
                                     ts = __hip_atomic_load(TS + (TS_SEL == 0 ? 31 : TS_SEL - 1), __ATOMIC_RELAXED, __HIP_MEMORY_SCOPE_AGENT);
            unsigned long long t1 = TS_MODE == 1 ? tb : te, t0 = TS_MODE == 2 ? tb : ts;
            if (TS_MODE == 3) { t0 = __hip_atomic_load(TS + 31, __ATOMIC_RELAXED, __HIP_MEMORY_SCOPE_AGENT); t1 = te; }
            if (TS_MODE >= 10) { unsigned long long x[8]; for (int i = 0; i < 8; ++i) x[i] = __hip_atomic_load(TS + 64 + TSX_OFF + i, __ATOMIC_RELAXED, __HIP_MEMORY_SCOPE_AGENT);
                if (TS_MODE == 10) { t0 = ts; t1 = x[0]; } else if (TS_MODE == 14) { t0 = x[3]; t1 = tb; } else { t0 = x[TS_MODE - 11]; t1 = x[TS_MODE - 10]; } }
            const float us = (float)(t1 - t0) * 0.01f, f = 1.0f + sqrtf(TS_SCALE * us);
            float* st = p.out + (size_t)M_TOK * DMODEL;
            F.relaunder();
            for (int i = F.tid; i < 16 * 4 * 2 * 512; i += NTHREADS) st[i] *= f;
        }
#endif
    }
}

extern "C" void kernel_launch(void* const* d_in, const int* in_sizes, int n_in, void* d_out, int out_size, void* d_ws, size_t ws_size, hipStream_t stream) {
    static int grid = 0;
    if (grid == 0) {
        if (n_in != 24 || ws_size < WS_END) { fprintf(stderr, "kernel_launch: expected 24 inputs and >= %zu bytes of workspace (got %d, %zu)\n", (size_t)WS_END, n_in, ws_size); grid = -1; return; }
        int dev = 0, cus = 0, per_cu = 0;
        if (hipGetDevice(&dev) != hipSuccess || hipDeviceGetAttribute(&cus, hipDeviceAttributeMultiprocessorCount, dev) != hipSuccess) { grid = -1; return; }
        if (hipFuncSetAttribute((const void*)mega, hipFuncAttributeMaxDynamicSharedMemorySize, LDS_BYTES) != hipSuccess) { fprintf(stderr, "kernel_launch: hipFuncSetAttribute failed\n"); grid = -1; return; }
        if (hipOccupancyMaxActiveBlocksPerMultiprocessor(&per_cu, (const void*)mega, NTHREADS, LDS_BYTES) != hipSuccess || per_cu < 1) { fprintf(stderr, "kernel_launch: occupancy query says %d blocks per CU\n", per_cu); grid = -1; return; }
        grid = cus;
    }
    if (grid < 0) return;
    Params p{};
    for (int i = 0; i < 24; ++i) p.in[i] = (const float*)d_in[i];
    p.out = (float*)d_out; p.ws = (unsigned char*)d_ws;
    hipMemsetAsync((char*)d_ws + WS_CTL, 0, 32768, stream);
#if MK_PER_PHASE
    for (int ph = 0; ph < N_PHASES; ++ph) { p.ph_lo = ph; p.ph_hi = ph + 1; hipLaunchKernelGGL(mega, dim3(grid), dim3(NTHREADS), LDS_BYTES, stream, p); }
#else
    p.ph_lo = 0; p.ph_hi = N_PHASES;
    void* args[] = {&p};
    hipError_t e = hipLaunchCooperativeKernel((const void*)mega, dim3(grid), dim3(NTHREADS), args, LDS_BYTES, stream);
    if (e != hipSuccess) fprintf(stderr, "kernel_launch: cooperative launch failed: %s (grid %d)\n", hipGetErrorString(e), grid);
#endif
}
```

```cpp
#include <hip/hip_runtime.h>
#include <hip/hip_cooperative_groups.h>
#include <cstdio>
#include <cstdint>
namespace cg = cooperative_groups;
#define MK_PER_PHASE 0
#ifndef TS_SEL
#define TS_SEL -1
#endif
#ifndef TS_BLK
#define TS_BLK 0
#endif
namespace pg8 {
#define PG8_LAS __attribute__((address_space(3)))
typedef unsigned short bf16_t;
typedef short bf16x8 __attribute__((ext_vector_type(8)));
typedef float f32x4 __attribute__((ext_vector_type(4)));
typedef unsigned u32x4 __attribute__((ext_vector_type(4)));
constexpr int BM = 256, BK = 64, HALF = 128, HTB = HALF * BK * 2  , STAGE_BYTES = 8 * HTB, NXCD = 8, WGM = 8;

__host__ __device__ __forceinline__ int lds_byte(int r, int c) { const int st = (r >> 4) * 2 + (c >> 5), rr = r & 15, cc = c & 31, ob = rr * 64 + cc * 2; return st * 1024 + (ob ^ (((ob >> 9) & 1) << 5)); }
__host__ __device__ __forceinline__ void stage_rc(int b, int& R, int& C) { const int st = b / 1024, sb = b % 1024, swz = sb ^ (((sb >> 9) & 1) << 5); R = (st >> 1) * 16 + swz / 64; C = (st & 1) * 32 + (swz % 64) / 2; }
__host__ __device__ __forceinline__ int perm32(int rho) { const int n = rho >> 4, i = rho & 15; return 8 * (i >> 2) + 4 * n + (i & 3); }

struct Unit { int pm, pn; };
struct Gemm { const bf16_t* A; const bf16_t* Bt; int M, N, K; };

struct StaticOrder {
    int nM, nN, nwg, G, c;
    __host__ __device__ void init(int M, int N, int G_, int c_) { nM = M / BM; nN = N / BM; nwg = nM * nN; G = G_; c = c_; }
    __host__ __device__ bool next(int i, Unit& u) const {
        const long L = (long)i * G + c; if (L >= nwg) return false;
        int wgid = (int)L; { const int q = nwg / NXCD, r = nwg % NXCD, xcd = wgid % NXCD, off = wgid / NXCD; wgid = (xcd < r ? xcd * (q + 1) : r * (q + 1) + (xcd - r) * q) + off; }
        const int nig = WGM * nN, gid = wgid / nig, fm = gid * WGM, gsz = (nM - fm) < WGM ? (nM - fm) : WGM;
        u.pm = fm + ((wgid % nig) % gsz); u.pn = (wgid % nig) / gsz; return true;
    }
    __device__ __forceinline__ void a_ready(const Unit&) const {}
    __device__ __forceinline__ void done(const Unit&) const {}
};

__device__ __forceinline__ unsigned cvt_pk_bf16(float lo, float hi) { unsigned r; asm volatile("v_cvt_pk_bf16_f32 %0, %1, %2" : "=v"(r) : "v"(lo), "v"(hi)); return r; }
typedef float f32x2 __attribute__((ext_vector_type(2)));
typedef unsigned u32x2 __attribute__((ext_vector_type(2)));
constexpr int NIN = 1792, DM = 1024, DFF = 4096, NU = 1280, SSQW = 16;
constexpr size_t XCT_LAT_OFF = (size_t)16 * 4 * 128 * 256;
__device__ __forceinline__ int cond_of_panel(int pm) { return pm < 16 ? 0 : (pm < 20 ? 1 : 2); }
__device__ __forceinline__ float row_rstd(const float* ssq, int row) {
    const f32x4* sp = (const f32x4*)(ssq + (size_t)row * SSQW);
    const f32x4 s = (sp[0] + sp[1]) + (sp[2] + sp[3]);
    return 1.0f / sqrtf(((s[0] + s[1]) + (s[2] + s[3])) * (1.0f / 1024.0f) + 1e-6f);
}
constexpr int RTAB_OFF = 131072;
struct EpiIn {
    static constexpr bool PERM = true, AFTER_DRAIN = false;
    bf16_t* U; bf16_t* XCT; const float* ssq; const float* bias;
    static constexpr bool NEEDS_RSTD = true;
    __device__ __forceinline__ void operator()(const f32x4 (&acc)[2][2][4][2], const Unit& u, int wr, int wc, int fr, int fq, const PG8_LAS float* rtab) const {
        const int cond = cond_of_panel(u.pm);
        const int bcol0 = u.pn * BM + wc * 32 + 8 * fq;
        f32x4 bv[2][2];
#pragma unroll
        for (int bj = 0; bj < 2; ++bj)
#pragma unroll
            for (int n = 0; n < 2; ++n) bv[bj][n] = *(const f32x4*)(bias + cond * NIN + bcol0 + bj * HALF + 4 * n);
        float sq[2][4];
#pragma unroll
        for (int ai = 0; ai < 2; ++ai)
#pragma unroll
            for (int m = 0; m < 4; ++m) sq[ai][m] = rtab[ai * HALF + wr * 64 + m * 16 + fr];
#pragma unroll
        for (int ai = 0; ai < 2; ++ai)
#pragma unroll
            for (int m = 0; m < 4; ++m) {
                const int row = u.pm * BM + ai * HALF + wr * 64 + m * 16 + fr;
                const float rs = sq[ai][m];
#pragma unroll
                for (int bj = 0; bj < 2; ++bj) {
                    const f32x4 v0 = acc[ai][bj][m][0] * rs + bv[bj][0], v1 = acc[ai][bj][m][1] * rs + bv[bj][1];
                    u32x4 w; w.x = cvt_pk_bf16(v0[0], v0[1]); w.y = cvt_pk_bf16(v0[2], v0[3]); w.z = cvt_pk_bf16(v1[0], v1[1]); w.w = cvt_pk_bf16(v1[2], v1[3]);
                    if (u.pn < 5) { *(u32x4*)(U + (size_t)row * NU + bcol0 + bj * HALF) = w; }
                    else {
                        const int cc = bcol0 + bj * HALF - NU, hd = cc >> 7, mm = cc & 127, m0 = mm & 63;
                        int L, t; bf16_t* base;
                        if (u.pm < 16) { L = 256; t = row & 255; base = XCT + (size_t)(u.pm * 4 + hd) * 128 * 256; }
                        else { const int rl = row - 4096; L = 1024; t = rl & 1023; base = XCT + XCT_LAT_OFF + (size_t)((rl >> 10) * 4 + hd) * 128 * 1024; }
                        const int k = (mm >> 6) * L + t;
                        bf16_t* p = base + ((size_t)(((m0 >> 4) * (L >> 4) + (k >> 5)) * 64 + ((k >> 3) & 3) * 16 + (m0 & 15))) * 8 + (k & 7);
                        p[0] = (bf16_t)(w.x & 0xffffu); p[8] = (bf16_t)(w.x >> 16); p[16] = (bf16_t)(w.y & 0xffffu); p[24] = (bf16_t)(w.y >> 16);
                        p[32] = (bf16_t)(w.z & 0xffffu); p[40] = (bf16_t)(w.z >> 16); p[48] = (bf16_t)(w.w & 0xffffu); p[56] = (bf16_t)(w.w >> 16);
                    }
                }
            }
    }
};
struct EpiUp {
    static constexpr bool PERM = true, AFTER_DRAIN = false;
    bf16_t* H; const float* ssq; const float* bias;
    static constexpr bool NEEDS_RSTD = true;
    __device__ __forceinline__ void operator()(const f32x4 (&acc)[2][2][4][2], const Unit& u, int wr, int wc, int fr, int fq, const PG8_LAS float* rtab) const {
        const int cond = cond_of_panel(u.pm);
        const int bcol0 = u.pn * BM + wc * 32 + 8 * fq;
        f32x4 bv[2][2];
#pragma unroll
        for (int bj = 0; bj < 2; ++bj)
#pragma unroll
            for (int n = 0; n < 2; ++n) bv[bj][n] = *(const f32x4*)(bias + cond * DFF + bcol0 + bj * HALF + 4 * n);
        float sq[2][4];
#pragma unroll
        for (int ai = 0; ai < 2; ++ai)
#pragma unroll
            for (int m = 0; m < 4; ++m) sq[ai][m] = rtab[ai * HALF + wr * 64 + m * 16 + fr];
#pragma unroll
        for (int ai = 0; ai < 2; ++ai)
#pragma unroll
            for (int m = 0; m < 4; ++m) {
                const int row = u.pm * BM + ai * HALF + wr * 64 + m * 16 + fr;
                const float rs = sq[ai][m];
#pragma unroll
                for (int bj = 0; bj < 2; ++bj) {
                    f32x4 v0 = acc[ai][bj][m][0] * rs + bv[bj][0], v1 = acc[ai][bj][m][1] * rs + bv[bj][1];
                    v0 = __builtin_elementwise_max(v0, (f32x4){0.f, 0.f, 0.f, 0.f}); v1 = __builtin_elementwise_max(v1, (f32x4){0.f, 0.f, 0.f, 0.f});
                    v0 = v0 * v0; v1 = v1 * v1;
                    u32x4 w; w.x = cvt_pk_bf16(v0[0], v0[1]); w.y = cvt_pk_bf16(v0[2], v0[3]); w.z = cvt_pk_bf16(v1[0], v1[1]); w.w = cvt_pk_bf16(v1[2], v1[3]);
                    *(u32x4*)(H + (size_t)row * DFF + bcol0 + bj * HALF) = w;
                }
            }
    }
};
struct EpiRes {
    static constexpr bool PERM = false, AFTER_DRAIN = false, NEEDS_RSTD = false;
    float* X; bf16_t* A; const float* gate; const float* Gn; float* ssq_out;
    __device__ __forceinline__ void operator()(const f32x4 (&acc)[2][2][4][2], const Unit& u, int wr, int wc, int fr, int fq, const PG8_LAS float*) const {
        const int cond = cond_of_panel(u.pm);
        const int col0 = u.pn * BM + wc * 32 + 4 * fq;
#pragma unroll
        for (int ai = 0; ai < 2; ++ai)
#pragma unroll
            for (int m = 0; m < 4; ++m) {
                const int row = u.pm * BM + ai * HALF + wr * 64 + m * 16 + fr;
                float q = 0.f;
#pragma unroll
                for (int bj = 0; bj < 2; ++bj)
#pragma unroll
                    for (int n = 0; n < 2; ++n) {
                        const int c = col0 + bj * HALF + n * 16;
                        float* xp = X + (size_t)row * DM + c;
                        const f32x4 g4 = *(const f32x4*)(gate + cond * 6144 + c);
                        const f32x4 x1 = *(const f32x4*)xp + g4 * acc[ai][bj][m][n];
                        *(f32x4*)xp = x1;
                        q += (x1[0] * x1[0] + x1[1] * x1[1]) + (x1[2] * x1[2] + x1[3] * x1[3]);
                        if (Gn) { const f32x4 a = x1 * *(const f32x4*)(Gn + cond * DM + c); u32x2 w; w.x = cvt_pk_bf16(a[0], a[1]); w.y = cvt_pk_bf16(a[2], a[3]);
                            *(u32x2*)(A + (size_t)row * DM + c) = w; }
                    }
                q += __shfl_xor(q, 16); q += __shfl_xor(q, 32);
                if (fq == 0) ssq_out[(size_t)row * SSQW + u.pn * 4 + wc] = q;
                if (m & 1) asm volatile("" ::: "memory");
            }
    }
};
template <class Epi, class Sched, bool ALIGN_EPI = false, bool SP2 = false>
__device__ __forceinline__ void gemm_phase(PG8_LAS unsigned char* lds, const Gemm g, const Sched& S, const Epi& E, int tid_in) {
    int tid_ = tid_in; asm volatile("" : "+v"(tid_)); const int tid = tid_, wid = __builtin_amdgcn_readfirstlane(tid >> 6), lane = tid & 63, wr = wid >> 2, wc = wid & 3, fr = lane & 15, fq = lane >> 4;
    const int K = g.K, nt = K / BK;
    unsigned voffA[2], voffB[2];
#pragma unroll
    for (int i = 0; i < 2; ++i) { int R, C; stage_rc(tid * 16 + i * 8192, R, C); const int Rb = Epi::PERM ? ((R & ~31) + perm32(R & 31)) : R;
        voffA[i] = (unsigned)(R * K + C) * 2u; voffB[i] = (unsigned)(Rb * K + C) * 2u; }
    const size_t kstep = (size_t)(BK * 2);
    const size_t hstep = (size_t)HALF * K * 2;
    const size_t tstep = 2 * hstep;
    const unsigned ldsw = (unsigned)wid * 1024u;
    const int aoff = lds_byte(wr * 64 + fr, fq * 8), boff = lds_byte(wc * 32 + fr, fq * 8);
#define PG8_SA(b, h) (((b) * 2 + (h)) * HTB)
#define PG8_SB(b, h) ((4 + (b) * 2 + (h)) * HTB)
#define PG8_STAGE(bufoff, gbase, voff) do { _Pragma("unroll") for (int _i = 0; _i < 2; ++_i) \
        __builtin_amdgcn_global_load_lds((const unsigned*)((const char*)(gbase) + (voff)[_i]), (PG8_LAS unsigned*)(lds + (bufoff) + ldsw + _i * 8192), 16, 0, 0); } while (0)
#define PG8_LDA(dst, b, h) do { _Pragma("unroll") for (int m = 0; m < 4; ++m) _Pragma("unroll") for (int k = 0; k < 2; ++k) dst[m][k] = *(const PG8_LAS bf16x8*)(lds + PG8_SA(b, h) + aoff + m * 2048 + k * 1024); } while (0)
#define PG8_LDB(dst, b, h) do { _Pragma("unroll") for (int n = 0; n < 2; ++n) _Pragma("unroll") for (int k = 0; k < 2; ++k) dst[n][k] = *(const PG8_LAS bf16x8*)(lds + PG8_SB(b, h) + boff + n * 2048 + k * 1024); } while (0)
#define PG8_MMA(ai, bj, At, Bt) do { __builtin_amdgcn_s_setprio(1); _Pragma("unroll") for (int m = 0; m < 4; ++m) _Pragma("unroll") for (int n = 0; n < 2; ++n) _Pragma("unroll") for (int k = 0; k < 2; ++k) \
        acc[ai][bj][m][n] = __builtin_amdgcn_mfma_f32_16x16x32_bf16(Bt[n][k], At[m][k], acc[ai][bj][m][n], 0, 0, 0); __builtin_amdgcn_s_setprio(0); } while (0)
#define PG8_WAIT_V(n) asm volatile("s_waitcnt vmcnt(" #n ")" ::: "memory")
#define PG8_WAIT_L(n) asm volatile("s_waitcnt lgkmcnt(" #n ")" ::: "memory")
#define PG8_BAR __builtin_amdgcn_s_barrier()
#define PG8_SCHED __builtin_amdgcn_sched_barrier(0)
    Unit cur, nxt; int ui = 0;
    if (!S.next(0, cur)) return;
    f32x4 acc[2][2][4][2];
#pragma unroll
    for (int a = 0; a < 2; ++a)
#pragma unroll
        for (int b = 0; b < 2; ++b)
#pragma unroll
            for (int m = 0; m < 4; ++m)
#pragma unroll
                for (int n = 0; n < 2; ++n) acc[a][b][m][n] = (f32x4){0.f, 0.f, 0.f, 0.f};
    bf16x8 At[4][2], B0[2][2], B1[2][2];
    const char* cA = (const char*)g.A + (size_t)cur.pm * tstep; const char* cB = (const char*)g.Bt + (size_t)cur.pn * tstep;
    if constexpr (Epi::NEEDS_RSTD) { if (tid < 256) ((PG8_LAS float*)(lds + RTAB_OFF))[tid] = row_rstd(E.ssq, cur.pm * BM + tid); }
    S.a_ready(cur);
    if constexpr (SP2) {
        PG8_STAGE(PG8_SB(0, 0), cB, voffB); PG8_STAGE(PG8_SB(0, 1), cB + hstep, voffB); PG8_STAGE(PG8_SA(0, 0), cA, voffA); PG8_STAGE(PG8_SA(0, 1), cA + hstep, voffA);
        if (wr == 1) PG8_BAR;
        PG8_WAIT_V(2); PG8_BAR;
        PG8_STAGE(PG8_SB(1, 0), cB + kstep, voffB); PG8_STAGE(PG8_SA(1, 0), cA + kstep, voffA); PG8_STAGE(PG8_SB(1, 1), cB + hstep + kstep, voffB);
        PG8_WAIT_V(6); PG8_BAR;
    } else {
        PG8_STAGE(PG8_SB(0, 0), cB, voffB); PG8_STAGE(PG8_SA(0, 0), cA, voffA); PG8_STAGE(PG8_SB(0, 1), cB + hstep, voffB); PG8_STAGE(PG8_SA(0, 1), cA + hstep, voffA);
        if (wr == 1) PG8_BAR;
        PG8_WAIT_V(4); PG8_BAR;
        PG8_STAGE(PG8_SB(1, 0), cB + kstep, voffB); PG8_STAGE(PG8_SA(1, 0), cA + kstep, voffA); PG8_STAGE(PG8_SB(1, 1), cB + hstep + kstep, voffB);
        PG8_WAIT_V(6); PG8_BAR;
    }
    for (;;) {
        const bool has_next = S.next(ui + 1, nxt);
        const char* nA = has_next ? (const char*)g.A + (size_t)nxt.pm * tstep : cA; const char* nB = has_next ? (const char*)g.Bt + (size_t)nxt.pn * tstep : cB;
        for (int t = 0; t < nt; t += 2) {
            const bool last = (t == nt - 2);
            const char* a1 = cA + (size_t)(t + 1) * kstep;
            const char* a2 = last ? nA : cA + (size_t)(t + 2) * kstep; const char* b2 = last ? nB : cB + (size_t)(t + 2) * kstep;
            const char* a3 = a2 + kstep; const char* b3 = b2 + kstep;
            if (last && has_next) S.a_ready(nxt);
            if constexpr (SP2) {
            PG8_LDB(B0, 0, 0); PG8_LDB(B1, 0, 1); PG8_SCHED; PG8_LDA(At, 0, 0); PG8_STAGE(PG8_SA(1, 1), a1 + hstep, voffA);
            PG8_WAIT_V(8); PG8_WAIT_L(0); PG8_BAR; PG8_MMA(0, 0, At, B0); PG8_MMA(0, 1, At, B1); PG8_BAR; PG8_SCHED;
            PG8_LDA(At, 0, 1); PG8_STAGE(PG8_SB(0, 0), b2, voffB); PG8_STAGE(PG8_SB(0, 1), b2 + hstep, voffB); PG8_STAGE(PG8_SA(0, 0), a2, voffA);
            PG8_WAIT_V(8); PG8_WAIT_L(0); PG8_BAR; PG8_MMA(1, 0, At, B0); PG8_MMA(1, 1, At, B1); PG8_BAR; PG8_SCHED;
            PG8_LDB(B0, 1, 0); PG8_LDB(B1, 1, 1); PG8_SCHED; PG8_LDA(At, 1, 0); PG8_STAGE(PG8_SA(0, 1), a2 + hstep, voffA);
            PG8_WAIT_V(8); PG8_WAIT_L(0); PG8_BAR; PG8_MMA(0, 0, At, B0); PG8_MMA(0, 1, At, B1); PG8_BAR; PG8_SCHED;
            PG8_LDA(At, 1, 1); PG8_STAGE(PG8_SB(1, 0), b3, voffB); PG8_STAGE(PG8_SB(1, 1), b3 + hstep, voffB); PG8_STAGE(PG8_SA(1, 0), a3, voffA);
            PG8_WAIT_V(8); PG8_WAIT_L(0); PG8_BAR; PG8_MMA(1, 0, At, B0); PG8_MMA(1, 1, At, B1); PG8_BAR; PG8_SCHED;
            } else {
            PG8_LDB(B0, 0, 0); PG8_SCHED; PG8_LDA(At, 0, 0); PG8_STAGE(PG8_SA(1, 1), a1 + hstep, voffA);
            PG8_WAIT_L(8); PG8_BAR; PG8_WAIT_L(0); PG8_MMA(0, 0, At, B0); PG8_BAR; PG8_SCHED;
            PG8_LDB(B1, 0, 1); PG8_STAGE(PG8_SB(0, 0), b2, voffB);
            PG8_BAR; PG8_WAIT_L(0); PG8_MMA(0, 1, At, B1); PG8_BAR;
            PG8_LDA(At, 0, 1); PG8_STAGE(PG8_SA(0, 0), a2, voffA);
            PG8_BAR; PG8_WAIT_L(0); PG8_MMA(1, 0, At, B0); PG8_BAR; PG8_SCHED;
            PG8_STAGE(PG8_SB(0, 1), b2 + hstep, voffB);
            PG8_WAIT_V(6); PG8_BAR; PG8_MMA(1, 1, At, B1); PG8_BAR;
            PG8_LDB(B0, 1, 0); PG8_SCHED; PG8_LDA(At, 1, 0); PG8_STAGE(PG8_SA(0, 1), a2 + hstep, voffA);
            PG8_WAIT_L(8); PG8_BAR; PG8_WAIT_L(0); PG8_MMA(0, 0, At, B0); PG8_BAR; PG8_SCHED;
            PG8_LDB(B1, 1, 1); PG8_STAGE(PG8_SB(1, 0), b3, voffB);
            PG8_BAR; PG8_WAIT_L(0); PG8_MMA(0, 1, At, B1); PG8_BAR;
            PG8_LDA(At, 1, 1); PG8_STAGE(PG8_SA(1, 0), a3, voffA);
            PG8_BAR; PG8_WAIT_L(0); PG8_MMA(1, 0, At, B0); PG8_BAR; PG8_SCHED;
            PG8_STAGE(PG8_SB(1, 1), b3 + hstep, voffB);
            PG8_WAIT_V(6); PG8_BAR; PG8_MMA(1, 1, At, B1); PG8_BAR;
            }
        }
        if constexpr (ALIGN_EPI) { if (wr == 0) PG8_BAR; }
        if constexpr (!Epi::AFTER_DRAIN) { E(acc, cur, wr, wc, fr, fq, (const PG8_LAS float*)(lds + RTAB_OFF + (ui & 1) * 1024)); S.done(cur); }
        if (!has_next) break;
#pragma unroll
        for (int a = 0; a < 2; ++a)
#pragma unroll
            for (int b = 0; b < 2; ++b)
#pragma unroll
                for (int m = 0; m < 4; ++m)
#pragma unroll
                    for (int n = 0; n < 2; ++n) acc[a][b][m][n] = (f32x4){0.f, 0.f, 0.f, 0.f};
        cur = nxt; cA = nA; cB = nB; ++ui;
        if constexpr (Epi::NEEDS_RSTD) { if (tid < 256) ((PG8_LAS float*)(lds + RTAB_OFF + (ui & 1) * 1024))[tid] = row_rstd(E.ssq, cur.pm * BM + tid); }
        if constexpr (ALIGN_EPI) { if (wr == 1) PG8_BAR; }
    }
    PG8_WAIT_V(0);
    if constexpr (!ALIGN_EPI) { if (wr == 0) PG8_BAR; }
    PG8_BAR;
    if constexpr (Epi::AFTER_DRAIN) { E.fused(acc, cur, wr, wc, fr, fq, lds, wid, lane); S.done(cur); }
#undef PG8_SA
#undef PG8_SB
#undef PG8_STAGE
#undef PG8_LDA
#undef PG8_LDB
#undef PG8_MMA
#undef PG8_WAIT_V
#undef PG8_WAIT_L
#undef PG8_BAR
#undef PG8_SCHED
}
struct StaticOrder128 {
    int nM, nN, nwg, G, c, pm0;
    __host__ __device__ void init(int M, int N, int G_, int c_, int pm0_ = 0) { nM = M / BM; nN = N / HALF; nwg = nM * nN; G = G_; c = c_; pm0 = pm0_; }
    __host__ __device__ bool next(int i, Unit& u) const {
        const long L = (long)i * G + c; if (L >= nwg) return false;
        int wgid = (int)L; { const int q = nwg / NXCD, r = nwg % NXCD, xcd = wgid % NXCD, off = wgid / NXCD; wgid = (xcd < r ? xcd * (q + 1) : r * (q + 1) + (xcd - r) * q) + off; }
        const int nig = WGM * nN, gid = wgid / nig, fm = gid * WGM, gsz = (nM - fm) < WGM ? (nM - fm) : WGM;
        u.pm = pm0 + fm + ((wgid % nig) % gsz); u.pn = (wgid % nig) / gsz; return true;
    }
    __device__ __forceinline__ void a_ready(const Unit&) const {}
    __device__ __forceinline__ void done(const Unit&) const {}
};
template <class Epi, class Sched>
__device__ __forceinline__ void gemm_phase_n128(PG8_LAS unsigned char* lds, const Gemm g, const Sched& S, const Epi& E, int tid_in) {
    int tid_ = tid_in; asm volatile("" : "+v"(tid_));
    const int tid = tid_, wid = __builtin_amdgcn_readfirstlane(tid >> 6), lane = tid & 63, wh = wid >> 2, wr = wid >> 1, wc = wid & 1, fr = lane & 15, fq = lane >> 4;
    const int K = g.K, nt = K / BK;
    unsigned voffA[2], voffB[2];
#pragma unroll
    for (int i = 0; i < 2; ++i) { int R, C; stage_rc(tid * 16 + i * 8192, R, C); const int Rb = Epi::PERM ? ((R & ~31) + perm32(R & 31)) : R;
        voffA[i] = (unsigned)(R * K + C) * 2u; voffB[i] = (unsigned)(Rb * K + C) * 2u; }
    const size_t kstep = (size_t)(BK * 2);
    const size_t hstep = (size_t)HALF * K * 2;
    const size_t tstep = 2 * hstep;
    const unsigned ldsw = (unsigned)wid * 1024u;
    const int aoff = lds_byte(wr * 32 + fr, fq * 8), boff = lds_byte(wc * 64 + fr, fq * 8);
#define PG8_SA(b, h) (((b) * 2 + (h)) * HTB)
#define PG8_SB(b) ((4 + (b) * 2) * HTB)
#define PG8_STAGE(bufoff, gbase, voff) do { _Pragma("unroll") for (int _i = 0; _i < 2; ++_i) \
        __builtin_amdgcn_global_load_lds((const unsigned*)((const char*)(gbase) + (voff)[_i]), (PG8_LAS unsigned*)(lds + (bufoff) + ldsw + _i * 8192), 16, 0, 0); } while (0)
#define PG8_LDA(dst, b, h) do { _Pragma("unroll") for (int m = 0; m < 2; ++m) _Pragma("unroll") for (int k = 0; k < 2; ++k) dst[m][k] = *(const PG8_LAS bf16x8*)(lds + PG8_SA(b, h) + aoff + m * 2048 + k * 1024); } while (0)
#define PG8_LDB(dst, b) do { _Pragma("unroll") for (int n = 0; n < 4; ++n) _Pragma("unroll") for (int k = 0; k < 2; ++k) dst[n][k] = *(const PG8_LAS bf16x8*)(lds + PG8_SB(b) + boff + n * 2048 + k * 1024); } while (0)
#define PG8_MMA(ai, At, Bt) do { __builtin_amdgcn_s_setprio(1); _Pragma("unroll") for (int m = 0; m < 2; ++m) _Pragma("unroll") for (int n = 0; n < 4; ++n) _Pragma("unroll") for (int k = 0; k < 2; ++k) \
        acc[ai][m][n] = __builtin_amdgcn_mfma_f32_16x16x32_bf16(Bt[n][k], At[m][k], acc[ai][m][n], 0, 0, 0); __builtin_amdgcn_s_setprio(0); } while (0)
#define PG8_WAIT_V(n) asm volatile("s_waitcnt vmcnt(" #n ")" ::: "memory")
#define PG8_WAIT_L(n) asm volatile("s_waitcnt lgkmcnt(" #n ")" ::: "memory")
#define PG8_BAR __builtin_amdgcn_s_barrier()
#define PG8_SCHED __builtin_amdgcn_sched_barrier(0)
    Unit cur, nxt; int ui = 0;
    if (!S.next(0, cur)) return;
    f32x4 acc[2][2][4];
#pragma unroll
    for (int a = 0; a < 2; ++a)
#pragma unroll
        for (int m = 0; m < 2; ++m)
#pragma unroll
            for (int n = 0; n < 4; ++n) acc[a][m][n] = (f32x4){0.f, 0.f, 0.f, 0.f};
    bf16x8 At[2][2], Bf[4][2];
    const char* cA = (const char*)g.A + (size_t)cur.pm * tstep; const char* cB = (const char*)g.Bt + (size_t)cur.pn * hstep;
    if constexpr (Epi::NEEDS_RSTD) { if (tid < 256) ((PG8_LAS float*)(lds + RTAB_OFF))[tid] = row_rstd(E.ssq, cur.pm * BM + tid); }
    S.a_ready(cur);
    PG8_STAGE(PG8_SB(0), cB, voffB); PG8_STAGE(PG8_SA(0, 0), cA, voffA); PG8_STAGE(PG8_SA(0, 1), cA + hstep, voffA);
    if (wh == 1) PG8_BAR;
    PG8_WAIT_V(2); PG8_BAR;
    PG8_STAGE(PG8_SB(1), cB + kstep, voffB); PG8_STAGE(PG8_SA(1, 0), cA + kstep, voffA);
    PG8_WAIT_V(4); PG8_BAR;
    for (;;) {
        const bool has_next = S.next(ui + 1, nxt);
        const char* nA = has_next ? (const char*)g.A + (size_t)nxt.pm * tstep : cA; const char* nB = has_next ? (const char*)g.Bt + (size_t)nxt.pn * hstep : cB;
        for (int t = 0; t < nt; t += 2) {
            const bool last = (t == nt - 2);
            const char* a1 = cA + (size_t)(t + 1) * kstep;
            const char* a2 = last ? nA : cA + (size_t)(t + 2) * kstep; const char* b2 = last ? nB : cB + (size_t)(t + 2) * kstep;
            const char* a3 = a2 + kstep; const char* b3 = b2 + kstep;
            if (last && has_next) S.a_ready(nxt);
            PG8_LDB(Bf, 0); PG8_SCHED; PG8_LDA(At, 0, 0); PG8_STAGE(PG8_SA(1, 1), a1 + hstep, voffA);
            PG8_WAIT_V(6); PG8_WAIT_L(0); PG8_BAR; PG8_MMA(0, At, Bf); PG8_BAR; PG8_SCHED;
            PG8_LDA(At, 0, 1); PG8_STAGE(PG8_SB(0), b2, voffB); PG8_STAGE(PG8_SA(0, 0), a2, voffA);
            PG8_WAIT_V(6); PG8_WAIT_L(0); PG8_BAR; PG8_MMA(1, At, Bf); PG8_BAR; PG8_SCHED;
            PG8_LDB(Bf, 1); PG8_SCHED; PG8_LDA(At, 1, 0); PG8_STAGE(PG8_SA(0, 1), a2 + hstep, voffA);
            PG8_WAIT_V(6); PG8_WAIT_L(0); PG8_BAR; PG8_MMA(0, At, Bf); PG8_BAR; PG8_SCHED;
            PG8_LDA(At, 1, 1); PG8_STAGE(PG8_SB(1), b3, voffB); PG8_STAGE(PG8_SA(1, 0), a3, voffA);
            PG8_WAIT_V(6); PG8_WAIT_L(0); PG8_BAR; PG8_MMA(1, At, Bf); PG8_BAR; PG8_SCHED;
        }
        if (wh == 0) PG8_BAR;
        E(acc, cur, wr, wc, fr, fq, (const PG8_LAS float*)(lds + RTAB_OFF + (ui & 1) * 1024)); S.done(cur);
        if (!has_next) break;
#pragma unroll
        for (int a = 0; a < 2; ++a)
#pragma unroll
            for (int m = 0; m < 2; ++m)
#pragma unroll
                for (int n = 0; n < 4; ++n) acc[a][m][n] = (f32x4){0.f, 0.f, 0.f, 0.f};
        cur = nxt; cA = nA; cB = nB; ++ui;
        if constexpr (Epi::NEEDS_RSTD) { if (tid < 256) ((PG8_LAS float*)(lds + RTAB_OFF + (ui & 1) * 1024))[tid] = row_rstd(E.ssq, cur.pm * BM + tid); }
        if (wh == 1) PG8_BAR;
    }
    PG8_WAIT_V(0);
    PG8_BAR;
#undef PG8_SA
#undef PG8_SB
#undef PG8_STAGE
#undef PG8_LDA
#undef PG8_LDB
#undef PG8_MMA
#undef PG8_WAIT_V
#undef PG8_WAIT_L
#undef PG8_BAR
#undef PG8_SCHED
}
struct EpiUp128 {
    static constexpr bool PERM = true, NEEDS_RSTD = true;
    bf16_t* H; const float* ssq; const float* bias;
    __device__ __forceinline__ void operator()(const f32x4 (&acc)[2][2][4], const Unit& u, int wr, int wc, int fr, int fq, const PG8_LAS float* rtab) const {
        const int cond = cond_of_panel(u.pm);
        const int bcol0 = u.pn * HALF + wc * 64 + 8 * fq;
        f32x4 bv[2][2];
#pragma unroll
        for (int g2 = 0; g2 < 2; ++g2)
#pragma unroll
            for (int n = 0; n < 2; ++n) bv[g2][n] = *(const f32x4*)(bias + cond * DFF + bcol0 + 32 * g2 + 4 * n);
        float sq[2][2];
#pragma unroll
        for (int ai = 0; ai < 2; ++ai)
#pragma unroll
            for (int m = 0; m < 2; ++m) sq[ai][m] = rtab[ai * HALF + wr * 32 + m * 16 + fr];
#pragma unroll
        for (int ai = 0; ai < 2; ++ai)
#pragma unroll
            for (int m = 0; m < 2; ++m) {
                const int row = u.pm * BM + ai * HALF + wr * 32 + m * 16 + fr;
                const float rs = sq[ai][m];
#pragma unroll
                for (int g2 = 0; g2 < 2; ++g2) {
                    f32x4 v0 = acc[ai][m][2 * g2] * rs + bv[g2][0], v1 = acc[ai][m][2 * g2 + 1] * rs + bv[g2][1];
                    v0 = __builtin_elementwise_max(v0, (f32x4){0.f, 0.f, 0.f, 0.f}); v1 = __builtin_elementwise_max(v1, (f32x4){0.f, 0.f, 0.f, 0.f});
                    v0 = v0 * v0; v1 = v1 * v1;
                    u32x4 w; w.x = cvt_pk_bf16(v0[0], v0[1]); w.y = cvt_pk_bf16(v0[2], v0[3]); w.z = cvt_pk_bf16(v1[0], v1[1]); w.w = cvt_pk_bf16(v1[2], v1[3]);
                    *(u32x4*)(H + (size_t)row * DFF + bcol0 + 32 * g2) = w;
                }
            }
    }
};
struct EpiRes128 {
    static constexpr bool PERM = false, NEEDS_RSTD = false;
    float* X; bf16_t* A; const float* gate; const float* Gn; float* ssq_out;
    __device__ __forceinline__ void operator()(const f32x4 (&acc)[2][2][4], const Unit& u, int wr, int wc, int fr, int fq, const PG8_LAS float*) const {
        const int cond = cond_of_panel(u.pm);
        const int col0 = u.pn * HALF + wc * 64 + 4 * fq;
#pragma unroll
        for (int ai = 0; ai < 2; ++ai)
#pragma unroll
            for (int m = 0; m < 2; ++m) {
                const int row = u.pm * BM + ai * HALF + wr * 32 + m * 16 + fr;
                float q = 0.f;
#pragma unroll
                for (int n = 0; n < 4; ++n) {
                    const int c = col0 + n * 16;
                    float* xp = X + (size_t)row * DM + c;
                    const f32x4 g4 = *(const f32x4*)(gate + cond * 6144 + c);
                    const f32x4 x1 = *(const f32x4*)xp + g4 * acc[ai][m][n];
                    *(f32x4*)xp = x1;
                    q += (x1[0] * x1[0] + x1[1] * x1[1]) + (x1[2] * x1[2] + x1[3] * x1[3]);
                    if (Gn) { const f32x4 a = x1 * *(const f32x4*)(Gn + cond * DM + c); u32x2 w; w.x = cvt_pk_bf16(a[0], a[1]); w.y = cvt_pk_bf16(a[2], a[3]);
                        *(u32x2*)(A + (size_t)row * DM + c) = w; }
                }
                q += __shfl_xor(q, 16); q += __shfl_xor(q, 32);
                if (fq == 0) ssq_out[(size_t)row * SSQW + u.pn * 2 + wc] = q;
                asm volatile("" ::: "memory");
            }
    }
};
struct StaticOrder192 {
    int nM, nN, nwg, G, c;
    __host__ __device__ void init(int M, int N, int G_, int c_) { nM = M / 192; nN = N / HALF; nwg = nM * nN; G = G_; c = c_; }
    __host__ __device__ bool next(int i, Unit& u) const {
        const long L = (long)i * G + c; if (L >= nwg) return false;
        int wgid = (int)L; { const int q = nwg / NXCD, r = nwg % NXCD, xcd = wgid % NXCD, off = wgid / NXCD; wgid = (xcd < r ? xcd * (q + 1) : r * (q + 1) + (xcd - r) * q) + off; }
        const int nig = WGM * nN, gid = wgid / nig, fm = gid * WGM, gsz = (nM - fm) < WGM ? (nM - fm) : WGM;
        u.pm = fm + ((wgid % nig) % gsz); u.pn = (wgid % nig) / gsz; return true;
    }
};
#ifndef M192_SLOTS
#define M192_SLOTS 4
#endif
#ifndef M192_TOUCH
#define M192_TOUCH 0
#endif
template <class Epi, class Sched>
__device__ __forceinline__ void gemm_phase_m192(PG8_LAS unsigned char* lds, const Gemm g, const Sched& S, const Epi& E, int tid_in, unsigned long long* TSX = nullptr) {
    int tid_ = tid_in; asm volatile("" : "+v"(tid_));
    const int tid = tid_, wid = __builtin_amdgcn_readfirstlane(tid >> 6), lane = tid & 63, wh = wid >> 2, wr = wid >> 1, wc = wid & 1, fr = lane & 15, fq = lane >> 4;
    const int K = g.K, nt = K / BK;
    constexpr unsigned SLOT = 40960u, PIECE = 8192u, BOFF = 3u * PIECE;
    constexpr int NS = M192_SLOTS, LA = NS - 1;
    unsigned voffA, voffB;
    { int R, C; stage_rc(tid * 16, R, C); const int Rb = Epi::PERM ? ((R & ~31) + perm32(R & 31)) : R; voffA = (unsigned)(R * K + C) * 2u; voffB = (unsigned)(Rb * K + C) * 2u; }
    const size_t kstep = (size_t)(BK * 2), pstep = (size_t)64 * K * 2;
    const unsigned ldsw = (unsigned)wid * 1024u;
    const int sub = lds_byte(fr, fq * 8);
    unsigned aofs[3];
#pragma unroll
    for (int m = 0; m < 3; ++m) { const int mt = 3 * wr + m; aofs[m] = (unsigned)((mt >> 2) * PIECE + ((mt & 3) * 2) * 1024 + sub); }
    const unsigned bofs = BOFF + (unsigned)wc * PIECE + (unsigned)sub;
    constexpr int TOUCH = M192_TOUCH; constexpr unsigned DUMMY = (unsigned)NS * SLOT;
    const int tpc = tid < 320 ? tid >> 6 : 4, trow = tid & 63;
    const size_t toff = (size_t)(tpc < 3 ? tpc : tpc - 3) * pstep + (size_t)trow * K * 2;
#define PG8_STAGE5(slot, ga, gb) do { \
        _Pragma("unroll") for (int _p = 0; _p < 3; ++_p) __builtin_amdgcn_global_load_lds((const unsigned*)((ga) + _p * pstep + voffA), (PG8_LAS unsigned*)(lds + (slot) + _p * PIECE + ldsw), 16, 0, 0); \
        _Pragma("unroll") for (int _q = 0; _q < 2; ++_q) __builtin_amdgcn_global_load_lds((const unsigned*)((gb) + _q * pstep + voffB), (PG8_LAS unsigned*)(lds + (slot) + BOFF + _q * PIECE + ldsw), 16, 0, 0); } while (0)
#define PG8_WAIT_V(n) asm volatile("s_waitcnt vmcnt(" #n ")" ::: "memory")
#define PG8_WAIT_L(n) asm volatile("s_waitcnt lgkmcnt(" #n ")" ::: "memory")
#define PG8_BAR __builtin_amdgcn_s_barrier()
#define PG8_SCHED __builtin_amdgcn_sched_barrier(0)
#if TS_SEL >= 0
#define M192_STAMP(i) do { if (blockIdx.x == TS_BLK && wid == 0 && TSX) __hip_atomic_store(TSX + (i), (unsigned long long)__builtin_amdgcn_s_memrealtime(), __ATOMIC_RELAXED, __HIP_MEMORY_SCOPE_AGENT); } while (0)
#else
#define M192_STAMP(i) do {} while (0)
#endif
    M192_STAMP(0);
    Unit cur, nxt; int ui = 0;
    if (!S.next(0, cur)) return;
    f32x4 acc[3][4];
#pragma unroll
    for (int m = 0; m < 3; ++m)
#pragma unroll
        for (int n = 0; n < 4; ++n) acc[m][n] = (f32x4){0.f, 0.f, 0.f, 0.f};
    bf16x8 At[3][2], Bf[4][2];
    f32x4 xpre[3][4];
    E.prefetch(xpre, cur, wr, wc, fr, fq);
    const char* cA = (const char*)g.A + (size_t)cur.pm * 3 * pstep; const char* cB = (const char*)g.Bt + (size_t)cur.pn * 2 * pstep;
#pragma unroll
    for (int i = 0; i < LA; ++i) PG8_STAGE5((unsigned)i * SLOT, cA + i * kstep, cB + i * kstep);
    if (LA == 2) PG8_WAIT_V(5); else PG8_WAIT_V(10);
    if (wh == 1) PG8_BAR;
    PG8_BAR;
    unsigned rs = 0u, ss = (unsigned)LA * SLOT;
    M192_STAMP(1);
    for (;;) {
        const bool has_next = S.next(ui + 1, nxt);
        const char* nA = has_next ? (const char*)g.A + (size_t)nxt.pm * 3 * pstep : cA; const char* nB = has_next ? (const char*)g.Bt + (size_t)nxt.pn * 2 * pstep : cB;
        for (int t = 0; t < nt; ++t) {
            const bool tail = t >= nt - LA;
            const char* a2 = tail ? nA + (size_t)(t + LA - nt) * kstep : cA + (size_t)(t + LA) * kstep;
            const char* b2 = tail ? nB + (size_t)(t + LA - nt) * kstep : cB + (size_t)(t + LA) * kstep;
#pragma unroll
            for (int n = 0; n < 4; ++n)
#pragma unroll
                for (int k = 0; k < 2; ++k) Bf[n][k] = *(const PG8_LAS bf16x8*)(lds + rs + bofs + n * 2048 + k * 1024);
            PG8_SCHED;
#pragma unroll
            for (int m = 0; m < 3; ++m)
#pragma unroll
                for (int k = 0; k < 2; ++k) At[m][k] = *(const PG8_LAS bf16x8*)(lds + rs + aofs[m] + k * 1024);
            PG8_STAGE5(ss, a2, b2);
            if (TOUCH > 0) { const int tt = t + TOUCH; const bool nx = tt >= nt;
                const char* ta = (tpc < 3 ? (nx ? nA : cA) : (nx ? nB : cB)) + toff + (size_t)(nx ? (tt - nt < nt ? tt - nt : 0) : tt) * kstep;
                __builtin_amdgcn_global_load_lds((const unsigned*)ta, (PG8_LAS unsigned*)(lds + DUMMY + (unsigned)wid * 256u), 4, 0, 0);
                PG8_WAIT_V(6); } else { if (LA == 2) PG8_WAIT_V(5); else PG8_WAIT_V(10); }
            PG8_WAIT_L(0); PG8_BAR;
            __builtin_amdgcn_s_setprio(1);
#pragma unroll
            for (int m = 0; m < 3; ++m)
#pragma unroll
                for (int n = 0; n < 4; ++n)
#pragma unroll
                    for (int k = 0; k < 2; ++k) acc[m][n] = __builtin_amdgcn_mfma_f32_16x16x32_bf16(Bf[n][k], At[m][k], acc[m][n], 0, 0, 0);
            __builtin_amdgcn_s_setprio(0);
            PG8_BAR; PG8_SCHED;
            rs = rs == (unsigned)LA * SLOT ? 0u : rs + SLOT; ss = ss == (unsigned)LA * SLOT ? 0u : ss + SLOT;
        }
        if (wh == 0) PG8_BAR;
        M192_STAMP(2);
        E(acc, xpre, cur, wr, wc, fr, fq);
        asm volatile("s_waitcnt vmcnt(0)" ::: "memory"); M192_STAMP(3);
        if (!has_next) break;
        E.prefetch(xpre, nxt, wr, wc, fr, fq);
#pragma unroll
        for (int m = 0; m < 3; ++m)
#pragma unroll
            for (int n = 0; n < 4; ++n) acc[m][n] = (f32x4){0.f, 0.f, 0.f, 0.f};
        cur = nxt; cA = nA; cB = nB; ++ui;
        if (wh == 1) PG8_BAR;
    }
    PG8_WAIT_V(0);
    PG8_BAR;
#undef PG8_STAGE5
#undef PG8_WAIT_V
#undef PG8_WAIT_L
#undef PG8_BAR
#undef PG8_SCHED
}
__device__ __forceinline__ int cond_of_row(int row) { return row < 4096 ? 0 : (row < 5120 ? 1 : 2); }
struct EpiRes192 {
    static constexpr bool PERM = false;
    float* X; bf16_t* A; const float* gate; const float* Gn; float* ssq_out;
    __device__ __forceinline__ void prefetch(f32x4 (&xpre)[3][4], const Unit& u, int wr, int wc, int fr, int fq) const {
        const int col0 = u.pn * HALF + wc * 64 + 4 * fq;
#pragma unroll
        for (int m = 0; m < 3; ++m)
#pragma unroll
            for (int n = 0; n < 4; ++n) xpre[m][n] = *(const f32x4*)(X + (size_t)(u.pm * 192 + wr * 48 + m * 16 + fr) * DM + col0 + n * 16);
    }
    __device__ __forceinline__ void operator()(const f32x4 (&acc)[3][4], const f32x4 (&xpre)[3][4], const Unit& u, int wr, int wc, int fr, int fq) const {
        const int col0 = u.pn * HALF + wc * 64 + 4 * fq;
#pragma unroll
        for (int m = 0; m < 3; ++m) {
            const int row = u.pm * 192 + wr * 48 + m * 16 + fr;
            const int cond = cond_of_row(u.pm * 192 + wr * 48 + m * 16);
            float q = 0.f;
#pragma unroll
            for (int n = 0; n < 4; ++n) {
                const int c = col0 + n * 16;
                const f32x4 g4 = *(const f32x4*)(gate + cond * 6144 + c);
                const f32x4 x1 = xpre[m][n] + g4 * acc[m][n];
                *(f32x4*)(X + (size_t)row * DM + c) = x1;
                q += (x1[0] * x1[0] + x1[1] * x1[1]) + (x1[2] * x1[2] + x1[3] * x1[3]);
                if (Gn) { const f32x4 a = x1 * *(const f32x4*)(Gn + cond * DM + c); u32x2 w; w.x = cvt_pk_bf16(a[0], a[1]); w.y = cvt_pk_bf16(a[2], a[3]);
                    *(u32x2*)(A + (size_t)row * DM + c) = w; }
            }
            q += __shfl_xor(q, 16); q += __shfl_xor(q, 32);
            if (fq == 0) ssq_out[(size_t)row * SSQW + u.pn * 2 + wc] = q;
        }
    }
};
}
#define GAS __attribute__((address_space(1)))
#define LAS __attribute__((address_space(3)))
typedef unsigned short bf16;
typedef unsigned v4u __attribute__((ext_vector_type(4)));
typedef unsigned v2u __attribute__((ext_vector_type(2)));
typedef float f32x4 __attribute__((ext_vector_type(4)));
typedef float f32x2 __attribute__((ext_vector_type(2)));
typedef short bf16x8 __attribute__((ext_vector_type(8)));
constexpr int NWAVES = 8, NTHREADS = 512;
constexpr int M_TOK = 6144, M_CTX = 4096, DMODEL = 1024, NINP = 1792, NUC = 1280, FFD = 4096, DEPTHL = 4, DRNN = 512;
constexpr int LDS_BYTES = 163840;
constexpr size_t al256(size_t x) { return (x + 255) & ~(size_t)255; }
constexpr size_t WS_CTL = 0, CTL_BYTES = 1u << 20;
constexpr size_t WS_MODS = WS_CTL + CTL_BYTES;
constexpr size_t WS_GV = WS_MODS + al256((size_t)4 * 3 * 6144 * 4);
constexpr size_t WS_BIASIN = WS_GV + al256((size_t)4 * 2 * 3 * 1024 * 4);
constexpr size_t WS_BIAS1 = WS_BIASIN + al256((size_t)4 * 3 * NINP * 4);
constexpr size_t WS_SSQ = WS_BIAS1 + al256((size_t)4 * 3 * FFD * 4);
constexpr size_t WS_WIN = WS_SSQ + al256((size_t)9 * M_TOK * 16 * 4);
constexpr size_t WS_WOUT = WS_WIN + al256((size_t)4 * NINP * 1024 * 2);
constexpr size_t WS_W1 = WS_WOUT + al256((size_t)4 * 1024 * 1024 * 2);
constexpr size_t WS_W2 = WS_W1 + al256((size_t)4 * FFD * 1024 * 2);
constexpr size_t WS_WG = WS_W2 + al256((size_t)4 * FFD * 1024 * 2);
constexpr size_t WS_GB = WS_WG + al256((size_t)4 * 8 * 4 * 4 * 2 * 32 * 64 * 2);
constexpr size_t WS_T256 = WS_GB + al256((size_t)4 * 2 * 2 * 512 * 4);
constexpr size_t WS_T1024 = WS_T256 + al256((size_t)256 * 512 * 2);
constexpr size_t WS_X = WS_T1024 + al256((size_t)1024 * 2048 * 2);
constexpr size_t WS_A = WS_X + al256((size_t)M_TOK * 1024 * 4);
constexpr size_t WS_U = WS_A + al256((size_t)M_TOK * 1024 * 2);
constexpr size_t WS_XCT = WS_U + al256((size_t)M_TOK * NUC * 2);
constexpr size_t WS_CAT = WS_XCT + al256((size_t)M_TOK * 512 * 2);
constexpr size_t WS_HF = WS_CAT + al256((size_t)M_TOK * 1024 * 2);
constexpr size_t WS_PB = WS_HF + al256((size_t)M_TOK * 512 * 4);
constexpr size_t WS_HID = WS_PB + al256((size_t)M_TOK * 512 * 4);
constexpr size_t WS_END = WS_HID + al256((size_t)M_TOK * FFD * 2);
static_assert(WS_END <= ((size_t)256 << 20), "workspace map exceeds 256 MiB");

__device__ __forceinline__ unsigned f2bf(float f) { unsigned u = __builtin_bit_cast(unsigned, f); return (u + 0x7fffu + ((u >> 16) & 1u)) >> 16; }
__device__ __forceinline__ unsigned pk2(float lo, float hi) { return f2bf(lo) | (f2bf(hi) << 16); }
__device__ __forceinline__ float bf2f(unsigned short b) { return __builtin_bit_cast(float, (unsigned)b << 16); }
__device__ __forceinline__ float bflo(unsigned w) { return __builtin_bit_cast(float, w << 16); }
__device__ __forceinline__ float bfhi(unsigned w) { return __builtin_bit_cast(float, w & 0xffff0000u); }
__device__ __forceinline__ float wave_sum(float v) {
#pragma unroll
    for (int o = 1; o < 64; o <<= 1) v += __shfl_xor(v, o);
    return v;
}
__device__ __forceinline__ float rdlane(float v, int l) { return __builtin_bit_cast(float, __builtin_amdgcn_readlane(__builtin_bit_cast(int, v), l)); }

__device__ __forceinline__ int launder_v(int x) { asm volatile("" : "+v"(x)); return x; }
__device__ __forceinline__ int launder_s(int x) { asm volatile("" : "+s"(x)); return x; }
#define CAS __attribute__((address_space(4)))
typedef const float* cfp_t;
struct Params { const float* in[24]; float* out; unsigned char* ws; int ph_lo, ph_hi; };
struct Frame {
    LAS unsigned char* lds;
    int tid, lane, wave, G, bid;
    __device__ __forceinline__ void relaunder() { wave = launder_s(wave); asm volatile("v_mbcnt_lo_u32_b32 %0, -1, 0\n\tv_mbcnt_hi_u32_b32 %0, -1, %0" : "=v"(lane)); tid = wave * 64 + lane;
        bid = launder_s(bid); G = launder_s(G);
        size_t z = 0; asm volatile("" : "+s"(z), "+s"(in)); ws = ws0 + z; out = out0 + z; }
    __device__ __forceinline__ const float* inp(int i) const { return (const float*)(const GAS float*)in[i]; }
    const CAS cfp_t* in; float* out; unsigned char* ws; float* out0; unsigned char* ws0; unsigned long long* tsx;
};
enum { I_XP = 0, I_XS, I_STATE, I_C, I_CCTX, I_N1G, I_N2G, I_FG, I_WMOD, I_BMOD, I_WIN, I_CONVW, I_CONVB, I_WR, I_BR, I_WI, I_BI, I_LAM, I_POOLW, I_POOLS, I_FW, I_WOUT, I_W1, I_W2 };
#define XB_TMO      128
#define XB_XCNT(j)  (256  + 64 * (j))
#define XB_XSUB(j)  (1280 + 64 * (j))
#define XB_XGEN(j)  (2304 + 64 * (j))
#define XB_TOP      3328
#define XB_TOPGEN   3392
#define XCD_BAR_WORDS 3456
#define XB_SPIN_CAP (1u << 18)

__device__ __forceinline__ unsigned xb_ld(unsigned* p)              { return __hip_atomic_load(p, __ATOMIC_RELAXED, __HIP_MEMORY_SCOPE_AGENT); }
__device__ __forceinline__ unsigned xb_add(unsigned* p, unsigned v) { return __hip_atomic_fetch_add(p, v, __ATOMIC_RELAXED, __HIP_MEMORY_SCOPE_AGENT); }
__device__ __forceinline__ unsigned xb_xcc_id() { return (unsigned)__builtin_amdgcn_s_getreg((3 << 11) | 20) & 0xFu; }
#define XB_SPIN(cond, bar) do { unsigned _sp = 0; while (cond) { __builtin_amdgcn_s_sleep(1); \
    if ((++_sp & 255u) == 0u) { if (xb_ld(&(bar)[XB_TMO])) break; if (_sp > XB_SPIN_CAP) { atomicAdd(&(bar)[XB_TMO], 1u); break; } } } } while (0)

struct XcdBarrier {
    unsigned* bar; unsigned x;
    volatile unsigned* st;
};

__device__ __forceinline__ XcdBarrier xcd_barrier_post(unsigned* bar, volatile unsigned* st) {
    XcdBarrier b; b.bar = bar; b.x = xb_xcc_id(); b.st = st;
    if (threadIdx.x == 0) (void)xb_add(&bar[XB_XCNT(b.x)], 1u);
    return b;
}
__device__ __forceinline__ void xcd_barrier_complete(unsigned* bar, unsigned x, unsigned& nloc, unsigned& nx) {
    const unsigned G = gridDim.x * gridDim.y * gridDim.z;
    unsigned sum, cnt, mine, sp = 0u;
    for (;;) {
        sum = 0u; cnt = 0u; mine = 0u;
#pragma unroll
        for (unsigned j = 0; j < 16; ++j) { const unsigned c = xb_ld(&bar[XB_XCNT(j)]); sum += c; cnt += (c > 0u) ? 1u : 0u; mine = (j == x) ? c : mine; }
        if (sum == G) break;
        __builtin_amdgcn_s_sleep(1);
        if ((++sp & 255u) == 0u) { if (xb_ld(&bar[XB_TMO])) break; if (sp > XB_SPIN_CAP) { atomicAdd(&bar[XB_TMO], 1u); break; } }
    }
    nloc = mine > 0u ? mine : 1u; nx = cnt > 0u ? cnt : 1u;
}

__device__ __forceinline__ void xcd_barrier(const XcdBarrier& b) {
    asm volatile("s_waitcnt vmcnt(0)" ::: "memory");
    __syncthreads();
    if (threadIdx.x == 0) {
        unsigned* bar = b.bar;
        __builtin_amdgcn_s_waitcnt(0);
        unsigned nloc = b.st[0], nx = b.st[1];
        if (nloc == 0u) { xcd_barrier_complete(bar, b.x, nloc, nx); b.st[0] = nloc; b.st[1] = nx; }
        const unsigned old = xb_add(&bar[XB_XSUB(b.x)], 1u);
        const unsigned gen = old / nloc;
        if (old + 1u == (gen + 1u) * nloc) {
            __builtin_amdgcn_fence(__ATOMIC_RELEASE, "agent");
            asm volatile("s_waitcnt vmcnt(0)" ::: "memory");
            const unsigned og = xb_add(&bar[XB_TOP], 1u);
            const unsigned tg = og / nx;
            if (og + 1u == (tg + 1u) * nx) xb_add(&bar[XB_TOPGEN], 1u);
            else XB_SPIN(xb_ld(&bar[XB_TOPGEN]) == tg, bar);
            __builtin_amdgcn_fence(__ATOMIC_ACQUIRE, "agent");
            xb_add(&bar[XB_XGEN(b.x)], 1u);
            asm volatile("s_waitcnt vmcnt(0)" ::: "memory");
        } else {
            XB_SPIN(xb_ld(&bar[XB_XGEN(b.x)]) == gen, bar);
            __builtin_amdgcn_fence(__ATOMIC_ACQUIRE, "agent");
            asm volatile("s_waitcnt vmcnt(0)" ::: "memory");
        }
    }
    __syncthreads();
}
__device__ __forceinline__ void p0a_mods(const Frame& F) {
    LAS float* sl = (LAS float*)F.lds;
    LAS float* red = sl + 3 * 1024;
    const float* c_ctx = F.inp(I_CCTX); const float* cv = F.inp(I_C);
    for (int i = F.tid; i < 3 * 1024; i += NTHREADS) { const int cd = i >> 10, k = i & 1023; const float c = cd == 0 ? c_ctx[k] : cv[(cd - 1) * 1024 + k]; sl[i] = c / (1.0f + expf(-c)); }
    __syncthreads();
    float* mods = (float*)(F.ws + WS_MODS);
    for (int it = F.bid; it < 256; it += F.G) {
        const int l = it >> 6, ch = it & 63;
        const float* W = F.inp(I_WMOD) + (size_t)l * 1024 * 6144 + ch * 96;
        if (F.tid < 504) {
            const int c4 = F.tid % 24, kr = F.tid / 24;
            f32x4 a0 = {0.f, 0.f, 0.f, 0.f}, a1 = a0, a2 = a0;
#pragma unroll 16
            for (int k = kr; k < 1024; k += 21) { const f32x4 w = *(const f32x4*)(W + (size_t)k * 6144 + c4 * 4); a0 += w * sl[k]; a1 += w * sl[1024 + k]; a2 += w * sl[2048 + k]; }
            *(LAS f32x4*)(red + (kr * 3 + 0) * 96 + c4 * 4) = a0; *(LAS f32x4*)(red + (kr * 3 + 1) * 96 + c4 * 4) = a1; *(LAS f32x4*)(red + (kr * 3 + 2) * 96 + c4 * 4) = a2;
        }
        __syncthreads();
        if (F.tid < 288) { const int cd = F.tid / 96, col = F.tid % 96; float s = 0.f;
#pragma unroll
            for (int kr = 0; kr < 21; ++kr) s += red[(kr * 3 + cd) * 96 + col];
            mods[(size_t)(l * 3 + cd) * 6144 + ch * 96 + col] = s + F.inp(I_BMOD)[l * 6144 + ch * 96 + col]; }
        __syncthreads();
    }
}

template <bool BIAS>
__device__ __forceinline__ void strip_item(const float* W, int N, int kb, int ke, int n0, bf16* WT, int ldt, int trow0, const float* sh, float* bias_out, int bstride, LAS float* scr, int lane) {
    float b0 = 0.f, b1 = 0.f, b2 = 0.f;
    const int nn = lane & 31, half = lane >> 5;
    float tv[32];
#pragma unroll
    for (int i = 0; i < 32; ++i) tv[i] = W[(size_t)(kb + 2 * i + half) * N + n0 + nn];
    for (int k0 = kb; k0 < ke; k0 += 64) {
#pragma unroll
        for (int i = 0; i < 32; ++i) scr[(2 * i + half) * 33 + nn] = tv[i];
        if (k0 + 64 < ke) {
#pragma unroll
            for (int i = 0; i < 32; ++i) tv[i] = W[(size_t)(k0 + 64 + 2 * i + half) * N + n0 + nn];
        }
        asm volatile("s_waitcnt lgkmcnt(0)" ::: "memory");
        const int c = lane & 7;
#pragma unroll
        for (int j = 0; j < 4; ++j) { const int n = (lane >> 3) + 8 * j; const LAS float* s = scr + (8 * c) * 33 + n;
            v4u o; o.x = pk2(s[0 * 33], s[1 * 33]); o.y = pk2(s[2 * 33], s[3 * 33]); o.z = pk2(s[4 * 33], s[5 * 33]); o.w = pk2(s[6 * 33], s[7 * 33]);
            *(v4u*)(WT + (size_t)(trow0 + n) * ldt + k0 + 8 * c) = o; }
        if (BIAS) {
            const float s0 = sh[k0 + lane], s1 = sh[6144 + k0 + lane], s2 = sh[2 * 6144 + k0 + lane];
#pragma unroll 8
            for (int kk = 0; kk < 32; ++kk) { const float w = scr[(half * 32 + kk) * 33 + nn]; const int src = half * 32 + kk;
                b0 += w * __shfl(s0, src); b1 += w * __shfl(s1, src); b2 += w * __shfl(s2, src); }
        }
        asm volatile("s_waitcnt lgkmcnt(0)" ::: "memory");
    }
    if (BIAS) {
        b0 += __shfl_xor(b0, 32); b1 += __shfl_xor(b1, 32); b2 += __shfl_xor(b2, 32);
        if (lane < 32) { bias_out[n0 + lane] = b0; bias_out[bstride + n0 + lane] = b1; bias_out[2 * bstride + n0 + lane] = b2; }
    }
}
__device__ __forceinline__ float dft64(float tabreg, int c, int mm) { const int m = mm & 63; const int idx = (mm < 64) ? ((c * m) & 63) : ((c * m - 16) & 63); return __shfl(tabreg, idx); }

__device__ __forceinline__ void p0b_items(Frame F, int llo, int lhi, int gw, int NGW, bool with_rows) {
    const int nl = lhi - llo;
    const float tabreg = cospif((float)F.lane * (1.0f / 32.0f)) * 0.125f;
    const int N_FOUT = 256 * nl, N_FIN = 256 * nl, N_POOLF = 64 * nl, N_FBIAS = 4 * nl, N_W1 = 128 * nl, N_W2 = 128 * nl, N_WIN = 40 * nl, N_WOUTA = 32 * nl, N_ROWS = with_rows ? M_TOK : 0;
    const int NITEMS = N_FOUT + N_FIN + N_POOLF + N_FBIAS + N_W1 + N_W2 + N_WIN + N_WOUTA + N_ROWS;
    const int nA = N_FBIAS + N_FOUT, nW = N_W1 + N_W2 + N_WIN + N_WOUTA, NQ = nA + nW + N_POOLF + N_FIN + N_ROWS / 8;
    unsigned* head = (unsigned*)(F.ws + WS_CTL) + 2048 + 64 * (gw & 7);
    for (int sit = gw;; sit += NGW) {
        int it0, nrep = 1;
        if (with_rows) {
            unsigned idx = 0; if (F.lane == 0) idx = __hip_atomic_fetch_add(head, 1u, __ATOMIC_RELAXED, __HIP_MEMORY_SCOPE_AGENT);
            const int j = (int)__builtin_amdgcn_readfirstlane(idx) * 8 + (gw & 7);
            if (j >= NQ) break;
            if (j < nA) it0 = j;
            else if (j < nA + nW) it0 = nA + N_FIN + N_POOLF + (j - nA);
            else if (j < nA + nW + N_POOLF) it0 = nA + N_FIN + (j - nA - nW);
            else if (j < nA + nW + N_POOLF + N_FIN) it0 = nA + (j - nA - nW - N_POOLF);
            else { it0 = nA + N_FIN + N_POOLF + nW + 8 * (j - nA - nW - N_POOLF - N_FIN); nrep = 8; }
        } else { if (sit >= NITEMS) break; it0 = sit; }
      for (int rep = 0; rep < nrep; ++rep) {
        const int it = it0 + rep;
        int r = it; F.relaunder(); const int lane = F.lane;
        LAS float* scr = (LAS float*)(F.lds + F.wave * 16384);
        const float* mods = (const float*)(F.ws + WS_MODS);
        bf16* WINT = (bf16*)(F.ws + WS_WIN); bf16* WOUTT = (bf16*)(F.ws + WS_WOUT); bf16* W1T = (bf16*)(F.ws + WS_W1); bf16* W2T = (bf16*)(F.ws + WS_W2);
        float* BIASIN = (float*)(F.ws + WS_BIASIN); float* BIAS1 = (float*)(F.ws + WS_BIAS1);

        if (r < N_FBIAS) {
            const int l = llo + (r >> 2), hd = r & 3, rg = lane >> 4, c4 = lane & 15;
            const float* wp = F.inp(I_WIN) + (size_t)l * 1024 * 1536 + (size_t)rg * 1536 + 1280 + 64 * hd + 4 * c4;
            const float* sh = mods + (size_t)l * 3 * 6144 + rg;
            f32x4 b0 = {0.f, 0.f, 0.f, 0.f}, b1 = b0, b2 = b0;
            for (int i0 = 0; i0 < 256; i0 += 16) { f32x4 wv[16];
#pragma unroll
                for (int i = 0; i < 16; ++i) wv[i] = *(const f32x4*)(wp + (size_t)(4 * (i0 + i)) * 1536);
#pragma unroll
                for (int i = 0; i < 16; ++i) { const int k = 4 * (i0 + i); b0 += wv[i] * sh[k]; b1 += wv[i] * sh[6144 + k]; b2 += wv[i] * sh[2 * 6144 + k]; } }
#pragma unroll
            for (int e = 0; e < 4; ++e) { b0[e] += __shfl_xor(b0[e], 16); b0[e] += __shfl_xor(b0[e], 32); b1[e] += __shfl_xor(b1[e], 16); b1[e] += __shfl_xor(b1[e], 32); b2[e] += __shfl_xor(b2[e], 16); b2[e] += __shfl_xor(b2[e], 32); }
            if (lane < 16) { *(LAS f32x4*)(scr + 4 * lane) = b0; *(LAS f32x4*)(scr + 64 + 4 * lane) = b1; *(LAS f32x4*)(scr + 128 + 4 * lane) = b2; }
            asm volatile("s_waitcnt lgkmcnt(0)" ::: "memory");
            for (int hf = 0; hf < 2; ++hf) {
                const int mm = hf * 64 + lane; float s0 = 0.f, s1 = 0.f, s2 = 0.f;
#pragma unroll 8
                for (int c = 0; c < 64; ++c) { const int idx = hf == 0 ? ((c * lane) & 63) : ((c * lane - 16) & 63); const float dv = __shfl(tabreg, idx);
                    s0 += scr[c] * dv; s1 += scr[64 + c] * dv; s2 += scr[128 + c] * dv; }
                float* bo = BIASIN + (size_t)l * 3 * NINP + 1280 + 128 * hd + mm;
                bo[0] = s0; bo[NINP] = s1; bo[2 * NINP] = s2;
            }
            asm volatile("s_waitcnt lgkmcnt(0)" ::: "memory");
            continue;
        }
        r -= N_FBIAS;
        if (r < N_FOUT) {
            const int l = llo + (r >> 8), it16 = (r >> 4) & 15, nb = r & 15, lr = lane & 15, lq = lane >> 4;
            const float* fw = F.inp(I_FW) + (size_t)l * 65536 + (size_t)(it16 * 16 + lr) * 256 + lq;
            const float* wo = F.inp(I_WOUT) + (size_t)l * 1048576 + (size_t)(768 + lq) * 1024 + nb * 64 + lr;
            f32x4 acc[4];
#pragma unroll
            for (int nt = 0; nt < 4; ++nt) acc[nt] = (f32x4){0.f, 0.f, 0.f, 0.f};
#pragma unroll 4
            for (int ks = 0; ks < 64; ++ks) { const float av = fw[4 * ks];
#pragma unroll
                for (int nt = 0; nt < 4; ++nt) acc[nt] = __builtin_amdgcn_mfma_f32_16x16x4f32(av, wo[(size_t)(4 * ks) * 1024 + 16 * nt], acc[nt], 0, 0, 0); }
#pragma unroll
            for (int nt = 0; nt < 4; ++nt) { v2u o; o.x = pk2(acc[nt][0], acc[nt][1]); o.y = pk2(acc[nt][2], acc[nt][3]);
                *(v2u*)(WOUTT + (size_t)l * 1048576 + (size_t)(nb * 64 + 16 * nt + lr) * 1024 + 768 + it16 * 16 + 4 * lq) = o; }
            continue;
        }
        r -= N_FOUT;
        if (r < N_FIN) {
            const int l = llo + (r >> 8), hd = (r >> 6) & 3, kt = r & 63, lr = lane & 15, lq = lane >> 4;
            const float* wp = F.inp(I_WIN) + (size_t)l * 1024 * 1536 + (size_t)(kt * 16 + lr) * 1536 + 1280 + 64 * hd + lq;
            f32x4 acc[8];
#pragma unroll
            for (int nt = 0; nt < 8; ++nt) acc[nt] = (f32x4){0.f, 0.f, 0.f, 0.f};
#pragma unroll 2
            for (int ks = 0; ks < 16; ++ks) { const float av = wp[4 * ks]; const int c = 4 * ks + lq;
#pragma unroll
                for (int nt = 0; nt < 8; ++nt) acc[nt] = __builtin_amdgcn_mfma_f32_16x16x4f32(av, dft64(tabreg, c, 16 * nt + lr), acc[nt], 0, 0, 0); }
#pragma unroll
            for (int nt = 0; nt < 8; ++nt) { v2u o; o.x = pk2(acc[nt][0], acc[nt][1]); o.y = pk2(acc[nt][2], acc[nt][3]);
                *(v2u*)(WINT + (size_t)l * NINP * 1024 + (size_t)(1280 + 128 * hd + 16 * nt + lr) * 1024 + kt * 16 + 4 * lq) = o; }
            continue;
        }
        r -= N_FIN;
        if (r < N_POOLF) {
            const int l = llo + (r >> 6), g = (r >> 4) & 3, nb = r & 15, lr = lane & 15, lq = lane >> 4;
            const float* pw = F.inp(I_POOLW) + (size_t)(l * 4 + g) * 4096 + lr * 64 + lq;
            const float* ps = F.inp(I_POOLS) + l * 256 + 64 * g + lq;
            const float* wo = F.inp(I_WOUT) + (size_t)l * 1048576 + (size_t)(512 + 64 * g + lq) * 1024 + nb * 64 + lr;
            f32x4 acc[4][4];
#pragma unroll
            for (int mt = 0; mt < 4; ++mt)
#pragma unroll
                for (int nt = 0; nt < 4; ++nt) acc[mt][nt] = (f32x4){0.f, 0.f, 0.f, 0.f};
#pragma unroll 2
            for (int ks = 0; ks < 16; ++ks) { const float sc = ps[4 * ks]; float av[4], bv[4];
#pragma unroll
                for (int mt = 0; mt < 4; ++mt) av[mt] = pw[mt * 1024 + 4 * ks] * sc;
#pragma unroll
                for (int nt = 0; nt < 4; ++nt) bv[nt] = wo[(size_t)(4 * ks) * 1024 + 16 * nt];
#pragma unroll
                for (int mt = 0; mt < 4; ++mt)
#pragma unroll
                    for (int nt = 0; nt < 4; ++nt) acc[mt][nt] = __builtin_amdgcn_mfma_f32_16x16x4f32(av[mt], bv[nt], acc[mt][nt], 0, 0, 0); }
#pragma unroll
            for (int mt = 0; mt < 4; ++mt)
#pragma unroll
                for (int nt = 0; nt < 4; ++nt) { v2u o; o.x = pk2(acc[mt][nt][0], acc[mt][nt][1]); o.y = pk2(acc[mt][nt][2], acc[mt][nt][3]);
                    *(v2u*)(WOUTT + (size_t)l * 1048576 + (size_t)(nb * 64 + 16 * nt + lr) * 1024 + 512 + 64 * g + 16 * mt + 4 * lq) = o; }
            continue;
        }
        r -= N_POOLF;
        if (r < N_W1) {
            const int l = llo + (r >> 7), nb = r & 127;
            strip_item<true>(F.inp(I_W1) + (size_t)l * 1024 * 4096, 4096, 0, 1024, nb * 32, W1T + (size_t)l * 4096 * 1024, 1024, nb * 32,
                             mods + (size_t)l * 3 * 6144 + 3 * 1024, BIAS1 + (size_t)l * 3 * FFD, FFD, scr, lane);
            continue;
        }
        r -= N_W1;
        if (r < N_W2) {
            const int l = llo + (r >> 7), nb = (r >> 2) & 31, kq = r & 3;
            strip_item<false>(F.inp(I_W2) + (size_t)l * 4096 * 1024, 1024, kq * 1024, kq * 1024 + 1024, nb * 32, W2T + (size_t)l * 1024 * 4096, 4096, nb * 32, nullptr, nullptr, 0, scr, lane);
            continue;
        }
        r -= N_W2;
        if (r < N_WIN) {
            const int l = llo + r / 40, nb = r % 40;
            strip_item<true>(F.inp(I_WIN) + (size_t)l * 1024 * 1536, 1536, 0, 1024, nb * 32, WINT + (size_t)l * NINP * 1024, 1024, nb * 32,
                             mods + (size_t)l * 3 * 6144, BIASIN + (size_t)l * 3 * NINP, NINP, scr, lane);
            continue;
        }
        r -= N_WIN;
        if (r < N_WOUTA) {
            const int l = llo + (r >> 5), nb = r & 31;
            strip_item<false>(F.inp(I_WOUT) + (size_t)l * 1048576, 1024, 0, 512, nb * 32, WOUTT + (size_t)l * 1048576, 1024, nb * 32, nullptr, nullptr, 0, scr, lane);
            continue;
        }
        r -= N_WOUTA;
        if (with_rows) {
            const int cond = r < M_CTX ? 0 : 1 + ((r - M_CTX) >> 10);
            const float* src = r < M_CTX ? F.inp(I_XP) + (size_t)r * 1024 : F.inp(I_XS) + (size_t)(r - M_CTX) * 1024;
            const f32x4* xr = (const f32x4*)src + lane;
            const f32x4* gp = (const f32x4*)F.inp(I_N1G) + lane;
            const f32x4* sp = (const f32x4*)(mods + (size_t)cond * 6144 + 1024) + lane;
            f32x4 v[4]; float s = 0.f;
#pragma unroll
            for (int j = 0; j < 4; ++j) { v[j] = xr[64 * j]; s += (v[j][0] * v[j][0] + v[j][1] * v[j][1]) + (v[j][2] * v[j][2] + v[j][3] * v[j][3]); }
            s = wave_sum(s);
            f32x4* xo = (f32x4*)((float*)(F.ws + WS_X) + (size_t)r * 1024) + lane;
            v2u* ao = (v2u*)((bf16*)(F.ws + WS_A) + (size_t)r * 1024) + lane;
#pragma unroll
            for (int j = 0; j < 4; ++j) { xo[64 * j] = v[j]; const f32x4 a = v[j] * (gp[64 * j] * (sp[64 * j] + 1.0f));
                v2u w; w.x = pk2(a[0], a[1]); w.y = pk2(a[2], a[3]); ao[64 * j] = w; }
            if (lane < 16) ((float*)(F.ws + WS_SSQ))[(size_t)r * 16 + lane] = lane == 0 ? s : 0.f;
        }
      }
    }
}
__device__ __forceinline__ void p0b_tail(Frame F) {
    F.relaunder();
    const float* mods = (const float*)(F.ws + WS_MODS);
    const int gt = F.bid * NTHREADS + F.tid, NGT = F.G * NTHREADS;
    {
        float* GV = (float*)(F.ws + WS_GV);
        for (int i = gt; i < 4 * 2 * 3 * 1024; i += NGT) { const int c = i & 1023, cd = (i >> 10) % 3, w = (i / 3072) & 1, l = i / 6144;
            const float g = (w == 0 ? F.inp(I_N1G) : F.inp(I_N2G))[l * 1024 + c]; GV[i] = g * (1.0f + mods[(size_t)(l * 3 + cd) * 6144 + (w == 0 ? 1 : 4) * 1024 + c]); }
    }
    {
        bf16* WG = (bf16*)(F.ws + WS_WG);
        for (int i = gt; i < 4 * 8 * 4 * 4 * 2 * 32 * 64; i += NGT) { const int c = i & 63, n = (i >> 6) & 31, dir = (i >> 11) & 1, tap = (i >> 12) & 3, q = (i >> 14) & 3, h = (i >> 16) & 7, l = i >> 19;
            const float* src = n < 16 ? F.inp(I_WR) : F.inp(I_WI);
            WG[i] = (bf16)f2bf(-1.4426950408889634f * F.inp(I_CONVW)[(l * 4 + tap) * 512 + 64 * h + c] * src[((size_t)((l * 2 + dir) * 8 + h) * 64 + c) * 64 + 16 * q + (n & 15)]); }
        float* GB = (float*)(F.ws + WS_GB);
        for (int i = gt; i < 4 * 2 * 2 * 512; i += NGT) { const int ch = i & 511, g = (i >> 9) & 1, dir = (i >> 10) & 1, l = i >> 11, h = ch >> 6, j = ch & 63;
            const float* W = (g == 0 ? F.inp(I_WR) : F.inp(I_WI)) + (size_t)((l * 2 + dir) * 8 + h) * 4096 + j;
            float s = (g == 0 ? F.inp(I_BR) : F.inp(I_BI))[(l * 2 + dir) * 512 + ch];
            { float wv[64];
#pragma unroll
              for (int c = 0; c < 64; ++c) wv[c] = W[c * 64];
#pragma unroll
              for (int c = 0; c < 64; ++c) s += F.inp(I_CONVB)[l * 512 + 64 * h + c] * wv[c]; }
            GB[i] = -1.4426950408889634f * s; }
    }
    {
        for (int i = gt; i < (256 * 512 + 1024 * 2048) / 8; i += NGT) {
            int L, e; bf16* T;
            if (i < 256 * 512 / 8) { L = 256; e = i * 8; T = (bf16*)(F.ws + WS_T256); } else { L = 1024; e = (i - 256 * 512 / 8) * 8; T = (bf16*)(F.ws + WS_T1024); }
            const int kpos = e / (2 * L), k2 = e % (2 * L), sn = k2 >= L, l0 = k2 - (sn ? L : 0);
            const float scale = L == 256 ? 0.0625f : 0.03125f, inv = 2.0f / (float)L;
            float v[8];
#pragma unroll
            for (int j = 0; j < 8; ++j) { const int a = (kpos * (l0 + j)) & (L - 1); v[j] = sn ? -sinpif((float)a * inv) * scale : cospif((float)a * inv) * scale; }
            v4u o; o.x = pk2(v[0], v[1]); o.y = pk2(v[2], v[3]); o.z = pk2(v[4], v[5]); o.w = pk2(v[6], v[7]);
            *(v4u*)(T + ((size_t)(((kpos >> 4) * (L >> 4) + (k2 >> 5)) * 64 + ((k2 >> 3) & 3) * 16 + (kpos & 15))) * 8) = o;
        }
    }
}
#define LRU_STAMP(i) do { if (TS_SEL >= 0 && F.tsx && F.wave == 0) __hip_atomic_store(F.tsx + (i), (unsigned long long)__builtin_amdgcn_s_memrealtime(), __ATOMIC_RELAXED, __HIP_MEMORY_SCOPE_AGENT); } while (0)
__device__ __forceinline__ float sigmoidf_(float x) { return 1.0f / (1.0f + expf(-x)); }
__device__ __forceinline__ float gelu_tanh(float x) { return 0.5f * x * (1.0f + tanhf(0.7978845608028654f * (x + 0.044715f * x * x * x))); }
__device__ __forceinline__ void seq_geom(int seq, int& L, int& row0) { if (seq < 16) { L = 256; row0 = seq * 256; } else { L = 1024; row0 = M_CTX + (seq - 16) * 1024; } }

__device__ __forceinline__ float fexp(float x) { return __builtin_amdgcn_exp2f(x * 1.4426950408889634f); }
__device__ __forceinline__ float fsigmoid(float x) { return __builtin_amdgcn_rcpf(1.0f + __builtin_amdgcn_exp2f(x * -1.4426950408889634f)); }
__device__ __forceinline__ float fgelu_tanh(float x) { return x * fsigmoid(1.5957691216057308f * (x + 0.044715f * x * x * x)); }
__device__ __forceinline__ float neg_expm1(float y) {
    float p = 1.0f / 720.0f; p = p * y + (1.0f / 120.0f); p = p * y + (1.0f / 24.0f); p = p * y + (1.0f / 6.0f); p = p * y + 0.5f; p = p * y + 1.0f;
    return y < -0.5f ? 1.0f - fexp(y) : -y * p;
}
__device__ __forceinline__ float one_minus_sq(float a, float y) {
    float p = 1.0f / 720.0f; p = p * y + (1.0f / 120.0f); p = p * y + (1.0f / 24.0f); p = p * y + (1.0f / 6.0f); p = p * y + 0.5f; p = p * y + 1.0f;
    return y < -0.5f ? __builtin_fmaf(-a, a, 1.0f) : -y * p;
}
__device__ __forceinline__ void lru_unit(Frame F, int l, int seq, int h, int q) {
    F.relaunder();
    LRU_STAMP(0);
    int L, row0; seq_geom(seq, L, row0);
    const int tid = F.tid, lane = F.lane, wave = F.wave;
    LAS bf16* XR = (LAS bf16*)F.lds;
    LAS bf16* XG = (LAS bf16*)(F.lds + 37440);
    LAS float* SL = (LAS float*)(F.lds + 94208);
    LAS float* WTP = (LAS float*)(F.lds + 53824);
    LAS float* WTH = WTP + 256;
    LAS float* CHKP = WTP + 512;
    LAS float* CHKH = WTP + 576;
    LAS bf16* WGL = (LAS bf16*)(F.lds + 57344);
    const bf16* U = (const bf16*)(F.ws + WS_U);
    bf16* CAT = (bf16*)(F.ws + WS_CAT);
    const int chb = 64 * h + 16 * q;
    const int nch = L >> 8;
    const int j16 = lane & 15, lq = lane >> 4;
    float gbr[2], gbi[2], sp8[2], cwo[4];
    { const float* GB = (const float*)(F.ws + WS_GB) + (size_t)l * 2048 + chb + j16;
#pragma unroll
        for (int d = 0; d < 2; ++d) { gbr[d] = GB[d * 1024]; gbi[d] = GB[d * 1024 + 512];
            sp8[d] = (-8.0f * 1.4426950408889634f) * log1pf(expf(-F.inp(I_LAM)[(l * 2 + d) * 512 + chb + j16])); } }
#pragma unroll
    for (int k = 0; k < 4; ++k) cwo[k] = F.inp(I_CONVW)[(l * 4 + k) * 512 + chb + j16];
    const float cbo = F.inp(I_CONVB)[l * 512 + chb + j16];
    float carf = seq < 16 ? 0.f : F.inp(I_STATE)[(((seq - 16) * 4 + l) * 2 + 0) * 512 + chb + j16];
    const float h0b = seq < 16 ? 0.f : F.inp(I_STATE)[(((seq - 16) * 4 + l) * 2 + 1) * 512 + chb + j16];
    v4u xv[5], gv;
#pragma unroll
    for (int i = 0; i < 5; ++i) { const int id = tid + NTHREADS * i, tr = id >> 3, v = id & 7, t = tr - 2; xv[i] = (v4u){0u, 0u, 0u, 0u};
        if (id < 260 * 8 && t >= 0 && t < L) xv[i] = *(const v4u*)(U + (size_t)(row0 + t) * NUC + 64 * h + 8 * v); }
    gv = *(const v4u*)(U + (size_t)(row0 + (tid >> 1)) * NUC + 512 + chb + 8 * (tid & 1));
    { const bf16* WGb = (const bf16*)(F.ws + WS_WG) + (size_t)((l * 8 + h) * 4 + q) * (4 * 2 * 32 * 64);
        v4u wv[4];
#pragma unroll
        for (int i = 0; i < 4; ++i) { const int id = tid + NTHREADS * i; wv[i] = *(const v4u*)(WGb + (size_t)(id >> 3) * 64 + 8 * (id & 7)); }
#pragma unroll
        for (int i = 0; i < 4; ++i) { const int id = tid + NTHREADS * i; *(LAS v4u*)(WGL + (id >> 3) * 72 + 8 * (id & 7)) = wv[i]; } }
#pragma unroll 1
    for (int c = 0; c < nch; ++c) {
        const int c0 = c * 256; const bool last = c == nch - 1;
        LAS bf16* PBLc = (LAS bf16*)(F.lds + (c == 0 ? 45632 : 143360 + (c - 1) * 8192));
#pragma unroll
        for (int i = 0; i < 5; ++i) { const int id = tid + NTHREADS * i; if (id < 260 * 8) *(LAS v4u*)(XR + (id >> 3) * 72 + 8 * (id & 7)) = xv[i]; }
        *(LAS v4u*)(XG + tid * 8) = gv;
        if (!last) {
#pragma unroll
            for (int i = 0; i < 5; ++i) { const int id = tid + NTHREADS * i, tr = id >> 3, v = id & 7, t = c0 + 256 - 2 + tr; xv[i] = (v4u){0u, 0u, 0u, 0u};
                if (id < 260 * 8 && t < L) xv[i] = *(const v4u*)(U + (size_t)(row0 + t) * NUC + 64 * h + 8 * v); }
            gv = *(const v4u*)(U + (size_t)(row0 + c0 + 256 + (tid >> 1)) * NUC + 512 + chb + 8 * (tid & 1));
        }
        __syncthreads();
        LRU_STAMP(1);
        f32x4 acc[2][4];
#pragma unroll
        for (int mt = 0; mt < 2; ++mt)
#pragma unroll
            for (int nt = 0; nt < 4; ++nt) { const float gb = (nt & 1) ? gbi[nt >> 1] : gbr[nt >> 1]; acc[mt][nt] = (f32x4){gb, gb, gb, gb}; }
#pragma unroll
        for (int k = 0; k < 4; ++k)
#pragma unroll
            for (int ks = 0; ks < 2; ++ks) { bf16x8 bw[4];
#pragma unroll
                for (int nt = 0; nt < 4; ++nt) bw[nt] = *(const LAS bf16x8*)(WGL + (k * 64 + 16 * nt + j16) * 72 + 32 * ks + 8 * lq);
#pragma unroll
                for (int mt = 0; mt < 2; ++mt) { const bf16x8 a = *(const LAS bf16x8*)(XR + (32 * wave + 16 * mt + j16 + k) * 72 + 32 * ks + 8 * lq);
#pragma unroll
                    for (int nt = 0; nt < 4; ++nt) acc[mt][nt] = __builtin_amdgcn_mfma_f32_16x16x32_bf16(a, bw[nt], acc[mt][nt], 0, 0, 0); } }
        LRU_STAMP(3);
        float Pc[2][8], Hc[2][8], rP[2][2], rH[2][2];
#pragma unroll
        for (int mt = 0; mt < 2; ++mt) {
            float av[2][4], bv[2][4];
#pragma unroll
            for (int rg = 0; rg < 4; ++rg) { const int tl = 32 * wave + 16 * mt + 4 * lq + rg;
                float xc = cbo;
#pragma unroll
                for (int k = 0; k < 4; ++k) xc += bf2f(XR[(tl + k) * 72 + 16 * q + j16]) * cwo[k];
#pragma unroll
                for (int d = 0; d < 2; ++d) { const float r = __builtin_amdgcn_rcpf(1.0f + __builtin_amdgcn_exp2f(acc[mt][2 * d][rg])), ig = __builtin_amdgcn_rcpf(1.0f + __builtin_amdgcn_exp2f(acc[mt][2 * d + 1][rg]));
                    const float la2 = sp8[d] * r, a = __builtin_amdgcn_exp2f(la2); av[d][rg] = a; bv[d][rg] = __builtin_amdgcn_sqrtf(one_minus_sq(a, la2 * 1.3862943611198906f)) * (ig * xc); } }
            float P = 1.f, Hl = 0.f;
#pragma unroll
            for (int rg = 0; rg < 4; ++rg) { Hl = av[0][rg] * Hl + bv[0][rg]; P *= av[0][rg]; Pc[0][4 * mt + rg] = P; Hc[0][4 * mt + rg] = Hl; }
            rP[0][mt] = P; rH[0][mt] = Hl; P = 1.f; Hl = 0.f;
#pragma unroll
            for (int rg = 3; rg >= 0; --rg) { Hl = av[1][rg] * Hl + bv[1][rg]; P *= av[1][rg]; Pc[1][4 * mt + rg] = P; Hc[1][4 * mt + rg] = Hl; }
            rP[1][mt] = P; rH[1][mt] = Hl;
        }
        LRU_STAMP(4);
        float EP[2][2], EH[2][2], WPt[2], WHt[2];
#pragma unroll
        for (int d = 0; d < 2; ++d) { float ep = 1.f, eh = 0.f;
#pragma unroll
            for (int rr = 0; rr < 8; ++rr) { const int r = d == 0 ? rr : 7 - rr, mt = r >> 2, lq2 = r & 3;
                const float p = __shfl(rP[d][mt], j16 + 16 * lq2), hh = __shfl(rH[d][mt], j16 + 16 * lq2);
                if (lq2 == lq) { EP[d][mt] = ep; EH[d][mt] = eh; }
                eh = p * eh + hh; ep *= p; }
            WPt[d] = ep; WHt[d] = eh; }
        if (lq == 0) {
#pragma unroll
            for (int d = 0; d < 2; ++d) { WTP[(d * 8 + wave) * 16 + j16] = WPt[d]; WTH[(d * 8 + wave) * 16 + j16] = WHt[d]; } }
        __syncthreads();
        LRU_STAMP(5);
        float cwf = 0.f, cwb = 0.f, qwb = 1.f;
        { float cv = carf;
#pragma unroll
            for (int w = 0; w < 8; ++w) { if (w == wave) cwf = cv; cv = WTP[w * 16 + j16] * cv + WTH[w * 16 + j16]; }
            carf = cv;
            cv = last ? h0b : 0.f; float qv = 1.f;
#pragma unroll
            for (int w = 7; w >= 0; --w) { if (w == wave) { cwb = cv; qwb = qv; } const float pw = WTP[(8 + w) * 16 + j16]; cv = pw * cv + WTH[(8 + w) * 16 + j16]; qv *= pw; }
            if (wave == 0 && lq == 0) { CHKP[c * 16 + j16] = qv; CHKH[c * 16 + j16] = cv; }
            if (nch == 1 && wave == 0 && lq == 0) {
                float* so = F.out + (size_t)M_TOK * DMODEL + (size_t)((seq * 4 + l) * 2) * 512 + chb + j16; so[0] = carf; so[512] = cv; } }
        LRU_STAMP(6);
#pragma unroll
        for (int mt = 0; mt < 2; ++mt) {
            const float hinf = EP[0][mt] * cwf + EH[0][mt], hinb = EP[1][mt] * cwb + EH[1][mt], pbf = EP[1][mt] * qwb;
#pragma unroll
            for (int rg = 0; rg < 4; ++rg) { const int p = 4 * mt + rg, tl = 32 * wave + 16 * mt + 4 * lq + rg; const size_t row = (size_t)(row0 + c0 + tl);
                const float s = (Hc[0][p] + Pc[0][p] * hinf) + (Hc[1][p] + Pc[1][p] * hinb), g = fgelu_tanh(bf2f(XG[tl * 16 + j16]));
                if (last) CAT[row * DMODEL + chb + j16] = (bf16)f2bf(s * g);
                else { SL[(c * 8 + p) * 512 + tid] = s * g; PBLc[p * 512 + tid] = (bf16)f2bf(Pc[1][p] * pbf * g); } }
        }
        if (!last) __syncthreads();
    }
    LRU_STAMP(7);
    if (nch > 1) {
        __syncthreads();
        float cin[3]; { float cv = CHKH[(nch - 1) * 16 + j16];
#pragma unroll
            for (int c = 2; c >= 0; --c) { cin[c] = cv; if (c < nch - 1) cv = CHKP[c * 16 + j16] * cv + CHKH[c * 16 + j16]; } }
#pragma unroll
        for (int c = 0; c < 3; ++c) if (c < nch - 1) {
            const LAS bf16* PBLc = (const LAS bf16*)(F.lds + (c == 0 ? 45632 : 143360 + (c - 1) * 8192));
#pragma unroll
            for (int p = 0; p < 8; ++p) { const size_t row = (size_t)(row0 + 256 * c + 32 * wave + 16 * (p >> 2) + 4 * lq + (p & 3));
                CAT[row * DMODEL + chb + j16] = (bf16)f2bf(SL[(c * 8 + p) * 512 + tid] + bf2f(PBLc[p * 512 + tid]) * cin[c]); }
        }
    }
    __syncthreads();
}

__device__ __forceinline__ void pool1d_unit(Frame F, int seq, int tb) {
    F.relaunder();
    const bf16* U = (const bf16*)(F.ws + WS_U); bf16* CAT = (bf16*)(F.ws + WS_CAT);
    const int row0 = seq * 256;
#pragma unroll 1
    for (int i = 0; i < 4; ++i) { const int id = F.tid + NTHREADS * i, t = tb * 64 + (id >> 5), v = id & 31, g = v >> 3, hw = 1 << g;
        const int lo = max(t - hw, 0), hi = min(t + hw, 256);
        v4u x[16];
#pragma unroll
        for (int k = 0; k < 16; ++k) { const int tt = t - 8 + k; x[k] = (v4u){0u, 0u, 0u, 0u}; if (tt >= lo && tt < hi) x[k] = *(const v4u*)(U + (size_t)(row0 + tt) * NUC + 1024 + 8 * v); }
        float s[8];
#pragma unroll
        for (int c = 0; c < 8; ++c) s[c] = 0.f;
#pragma unroll
        for (int k = 0; k < 16; ++k) { s[0] += bflo(x[k].x); s[1] += bfhi(x[k].x); s[2] += bflo(x[k].y); s[3] += bfhi(x[k].y); s[4] += bflo(x[k].z); s[5] += bfhi(x[k].z); s[6] += bflo(x[k].w); s[7] += bfhi(x[k].w); }
        const float inv = 1.0f / (float)(hi - lo);
        const v4u xs = x[8];
        v4u o; o.x = pk2(s[0] * inv - bflo(xs.x), s[1] * inv - bfhi(xs.x)); o.y = pk2(s[2] * inv - bflo(xs.y), s[3] * inv - bfhi(xs.y));
        o.z = pk2(s[4] * inv - bflo(xs.z), s[5] * inv - bfhi(xs.z)); o.w = pk2(s[6] * inv - bflo(xs.w), s[7] * inv - bfhi(xs.w));
        *(v4u*)(CAT + (size_t)(row0 + t) * DMODEL + 512 + 8 * v) = o; }
}
__device__ __forceinline__ void pool2d_unit(Frame F, int b, int g, int oc) {
    F.relaunder();
    const bf16* U = (const bf16*)(F.ws + WS_U); bf16* CAT = (bf16*)(F.ws + WS_CAT);
    LAS float* T1 = (LAS float*)F.lds;
    LAS float* T2 = (LAS float*)(F.lds + 32768);
    const int row0 = M_CTX + b * 1024, colb = 64 * g + 8 * oc, hw = 1 << g;
#pragma unroll
    for (int i = 0; i < 2; ++i) { const int t = F.tid + NTHREADS * i;
        const v4u x = *(const v4u*)(U + (size_t)(row0 + t) * NUC + 1024 + colb);
        *(LAS f32x4*)(T1 + t * 8) = (f32x4){bflo(x.x), bfhi(x.x), bflo(x.y), bfhi(x.y)}; *(LAS f32x4*)(T1 + t * 8 + 4) = (f32x4){bflo(x.z), bfhi(x.z), bflo(x.w), bfhi(x.w)}; }
    __syncthreads();
    const int j4 = 4 * (F.tid & 1), tq = F.tid >> 1;
#pragma unroll
    for (int i = 0; i < 4; ++i) { const int t = tq + 256 * i, r = t >> 6, c = t & 63, lo = max(c - hw, 0), hi = min(c + hw, 64);
        f32x4 s = {0.f, 0.f, 0.f, 0.f};
        for (int c2 = lo; c2 < hi; ++c2) s += *(const LAS f32x4*)(T1 + (r * 64 + c2) * 8 + j4);
        *(LAS f32x4*)(T2 + t * 8 + j4) = s * (1.0f / (float)(hi - lo)); }
    __syncthreads();
#pragma unroll
    for (int i = 0; i < 4; ++i) { const int t = tq + 256 * i, r = t >> 6, c = t & 63, lo = max(r - hw, 0), hi = min(r + hw, 16);
        f32x4 s = {0.f, 0.f, 0.f, 0.f};
        for (int r2 = lo; r2 < hi; ++r2) s += *(const LAS f32x4*)(T2 + (r2 * 64 + c) * 8 + j4);
        const f32x4 o = s * (1.0f / (float)(hi - lo)) - *(const LAS f32x4*)(T1 + t * 8 + j4);
        v2u w; w.x = pk2(o[0], o[1]); w.y = pk2(o[2], o[3]);
        *(v2u*)(CAT + (size_t)(row0 + t) * DMODEL + 512 + colb + j4) = w; }
    __syncthreads();
}
__device__ __forceinline__ void fourier_unit(Frame F, int seq, int hd, int nb) {
    F.relaunder();
    LRU_STAMP(0);
    int L, row0; seq_geom(seq, L, row0);
    const int lane = F.lane, wave = F.wave, j16 = lane & 15, kq = 8 * (lane >> 4);
    const bf16* XCT = (const bf16*)(F.ws + WS_XCT) + (seq < 16 ? (size_t)(seq * 4 + hd) * 128 * 256 : pg8::XCT_LAT_OFF + (size_t)((seq - 16) * 4 + hd) * 128 * 1024);
    const bf16* T = seq < 16 ? (const bf16*)(F.ws + WS_T256) : (const bf16*)(F.ws + WS_T1024);
    const int K2 = 2 * L, KB2 = K2 >> 5, kw = K2 / 8, kbeg = wave * kw;
    const bf16* Ab = XCT + ((size_t)(kbeg >> 5) * 64 + lane) * 8;
    const bf16* Bb = T + ((size_t)((nb * 4) * KB2 + (kbeg >> 5)) * 64 + lane) * 8;
    f32x4 acc[4][4];
#pragma unroll
    for (int mt = 0; mt < 4; ++mt)
#pragma unroll
        for (int nt = 0; nt < 4; ++nt) acc[mt][nt] = (f32x4){0.f, 0.f, 0.f, 0.f};
    const bf16* Ap = Ab; const bf16* Bp = Bb;
    const size_t a16 = (size_t)KB2 * 512, b16 = (size_t)KB2 * 512;
#define FOU_LOAD(A_, B_, ks_) do { _Pragma("unroll") for (int mt = 0; mt < 4; ++mt) A_[mt] = *(const bf16x8*)(Ap + mt * a16 + (size_t)(ks_) * 16); \
                                   _Pragma("unroll") for (int nt = 0; nt < 4; ++nt) B_[nt] = *(const bf16x8*)(Bp + nt * b16 + (size_t)(ks_) * 16); } while (0)
#define FOU_MMA(A_, B_) do { _Pragma("unroll") for (int mt = 0; mt < 4; ++mt) _Pragma("unroll") for (int nt = 0; nt < 4; ++nt) \
                                   acc[mt][nt] = __builtin_amdgcn_mfma_f32_16x16x32_bf16(A_[mt], B_[nt], acc[mt][nt], 0, 0, 0); } while (0)
    bf16x8 fa0[4], fb0[4], fa1[4], fb1[4], fa2[4], fb2[4];
    FOU_LOAD(fa0, fb0, 0); FOU_LOAD(fa1, fb1, 32);
    if (kw == 64) { FOU_MMA(fa0, fb0); FOU_MMA(fa1, fb1); }
    else {
        FOU_LOAD(fa2, fb2, 64);
        FOU_MMA(fa0, fb0); FOU_LOAD(fa0, fb0, 96);
        FOU_MMA(fa1, fb1); FOU_LOAD(fa1, fb1, 128);
        FOU_MMA(fa2, fb2); FOU_LOAD(fa2, fb2, 160);
        FOU_MMA(fa0, fb0); FOU_LOAD(fa0, fb0, 192);
        FOU_MMA(fa1, fb1); FOU_LOAD(fa1, fb1, 224);
        FOU_MMA(fa2, fb2); FOU_MMA(fa0, fb0); FOU_MMA(fa1, fb1);
    }
#undef FOU_LOAD
#undef FOU_MMA
    LRU_STAMP(1);
    LAS float* red = (LAS float*)F.lds;
#pragma unroll
    for (int mt = 0; mt < 4; ++mt)
#pragma unroll
        for (int nt = 0; nt < 4; ++nt) *(LAS f32x4*)(red + (size_t)(wave * 64 + 16 * nt + j16) * 68 + 16 * mt + 4 * (lane >> 4)) = acc[mt][nt];
    __syncthreads();
    LRU_STAMP(2);
    { const int kp = F.tid >> 3, mg = F.tid & 7;
        f32x4 s0 = {0.f, 0.f, 0.f, 0.f}, s1 = s0;
#pragma unroll
        for (int w = 0; w < 8; ++w) { const LAS f32x4* p = (const LAS f32x4*)(red + (size_t)(w * 64 + kp) * 68 + 8 * mg); s0 += p[0]; s1 += p[1]; }
        v4u o; o.x = pk2(s0[0], s0[1]); o.y = pk2(s0[2], s0[3]); o.z = pk2(s1[0], s1[1]); o.w = pk2(s1[2], s1[3]);
        *(v4u*)((bf16*)(F.ws + WS_CAT) + (size_t)(row0 + nb * 64 + kp) * DMODEL + 768 + 64 * hd + 8 * mg) = o; }
    __syncthreads();
    LRU_STAMP(3);
}
#ifndef REP_LRU
#define REP_LRU 1
#endif
#ifndef REP_FOU
#define REP_FOU 1
#endif
#ifndef REP_POOL
#define REP_POOL 1
#endif
__device__ __forceinline__ void mixer_phase(const Frame& F, int l) {
    constexpr int N_LRU_LAT = 64, N_FOU_LAT = 128, N_P2D = 64, N_LRU_CTX = 512, N_FOU_CTX = 256, N_P1D = 64;
    constexpr int NREST = N_FOU_LAT + N_P2D + N_LRU_CTX + N_FOU_CTX + N_P1D;
    if (false && F.G == 256 && REP_LRU == 1 && REP_FOU == 1 && REP_POOL == 1) {
        const int b = F.bid;
        if (b < 64) { lru_unit(F, l, 16 + (b >> 5), (b >> 2) & 7, b & 3); fourier_unit(F, b >> 4, (b >> 2) & 3, b & 3); }
        else if (b < 192) { const int i = b - 64; fourier_unit(F, 16 + (i >> 6), (i >> 4) & 3, i & 15);
            for (int k = 0; k < 3; ++k) { const int r = 3 * i + k; lru_unit(F, l, r >> 5, (r >> 2) & 7, r & 3); } }
        else { const int i = b - 192;
            for (int k = 0; k < 2; ++k) { const int r = 384 + 2 * i + k; lru_unit(F, l, r >> 5, (r >> 2) & 7, r & 3); }
            for (int k = 0; k < 3; ++k) { const int r = 64 + 3 * i + k; fourier_unit(F, r >> 4, (r >> 2) & 3, r & 3); }
            pool2d_unit(F, i >> 5, (i >> 3) & 3, i & 7); pool1d_unit(F, i >> 2, i & 3); }
        return;
    }
    const int nlat = F.G >= 128 ? 64 : F.G / 4;
    if (F.bid < nlat) {
        for (int r = F.bid; r < N_LRU_LAT; r += nlat) {
#ifndef SKIP_LRU
            for (int rp = 0; rp < REP_LRU; ++rp) lru_unit(F, l, 16 + (r >> 5), (r >> 2) & 7, r & 3);
#endif
        }
        return;
    }
#if TS_SEL >= 0
    int ustamp = 0; unsigned long long* TSX = (unsigned long long*)(F.ws0 + WS_CTL + 2048) + 64;
#define MIX_STAMP() do { if (F.bid == TS_BLK && F.wave == 0 && l == (TS_SEL - 2) / 5 && ustamp < 8) __hip_atomic_store(TSX + ustamp, (unsigned long long)__builtin_amdgcn_s_memrealtime(), __ATOMIC_RELAXED, __HIP_MEMORY_SCOPE_AGENT); ++ustamp; } while (0)
#else
#define MIX_STAMP() do {} while (0)
#endif
    for (int it = F.bid - nlat; ; it += F.G - nlat) {
        MIX_STAMP();
        if (it >= NREST) break;
        int r = it;
        if (r < N_P2D) {
#ifndef SKIP_POOL
            for (int rp = 0; rp < REP_POOL; ++rp) pool2d_unit(F, r >> 5, (r >> 3) & 3, r & 7);
#endif
            continue; } r -= N_P2D;
        if (r < N_FOU_LAT) {
#ifndef SKIP_FOU
            { Frame F2 = F;
#if TS_SEL >= 0
              if (F.bid == TS_BLK && l == (TS_SEL - 2) / 5) F2.tsx = TSX + 32;
#endif
              for (int rp = 0; rp < REP_FOU; ++rp) fourier_unit(F2, 16 + ((r & 7) >> 2), r & 3, r >> 3); }
#endif
            continue; } r -= N_FOU_LAT;
        if (r < N_LRU_CTX) {
#ifndef SKIP_LRU
            { Frame F2 = F;
#if TS_SEL >= 0
              if (F.bid == TS_BLK && l == (TS_SEL - 2) / 5 && ustamp == 2) F2.tsx = TSX + 16;
#endif
              for (int rp = 0; rp < REP_LRU; ++rp) lru_unit(F2, l, r >> 5, (r >> 2) & 7, r & 3); }
#endif
            continue; } r -= N_LRU_CTX;
        if (r < N_FOU_CTX) {
#ifndef SKIP_FOU
            for (int rp = 0; rp < REP_FOU; ++rp) fourier_unit(F, r >> 4, (r >> 2) & 3, r & 3);
#endif
            continue; } r -= N_FOU_CTX;
#ifndef SKIP_POOL
        for (int rp = 0; rp < REP_POOL; ++rp) pool1d_unit(F, r >> 2, r & 3);
#endif
    }
}
#ifndef MK_PER_PHASE
#define MK_PER_PHASE 0
#endif
#ifndef MK_BARRIER
#define MK_BARRIER 1
#endif
#ifndef REP_P0
#define REP_P0 1
#endif
#ifndef REP_MIX
#define REP_MIX 1
#endif
#ifndef REP_G1
#define REP_G1 1
#endif
#ifndef REP_G3
#define REP_G3 1
#endif
#ifndef TS_SEL
#define TS_SEL -1
#endif
#ifndef TS_MODE
#define TS_MODE 0
#endif
#ifndef TS_BLK
#define TS_BLK 0
#endif
#ifndef TSX_OFF
#define TSX_OFF 0
#endif
#ifndef TS_SCALE
#define TS_SCALE 1e-6f
#endif
constexpr int N_PHASES = 2 + 5 * DEPTHL + 1;
constexpr int CW_BAR = 4096;
__device__ __forceinline__ void final_norm(const Frame& F) {
    const int gw = F.bid * NWAVES + F.wave, NGW = F.G * NWAVES;
    const float* X = (const float*)(F.ws + WS_X); const float* ssq = (const float*)(F.ws + WS_SSQ) + (size_t)8 * M_TOK * 16;
    const f32x4* gp = (const f32x4*)F.inp(I_FG) + F.lane;
    for (int r = gw; r < M_TOK; r += NGW) {
        const float rs = pg8::row_rstd(ssq, r);
        const f32x4* xr = (const f32x4*)(X + (size_t)r * 1024) + F.lane; f32x4* o = (f32x4*)(F.out + (size_t)r * 1024) + F.lane;
#pragma unroll
        for (int j = 0; j < 4; ++j) o[64 * j] = xr[64 * j] * rs * gp[64 * j];
    }
}
__global__ void __launch_bounds__(NTHREADS, 2) mega(Params p) {
    extern __shared__ __attribute__((aligned(16))) unsigned char lds[];
    Frame F;
    F.lds = (LAS unsigned char*)lds; F.tid = threadIdx.x; F.lane = F.tid & 63; F.wave = __builtin_amdgcn_readfirstlane(F.tid >> 6);
    F.G = gridDim.x; F.bid = blockIdx.x; F.in = (const CAS cfp_t*)__builtin_amdgcn_kernarg_segment_ptr(); F.out0 = p.out; F.ws0 = p.ws; F.out = p.out; F.ws = p.ws; F.tsx = nullptr;
#if MK_BARRIER
    volatile unsigned* bst = (volatile unsigned*)(p.ws + WS_CTL) + 1024 + 2 * blockIdx.x;
    XcdBarrier bar = xcd_barrier_post((unsigned*)(p.ws + WS_CTL) + CW_BAR, bst);
#else
    cg::grid_group grid = cg::this_grid();
#endif
#if TS_SEL >= 0
    unsigned long long* TS = (unsigned long long*)(p.ws + WS_CTL + 2048);
    if (blockIdx.x == TS_BLK && threadIdx.x == 0) TS[31] = __builtin_amdgcn_s_memrealtime();
#endif
    for (int ph = p.ph_lo; ph < p.ph_hi; ++ph) {
        { size_t z = 0; asm volatile("" : "+s"(z)); F.ws = F.ws0 + z; }
        bf16* A = (bf16*)(F.ws + WS_A); bf16* CAT = (bf16*)(F.ws + WS_CAT); bf16* HID = (bf16*)(F.ws + WS_HID); bf16* U = (bf16*)(F.ws + WS_U); bf16* XCT = (bf16*)(F.ws + WS_XCT);
        float* X = (float*)(F.ws + WS_X); float* SSQ = (float*)(F.ws + WS_SSQ); const float* MODS = (const float*)(F.ws + WS_MODS); const float* GV = (const float*)(F.ws + WS_GV);
        if (ph == 0) {
#ifndef SKIP_P0A
 F.relaunder(); p0a_mods(F);
#endif
 }
        else if (ph == 1) {
#ifndef SKIP_P0B
 F.relaunder();
 { const bool defer = false && F.G >= 224;
   p0b_items(F, 0, defer ? 1 : DEPTHL, F.bid * NWAVES + F.wave, F.G * NWAVES, true); p0b_tail(F); }
#endif
 }
        else if (ph == N_PHASES - 1) { F.relaunder(); final_norm(F); }
        else {
            const int l = (ph - 2) / 5, k = (ph - 2) % 5;
            if (k == 0) {
                F.relaunder();
                pg8::Gemm g{A, (const bf16*)(F.ws + WS_WIN) + (size_t)l * NINP * 1024, M_TOK, NINP, 1024}; pg8::StaticOrder S; S.init(M_TOK, NINP, F.G, F.bid);
                pg8::EpiIn E{U, XCT, SSQ + (size_t)(2 * l) * M_TOK * 16, (const float*)(F.ws + WS_BIASIN) + (size_t)l * 3 * NINP};
#ifndef SKIP_G1
                pg8::gemm_phase<pg8::EpiIn, pg8::StaticOrder, true, true>(F.lds, g, S, E, F.tid);
#endif
            } else if (k == 1) {
#ifndef SKIP_MIX
                for (int rep = 0; rep < REP_MIX; ++rep) mixer_phase(F, l);
#endif
            } else if (k == 2 || k == 4) {
                F.relaunder();
                const bool dn = k == 4;
                pg8::Gemm g{dn ? HID : CAT, dn ? (const bf16*)(F.ws + WS_W2) + (size_t)l * FFD * 1024 : (const bf16*)(F.ws + WS_WOUT) + (size_t)l * 1024 * 1024, M_TOK, 1024, dn ? FFD : 1024};
                pg8::StaticOrder192 S; S.init(M_TOK, 1024, F.G, F.bid);
                const float* Gn = dn ? (l < DEPTHL - 1 ? GV + (size_t)((l + 1) * 2 * 3) * 1024 : nullptr) : GV + (size_t)((l * 2 + 1) * 3) * 1024;
                const int inst = dn ? (l < DEPTHL - 1 ? 2 * (l + 1) : 8) : 2 * l + 1;
                pg8::EpiRes192 E{X, A, MODS + (size_t)l * 3 * 6144 + (dn ? 5 : 2) * 1024, Gn, SSQ + (size_t)inst * M_TOK * 16};
#ifndef SKIP_G24
                #if TS_SEL >= 0
                pg8::gemm_phase_m192<pg8::EpiRes192, pg8::StaticOrder192>(F.lds, g, S, E, F.tid, ph == TS_SEL ? (unsigned long long*)(p.ws + WS_CTL + 2048) + 64 : nullptr);
#else
                pg8::gemm_phase_m192<pg8::EpiRes192, pg8::StaticOrder192>(F.lds, g, S, E, F.tid);
#endif
                if (false && dn && l + 1 < DEPTHL && F.G >= 224 && F.bid >= 192) p0b_items(F, l + 1, l + 2, (F.bid - 192) * NWAVES + F.wave, (F.G - 192) * NWAVES, false);
#endif
            } else {
                F.relaunder();
                { pg8::Gemm g{A, (const bf16*)(F.ws + WS_W1) + (size_t)l * FFD * 1024, M_CTX, FFD, 1024}; pg8::StaticOrder S; S.init(M_CTX, FFD, F.G, F.bid);
                  pg8::EpiUp E{HID, SSQ + (size_t)(2 * l + 1) * M_TOK * 16, (const float*)(F.ws + WS_BIAS1) + (size_t)l * 3 * FFD};
#ifndef SKIP_G3
                  pg8::gemm_phase<pg8::EpiUp, pg8::StaticOrder, true, true>(F.lds, g, S, E, F.tid);
#endif
                }
                F.relaunder();
                { const int l2 = launder_s(l);
                  pg8::Gemm g{(const bf16*)(F.ws + WS_A), (const bf16*)(F.ws + WS_W1) + (size_t)l2 * FFD * 1024, M_TOK, FFD, 1024}; pg8::StaticOrder128 S; S.init(M_TOK - M_CTX, FFD, F.G, F.bid, M_CTX / 256);
                  pg8::EpiUp128 E{(bf16*)(F.ws + WS_HID), (const float*)(F.ws + WS_SSQ) + (size_t)(2 * l2 + 1) * M_TOK * 16, (const float*)(F.ws + WS_BIAS1) + (size_t)l2 * 3 * FFD};
#ifndef SKIP_G3
                  pg8::gemm_phase_n128<pg8::EpiUp128, pg8::StaticOrder128>(F.lds, g, S, E, F.tid);
#endif
                }
            }
        }
#if TS_SEL >= 0
        if (blockIdx.x == TS_BLK && F.wave == 0) __hip_atomic_store(TS + 32 + ph, (unsigned long long)__builtin_amdgcn_s_memrealtime(), __ATOMIC_RELAXED, __HIP_MEMORY_SCOPE_AGENT);
#endif
#if MK_BARRIER
        if (ph + 1 < p.ph_hi) xcd_barrier(bar);
#else
        if (ph + 1 < p.ph_hi) grid.sync();
#endif
#if TS_SEL >= 0
        if (blockIdx.x == TS_BLK && F.wave == 0) __hip_atomic_store(TS + ph, (unsigned long long)__builtin_amdgcn_s_memrealtime(), __ATOMIC_RELAXED, __HIP_MEMORY_SCOPE_AGENT);
        if (ph == N_PHASES - 2 && blockIdx.x == 255 - TS_BLK) {
            const unsigned long long te = __hip_atomic_load(TS + TS_SEL, __ATOMIC_RELAXED, __HIP_MEMORY_SCOPE_AGENT), tb = __hip_atomic_load(TS + 32 + TS_SEL, __ATOMIC_RELAXED, __HIP_MEMORY_SCOPE_AGENT),
                                     ts = __hip_atomic_load(TS + (TS_SEL == 0 ? 31 : TS_SEL - 1), __ATOMIC_RELAXED, __HIP_MEMORY_SCOPE_AGENT);
            unsigned long long t1 = TS_MODE == 1 ? tb : te, t0 = TS_MODE == 2 ? tb : ts;
            if (TS_MODE == 3) { t0 = __hip_atomic_load(TS + 31, __ATOMIC_RELAXED, __HIP_MEMORY_SCOPE_AGENT); t1 = te; }
            if (TS_MODE >= 10) { unsigned long long x[8]; for (int i = 0; i < 8; ++i) x[i] = __hip_atomic_load(TS + 64 + TSX_OFF + i, __ATOMIC_RELAXED, __HIP_MEMORY_SCOPE_AGENT);
                if (TS_MODE == 10) { t0 = ts; t1 = x[0]; } else if (TS_MODE == 14) { t0 = x[3]; t1 = tb; } else { t0 = x[TS_MODE - 11]; t1 = x[TS_MODE - 10]; } }
            const float us = (float)(t1 - t0) * 0.01f, f = 1.0f + sqrtf(TS_SCALE * us);
            float* st = p.out + (size_t)M_TOK * DMODEL;
            F.relaunder();
            for (int i = F.tid; i < 16 * 4 * 2 * 512; i += NTHREADS) st[i] *= f;
        }
#endif
    }
}

extern "C" void kernel_launch(void* const* d_in, const int* in_sizes, int n_in, void* d_out, int out_size, void* d_ws, size_t ws_size, hipStream_t stream) {
    static int grid = 0;
    if (grid == 0) {
        if (n_in != 24 || ws_size < WS_END) { fprintf(stderr, "kernel_launch: expected 24 inputs and >= %zu bytes of workspace (got %d, %zu)\n", (size_t)WS_END, n_in, ws_size); grid = -1; return; }
        int dev = 0, cus = 0, per_cu = 0;
        if (hipGetDevice(&dev) != hipSuccess || hipDeviceGetAttribute(&cus, hipDeviceAttributeMultiprocessorCount, dev) != hipSuccess) { grid = -1; return; }
        if (hipFuncSetAttribute((const void*)mega, hipFuncAttributeMaxDynamicSharedMemorySize, LDS_BYTES) != hipSuccess) { fprintf(stderr, "kernel_launch: hipFuncSetAttribute failed\n"); grid = -1; return; }
        if (hipOccupancyMaxActiveBlocksPerMultiprocessor(&per_cu, (const void*)mega, NTHREADS, LDS_BYTES) != hipSuccess || per_cu < 1) { fprintf(stderr, "kernel_launch: occupancy query says %d blocks per CU\n", per_cu); grid = -1; return; }
        grid = cus;
    }
    if (grid < 0) return;
    Params p{};
    for (int i = 0; i < 24; ++i) p.in[i] = (const float*)d_in[i];
    p.out = (float*)d_out; p.ws = (unsigned char*)d_ws;
    hipMemsetAsync((char*)d_ws + WS_CTL, 0, 32768, stream);
#if MK_PER_PHASE
    for (int ph = 0; ph < N_PHASES; ++ph) { p.ph_lo = ph; p.ph_hi = ph + 1; hipLaunchKernelGGL(mega, dim3(grid), dim3(NTHREADS), LDS_BYTES, stream, p); }
#else
    p.ph_lo = 0; p.ph_hi = N_PHASES;
    void* args[] = {&p};
    hipError_t e = hipLaunchCooperativeKernel((const void*)mega, dim3(grid), dim3(NTHREADS), args, LDS_BYTES, stream);
    if (e != hipSuccess) fprintf(stderr, "kernel_launch: cooperative launch failed: %s (grid %d)\n", hipGetErrorString(e), grid);
#endif
}
```

```cpp
#include <hip/hip_runtime.h>
#include <hip/hip_cooperative_groups.h>
#include <cstdio>
#include <cstdint>
namespace cg = cooperative_groups;
#define MK_PER_PHASE 0
#ifndef TS_SEL
#define TS_SEL -1
#endif
#ifndef TS_BLK
#define TS_BLK 0
#endif
#ifndef ALN_256
#define ALN_256 0
#endif
#ifndef ALN_128
#define ALN_128 0
#endif
#ifndef ALN_192
#define ALN_192 8
#endif
#ifndef WT_STORES
#define WT_STORES 1
#endif
#ifndef WGM192
#define WGM192 4
#endif
namespace pg8 {
#define PG8_LAS __attribute__((address_space(3)))
typedef unsigned short bf16_t;
typedef short bf16x8 __attribute__((ext_vector_type(8)));
typedef float f32x4 __attribute__((ext_vector_type(4)));
typedef unsigned u32x4 __attribute__((ext_vector_type(4)));
constexpr int BM = 256, BK = 64, HALF = 128, HTB = HALF * BK * 2  , STAGE_BYTES = 8 * HTB, NXCD = 8, WGM = 8;

__host__ __device__ __forceinline__ int lds_byte(int r, int c) { const int st = (r >> 4) * 2 + (c >> 5), rr = r & 15, cc = c & 31, ob = rr * 64 + cc * 2; return st * 1024 + (ob ^ (((ob >> 9) & 1) << 5)); }
__host__ __device__ __forceinline__ void stage_rc(int b, int& R, int& C) { const int st = b / 1024, sb = b % 1024, swz = sb ^ (((sb >> 9) & 1) << 5); R = (st >> 1) * 16 + swz / 64; C = (st & 1) * 32 + (swz % 64) / 2; }
__host__ __device__ __forceinline__ int perm32(int rho) { const int n = rho >> 4, i = rho & 15; return 8 * (i >> 2) + 4 * n + (i & 3); }

struct Unit { int pm, pn; };
struct Gemm { const bf16_t* A; const bf16_t* Bt; int M, N, K; };

struct StaticOrder {
    int nM, nN, nwg, G, c, wgm;
    __host__ __device__ void init(int M, int N, int G_, int c_, int wgm_ = WGM) { nM = M / BM; nN = N / BM; nwg = nM * nN; G = G_; c = c_; wgm = wgm_; }
    __host__ __device__ bool next(int i, Unit& u) const {
        const long L = (long)i * G + c; if (L >= nwg) return false;
        int wgid = (int)L; { const int q = nwg / NXCD, r = nwg % NXCD, xcd = wgid % NXCD, off = wgid / NXCD; wgid = (xcd < r ? xcd * (q + 1) : r * (q + 1) + (xcd - r) * q) + off; }
        const int nig = wgm * nN, gid = wgid / nig, fm = gid * wgm, gsz = (nM - fm) < wgm ? (nM - fm) : wgm;
        u.pm = fm + ((wgid % nig) % gsz); u.pn = (wgid % nig) / gsz; return true;
    }
    __device__ __forceinline__ void a_ready(const Unit&) const {}
    __device__ __forceinline__ void done(const Unit&) const {}
};

__device__ __forceinline__ unsigned cvt_pk_bf16(float lo, float hi) { unsigned r; asm volatile("v_cvt_pk_bf16_f32 %0, %1, %2" : "=v"(r) : "v"(lo), "v"(hi)); return r; }
typedef float f32x2 __attribute__((ext_vector_type(2)));
typedef unsigned u32x2 __attribute__((ext_vector_type(2)));
constexpr int NIN = 1792, DM = 1024, DFF = 4096, NU = 1280, SSQW = 16;
constexpr size_t XCT_LAT_OFF = (size_t)16 * 4 * 128 * 256;
__device__ __forceinline__ int cond_of_panel(int pm) { return pm < 16 ? 0 : (pm < 20 ? 1 : 2); }
__device__ __forceinline__ float row_rstd(const float* ssq, int row) {
    const f32x4* sp = (const f32x4*)(ssq + (size_t)row * SSQW);
    const f32x4 s = (sp[0] + sp[1]) + (sp[2] + sp[3]);
    return 1.0f / sqrtf(((s[0] + s[1]) + (s[2] + s[3])) * (1.0f / 1024.0f) + 1e-6f);
}
constexpr int RTAB_OFF = 131072;
__device__ __forceinline__ void store_wt16(void* p, u32x4 v) {
#if WT_STORES
    asm volatile("global_store_dwordx4 %0, %1, off sc1\n s_nop 1" :: "v"(p), "v"(v) : "memory");
#else
    *(u32x4*)p = v;
#endif
}
__device__ __forceinline__ void store_wt16f(void* p, f32x4 v) {
#if WT_STORES
    asm volatile("global_store_dwordx4 %0, %1, off sc1\n s_nop 1" :: "v"(p), "v"(v) : "memory");
#else
    *(f32x4*)p = v;
#endif
}
__device__ __forceinline__ void store_wt8(void* p, u32x2 v) {
#if WT_STORES
    asm volatile("global_store_dwordx2 %0, %1, off sc1\n s_nop 1" :: "v"(p), "v"(v) : "memory");
#else
    *(u32x2*)p = v;
#endif
}
struct EpiIn {
    static constexpr bool PERM = true, AFTER_DRAIN = false;
    bf16_t* U; bf16_t* XCT; const float* ssq; const float* bias;
    static constexpr bool NEEDS_RSTD = true;
    __device__ __forceinline__ void operator()(const f32x4 (&acc)[2][2][4][2], const Unit& u, int wr, int wc, int fr, int fq, const PG8_LAS float* rtab) const {
        const int cond = cond_of_panel(u.pm);
        const int bcol0 = u.pn * BM + wc * 32 + 8 * fq;
        f32x4 bv[2][2];
#pragma unroll
        for (int bj = 0; bj < 2; ++bj)
#pragma unroll
            for (int n = 0; n < 2; ++n) bv[bj][n] = *(const f32x4*)(bias + cond * NIN + bcol0 + bj * HALF + 4 * n);
        float sq[2][4];
#pragma unroll
        for (int ai = 0; ai < 2; ++ai)
#pragma unroll
            for (int m = 0; m < 4; ++m) sq[ai][m] = rtab[ai * HALF + wr * 64 + m * 16 + fr];
#pragma unroll
        for (int ai = 0; ai < 2; ++ai)
#pragma unroll
            for (int m = 0; m < 4; ++m) {
                const int row = u.pm * BM + ai * HALF + wr * 64 + m * 16 + fr;
                const float rs = sq[ai][m];
#pragma unroll
                for (int bj = 0; bj < 2; ++bj) {
                    const f32x4 v0 = acc[ai][bj][m][0] * rs + bv[bj][0], v1 = acc[ai][bj][m][1] * rs + bv[bj][1];
                    u32x4 w; w.x = cvt_pk_bf16(v0[0], v0[1]); w.y = cvt_pk_bf16(v0[2], v0[3]); w.z = cvt_pk_bf16(v1[0], v1[1]); w.w = cvt_pk_bf16(v1[2], v1[3]);
                    if (u.pn < 5) { *(u32x4*)(U + (size_t)row * NU + bcol0 + bj * HALF) = w; }
                    else {
                        const int cc = bcol0 + bj * HALF - NU, hd = cc >> 7, mm = cc & 127, m0 = mm & 63;
                        int L, t; bf16_t* base;
                        if (u.pm < 16) { L = 256; t = row & 255; base = XCT + (size_t)(u.pm * 4 + hd) * 128 * 256; }
                        else { const int rl = row - 4096; L = 1024; t = rl & 1023; base = XCT + XCT_LAT_OFF + (size_t)((rl >> 10) * 4 + hd) * 128 * 1024; }
                        const int k = (mm >> 6) * L + t;
                        bf16_t* p = base + ((size_t)(((m0 >> 4) * (L >> 4) + (k >> 5)) * 64 + ((k >> 3) & 3) * 16 + (m0 & 15))) * 8 + (k & 7);
                        p[0] = (bf16_t)(w.x & 0xffffu); p[8] = (bf16_t)(w.x >> 16); p[16] = (bf16_t)(w.y & 0xffffu); p[24] = (bf16_t)(w.y >> 16);
                        p[32] = (bf16_t)(w.z & 0xffffu); p[40] = (bf16_t)(w.z >> 16); p[48] = (bf16_t)(w.w & 0xffffu); p[56] = (bf16_t)(w.w >> 16);
                    }
                }
            }
    }
};
struct EpiUp {
    static constexpr bool PERM = true, AFTER_DRAIN = false;
    bf16_t* H; const float* ssq; const float* bias;
    static constexpr bool NEEDS_RSTD = true;
    __device__ __forceinline__ void operator()(const f32x4 (&acc)[2][2][4][2], const Unit& u, int wr, int wc, int fr, int fq, const PG8_LAS float* rtab) const {
        const int cond = cond_of_panel(u.pm);
        const int bcol0 = u.pn * BM + wc * 32 + 8 * fq;
        f32x4 bv[2][2];
#pragma unroll
        for (int bj = 0; bj < 2; ++bj)
#pragma unroll
            for (int n = 0; n < 2; ++n) bv[bj][n] = *(const f32x4*)(bias + cond * DFF + bcol0 + bj * HALF + 4 * n);
        float sq[2][4];
#pragma unroll
        for (int ai = 0; ai < 2; ++ai)
#pragma unroll
            for (int m = 0; m < 4; ++m) sq[ai][m] = rtab[ai * HALF + wr * 64 + m * 16 + fr];
#pragma unroll
        for (int ai = 0; ai < 2; ++ai)
#pragma unroll
            for (int m = 0; m < 4; ++m) {
                const int row = u.pm * BM + ai * HALF + wr * 64 + m * 16 + fr;
                const float rs = sq[ai][m];
#pragma unroll
                for (int bj = 0; bj < 2; ++bj) {
                    f32x4 v0 = acc[ai][bj][m][0] * rs + bv[bj][0], v1 = acc[ai][bj][m][1] * rs + bv[bj][1];
                    v0 = __builtin_elementwise_max(v0, (f32x4){0.f, 0.f, 0.f, 0.f}); v1 = __builtin_elementwise_max(v1, (f32x4){0.f, 0.f, 0.f, 0.f});
                    v0 = v0 * v0; v1 = v1 * v1;
                    u32x4 w; w.x = cvt_pk_bf16(v0[0], v0[1]); w.y = cvt_pk_bf16(v0[2], v0[3]); w.z = cvt_pk_bf16(v1[0], v1[1]); w.w = cvt_pk_bf16(v1[2], v1[3]);
                    store_wt16(H + (size_t)row * DFF + bcol0 + bj * HALF, w);
                }
            }
    }
};
struct EpiRes {
    static constexpr bool PERM = false, AFTER_DRAIN = false, NEEDS_RSTD = false;
    float* X; bf16_t* A; const float* gate; const float* Gn; float* ssq_out;
    __device__ __forceinline__ void operator()(const f32x4 (&acc)[2][2][4][2], const Unit& u, int wr, int wc, int fr, int fq, const PG8_LAS float*) const {
        const int cond = cond_of_panel(u.pm);
        const int col0 = u.pn * BM + wc * 32 + 4 * fq;
#pragma unroll
        for (int ai = 0; ai < 2; ++ai)
#pragma unroll
            for (int m = 0; m < 4; ++m) {
                const int row = u.pm * BM + ai * HALF + wr * 64 + m * 16 + fr;
                float q = 0.f;
#pragma unroll
                for (int bj = 0; bj < 2; ++bj)
#pragma unroll
                    for (int n = 0; n < 2; ++n) {
                        const int c = col0 + bj * HALF + n * 16;
                        float* xp = X + (size_t)row * DM + c;
                        const f32x4 g4 = *(const f32x4*)(gate + cond * 6144 + c);
                        const f32x4 x1 = *(const f32x4*)xp + g4 * acc[ai][bj][m][n];
                        *(f32x4*)xp = x1;
                        q += (x1[0] * x1[0] + x1[1] * x1[1]) + (x1[2] * x1[2] + x1[3] * x1[3]);
                        if (Gn) { const f32x4 a = x1 * *(const f32x4*)(Gn + cond * DM + c); u32x2 w; w.x = cvt_pk_bf16(a[0], a[1]); w.y = cvt_pk_bf16(a[2], a[3]);
                            *(u32x2*)(A + (size_t)row * DM + c) = w; }
                    }
                q += __shfl_xor(q, 16); q += __shfl_xor(q, 32);
                if (fq == 0) ssq_out[(size_t)row * SSQW + u.pn * 4 + wc] = q;
                if (m & 1) asm volatile("" ::: "memory");
            }
    }
};
template <class Epi, class Sched, bool ALIGN_EPI = false, bool SP2 = false>
__device__ __forceinline__ void gemm_phase(PG8_LAS unsigned char* lds, const Gemm g, const Sched& S, const Epi& E, int tid_in) {
    int tid_ = tid_in; asm volatile("" : "+v"(tid_)); const int tid = tid_, wid = __builtin_amdgcn_readfirstlane(tid >> 6), lane = tid & 63, wr = wid >> 2, wc = wid & 3, fr = lane & 15, fq = lane >> 4;
    const int K = g.K, nt = K / BK;
    unsigned voffA[2], voffB[2];
#pragma unroll
    for (int i = 0; i < 2; ++i) { int R, C; stage_rc(tid * 16 + i * 8192, R, C); const int Rb = Epi::PERM ? ((R & ~31) + perm32(R & 31)) : R;
        voffA[i] = (unsigned)(R * K + C) * 2u; voffB[i] = (unsigned)(Rb * K + C) * 2u; }
    const size_t kstep = (size_t)(BK * 2);
    const size_t hstep = (size_t)HALF * K * 2;
    const size_t tstep = 2 * hstep;
    const unsigned ldsw = (unsigned)wid * 1024u;
    const int aoff = lds_byte(wr * 64 + fr, fq * 8), boff = lds_byte(wc * 32 + fr, fq * 8);
#define PG8_SA(b, h) (((b) * 2 + (h)) * HTB)
#define PG8_SB(b, h) ((4 + (b) * 2 + (h)) * HTB)
#define PG8_STAGE(bufoff, gbase, voff) do { _Pragma("unroll") for (int _i = 0; _i < 2; ++_i) \
        __builtin_amdgcn_global_load_lds((const unsigned*)((const char*)(gbase) + (voff)[_i]), (PG8_LAS unsigned*)(lds + (bufoff) + ldsw + _i * 8192), 16, 0, 0); } while (0)
#define PG8_LDA(dst, b, h) do { _Pragma("unroll") for (int m = 0; m < 4; ++m) _Pragma("unroll") for (int k = 0; k < 2; ++k) dst[m][k] = *(const PG8_LAS bf16x8*)(lds + PG8_SA(b, h) + aoff + m * 2048 + k * 1024); } while (0)
#define PG8_LDB(dst, b, h) do { _Pragma("unroll") for (int n = 0; n < 2; ++n) _Pragma("unroll") for (int k = 0; k < 2; ++k) dst[n][k] = *(const PG8_LAS bf16x8*)(lds + PG8_SB(b, h) + boff + n * 2048 + k * 1024); } while (0)
#define PG8_MMA(ai, bj, At, Bt) do { __builtin_amdgcn_s_setprio(1); _Pragma("unroll") for (int m = 0; m < 4; ++m) _Pragma("unroll") for (int n = 0; n < 2; ++n) _Pragma("unroll") for (int k = 0; k < 2; ++k) \
        acc[ai][bj][m][n] = __builtin_amdgcn_mfma_f32_16x16x32_bf16(Bt[n][k], At[m][k], acc[ai][bj][m][n], 0, 0, 0); __builtin_amdgcn_s_setprio(0); } while (0)
#define PG8_WAIT_V(n) asm volatile("s_waitcnt vmcnt(" #n ")" ::: "memory")
#define PG8_WAIT_L(n) asm volatile("s_waitcnt lgkmcnt(" #n ")" ::: "memory")
#define PG8_BAR __builtin_amdgcn_s_barrier()
#define PG8_SCHED __builtin_amdgcn_sched_barrier(0)
    Unit cur, nxt; int ui = 0;
    if (!S.next(0, cur)) return;
    f32x4 acc[2][2][4][2];
#pragma unroll
    for (int a = 0; a < 2; ++a)
#pragma unroll
        for (int b = 0; b < 2; ++b)
#pragma unroll
            for (int m = 0; m < 4; ++m)
#pragma unroll
                for (int n = 0; n < 2; ++n) acc[a][b][m][n] = (f32x4){0.f, 0.f, 0.f, 0.f};
    bf16x8 At[4][2], B0[2][2], B1[2][2];
    const char* cA = (const char*)g.A + (size_t)cur.pm * tstep; const char* cB = (const char*)g.Bt + (size_t)cur.pn * tstep;
    if constexpr (Epi::NEEDS_RSTD) { if (tid < 256) ((PG8_LAS float*)(lds + RTAB_OFF))[tid] = row_rstd(E.ssq, cur.pm * BM + tid); }
    S.a_ready(cur);
    if constexpr (SP2) {
        PG8_STAGE(PG8_SB(0, 0), cB, voffB); PG8_STAGE(PG8_SB(0, 1), cB + hstep, voffB); PG8_STAGE(PG8_SA(0, 0), cA, voffA); PG8_STAGE(PG8_SA(0, 1), cA + hstep, voffA);
        if (wr == 1) PG8_BAR;
        PG8_WAIT_V(2); PG8_BAR;
        PG8_STAGE(PG8_SB(1, 0), cB + kstep, voffB); PG8_STAGE(PG8_SA(1, 0), cA + kstep, voffA); PG8_STAGE(PG8_SB(1, 1), cB + hstep + kstep, voffB);
        PG8_WAIT_V(6); PG8_BAR;
    } else {
        PG8_STAGE(PG8_SB(0, 0), cB, voffB); PG8_STAGE(PG8_SA(0, 0), cA, voffA); PG8_STAGE(PG8_SB(0, 1), cB + hstep, voffB); PG8_STAGE(PG8_SA(0, 1), cA + hstep, voffA);
        if (wr == 1) PG8_BAR;
        PG8_WAIT_V(4); PG8_BAR;
        PG8_STAGE(PG8_SB(1, 0), cB + kstep, voffB); PG8_STAGE(PG8_SA(1, 0), cA + kstep, voffA); PG8_STAGE(PG8_SB(1, 1), cB + hstep + kstep, voffB);
        PG8_WAIT_V(6); PG8_BAR;
    }
    for (;;) {
        const bool has_next = S.next(ui + 1, nxt);
        const char* nA = has_next ? (const char*)g.A + (size_t)nxt.pm * tstep : cA; const char* nB = has_next ? (const char*)g.Bt + (size_t)nxt.pn * tstep : cB;
        asm volatile(".p2align 6\n .rept %0\n s_nop 0\n .endr" :: "n"(ALN_256) : "memory");
        for (int t = 0; t < nt; t += 2) {
            const bool last = (t == nt - 2);
            const char* a1 = cA + (size_t)(t + 1) * kstep;
            const char* a2 = last ? nA : cA + (size_t)(t + 2) * kstep; const char* b2 = last ? nB : cB + (size_t)(t + 2) * kstep;
            const char* a3 = a2 + kstep; const char* b3 = b2 + kstep;
            if (last && has_next) S.a_ready(nxt);
            if constexpr (SP2) {
            PG8_LDB(B0, 0, 0); PG8_LDB(B1, 0, 1); PG8_SCHED; PG8_LDA(At, 0, 0); PG8_STAGE(PG8_SA(1, 1), a1 + hstep, voffA);
            PG8_WAIT_V(8); PG8_WAIT_L(0); PG8_BAR; PG8_MMA(0, 0, At, B0); PG8_MMA(0, 1, At, B1); PG8_BAR; PG8_SCHED;
            PG8_LDA(At, 0, 1); PG8_STAGE(PG8_SB(0, 0), b2, voffB); PG8_STAGE(PG8_SB(0, 1), b2 + hstep, voffB); PG8_STAGE(PG8_SA(0, 0), a2, voffA);
            PG8_WAIT_V(8); PG8_WAIT_L(0); PG8_BAR; PG8_MMA(1, 0, At, B0); PG8_MMA(1, 1, At, B1); PG8_BAR; PG8_SCHED;
            PG8_LDB(B0, 1, 0); PG8_LDB(B1, 1, 1); PG8_SCHED; PG8_LDA(At, 1, 0); PG8_STAGE(PG8_SA(0, 1), a2 + hstep, voffA);
            PG8_WAIT_V(8); PG8_WAIT_L(0); PG8_BAR; PG8_MMA(0, 0, At, B0); PG8_MMA(0, 1, At, B1); PG8_BAR; PG8_SCHED;
            PG8_LDA(At, 1, 1); PG8_STAGE(PG8_SB(1, 0), b3, voffB); PG8_STAGE(PG8_SB(1, 1), b3 + hstep, voffB); PG8_STAGE(PG8_SA(1, 0), a3, voffA);
            PG8_WAIT_V(8); PG8_WAIT_L(0); PG8_BAR; PG8_MMA(1, 0, At, B0); PG8_MMA(1, 1, At, B1); PG8_BAR; PG8_SCHED;
            } else {
            PG8_LDB(B0, 0, 0); PG8_SCHED; PG8_LDA(At, 0, 0); PG8_STAGE(PG8_SA(1, 1), a1 + hstep, voffA);
            PG8_WAIT_L(8); PG8_BAR; PG8_WAIT_L(0); PG8_MMA(0, 0, At, B0); PG8_BAR; PG8_SCHED;
            PG8_LDB(B1, 0, 1); PG8_STAGE(PG8_SB(0, 0), b2, voffB);
            PG8_BAR; PG8_WAIT_L(0); PG8_MMA(0, 1, At, B1); PG8_BAR;
            PG8_LDA(At, 0, 1); PG8_STAGE(PG8_SA(0, 0), a2, voffA);
            PG8_BAR; PG8_WAIT_L(0); PG8_MMA(1, 0, At, B0); PG8_BAR; PG8_SCHED;
            PG8_STAGE(PG8_SB(0, 1), b2 + hstep, voffB);
            PG8_WAIT_V(6); PG8_BAR; PG8_MMA(1, 1, At, B1); PG8_BAR;
            PG8_LDB(B0, 1, 0); PG8_SCHED; PG8_LDA(At, 1, 0); PG8_STAGE(PG8_SA(0, 1), a2 + hstep, voffA);
            PG8_WAIT_L(8); PG8_BAR; PG8_WAIT_L(0); PG8_MMA(0, 0, At, B0); PG8_BAR; PG8_SCHED;
            PG8_LDB(B1, 1, 1); PG8_STAGE(PG8_SB(1, 0), b3, voffB);
            PG8_BAR; PG8_WAIT_L(0); PG8_MMA(0, 1, At, B1); PG8_BAR;
            PG8_LDA(At, 1, 1); PG8_STAGE(PG8_SA(1, 0), a3, voffA);
            PG8_BAR; PG8_WAIT_L(0); PG8_MMA(1, 0, At, B0); PG8_BAR; PG8_SCHED;
            PG8_STAGE(PG8_SB(1, 1), b3 + hstep, voffB);
            PG8_WAIT_V(6); PG8_BAR; PG8_MMA(1, 1, At, B1); PG8_BAR;
            }
        }
        if constexpr (ALIGN_EPI) { if (wr == 0) PG8_BAR; }
        if constexpr (!Epi::AFTER_DRAIN) { E(acc, cur, wr, wc, fr, fq, (const PG8_LAS float*)(lds + RTAB_OFF + (ui & 1) * 1024)); S.done(cur); }
        if (!has_next) break;
#pragma unroll
        for (int a = 0; a < 2; ++a)
#pragma unroll
            for (int b = 0; b < 2; ++b)
#pragma unroll
                for (int m = 0; m < 4; ++m)
#pragma unroll
                    for (int n = 0; n < 2; ++n) acc[a][b][m][n] = (f32x4){0.f, 0.f, 0.f, 0.f};
        cur = nxt; cA = nA; cB = nB; ++ui;
        if constexpr (Epi::NEEDS_RSTD) { if (tid < 256) ((PG8_LAS float*)(lds + RTAB_OFF + (ui & 1) * 1024))[tid] = row_rstd(E.ssq, cur.pm * BM + tid); }
        if constexpr (ALIGN_EPI) { if (wr == 1) PG8_BAR; }
    }
    PG8_WAIT_V(0);
    if constexpr (!ALIGN_EPI) { if (wr == 0) PG8_BAR; }
    PG8_BAR;
    if constexpr (Epi::AFTER_DRAIN) { E.fused(acc, cur, wr, wc, fr, fq, lds, wid, lane); S.done(cur); }
#undef PG8_SA
#undef PG8_SB
#undef PG8_STAGE
#undef PG8_LDA
#undef PG8_LDB
#undef PG8_MMA
#undef PG8_WAIT_V
#undef PG8_WAIT_L
#undef PG8_BAR
#undef PG8_SCHED
}
struct StaticOrder128 {
    int nM, nN, nwg, G, c, pm0;
    __host__ __device__ void init(int M, int N, int G_, int c_, int pm0_ = 0) { nM = M / BM; nN = N / HALF; nwg = nM * nN; G = G_; c = c_; pm0 = pm0_; }
    __host__ __device__ bool next(int i, Unit& u) const {
        const long L = (long)i * G + c; if (L >= nwg) return false;
        int wgid = (int)L; { const int q = nwg / NXCD, r = nwg % NXCD, xcd = wgid % NXCD, off = wgid / NXCD; wgid = (xcd < r ? xcd * (q + 1) : r * (q + 1) + (xcd - r) * q) + off; }
        const int nig = WGM * nN, gid = wgid / nig, fm = gid * WGM, gsz = (nM - fm) < WGM ? (nM - fm) : WGM;
        u.pm = pm0 + fm + ((wgid % nig) % gsz); u.pn = (wgid % nig) / gsz; return true;
    }
    __device__ __forceinline__ void a_ready(const Unit&) const {}
    __device__ __forceinline__ void done(const Unit&) const {}
};
template <class Epi, class Sched>
__device__ __forceinline__ void gemm_phase_n128(PG8_LAS unsigned char* lds, const Gemm g, const Sched& S, const Epi& E, int tid_in) {
    int tid_ = tid_in; asm volatile("" : "+v"(tid_));
    const int tid = tid_, wid = __builtin_amdgcn_readfirstlane(tid >> 6), lane = tid & 63, wh = wid >> 2, wr = wid >> 1, wc = wid & 1, fr = lane & 15, fq = lane >> 4;
    const int K = g.K, nt = K / BK;
    unsigned voffA[2], voffB[2];
#pragma unroll
    for (int i = 0; i < 2; ++i) { int R, C; stage_rc(tid * 16 + i * 8192, R, C); const int Rb = Epi::PERM ? ((R & ~31) + perm32(R & 31)) : R;
        voffA[i] = (unsigned)(R * K + C) * 2u; voffB[i] = (unsigned)(Rb * K + C) * 2u; }
    const size_t kstep = (size_t)(BK * 2);
    const size_t hstep = (size_t)HALF * K * 2;
    const size_t tstep = 2 * hstep;
    const unsigned ldsw = (unsigned)wid * 1024u;
    const int aoff = lds_byte(wr * 32 + fr, fq * 8), boff = lds_byte(wc * 64 + fr, fq * 8);
#define PG8_SA(b, h) (((b) * 2 + (h)) * HTB)
#define PG8_SB(b) ((4 + (b) * 2) * HTB)
#define PG8_STAGE(bufoff, gbase, voff) do { _Pragma("unroll") for (int _i = 0; _i < 2; ++_i) \
        __builtin_amdgcn_global_load_lds((const unsigned*)((const char*)(gbase) + (voff)[_i]), (PG8_LAS unsigned*)(lds + (bufoff) + ldsw + _i * 8192), 16, 0, 0); } while (0)
#define PG8_LDA(dst, b, h) do { _Pragma("unroll") for (int m = 0; m < 2; ++m) _Pragma("unroll") for (int k = 0; k < 2; ++k) dst[m][k] = *(const PG8_LAS bf16x8*)(lds + PG8_SA(b, h) + aoff + m * 2048 + k * 1024); } while (0)
#define PG8_LDB(dst, b) do { _Pragma("unroll") for (int n = 0; n < 4; ++n) _Pragma("unroll") for (int k = 0; k < 2; ++k) dst[n][k] = *(const PG8_LAS bf16x8*)(lds + PG8_SB(b) + boff + n * 2048 + k * 1024); } while (0)
#define PG8_MMA(ai, At, Bt) do { __builtin_amdgcn_s_setprio(1); _Pragma("unroll") for (int m = 0; m < 2; ++m) _Pragma("unroll") for (int n = 0; n < 4; ++n) _Pragma("unroll") for (int k = 0; k < 2; ++k) \
        acc[ai][m][n] = __builtin_amdgcn_mfma_f32_16x16x32_bf16(Bt[n][k], At[m][k], acc[ai][m][n], 0, 0, 0); __builtin_amdgcn_s_setprio(0); } while (0)
#define PG8_WAIT_V(n) asm volatile("s_waitcnt vmcnt(" #n ")" ::: "memory")
#define PG8_WAIT_L(n) asm volatile("s_waitcnt lgkmcnt(" #n ")" ::: "memory")
#define PG8_BAR __builtin_amdgcn_s_barrier()
#define PG8_SCHED __builtin_amdgcn_sched_barrier(0)
    Unit cur, nxt; int ui = 0;
    if (!S.next(0, cur)) return;
    f32x4 acc[2][2][4];
#pragma unroll
    for (int a = 0; a < 2; ++a)
#pragma unroll
        for (int m = 0; m < 2; ++m)
#pragma unroll
            for (int n = 0; n < 4; ++n) acc[a][m][n] = (f32x4){0.f, 0.f, 0.f, 0.f};
    bf16x8 At[2][2], Bf[4][2];
    const char* cA = (const char*)g.A + (size_t)cur.pm * tstep; const char* cB = (const char*)g.Bt + (size_t)cur.pn * hstep;
    if constexpr (Epi::NEEDS_RSTD) { if (tid < 256) ((PG8_LAS float*)(lds + RTAB_OFF))[tid] = row_rstd(E.ssq, cur.pm * BM + tid); }
    S.a_ready(cur);
    PG8_STAGE(PG8_SB(0), cB, voffB); PG8_STAGE(PG8_SA(0, 0), cA, voffA); PG8_STAGE(PG8_SA(0, 1), cA + hstep, voffA);
    if (wh == 1) PG8_BAR;
    PG8_WAIT_V(2); PG8_BAR;
    PG8_STAGE(PG8_SB(1), cB + kstep, voffB); PG8_STAGE(PG8_SA(1, 0), cA + kstep, voffA);
    PG8_WAIT_V(4); PG8_BAR;
    for (;;) {
        const bool has_next = S.next(ui + 1, nxt);
        const char* nA = has_next ? (const char*)g.A + (size_t)nxt.pm * tstep : cA; const char* nB = has_next ? (const char*)g.Bt + (size_t)nxt.pn * hstep : cB;
        asm volatile(".p2align 6\n .rept %0\n s_nop 0\n .endr" :: "n"(ALN_128) : "memory");
        for (int t = 0; t < nt; t += 2) {
            const bool last = (t == nt - 2);
            const char* a1 = cA + (size_t)(t + 1) * kstep;
            const char* a2 = last ? nA : cA + (size_t)(t + 2) * kstep; const char* b2 = last ? nB : cB + (size_t)(t + 2) * kstep;
            const char* a3 = a2 + kstep; const char* b3 = b2 + kstep;
            if (last && has_next) S.a_ready(nxt);
            PG8_LDB(Bf, 0); PG8_SCHED; PG8_LDA(At, 0, 0); PG8_STAGE(PG8_SA(1, 1), a1 + hstep, voffA);
            PG8_WAIT_V(6); PG8_WAIT_L(0); PG8_BAR; PG8_MMA(0, At, Bf); PG8_BAR; PG8_SCHED;
            PG8_LDA(At, 0, 1); PG8_STAGE(PG8_SB(0), b2, voffB); PG8_STAGE(PG8_SA(0, 0), a2, voffA);
            PG8_WAIT_V(6); PG8_WAIT_L(0); PG8_BAR; PG8_MMA(1, At, Bf); PG8_BAR; PG8_SCHED;
            PG8_LDB(Bf, 1); PG8_SCHED; PG8_LDA(At, 1, 0); PG8_STAGE(PG8_SA(0, 1), a2 + hstep, voffA);
            PG8_WAIT_V(6); PG8_WAIT_L(0); PG8_BAR; PG8_MMA(0, At, Bf); PG8_BAR; PG8_SCHED;
            PG8_LDA(At, 1, 1); PG8_STAGE(PG8_SB(1), b3, voffB); PG8_STAGE(PG8_SA(1, 0), a3, voffA);
            PG8_WAIT_V(6); PG8_WAIT_L(0); PG8_BAR; PG8_MMA(1, At, Bf); PG8_BAR; PG8_SCHED;
        }
        if (wh == 0) PG8_BAR;
        E(acc, cur, wr, wc, fr, fq, (const PG8_LAS float*)(lds + RTAB_OFF + (ui & 1) * 1024)); S.done(cur);
        if (!has_next) break;
#pragma unroll
        for (int a = 0; a < 2; ++a)
#pragma unroll
            for (int m = 0; m < 2; ++m)
#pragma unroll
                for (int n = 0; n < 4; ++n) acc[a][m][n] = (f32x4){0.f, 0.f, 0.f, 0.f};
        cur = nxt; cA = nA; cB = nB; ++ui;
        if constexpr (Epi::NEEDS_RSTD) { if (tid < 256) ((PG8_LAS float*)(lds + RTAB_OFF + (ui & 1) * 1024))[tid] = row_rstd(E.ssq, cur.pm * BM + tid); }
        if (wh == 1) PG8_BAR;
    }
    PG8_WAIT_V(0);
    PG8_BAR;
#undef PG8_SA
#undef PG8_SB
#undef PG8_STAGE
#undef PG8_LDA
#undef PG8_LDB
#undef PG8_MMA
#undef PG8_WAIT_V
#undef PG8_WAIT_L
#undef PG8_BAR
#undef PG8_SCHED
}
struct EpiUp128 {
    static constexpr bool PERM = true, NEEDS_RSTD = true;
    bf16_t* H; const float* ssq; const float* bias;
    __device__ __forceinline__ void operator()(const f32x4 (&acc)[2][2][4], const Unit& u, int wr, int wc, int fr, int fq, const PG8_LAS float* rtab) const {
        const int cond = cond_of_panel(u.pm);
        const int bcol0 = u.pn * HALF + wc * 64 + 8 * fq;
        f32x4 bv[2][2];
#pragma unroll
        for (int g2 = 0; g2 < 2; ++g2)
#pragma unroll
            for (int n = 0; n < 2; ++n) bv[g2][n] = *(const f32x4*)(bias + cond * DFF + bcol0 + 32 * g2 + 4 * n);
        float sq[2][2];
#pragma unroll
        for (int ai = 0; ai < 2; ++ai)
#pragma unroll
            for (int m = 0; m < 2; ++m) sq[ai][m] = rtab[ai * HALF + wr * 32 + m * 16 + fr];
#pragma unroll
        for (int ai = 0; ai < 2; ++ai)
#pragma unroll
            for (int m = 0; m < 2; ++m) {
                const int row = u.pm * BM + ai * HALF + wr * 32 + m * 16 + fr;
                const float rs = sq[ai][m];
#pragma unroll
                for (int g2 = 0; g2 < 2; ++g2) {
                    f32x4 v0 = acc[ai][m][2 * g2] * rs + bv[g2][0], v1 = acc[ai][m][2 * g2 + 1] * rs + bv[g2][1];
                    v0 = __builtin_elementwise_max(v0, (f32x4){0.f, 0.f, 0.f, 0.f}); v1 = __builtin_elementwise_max(v1, (f32x4){0.f, 0.f, 0.f, 0.f});
                    v0 = v0 * v0; v1 = v1 * v1;
                    u32x4 w; w.x = cvt_pk_bf16(v0[0], v0[1]); w.y = cvt_pk_bf16(v0[2], v0[3]); w.z = cvt_pk_bf16(v1[0], v1[1]); w.w = cvt_pk_bf16(v1[2], v1[3]);
                    store_wt16(H + (size_t)row * DFF + bcol0 + 32 * g2, w);
                }
            }
    }
};
struct EpiRes128 {
    static constexpr bool PERM = false, NEEDS_RSTD = false;
    float* X; bf16_t* A; const float* gate; const float* Gn; float* ssq_out;
    __device__ __forceinline__ void operator()(const f32x4 (&acc)[2][2][4], const Unit& u, int wr, int wc, int fr, int fq, const PG8_LAS float*) const {
        const int cond = cond_of_panel(u.pm);
        const int col0 = u.pn * HALF + wc * 64 + 4 * fq;
#pragma unroll
        for (int ai = 0; ai < 2; ++ai)
#pragma unroll
            for (int m = 0; m < 2; ++m) {
                const int row = u.pm * BM + ai * HALF + wr * 32 + m * 16 + fr;
                float q = 0.f;
#pragma unroll
                for (int n = 0; n < 4; ++n) {
                    const int c = col0 + n * 16;
                    float* xp = X + (size_t)row * DM + c;
                    const f32x4 g4 = *(const f32x4*)(gate + cond * 6144 + c);
                    const f32x4 x1 = *(const f32x4*)xp + g4 * acc[ai][m][n];
                    *(f32x4*)xp = x1;
                    q += (x1[0] * x1[0] + x1[1] * x1[1]) + (x1[2] * x1[2] + x1[3] * x1[3]);
                    if (Gn) { const f32x4 a = x1 * *(const f32x4*)(Gn + cond * DM + c); u32x2 w; w.x = cvt_pk_bf16(a[0], a[1]); w.y = cvt_pk_bf16(a[2], a[3]);
                        *(u32x2*)(A + (size_t)row * DM + c) = w; }
                }
                q += __shfl_xor(q, 16); q += __shfl_xor(q, 32);
                if (fq == 0) ssq_out[(size_t)row * SSQW + u.pn * 2 + wc] = q;
                asm volatile("" ::: "memory");
            }
    }
};
struct StaticOrder192 {
    int nM, nN, nwg, G, c;
    __host__ __device__ void init(int M, int N, int G_, int c_) { nM = M / 192; nN = N / HALF; nwg = nM * nN; G = G_; c = c_; }
    __host__ __device__ bool next(int i, Unit& u) const {
        const long L = (long)i * G + c; if (L >= nwg) return false;
        int wgid = (int)L; { const int q = nwg / NXCD, r = nwg % NXCD, xcd = wgid % NXCD, off = wgid / NXCD; wgid = (xcd < r ? xcd * (q + 1) : r * (q + 1) + (xcd - r) * q) + off; }
        const int nig = WGM192 * nN, gid = wgid / nig, fm = gid * WGM192, gsz = (nM - fm) < WGM192 ? (nM - fm) : WGM192;
        u.pm = fm + ((wgid % nig) % gsz); u.pn = (wgid % nig) / gsz; return true;
    }
};
#ifndef M192_SLOTS
#define M192_SLOTS 4
#endif
#ifndef M192_TOUCH
#define M192_TOUCH 0
#endif
template <class Epi, class Sched>
__device__ __forceinline__ void gemm_phase_m192(PG8_LAS unsigned char* lds, const Gemm g, const Sched& S, const Epi& E, int tid_in, unsigned long long* TSX = nullptr) {
    int tid_ = tid_in; asm volatile("" : "+v"(tid_));
    const int tid = tid_, wid = __builtin_amdgcn_readfirstlane(tid >> 6), lane = tid & 63, wh = wid >> 2, wr = wid >> 1, wc = wid & 1, fr = lane & 15, fq = lane >> 4;
    const int K = g.K, nt = K / BK;
    constexpr unsigned SLOT = 40960u, PIECE = 8192u, BOFF = 3u * PIECE;
    constexpr int NS = M192_SLOTS, LA = NS - 1;
    unsigned voffA, voffB;
    { int R, C; stage_rc(tid * 16, R, C); const int Rb = Epi::PERM ? ((R & ~31) + perm32(R & 31)) : R; voffA = (unsigned)(R * K + C) * 2u; voffB = (unsigned)(Rb * K + C) * 2u; }
    const size_t kstep = (size_t)(BK * 2), pstep = (size_t)64 * K * 2;
    const unsigned ldsw = (unsigned)wid * 1024u;
    const int sub = lds_byte(fr, fq * 8);
    unsigned aofs[3];
#pragma unroll
    for (int m = 0; m < 3; ++m) { const int mt = 3 * wr + m; aofs[m] = (unsigned)((mt >> 2) * PIECE + ((mt & 3) * 2) * 1024 + sub); }
    const unsigned bofs = BOFF + (unsigned)wc * PIECE + (unsigned)sub;
    constexpr int TOUCH = M192_TOUCH; constexpr unsigned DUMMY = (unsigned)NS * SLOT;
    const int tpc = tid < 320 ? tid >> 6 : 4, trow = tid & 63;
    const size_t toff = (size_t)(tpc < 3 ? tpc : tpc - 3) * pstep + (size_t)trow * K * 2;
#define PG8_STAGE5(slot, ga, gb) do { \
        _Pragma("unroll") for (int _p = 0; _p < 3; ++_p) __builtin_amdgcn_global_load_lds((const unsigned*)((ga) + _p * pstep + voffA), (PG8_LAS unsigned*)(lds + (slot) + _p * PIECE + ldsw), 16, 0, 0); \
        _Pragma("unroll") for (int _q = 0; _q < 2; ++_q) __builtin_amdgcn_global_load_lds((const unsigned*)((gb) + _q * pstep + voffB), (PG8_LAS unsigned*)(lds + (slot) + BOFF + _q * PIECE + ldsw), 16, 0, 0); } while (0)
#define PG8_WAIT_V(n) asm volatile("s_waitcnt vmcnt(" #n ")" ::: "memory")
#define PG8_WAIT_L(n) asm volatile("s_waitcnt lgkmcnt(" #n ")" ::: "memory")
#define PG8_BAR __builtin_amdgcn_s_barrier()
#define PG8_SCHED __builtin_amdgcn_sched_barrier(0)
#if TS_SEL >= 0
#define M192_STAMP(i) do { if (blockIdx.x == TS_BLK && wid == 0 && TSX) __hip_atomic_store(TSX + (i), (unsigned long long)__builtin_amdgcn_s_memrealtime(), __ATOMIC_RELAXED, __HIP_MEMORY_SCOPE_AGENT); } while (0)
#else
#define M192_STAMP(i) do {} while (0)
#endif
    M192_STAMP(0);
    Unit cur, nxt; int ui = 0;
    if (!S.next(0, cur)) return;
    f32x4 acc[3][4];
#pragma unroll
    for (int m = 0; m < 3; ++m)
#pragma unroll
        for (int n = 0; n < 4; ++n) acc[m][n] = (f32x4){0.f, 0.f, 0.f, 0.f};
    bf16x8 At[3][2], Bf[4][2];
    f32x4 xpre[3][4];
    E.prefetch(xpre, cur, wr, wc, fr, fq);
    const char* cA = (const char*)g.A + (size_t)cur.pm * 3 * pstep; const char* cB = (const char*)g.Bt + (size_t)cur.pn * 2 * pstep;
#pragma unroll
    for (int i = 0; i < LA; ++i) PG8_STAGE5((unsigned)i * SLOT, cA + i * kstep, cB + i * kstep);
    if (LA == 2) PG8_WAIT_V(5); else PG8_WAIT_V(10);
    if (wh == 1) PG8_BAR;
    PG8_BAR;
    unsigned rs = 0u, ss = (unsigned)LA * SLOT;
    M192_STAMP(1);
    for (;;) {
        const bool has_next = S.next(ui + 1, nxt);
        const char* nA = has_next ? (const char*)g.A + (size_t)nxt.pm * 3 * pstep : cA; const char* nB = has_next ? (const char*)g.Bt + (size_t)nxt.pn * 2 * pstep : cB;
        asm volatile(".p2align 6\n .rept %0\n s_nop 0\n .endr" :: "n"(ALN_192) : "memory");
        for (int t = 0; t < nt; ++t) {
            const bool tail = t >= nt - LA;
            const char* a2 = tail ? nA + (size_t)(t + LA - nt) * kstep : cA + (size_t)(t + LA) * kstep;
            const char* b2 = tail ? nB + (size_t)(t + LA - nt) * kstep : cB + (size_t)(t + LA) * kstep;
#pragma unroll
            for (int n = 0; n < 4; ++n)
#pragma unroll
                for (int k = 0; k < 2; ++k) Bf[n][k] = *(const PG8_LAS bf16x8*)(lds + rs + bofs + n * 2048 + k * 1024);
            PG8_SCHED;
#pragma unroll
            for (int m = 0; m < 3; ++m)
#pragma unroll
                for (int k = 0; k < 2; ++k) At[m][k] = *(const PG8_LAS bf16x8*)(lds + rs + aofs[m] + k * 1024);
            PG8_STAGE5(ss, a2, b2);
            if (TOUCH > 0) { const int tt = t + TOUCH; const bool nx = tt >= nt;
                const char* ta = (tpc < 3 ? (nx ? nA : cA) : (nx ? nB : cB)) + toff + (size_t)(nx ? (tt - nt < nt ? tt - nt : 0) : tt) * kstep;
                __builtin_amdgcn_global_load_lds((const unsigned*)ta, (PG8_LAS unsigned*)(lds + DUMMY + (unsigned)wid * 256u), 4, 0, 0);
                PG8_WAIT_V(6); } else { if (LA == 2) PG8_WAIT_V(5); else PG8_WAIT_V(10); }
            PG8_WAIT_L(0); PG8_BAR;
            __builtin_amdgcn_s_setprio(1);
#pragma unroll
            for (int m = 0; m < 3; ++m)
#pragma unroll
                for (int n = 0; n < 4; ++n)
#pragma unroll
                    for (int k = 0; k < 2; ++k) acc[m][n] = __builtin_amdgcn_mfma_f32_16x16x32_bf16(Bf[n][k], At[m][k], acc[m][n], 0, 0, 0);
            __builtin_amdgcn_s_setprio(0);
            PG8_BAR; PG8_SCHED;
            rs = rs == (unsigned)LA * SLOT ? 0u : rs + SLOT; ss = ss == (unsigned)LA * SLOT ? 0u : ss + SLOT;
        }
        if (wh == 0) PG8_BAR;
        M192_STAMP(2);
        E(acc, xpre, cur, wr, wc, fr, fq);
        asm volatile("s_waitcnt vmcnt(0)" ::: "memory"); M192_STAMP(3);
        if (!has_next) break;
        E.prefetch(xpre, nxt, wr, wc, fr, fq);
#pragma unroll
        for (int m = 0; m < 3; ++m)
#pragma unroll
            for (int n = 0; n < 4; ++n) acc[m][n] = (f32x4){0.f, 0.f, 0.f, 0.f};
        cur = nxt; cA = nA; cB = nB; ++ui;
        if (wh == 1) PG8_BAR;
    }
    PG8_WAIT_V(0);
    PG8_BAR;
#undef PG8_STAGE5
#undef PG8_WAIT_V
#undef PG8_WAIT_L
#undef PG8_BAR
#undef PG8_SCHED
}
__device__ __forceinline__ int cond_of_row(int row) { return row < 4096 ? 0 : (row < 5120 ? 1 : 2); }
struct EpiRes192 {
    static constexpr bool PERM = false;
    float* X; bf16_t* A; const float* gate; const float* Gn; float* ssq_out; const float* XP; const float* XS;
    __device__ __forceinline__ void prefetch(f32x4 (&xpre)[3][4], const Unit& u, int wr, int wc, int fr, int fq) const {
        const int col0 = u.pn * HALF + wc * 64 + 4 * fq;
#pragma unroll
        for (int m = 0; m < 3; ++m)
            { const int row = u.pm * 192 + wr * 48 + m * 16 + fr; const float* xb = (row < 4096 ? XP + (size_t)row * DM : XS + (size_t)(row - 4096) * DM) + col0;
#pragma unroll
              for (int n = 0; n < 4; ++n) xpre[m][n] = *(const f32x4*)(xb + n * 16); }
    }
    __device__ __forceinline__ void operator()(const f32x4 (&acc)[3][4], const f32x4 (&xpre)[3][4], const Unit& u, int wr, int wc, int fr, int fq) const {
        const int col0 = u.pn * HALF + wc * 64 + 4 * fq;
#pragma unroll
        for (int m = 0; m < 3; ++m) {
            const int row = u.pm * 192 + wr * 48 + m * 16 + fr;
            const int cond = cond_of_row(u.pm * 192 + wr * 48 + m * 16);
            float q = 0.f;
#pragma unroll
            for (int n = 0; n < 4; ++n) {
                const int c = col0 + n * 16;
                const f32x4 g4 = *(const f32x4*)(gate + cond * 6144 + c);
                const f32x4 x1 = xpre[m][n] + g4 * acc[m][n];
                *(f32x4*)(X + (size_t)row * DM + c) = x1;
                q += (x1[0] * x1[0] + x1[1] * x1[1]) + (x1[2] * x1[2] + x1[3] * x1[3]);
                if (Gn) { const f32x4 a = x1 * *(const f32x4*)(Gn + cond * DM + c); u32x2 w; w.x = cvt_pk_bf16(a[0], a[1]); w.y = cvt_pk_bf16(a[2], a[3]);
                    *(u32x2*)(A + (size_t)row * DM + c) = w; }
            }
            q += __shfl_xor(q, 16); q += __shfl_xor(q, 32);
            if (fq == 0) ssq_out[(size_t)row * SSQW + u.pn * 2 + wc] = q;
        }
    }
};
}
#define GAS __attribute__((address_space(1)))
#define LAS __attribute__((address_space(3)))
typedef unsigned short bf16;
typedef unsigned v4u __attribute__((ext_vector_type(4)));
typedef unsigned v2u __attribute__((ext_vector_type(2)));
typedef float f32x4 __attribute__((ext_vector_type(4)));
typedef float f32x2 __attribute__((ext_vector_type(2)));
typedef short bf16x8 __attribute__((ext_vector_type(8)));
constexpr int NWAVES = 8, NTHREADS = 512;
constexpr int M_TOK = 6144, M_CTX = 4096, DMODEL = 1024, NINP = 1792, NUC = 1280, FFD = 4096, DEPTHL = 4, DRNN = 512;
constexpr int LDS_BYTES = 163840;
constexpr size_t al256(size_t x) { return (x + 255) & ~(size_t)255; }
constexpr size_t WS_CTL = 0, CTL_BYTES = 1u << 20;
constexpr size_t WS_MODS = WS_CTL + CTL_BYTES;
constexpr size_t WS_GV = WS_MODS + al256((size_t)4 * 3 * 6144 * 4);
constexpr size_t WS_BIASIN = WS_GV + al256((size_t)4 * 2 * 3 * 1024 * 4);
constexpr size_t WS_BIAS1 = WS_BIASIN + al256((size_t)4 * 3 * NINP * 4);
constexpr size_t WS_SSQ = WS_BIAS1 + al256((size_t)4 * 3 * FFD * 4);
constexpr size_t WS_WIN = WS_SSQ + al256((size_t)9 * M_TOK * 16 * 4);
constexpr size_t WS_WOUT = WS_WIN + al256((size_t)4 * NINP * 1024 * 2);
constexpr size_t WS_W1 = WS_WOUT + al256((size_t)4 * 1024 * 1024 * 2);
constexpr size_t WS_W2 = WS_W1 + al256((size_t)4 * FFD * 1024 * 2);
constexpr size_t WS_WG = WS_W2 + al256((size_t)4 * FFD * 1024 * 2);
constexpr size_t WS_GB = WS_WG + al256((size_t)4 * 8 * 4 * 4 * 2 * 32 * 64 * 2);
constexpr size_t WS_T256 = WS_GB + al256((size_t)4 * 2 * 2 * 512 * 4);
constexpr size_t WS_T1024 = WS_T256 + al256((size_t)256 * 512 * 2);
constexpr size_t WS_X = WS_T1024 + al256((size_t)1024 * 2048 * 2);
constexpr size_t WS_A = WS_X + al256((size_t)M_TOK * 1024 * 4);
constexpr size_t WS_U = WS_A + al256((size_t)M_TOK * 1024 * 2);
constexpr size_t WS_XCT = WS_U + al256((size_t)M_TOK * NUC * 2);
constexpr size_t WS_CAT = WS_XCT + al256((size_t)M_TOK * 512 * 2);
constexpr size_t WS_HF = WS_CAT + al256((size_t)M_TOK * 1024 * 2);
constexpr size_t WS_PB = WS_HF + al256((size_t)M_TOK * 512 * 4);
constexpr size_t WS_HID = WS_PB + al256((size_t)M_TOK * 512 * 4);
constexpr size_t WS_END = WS_HID + al256((size_t)M_TOK * FFD * 2);
static_assert(WS_END <= ((size_t)256 << 20), "workspace map exceeds 256 MiB");

__device__ __forceinline__ unsigned f2bf(float f) { unsigned u = __builtin_bit_cast(unsigned, f); return (u + 0x7fffu + ((u >> 16) & 1u)) >> 16; }
__device__ __forceinline__ unsigned pk2(float lo, float hi) { return f2bf(lo) | (f2bf(hi) << 16); }
__device__ __forceinline__ float bf2f(unsigned short b) { return __builtin_bit_cast(float, (unsigned)b << 16); }
__device__ __forceinline__ float bflo(unsigned w) { return __builtin_bit_cast(float, w << 16); }
__device__ __forceinline__ float bfhi(unsigned w) { return __builtin_bit_cast(float, w & 0xffff0000u); }
__device__ __forceinline__ float wave_sum(float v) {
#pragma unroll
    for (int o = 1; o < 64; o <<= 1) v += __shfl_xor(v, o);
    return v;
}
__device__ __forceinline__ float rdlane(float v, int l) { return __builtin_bit_cast(float, __builtin_amdgcn_readlane(__builtin_bit_cast(int, v), l)); }

__device__ __forceinline__ int launder_v(int x) { asm volatile("" : "+v"(x)); return x; }
__device__ __forceinline__ int launder_s(int x) { asm volatile("" : "+s"(x)); return x; }
#define CAS __attribute__((address_space(4)))
typedef const float* cfp_t;
struct Params { const float* in[24]; float* out; unsigned char* ws; int ph_lo, ph_hi; };
struct Frame {
    LAS unsigned char* lds;
    int tid, lane, wave, G, bid;
    __device__ __forceinline__ void relaunder() { wave = launder_s(wave); asm volatile("v_mbcnt_lo_u32_b32 %0, -1, 0\n\tv_mbcnt_hi_u32_b32 %0, -1, %0" : "=v"(lane)); tid = wave * 64 + lane;
        bid = launder_s(bid); G = launder_s(G);
        size_t z = 0; asm volatile("" : "+s"(z), "+s"(in)); ws = ws0 + z; out = out0 + z; }
    __device__ __forceinline__ const float* inp(int i) const { return (const float*)(const GAS float*)in[i]; }
    const CAS cfp_t* in; float* out; unsigned char* ws; float* out0; unsigned char* ws0; unsigned long long* tsx;
};
enum { I_XP = 0, I_XS, I_STATE, I_C, I_CCTX, I_N1G, I_N2G, I_FG, I_WMOD, I_BMOD, I_WIN, I_CONVW, I_CONVB, I_WR, I_BR, I_WI, I_BI, I_LAM, I_POOLW, I_POOLS, I_FW, I_WOUT, I_W1, I_W2 };
#define XB_TMO      128
#define XB_XCNT(j)  (256  + 64 * (j))
#define XB_XSUB(j)  (1280 + 64 * (j))
#define XB_XGEN(j)  (2304 + 64 * (j))
#define XB_TOP      3328
#define XB_TOPGEN   3392
#define XCD_BAR_WORDS 3456
#define XB_SPIN_CAP (1u << 18)

__device__ __forceinline__ unsigned xb_ld(unsigned* p)              { return __hip_atomic_load(p, __ATOMIC_RELAXED, __HIP_MEMORY_SCOPE_AGENT); }
__device__ __forceinline__ unsigned xb_add(unsigned* p, unsigned v) { return __hip_atomic_fetch_add(p, v, __ATOMIC_RELAXED, __HIP_MEMORY_SCOPE_AGENT); }
__device__ __forceinline__ unsigned xb_xcc_id() { return (unsigned)__builtin_amdgcn_s_getreg((3 << 11) | 20) & 0xFu; }
#define XB_SPIN(cond, bar) do { unsigned _sp = 0; while (cond) { __builtin_amdgcn_s_sleep(1); \
    if ((++_sp & 255u) == 0u) { if (xb_ld(&(bar)[XB_TMO])) break; if (_sp > XB_SPIN_CAP) { atomicAdd(&(bar)[XB_TMO], 1u); break; } } } } while (0)

struct XcdBarrier {
    unsigned* bar; unsigned x;
    volatile unsigned* st;
};

__device__ __forceinline__ XcdBarrier xcd_barrier_post(unsigned* bar, volatile unsigned* st) {
    XcdBarrier b; b.bar = bar; b.x = xb_xcc_id(); b.st = st;
    if (threadIdx.x == 0) (void)xb_add(&bar[XB_XCNT(b.x)], 1u);
    return b;
}
__device__ __forceinline__ void xcd_barrier_complete(unsigned* bar, unsigned x, unsigned& nloc, unsigned& nx) {
    const unsigned G = gridDim.x * gridDim.y * gridDim.z;
    unsigned sum, cnt, mine, sp = 0u;
    for (;;) {
        sum = 0u; cnt = 0u; mine = 0u;
#pragma unroll
        for (unsigned j = 0; j < 16; ++j) { const unsigned c = xb_ld(&bar[XB_XCNT(j)]); sum += c; cnt += (c > 0u) ? 1u : 0u; mine = (j == x) ? c : mine; }
        if (sum == G) break;
        __builtin_amdgcn_s_sleep(1);
        if ((++sp & 255u) == 0u) { if (xb_ld(&bar[XB_TMO])) break; if (sp > XB_SPIN_CAP) { atomicAdd(&bar[XB_TMO], 1u); break; } }
    }
    nloc = mine > 0u ? mine : 1u; nx = cnt > 0u ? cnt : 1u;
}

__device__ __forceinline__ void xcd_barrier(const XcdBarrier& b) {
    asm volatile("s_waitcnt vmcnt(0)" ::: "memory");
    __syncthreads();
    if (threadIdx.x == 0) {
        unsigned* bar = b.bar;
        __builtin_amdgcn_s_waitcnt(0);
        unsigned nloc = b.st[0], nx = b.st[1];
        if (nloc == 0u) { xcd_barrier_complete(bar, b.x, nloc, nx); b.st[0] = nloc; b.st[1] = nx; }
        const unsigned old = xb_add(&bar[XB_XSUB(b.x)], 1u);
        const unsigned gen = old / nloc;
        if (old + 1u == (gen + 1u) * nloc) {
            __builtin_amdgcn_fence(__ATOMIC_RELEASE, "agent");
            asm volatile("s_waitcnt vmcnt(0)" ::: "memory");
            const unsigned og = xb_add(&bar[XB_TOP], 1u);
            const unsigned tg = og / nx;
            if (og + 1u == (tg + 1u) * nx) xb_add(&bar[XB_TOPGEN], 1u);
            else XB_SPIN(xb_ld(&bar[XB_TOPGEN]) == tg, bar);
            __builtin_amdgcn_fence(__ATOMIC_ACQUIRE, "agent");
            xb_add(&bar[XB_XGEN(b.x)], 1u);
            asm volatile("s_waitcnt vmcnt(0)" ::: "memory");
        } else {
            XB_SPIN(xb_ld(&bar[XB_XGEN(b.x)]) == gen, bar);
            __builtin_amdgcn_fence(__ATOMIC_ACQUIRE, "agent");
            asm volatile("s_waitcnt vmcnt(0)" ::: "memory");
        }
    }
    __syncthreads();
}
__device__ __forceinline__ void p0a_mods(const Frame& F) {
    LAS float* sl = (LAS float*)F.lds;
    LAS float* red = sl + 3 * 1024;
    const float* c_ctx = F.inp(I_CCTX); const float* cv = F.inp(I_C);
    for (int i = F.tid; i < 3 * 1024; i += NTHREADS) { const int cd = i >> 10, k = i & 1023; const float c = cd == 0 ? c_ctx[k] : cv[(cd - 1) * 1024 + k]; sl[i] = c / (1.0f + expf(-c)); }
    __syncthreads();
    float* mods = (float*)(F.ws + WS_MODS);
    for (int it = F.bid; it < 256; it += F.G) {
        const int l = it >> 6, ch = it & 63;
        const float* W = F.inp(I_WMOD) + (size_t)l * 1024 * 6144 + ch * 96;
        if (F.tid < 504) {
            const int c4 = F.tid % 24, kr = F.tid / 24;
            f32x4 a0 = {0.f, 0.f, 0.f, 0.f}, a1 = a0, a2 = a0;
#pragma unroll 16
            for (int k = kr; k < 1024; k += 21) { const f32x4 w = __builtin_nontemporal_load((const f32x4*)(W + (size_t)k * 6144 + c4 * 4)); a0 += w * sl[k]; a1 += w * sl[1024 + k]; a2 += w * sl[2048 + k]; }
            *(LAS f32x4*)(red + (kr * 3 + 0) * 96 + c4 * 4) = a0; *(LAS f32x4*)(red + (kr * 3 + 1) * 96 + c4 * 4) = a1; *(LAS f32x4*)(red + (kr * 3 + 2) * 96 + c4 * 4) = a2;
        }
        __syncthreads();
        if (F.tid < 288) { const int cd = F.tid / 96, col = F.tid % 96; float s = 0.f;
#pragma unroll
            for (int kr = 0; kr < 21; ++kr) s += red[(kr * 3 + cd) * 96 + col];
            mods[(size_t)(l * 3 + cd) * 6144 + ch * 96 + col] = s + F.inp(I_BMOD)[l * 6144 + ch * 96 + col]; }
        __syncthreads();
    }
}

template <bool BIAS, bool NT = false>
__device__ __forceinline__ void strip_item(const float* W, int N, int kb, int ke, int n0, bf16* WT, int ldt, int trow0, const float* sh, float* bias_out, int bstride, LAS float* scr, int lane) {
    float b0 = 0.f, b1 = 0.f, b2 = 0.f;
    const int nn = lane & 31, half = lane >> 5;
    float tv[32];
#pragma unroll
    for (int i = 0; i < 32; ++i) { const float* q = W + (size_t)(kb + 2 * i + half) * N + n0 + nn; tv[i] = NT ? __builtin_nontemporal_load(q) : *q; }
    for (int k0 = kb; k0 < ke; k0 += 64) {
#pragma unroll
        for (int i = 0; i < 32; ++i) scr[(2 * i + half) * 33 + nn] = tv[i];
        if (k0 + 64 < ke) {
#pragma unroll
            for (int i = 0; i < 32; ++i) { const float* q = W + (size_t)(k0 + 64 + 2 * i + half) * N + n0 + nn; tv[i] = NT ? __builtin_nontemporal_load(q) : *q; }
        }
        asm volatile("s_waitcnt lgkmcnt(0)" ::: "memory");
        const int c = lane & 7;
#pragma unroll
        for (int j = 0; j < 4; ++j) { const int n = (lane >> 3) + 8 * j; const LAS float* s = scr + (8 * c) * 33 + n;
            v4u o; o.x = pk2(s[0 * 33], s[1 * 33]); o.y = pk2(s[2 * 33], s[3 * 33]); o.z = pk2(s[4 * 33], s[5 * 33]); o.w = pk2(s[6 * 33], s[7 * 33]);
            *(v4u*)(WT + (size_t)(trow0 + n) * ldt + k0 + 8 * c) = o; }
        if (BIAS) {
            const float s0 = sh[k0 + lane], s1 = sh[6144 + k0 + lane], s2 = sh[2 * 6144 + k0 + lane];
#pragma unroll 8
            for (int kk = 0; kk < 32; ++kk) { const float w = scr[(half * 32 + kk) * 33 + nn]; const int src = half * 32 + kk;
                b0 += w * __shfl(s0, src); b1 += w * __shfl(s1, src); b2 += w * __shfl(s2, src); }
        }
        asm volatile("s_waitcnt lgkmcnt(0)" ::: "memory");
    }
    if (BIAS) {
        b0 += __shfl_xor(b0, 32); b1 += __shfl_xor(b1, 32); b2 += __shfl_xor(b2, 32);
        if (lane < 32) { bias_out[n0 + lane] = b0; bias_out[bstride + n0 + lane] = b1; bias_out[2 * bstride + n0 + lane] = b2; }
    }
}
__device__ __forceinline__ float dft64(float tabreg, int c, int mm) { const int m = mm & 63; const int idx = (mm < 64) ? ((c * m) & 63) : ((c * m - 16) & 63); return __shfl(tabreg, idx); }

__device__ __forceinline__ void p0b_items(Frame F, int llo, int lhi, int gw, int NGW, bool with_rows) {
    const int nl = lhi - llo;
    const float tabreg = cospif((float)F.lane * (1.0f / 32.0f)) * 0.125f;
    const int N_FOUT = 256 * nl, N_FIN = 256 * nl, N_POOLF = 64 * nl, N_FBIAS = 4 * nl, N_W1 = 128 * nl, N_W2 = with_rows ? 0 : 128 * nl, N_WIN = 40 * nl, N_WOUTA = 32 * nl, N_ROWS = with_rows ? M_TOK : 0;
    const int NITEMS = N_FOUT + N_FIN + N_POOLF + N_FBIAS + N_W1 + N_W2 + N_WIN + N_WOUTA + N_ROWS;
    const int nA = N_FBIAS + N_FOUT, nW = N_W1 + N_W2 + N_WIN + N_WOUTA, NQ = nA + nW + N_POOLF + N_FIN + N_ROWS / 8;
    unsigned* head = (unsigned*)(F.ws + WS_CTL) + 2048 + 64 * (gw & 7);
    for (int sit = gw;; sit += NGW) {
        int it0, nrep = 1;
        if (with_rows) {
            unsigned idx = 0; if (F.lane == 0) idx = __hip_atomic_fetch_add(head, 1u, __ATOMIC_RELAXED, __HIP_MEMORY_SCOPE_AGENT);
            const int j = (int)__builtin_amdgcn_readfirstlane(idx) * 8 + (gw & 7);
            if (j >= NQ) break;
            if (j < nA) it0 = j;
            else if (j < nA + nW) it0 = nA + N_FIN + N_POOLF + (j - nA);
            else if (j < nA + nW + N_POOLF) it0 = nA + N_FIN + (j - nA - nW);
            else if (j < nA + nW + N_POOLF + N_FIN) it0 = nA + (j - nA - nW - N_POOLF);
            else { it0 = nA + N_FIN + N_POOLF + nW + 8 * (j - nA - nW - N_POOLF - N_FIN); nrep = 8; }
        } else { if (sit >= NITEMS) break; it0 = sit; }
      for (int rep = 0; rep < nrep; ++rep) {
        const int it = it0 + rep;
        int r = it; F.relaunder(); const int lane = F.lane;
        LAS float* scr = (LAS float*)(F.lds + F.wave * 16384);
        const float* mods = (const float*)(F.ws + WS_MODS);
        bf16* WINT = (bf16*)(F.ws + WS_WIN); bf16* WOUTT = (bf16*)(F.ws + WS_WOUT); bf16* W1T = (bf16*)(F.ws + WS_W1); bf16* W2T = (bf16*)(F.ws + WS_W2);
        float* BIASIN = (float*)(F.ws + WS_BIASIN); float* BIAS1 = (float*)(F.ws + WS_BIAS1);

        if (r < N_FBIAS) {
            const int l = llo + (r >> 2), hd = r & 3, rg = lane >> 4, c4 = lane & 15;
            const float* wp = F.inp(I_WIN) + (size_t)l * 1024 * 1536 + (size_t)rg * 1536 + 1280 + 64 * hd + 4 * c4;
            const float* sh = mods + (size_t)l * 3 * 6144 + rg;
            f32x4 b0 = {0.f, 0.f, 0.f, 0.f}, b1 = b0, b2 = b0;
            for (int i0 = 0; i0 < 256; i0 += 16) { f32x4 wv[16];
#pragma unroll
                for (int i = 0; i < 16; ++i) wv[i] = *(const f32x4*)(wp + (size_t)(4 * (i0 + i)) * 1536);
#pragma unroll
                for (int i = 0; i < 16; ++i) { const int k = 4 * (i0 + i); b0 += wv[i] * sh[k]; b1 += wv[i] * sh[6144 + k]; b2 += wv[i] * sh[2 * 6144 + k]; } }
#pragma unroll
            for (int e = 0; e < 4; ++e) { b0[e] += __shfl_xor(b0[e], 16); b0[e] += __shfl_xor(b0[e], 32); b1[e] += __shfl_xor(b1[e], 16); b1[e] += __shfl_xor(b1[e], 32); b2[e] += __shfl_xor(b2[e], 16); b2[e] += __shfl_xor(b2[e], 32); }
            if (lane < 16) { *(LAS f32x4*)(scr + 4 * lane) = b0; *(LAS f32x4*)(scr + 64 + 4 * lane) = b1; *(LAS f32x4*)(scr + 128 + 4 * lane) = b2; }
            asm volatile("s_waitcnt lgkmcnt(0)" ::: "memory");
            for (int hf = 0; hf < 2; ++hf) {
                const int mm = hf * 64 + lane; float s0 = 0.f, s1 = 0.f, s2 = 0.f;
#pragma unroll 8
                for (int c = 0; c < 64; ++c) { const int idx = hf == 0 ? ((c * lane) & 63) : ((c * lane - 16) & 63); const float dv = __shfl(tabreg, idx);
                    s0 += scr[c] * dv; s1 += scr[64 + c] * dv; s2 += scr[128 + c] * dv; }
                float* bo = BIASIN + (size_t)l * 3 * NINP + 1280 + 128 * hd + mm;
                bo[0] = s0; bo[NINP] = s1; bo[2 * NINP] = s2;
            }
            asm volatile("s_waitcnt lgkmcnt(0)" ::: "memory");
            continue;
        }
        r -= N_FBIAS;
        if (r < N_FOUT) {
            const int l = llo + (r >> 8), it16 = (r >> 4) & 15, nb = r & 15, lr = lane & 15, lq = lane >> 4;
            const float* fw = F.inp(I_FW) + (size_t)l * 65536 + (size_t)(it16 * 16 + lr) * 256 + lq;
            const float* wo = F.inp(I_WOUT) + (size_t)l * 1048576 + (size_t)(768 + lq) * 1024 + nb * 64 + lr;
            f32x4 acc[4];
#pragma unroll
            for (int nt = 0; nt < 4; ++nt) acc[nt] = (f32x4){0.f, 0.f, 0.f, 0.f};
#pragma unroll 4
            for (int ks = 0; ks < 64; ++ks) { const float av = fw[4 * ks];
#pragma unroll
                for (int nt = 0; nt < 4; ++nt) acc[nt] = __builtin_amdgcn_mfma_f32_16x16x4f32(av, wo[(size_t)(4 * ks) * 1024 + 16 * nt], acc[nt], 0, 0, 0); }
#pragma unroll
            for (int nt = 0; nt < 4; ++nt) { v2u o; o.x = pk2(acc[nt][0], acc[nt][1]); o.y = pk2(acc[nt][2], acc[nt][3]);
                *(v2u*)(WOUTT + (size_t)l * 1048576 + (size_t)(nb * 64 + 16 * nt + lr) * 1024 + 768 + it16 * 16 + 4 * lq) = o; }
            continue;
        }
        r -= N_FOUT;
        if (r < N_FIN) {
            const int l = llo + (r >> 8), hd = (r >> 6) & 3, kt = r & 63, lr = lane & 15, lq = lane >> 4;
            const float* wp = F.inp(I_WIN) + (size_t)l * 1024 * 1536 + (size_t)(kt * 16 + lr) * 1536 + 1280 + 64 * hd + lq;
            f32x4 acc[8];
#pragma unroll
            for (int nt = 0; nt < 8; ++nt) acc[nt] = (f32x4){0.f, 0.f, 0.f, 0.f};
#pragma unroll 2
            for (int ks = 0; ks < 16; ++ks) { const float av = wp[4 * ks]; const int c = 4 * ks + lq;
#pragma unroll
                for (int nt = 0; nt < 8; ++nt) acc[nt] = __builtin_amdgcn_mfma_f32_16x16x4f32(av, dft64(tabreg, c, 16 * nt + lr), acc[nt], 0, 0, 0); }
#pragma unroll
            for (int nt = 0; nt < 8; ++nt) { v2u o; o.x = pk2(acc[nt][0], acc[nt][1]); o.y = pk2(acc[nt][2], acc[nt][3]);
                *(v2u*)(WINT + (size_t)l * NINP * 1024 + (size_t)(1280 + 128 * hd + 16 * nt + lr) * 1024 + kt * 16 + 4 * lq) = o; }
            continue;
        }
        r -= N_FIN;
        if (r < N_POOLF) {
            const int l = llo + (r >> 6), g = (r >> 4) & 3, nb = r & 15, lr = lane & 15, lq = lane >> 4;
            const float* pw = F.inp(I_POOLW) + (size_t)(l * 4 + g) * 4096 + lr * 64 + lq;
            const float* ps = F.inp(I_POOLS) + l * 256 + 64 * g + lq;
            const float* wo = F.inp(I_WOUT) + (size_t)l * 1048576 + (size_t)(512 + 64 * g + lq) * 1024 + nb * 64 + lr;
            f32x4 acc[4][4];
#pragma unroll
            for (int mt = 0; mt < 4; ++mt)
#pragma unroll
                for (int nt = 0; nt < 4; ++nt) acc[mt][nt] = (f32x4){0.f, 0.f, 0.f, 0.f};
#pragma unroll 2
            for (int ks = 0; ks < 16; ++ks) { const float sc = ps[4 * ks]; float av[4], bv[4];
#pragma unroll
                for (int mt = 0; mt < 4; ++mt) av[mt] = pw[mt * 1024 + 4 * ks] * sc;
#pragma unroll
                for (int nt = 0; nt < 4; ++nt) bv[nt] = wo[(size_t)(4 * ks) * 1024 + 16 * nt];
#pragma unroll
                for (int mt = 0; mt < 4; ++mt)
#pragma unroll
                    for (int nt = 0; nt < 4; ++nt) acc[mt][nt] = __builtin_amdgcn_mfma_f32_16x16x4f32(av[mt], bv[nt], acc[mt][nt], 0, 0, 0); }
#pragma unroll
            for (int mt = 0; mt < 4; ++mt)
#pragma unroll
                for (int nt = 0; nt < 4; ++nt) { v2u o; o.x = pk2(acc[mt][nt][0], acc[mt][nt][1]); o.y = pk2(acc[mt][nt][2], acc[mt][nt][3]);
                    *(v2u*)(WOUTT + (size_t)l * 1048576 + (size_t)(nb * 64 + 16 * nt + lr) * 1024 + 512 + 64 * g + 16 * mt + 4 * lq) = o; }
            continue;
        }
        r -= N_POOLF;
        if (r < N_W1) {
            const int l = llo + (r >> 7), nb = r & 127;
            strip_item<true, true>(F.inp(I_W1) + (size_t)l * 1024 * 4096, 4096, 0, 1024, nb * 32, W1T + (size_t)l * 4096 * 1024, 1024, nb * 32,
                             mods + (size_t)l * 3 * 6144 + 3 * 1024, BIAS1 + (size_t)l * 3 * FFD, FFD, scr, lane);
            continue;
        }
        r -= N_W1;
        if (r < N_W2) {
            const int l = llo + (r >> 7), nb = (r >> 2) & 31, kq = r & 3;
            strip_item<false>(F.inp(I_W2) + (size_t)l * 4096 * 1024, 1024, kq * 1024, kq * 1024 + 1024, nb * 32, W2T + (size_t)l * 1024 * 4096, 4096, nb * 32, nullptr, nullptr, 0, scr, lane);
            continue;
        }
        r -= N_W2;
        if (r < N_WIN) {
            const int l = llo + r / 40, nb = r % 40;
            strip_item<true, true>(F.inp(I_WIN) + (size_t)l * 1024 * 1536, 1536, 0, 1024, nb * 32, WINT + (size_t)l * NINP * 1024, 1024, nb * 32,
                             mods + (size_t)l * 3 * 6144, BIASIN + (size_t)l * 3 * NINP, NINP, scr, lane);
            continue;
        }
        r -= N_WIN;
        if (r < N_WOUTA) {
            const int l = llo + (r >> 5), nb = r & 31;
            strip_item<false>(F.inp(I_WOUT) + (size_t)l * 1048576, 1024, 0, 512, nb * 32, WOUTT + (size_t)l * 1048576, 1024, nb * 32, nullptr, nullptr, 0, scr, lane);
            continue;
        }
        r -= N_WOUTA;
        if (with_rows) {
            const int cond = r < M_CTX ? 0 : 1 + ((r - M_CTX) >> 10);
            const float* src = r < M_CTX ? F.inp(I_XP) + (size_t)r * 1024 : F.inp(I_XS) + (size_t)(r - M_CTX) * 1024;
            const f32x4* xr = (const f32x4*)src + lane;
            const f32x4* gp = (const f32x4*)F.inp(I_N1G) + lane;
            const f32x4* sp = (const f32x4*)(mods + (size_t)cond * 6144 + 1024) + lane;
            f32x4 v[4]; float s = 0.f;
#pragma unroll
            for (int j = 0; j < 4; ++j) { v[j] = xr[64 * j]; s += (v[j][0] * v[j][0] + v[j][1] * v[j][1]) + (v[j][2] * v[j][2] + v[j][3] * v[j][3]); }
            s = wave_sum(s);
            v2u* ao = (v2u*)((bf16*)(F.ws + WS_A) + (size_t)r * 1024) + lane;
#pragma unroll
            for (int j = 0; j < 4; ++j) { const f32x4 a = v[j] * (gp[64 * j] * (sp[64 * j] + 1.0f));
                v2u w; w.x = pk2(a[0], a[1]); w.y = pk2(a[2], a[3]); ao[64 * j] = w; }
            if (lane < 16) ((float*)(F.ws + WS_SSQ))[(size_t)r * 16 + lane] = lane == 0 ? s : 0.f;
        }
      }
    }
}
__device__ __forceinline__ void w2_strips(Frame F, int l, int gw, int NGW) {
    F.relaunder();
    LAS float* scr = (LAS float*)(F.lds + F.wave * 16384);
    for (int it = gw; it < 256; it += NGW) { const int nb = (it >> 3) & 31, k8 = it & 7;
        strip_item<false, true>(F.inp(I_W2) + (size_t)l * 4096 * 1024, 1024, k8 * 512, k8 * 512 + 512, nb * 32, (bf16*)(F.ws + WS_W2) + (size_t)l * 1024 * 4096, 4096, nb * 32, nullptr, nullptr, 0, scr, F.lane); }
}
__device__ __forceinline__ void p0b_tail(Frame F, int what, int lsel, int gt, int NGT) {
    F.relaunder();
    const float* mods = (const float*)(F.ws + WS_MODS);
    if (what & 1) {
        float* GV = (float*)(F.ws + WS_GV);
        for (int i = gt; i < 4 * 2 * 3 * 1024; i += NGT) { const int c = i & 1023, cd = (i >> 10) % 3, w = (i / 3072) & 1, l = i / 6144;
            const float g = (w == 0 ? F.inp(I_N1G) : F.inp(I_N2G))[l * 1024 + c]; GV[i] = g * (1.0f + mods[(size_t)(l * 3 + cd) * 6144 + (w == 0 ? 1 : 4) * 1024 + c]); }
    }
    if (what & 2) {
        bf16* WG = (bf16*)(F.ws + WS_WG);
        for (int i = (lsel << 19) + gt; i < ((lsel + 1) << 19); i += NGT) { const int c = i & 63, n = (i >> 6) & 31, dir = (i >> 11) & 1, tap = (i >> 12) & 3, q = (i >> 14) & 3, h = (i >> 16) & 7, l = i >> 19;
            const float* src = n < 16 ? F.inp(I_WR) : F.inp(I_WI);
            WG[i] = (bf16)f2bf(-1.4426950408889634f * F.inp(I_CONVW)[(l * 4 + tap) * 512 + 64 * h + c] * src[((size_t)((l * 2 + dir) * 8 + h) * 64 + c) * 64 + 16 * q + (n & 15)]); }
        float* GB = (float*)(F.ws + WS_GB);
        for (int i = (lsel << 11) + gt; i < ((lsel + 1) << 11); i += NGT) { const int ch = i & 511, g = (i >> 9) & 1, dir = (i >> 10) & 1, l = i >> 11, h = ch >> 6, j = ch & 63;
            const float* W = (g == 0 ? F.inp(I_WR) : F.inp(I_WI)) + (size_t)((l * 2 + dir) * 8 + h) * 4096 + j;
            float s = (g == 0 ? F.inp(I_BR) : F.inp(I_BI))[(l * 2 + dir) * 512 + ch];
            { float wv[64];
#pragma unroll
              for (int c = 0; c < 64; ++c) wv[c] = W[c * 64];
#pragma unroll
              for (int c = 0; c < 64; ++c) s += F.inp(I_CONVB)[l * 512 + 64 * h + c] * wv[c]; }
            GB[i] = -1.4426950408889634f * s; }
    }
    if (what & 4) {
        for (int i = gt; i < (128 * 512 + 512 * 2048) / 8; i += NGT) {
            int L, e; bf16* T;
            if (i < 128 * 512 / 8) { L = 256; e = i * 8; T = (bf16*)(F.ws + WS_T256); } else { L = 1024; e = (i - 128 * 512 / 8) * 8; T = (bf16*)(F.ws + WS_T1024); }
            const int kpos = e / (2 * L), k2 = e % (2 * L), sn = k2 >= L, l0 = k2 - (sn ? L : 0);
            const float scale = L == 256 ? 0.0625f : 0.03125f, inv = 2.0f / (float)L;
            float v[8];
#pragma unroll
            for (int j = 0; j < 8; ++j) { const int a = (kpos * (l0 + j)) & (L - 1); v[j] = sn ? -sinpif((float)a * inv) * scale : cospif((float)a * inv) * scale; }
            v4u o; o.x = pk2(v[0], v[1]); o.y = pk2(v[2], v[3]); o.z = pk2(v[4], v[5]); o.w = pk2(v[6], v[7]);
            *(v4u*)(T + ((size_t)(((kpos >> 4) * (L >> 4) + (k2 >> 5)) * 64 + ((k2 >> 3) & 3) * 16 + (kpos & 15))) * 8) = o;
        }
    }
}
#ifdef UNIT_STAMPS
#define LRU_STAMP(i) do { if (TS_SEL >= 0 && F.tsx && F.wave == 0) __hip_atomic_store(F.tsx + (i), (unsigned long long)__builtin_amdgcn_s_memrealtime(), __ATOMIC_RELAXED, __HIP_MEMORY_SCOPE_AGENT); } while (0)
#else
#define LRU_STAMP(i) do {} while (0)
#endif
__device__ __forceinline__ float sigmoidf_(float x) { return 1.0f / (1.0f + expf(-x)); }
__device__ __forceinline__ float gelu_tanh(float x) { return 0.5f * x * (1.0f + tanhf(0.7978845608028654f * (x + 0.044715f * x * x * x))); }
__device__ __forceinline__ void seq_geom(int seq, int& L, int& row0) { if (seq < 16) { L = 256; row0 = seq * 256; } else { L = 1024; row0 = M_CTX + (seq - 16) * 1024; } }

__device__ __forceinline__ float fexp(float x) { return __builtin_amdgcn_exp2f(x * 1.4426950408889634f); }
__device__ __forceinline__ float fsigmoid(float x) { return __builtin_amdgcn_rcpf(1.0f + __builtin_amdgcn_exp2f(x * -1.4426950408889634f)); }
__device__ __forceinline__ float fgelu_tanh(float x) { return x * fsigmoid(1.5957691216057308f * (x + 0.044715f * x * x * x)); }
__device__ __forceinline__ float neg_expm1(float y) {
    float p = 1.0f / 720.0f; p = p * y + (1.0f / 120.0f); p = p * y + (1.0f / 24.0f); p = p * y + (1.0f / 6.0f); p = p * y + 0.5f; p = p * y + 1.0f;
    return y < -0.5f ? 1.0f - fexp(y) : -y * p;
}
__device__ __forceinline__ float one_minus_sq(float a, float y) {
    float p = 1.0f / 720.0f; p = p * y + (1.0f / 120.0f); p = p * y + (1.0f / 24.0f); p = p * y + (1.0f / 6.0f); p = p * y + 0.5f; p = p * y + 1.0f;
    return y < -0.5f ? __builtin_fmaf(-a, a, 1.0f) : -y * p;
}
__device__ __forceinline__ void lru_unit(Frame F, int l, int seq, int h, int q, int nseg) {
    F.relaunder();
    LRU_STAMP(0);
    const bool ctx = seq < 16;
    const int L = ctx ? 256 : 1024, row0 = ctx ? seq * 256 : M_CTX + (seq - 16) * 1024, niter = ctx ? nseg : 4;
    const int tid = F.tid, lane = F.lane, wave = F.wave;
    LAS bf16* XR = (LAS bf16*)F.lds;
    LAS bf16* XG = (LAS bf16*)(F.lds + 37440);
    LAS float* SL = (LAS float*)(F.lds + 94208);
    LAS float* WTP = (LAS float*)(F.lds + 53824);
    LAS float* WTH = WTP + 256;
    LAS float* CHKP = WTP + 512;
    LAS float* CHKH = WTP + 576;
    LAS bf16* WGL = (LAS bf16*)(F.lds + 57344);
    const bf16* U = (const bf16*)(F.ws + WS_U);
    bf16* CAT = (bf16*)(F.ws + WS_CAT);
    const int chb = 64 * h + 16 * q;
    const int j16 = lane & 15, lq = lane >> 4;
    float gbr[2], gbi[2], sp8[2], cwo[4];
    { const float* GB = (const float*)(F.ws + WS_GB) + (size_t)l * 2048 + chb + j16;
#pragma unroll
        for (int d = 0; d < 2; ++d) { gbr[d] = GB[d * 1024]; gbi[d] = GB[d * 1024 + 512];
            sp8[d] = (-8.0f * 1.4426950408889634f) * log1pf(expf(-F.inp(I_LAM)[(l * 2 + d) * 512 + chb + j16])); } }
#pragma unroll
    for (int k = 0; k < 4; ++k) cwo[k] = F.inp(I_CONVW)[(l * 4 + k) * 512 + chb + j16];
    const float cbo = F.inp(I_CONVB)[l * 512 + chb + j16];
    float carf = seq < 16 ? 0.f : F.inp(I_STATE)[(((seq - 16) * 4 + l) * 2 + 0) * 512 + chb + j16];
    const float h0b = seq < 16 ? 0.f : F.inp(I_STATE)[(((seq - 16) * 4 + l) * 2 + 1) * 512 + chb + j16];
    v4u xv[5], gv;
#pragma unroll
    for (int i = 0; i < 5; ++i) { const int id = tid + NTHREADS * i, tr = id >> 3, v = id & 7, t = tr - 2; xv[i] = (v4u){0u, 0u, 0u, 0u};
        if (id < 260 * 8 && t >= 0 && t < L) xv[i] = *(const v4u*)(U + (size_t)(row0 + t) * NUC + 64 * h + 8 * v); }
    gv = *(const v4u*)(U + (size_t)(row0 + (tid >> 1)) * NUC + 512 + chb + 8 * (tid & 1));
    { const bf16* WGb = (const bf16*)(F.ws + WS_WG) + (size_t)((l * 8 + h) * 4 + q) * (4 * 2 * 32 * 64);
        v4u wv[4];
#pragma unroll
        for (int i = 0; i < 4; ++i) { const int id = tid + NTHREADS * i; wv[i] = *(const v4u*)(WGb + (size_t)(id >> 3) * 64 + 8 * (id & 7)); }
#pragma unroll
        for (int i = 0; i < 4; ++i) { const int id = tid + NTHREADS * i; *(LAS v4u*)(WGL + (id >> 3) * 72 + 8 * (id & 7)) = wv[i]; } }
#pragma unroll 1
    for (int c = 0; c < niter; ++c) {
        const int c0 = c * 256; const bool last = ctx || c == niter - 1, more = c + 1 < niter;
        if (ctx) carf = 0.f;
        LAS bf16* PBLc = (LAS bf16*)(F.lds + (c == 0 ? 45632 : 143360 + (c - 1) * 8192));
#pragma unroll
        for (int i = 0; i < 5; ++i) { const int id = tid + NTHREADS * i; if (id < 260 * 8) *(LAS v4u*)(XR + (id >> 3) * 72 + 8 * (id & 7)) = xv[i]; }
        *(LAS v4u*)(XG + tid * 8) = gv;
        if (more) {
#pragma unroll
            for (int i = 0; i < 5; ++i) { const int id = tid + NTHREADS * i, tr = id >> 3, v = id & 7, t = c0 + 256 - 2 + tr, ts = (ctx ? 0 : c0 + 256) - 2 + tr; xv[i] = (v4u){0u, 0u, 0u, 0u};
                if (id < 260 * 8 && ts >= 0 && ts < L) xv[i] = *(const v4u*)(U + (size_t)(row0 + t) * NUC + 64 * h + 8 * v); }
            gv = *(const v4u*)(U + (size_t)(row0 + c0 + 256 + (tid >> 1)) * NUC + 512 + chb + 8 * (tid & 1));
        }
        __syncthreads();
        LRU_STAMP(1);
        f32x4 acc[2][4];
#pragma unroll
        for (int mt = 0; mt < 2; ++mt)
#pragma unroll
            for (int nt = 0; nt < 4; ++nt) { const float gb = (nt & 1) ? gbi[nt >> 1] : gbr[nt >> 1]; acc[mt][nt] = (f32x4){gb, gb, gb, gb}; }
#pragma unroll
        for (int k = 0; k < 4; ++k)
#pragma unroll
            for (int ks = 0; ks < 2; ++ks) { bf16x8 bw[4];
#pragma unroll
                for (int nt = 0; nt < 4; ++nt) bw[nt] = *(const LAS bf16x8*)(WGL + (k * 64 + 16 * nt + j16) * 72 + 32 * ks + 8 * lq);
#pragma unroll
                for (int mt = 0; mt < 2; ++mt) { const bf16x8 a = *(const LAS bf16x8*)(XR + (32 * wave + 16 * mt + j16 + k) * 72 + 32 * ks + 8 * lq);
#pragma unroll
                    for (int nt = 0; nt < 4; ++nt) acc[mt][nt] = __builtin_amdgcn_mfma_f32_16x16x32_bf16(a, bw[nt], acc[mt][nt], 0, 0, 0); } }
        LRU_STAMP(3);
        f32x2 PP[8], HH[8]; float rP[2][2], rH[2][2];
        const f32x2 sp8v = {sp8[0], sp8[1]};
#pragma unroll
        for (int mt = 0; mt < 2; ++mt) {
            float xcv[4];
#pragma unroll
            for (int rg = 0; rg < 4; ++rg) { const int tl = 32 * wave + 16 * mt + 4 * lq + rg;
                float xc = cbo;
#pragma unroll
                for (int k = 0; k < 4; ++k) xc += bf2f(XR[(tl + k) * 72 + 16 * q + j16]) * cwo[k];
                xcv[rg] = xc; }
            f32x2 P2 = {1.f, 1.f}, H2 = {0.f, 0.f};
#pragma unroll
            for (int i = 0; i < 4; ++i) { const int j = 3 - i;
                const f32x2 er = {__builtin_amdgcn_exp2f(acc[mt][0][i]), __builtin_amdgcn_exp2f(acc[mt][2][j])}, ei = {__builtin_amdgcn_exp2f(acc[mt][1][i]), __builtin_amdgcn_exp2f(acc[mt][3][j])};
                const f32x2 dr = er + 1.0f, di = ei + 1.0f;
                const f32x2 r = {__builtin_amdgcn_rcpf(dr.x), __builtin_amdgcn_rcpf(dr.y)}, ig = {__builtin_amdgcn_rcpf(di.x), __builtin_amdgcn_rcpf(di.y)};
                const f32x2 la2 = sp8v * r, a = {__builtin_amdgcn_exp2f(la2.x), __builtin_amdgcn_exp2f(la2.y)}, y = la2 * 1.3862943611198906f;
                f32x2 p = y * (1.0f / 720.0f) + (1.0f / 120.0f); p = p * y + (1.0f / 24.0f); p = p * y + (1.0f / 6.0f); p = p * y + 0.5f; p = p * y + 1.0f;
                const f32x2 sm = -(y * p), bg = 1.0f - a * a;
                const f32x2 m2 = {y.x < -0.5f ? bg.x : sm.x, y.y < -0.5f ? bg.y : sm.y};
                const f32x2 sq = {__builtin_amdgcn_sqrtf(m2.x), __builtin_amdgcn_sqrtf(m2.y)}, xc2 = {xcv[i], xcv[j]};
                H2 = a * H2 + sq * (ig * xc2); P2 = P2 * a; PP[4 * mt + i] = P2; HH[4 * mt + i] = H2; }
            rP[0][mt] = P2.x; rP[1][mt] = P2.y; rH[0][mt] = H2.x; rH[1][mt] = H2.y;
        }
        LRU_STAMP(4);
        float EP[2][2], EH[2][2], WPt[2], WHt[2];
#pragma unroll
        for (int d = 0; d < 2; ++d) { float ep = 1.f, eh = 0.f;
#pragma unroll
            for (int rr = 0; rr < 8; ++rr) { const int r = d == 0 ? rr : 7 - rr, mt = r >> 2, lq2 = r & 3;
                const float p = __shfl(rP[d][mt], j16 + 16 * lq2), hh = __shfl(rH[d][mt], j16 + 16 * lq2);
                if (lq2 == lq) { EP[d][mt] = ep; EH[d][mt] = eh; }
                eh = p * eh + hh; ep *= p; }
            WPt[d] = ep; WHt[d] = eh; }
        if (lq == 0) {
#pragma unroll
            for (int d = 0; d < 2; ++d) { WTP[(d * 8 + wave) * 16 + j16] = WPt[d]; WTH[(d * 8 + wave) * 16 + j16] = WHt[d]; } }
        __syncthreads();
        LRU_STAMP(5);
        float cwf = 0.f, cwb = 0.f, qwb = 1.f;
        { float cv = carf;
#pragma unroll
            for (int w = 0; w < 8; ++w) { if (w == wave) cwf = cv; cv = WTP[w * 16 + j16] * cv + WTH[w * 16 + j16]; }
            carf = cv;
            cv = last ? h0b : 0.f; float qv = 1.f;
#pragma unroll
            for (int w = 7; w >= 0; --w) { if (w == wave) { cwb = cv; qwb = qv; } const float pw = WTP[(8 + w) * 16 + j16]; cv = pw * cv + WTH[(8 + w) * 16 + j16]; qv *= pw; }
            if (!ctx && wave == 0 && lq == 0) { CHKP[c * 16 + j16] = qv; CHKH[c * 16 + j16] = cv; }
            if (ctx && wave == 0 && lq == 0) {
                float* so = F.out + (size_t)M_TOK * DMODEL + (size_t)(((seq + c) * 4 + l) * 2) * 512 + chb + j16; so[0] = carf; so[512] = cv; } }
        LRU_STAMP(6);
#pragma unroll
        for (int mt = 0; mt < 2; ++mt) {
            const float hinf = EP[0][mt] * cwf + EH[0][mt], hinb = EP[1][mt] * cwb + EH[1][mt], pbf = EP[1][mt] * qwb;
            const f32x2 hin2 = {hinf, hinb}; f32x2 t2[4];
#pragma unroll
            for (int i = 0; i < 4; ++i) t2[i] = HH[4 * mt + i] + PP[4 * mt + i] * hin2;
#pragma unroll
            for (int rg = 0; rg < 4; ++rg) { const int p = 4 * mt + rg, tl = 32 * wave + 16 * mt + 4 * lq + rg; const size_t row = (size_t)(row0 + c0 + tl);
                const float s = t2[rg].x + t2[3 - rg].y, g = fgelu_tanh(bf2f(XG[tl * 16 + j16]));
                if (last) CAT[row * DMODEL + chb + j16] = (bf16)f2bf(s * g);
                else { SL[(c * 8 + p) * 512 + tid] = s * g; PBLc[p * 512 + tid] = (bf16)f2bf(PP[4 * mt + 3 - rg].y * pbf * g); } }
        }
        if (more) __syncthreads();
    }
    LRU_STAMP(7);
    if (!ctx) {
        __syncthreads();
        float cin[3]; { float cv = CHKH[3 * 16 + j16];
#pragma unroll
            for (int c = 2; c >= 0; --c) { cin[c] = cv; cv = CHKP[c * 16 + j16] * cv + CHKH[c * 16 + j16]; } }
#pragma unroll
        for (int c = 0; c < 3; ++c) {
            const LAS bf16* PBLc = (const LAS bf16*)(F.lds + (c == 0 ? 45632 : 143360 + (c - 1) * 8192));
#pragma unroll
            for (int p = 0; p < 8; ++p) { const size_t row = (size_t)(row0 + 256 * c + 32 * wave + 16 * (p >> 2) + 4 * lq + (p & 3));
                CAT[row * DMODEL + chb + j16] = (bf16)f2bf(SL[(c * 8 + p) * 512 + tid] + bf2f(PBLc[p * 512 + tid]) * cin[c]); }
        }
    }
    __syncthreads();
}

__device__ __forceinline__ void pool1d_unit(Frame F, int seq, int tb) {
    F.relaunder();
    const bf16* U = (const bf16*)(F.ws + WS_U); bf16* CAT = (bf16*)(F.ws + WS_CAT);
    const int row0 = seq * 256;
#pragma unroll 1
    for (int i = 0; i < 4; ++i) { const int id = F.tid + NTHREADS * i, t = tb * 64 + (id >> 5), v = id & 31, g = v >> 3, hw = 1 << g;
        const int lo = max(t - hw, 0), hi = min(t + hw, 256);
        v4u x[16];
#pragma unroll
        for (int k = 0; k < 16; ++k) { const int tt = t - 8 + k; x[k] = (v4u){0u, 0u, 0u, 0u}; if (tt >= lo && tt < hi) x[k] = *(const v4u*)(U + (size_t)(row0 + tt) * NUC + 1024 + 8 * v); }
        float s[8];
#pragma unroll
        for (int c = 0; c < 8; ++c) s[c] = 0.f;
#pragma unroll
        for (int k = 0; k < 16; ++k) { s[0] += bflo(x[k].x); s[1] += bfhi(x[k].x); s[2] += bflo(x[k].y); s[3] += bfhi(x[k].y); s[4] += bflo(x[k].z); s[5] += bfhi(x[k].z); s[6] += bflo(x[k].w); s[7] += bfhi(x[k].w); }
        const float inv = 1.0f / (float)(hi - lo);
        const v4u xs = x[8];
        v4u o; o.x = pk2(s[0] * inv - bflo(xs.x), s[1] * inv - bfhi(xs.x)); o.y = pk2(s[2] * inv - bflo(xs.y), s[3] * inv - bfhi(xs.y));
        o.z = pk2(s[4] * inv - bflo(xs.z), s[5] * inv - bfhi(xs.z)); o.w = pk2(s[6] * inv - bflo(xs.w), s[7] * inv - bfhi(xs.w));
        *(v4u*)(CAT + (size_t)(row0 + t) * DMODEL + 512 + 8 * v) = o; }
}
__device__ __forceinline__ void pool2d_unit(Frame F, int b, int g, int oc) {
    F.relaunder();
    const bf16* U = (const bf16*)(F.ws + WS_U); bf16* CAT = (bf16*)(F.ws + WS_CAT);
    LAS float* T1 = (LAS float*)F.lds;
    LAS float* T2 = (LAS float*)(F.lds + 32768);
    const int row0 = M_CTX + b * 1024, colb = 64 * g + 8 * oc, hw = 1 << g;
#pragma unroll
    for (int i = 0; i < 2; ++i) { const int t = F.tid + NTHREADS * i;
        const v4u x = *(const v4u*)(U + (size_t)(row0 + t) * NUC + 1024 + colb);
        *(LAS f32x4*)(T1 + t * 8) = (f32x4){bflo(x.x), bfhi(x.x), bflo(x.y), bfhi(x.y)}; *(LAS f32x4*)(T1 + t * 8 + 4) = (f32x4){bflo(x.z), bfhi(x.z), bflo(x.w), bfhi(x.w)}; }
    __syncthreads();
    const int j4 = 4 * (F.tid & 1), tq = F.tid >> 1;
#pragma unroll
    for (int i = 0; i < 4; ++i) { const int t = tq + 256 * i, r = t >> 6, c = t & 63, lo = max(c - hw, 0), hi = min(c + hw, 64);
        f32x4 s = {0.f, 0.f, 0.f, 0.f};
        for (int c2 = lo; c2 < hi; ++c2) s += *(const LAS f32x4*)(T1 + (r * 64 + c2) * 8 + j4);
        *(LAS f32x4*)(T2 + t * 8 + j4) = s * (1.0f / (float)(hi - lo)); }
    __syncthreads();
#pragma unroll
    for (int i = 0; i < 4; ++i) { const int t = tq + 256 * i, r = t >> 6, c = t & 63, lo = max(r - hw, 0), hi = min(r + hw, 16);
        f32x4 s = {0.f, 0.f, 0.f, 0.f};
        for (int r2 = lo; r2 < hi; ++r2) s += *(const LAS f32x4*)(T2 + (r2 * 64 + c) * 8 + j4);
        const f32x4 o = s * (1.0f / (float)(hi - lo)) - *(const LAS f32x4*)(T1 + t * 8 + j4);
        v2u w; w.x = pk2(o[0], o[1]); w.y = pk2(o[2], o[3]);
        *(v2u*)(CAT + (size_t)(row0 + t) * DMODEL + 512 + colb + j4) = w; }
    __syncthreads();
}
__device__ __forceinline__ void fourier_unit_ctx(Frame F, int seq, int hd, int kb) {
    F.relaunder();
    const int lane = F.lane, wave = F.wave, j16 = lane & 15, nt = wave & 3, kh = wave >> 2, row0 = seq * 256;
    const bf16* XCT = (const bf16*)(F.ws + WS_XCT) + (size_t)(seq * 4 + hd) * 128 * 256;
    const bf16* Ap = XCT + ((size_t)(4 * kh) * 64 + lane) * 8;
    const bf16* Bp = (const bf16*)(F.ws + WS_T256) + ((size_t)((4 * kb + nt) * 16 + 4 * kh) * 64 + lane) * 8;
    bf16x8 aP[4][4], bP[4], aQ[4][4], bQ[4];
#pragma unroll
    for (int s = 0; s < 4; ++s) { bP[s] = *(const bf16x8*)(Bp + s * 512);
#pragma unroll
        for (int mt = 0; mt < 4; ++mt) aP[s][mt] = *(const bf16x8*)(Ap + mt * 8192 + s * 512); }
#pragma unroll
    for (int s = 0; s < 4; ++s) { bQ[s] = *(const bf16x8*)(Bp + 4096 + s * 512);
#pragma unroll
        for (int mt = 0; mt < 4; ++mt) aQ[s][mt] = *(const bf16x8*)(Ap + 4096 + mt * 8192 + s * 512); }
    f32x4 accP[4], accQ[4];
#pragma unroll
    for (int mt = 0; mt < 4; ++mt) { accP[mt] = (f32x4){0.f, 0.f, 0.f, 0.f}; accQ[mt] = (f32x4){0.f, 0.f, 0.f, 0.f}; }
#pragma unroll
    for (int s = 0; s < 4; ++s)
#pragma unroll
        for (int mt = 0; mt < 4; ++mt) accP[mt] = __builtin_amdgcn_mfma_f32_16x16x32_bf16(aP[s][mt], bP[s], accP[mt], 0, 0, 0);
#pragma unroll
    for (int s = 0; s < 4; ++s)
#pragma unroll
        for (int mt = 0; mt < 4; ++mt) accQ[mt] = __builtin_amdgcn_mfma_f32_16x16x32_bf16(aQ[s][mt], bQ[s], accQ[mt], 0, 0, 0);
    LAS float* redD = (LAS float*)F.lds; LAS float* redS = redD + 2 * 64 * 68;
    { LAS float* d = redD + (size_t)(kh * 64 + 16 * nt + j16) * 68 + 4 * (lane >> 4); LAS float* sx = redS + (size_t)(kh * 64 + 16 * nt + j16) * 68 + 4 * (lane >> 4);
#pragma unroll
      for (int mt = 0; mt < 4; ++mt) { *(LAS f32x4*)(d + 16 * mt) = accP[mt] + accQ[mt]; *(LAS f32x4*)(sx + 16 * mt) = accP[mt] - accQ[mt]; } }
    __syncthreads();
    bf16* CATo = (bf16*)(F.ws + WS_CAT) + (size_t)row0 * DMODEL + 768 + 64 * hd;
    { const int kp = F.tid >> 3, mg = F.tid & 7, k = 64 * kb + kp;
#pragma unroll
      for (int ps = 0; ps < 2; ++ps) { const LAS float* r = (ps == 0 ? redD : redS) + (size_t)kp * 68 + 8 * mg;
          const f32x4 s0 = *(const LAS f32x4*)r + *(const LAS f32x4*)(r + 64 * 68), s1 = *(const LAS f32x4*)(r + 4) + *(const LAS f32x4*)(r + 64 * 68 + 4);
          v4u o; o.x = pk2(s0[0], s0[1]); o.y = pk2(s0[2], s0[3]); o.z = pk2(s1[0], s1[1]); o.w = pk2(s1[2], s1[3]);
          if (ps == 0 || k != 0) *(v4u*)(CATo + (size_t)(ps == 0 ? k : 256 - k) * DMODEL + 8 * mg) = o; } }
    if (kb == 0) {
        const int mm = F.tid >> 3, part = F.tid & 7;
        const bf16* xp = XCT + ((size_t)((mm >> 4) * 16) * 64 + (mm & 15)) * 8;
        float s = 0.f;
#pragma unroll
        for (int v = 0; v < 4; ++v) { const int l8 = part * 4 + v;
            const v4u x = *(const v4u*)(xp + ((size_t)(l8 >> 2) * 64 + (l8 & 3) * 16) * 8);
            s += (bflo(x.x) - bfhi(x.x)) + (bflo(x.y) - bfhi(x.y)) + (bflo(x.z) - bfhi(x.z)) + (bflo(x.w) - bfhi(x.w)); }
        s += __shfl_xor(s, 1); s += __shfl_xor(s, 2); s += __shfl_xor(s, 4);
        if (part == 0) CATo[(size_t)128 * DMODEL + mm] = (bf16)f2bf(s * 0.0625f);
    }
    __syncthreads();
}
__device__ __forceinline__ void fourier_unit(Frame F, int seq, int hd, int kb) {
    F.relaunder();
    LRU_STAMP(0);
    int L, row0; seq_geom(seq, L, row0);
    const int lane = F.lane, wave = F.wave, j16 = lane & 15;
    const bf16* XCT = (const bf16*)(F.ws + WS_XCT) + (seq < 16 ? (size_t)(seq * 4 + hd) * 128 * 256 : pg8::XCT_LAT_OFF + (size_t)((seq - 16) * 4 + hd) * 128 * 1024);
    const bf16* T = seq < 16 ? (const bf16*)(F.ws + WS_T256) : (const bf16*)(F.ws + WS_T1024);
    const int KB2 = (2 * L) >> 5, kwp = L >> 3;
    const size_t g16 = (size_t)KB2 * 512, hoff = (size_t)(L >> 5) * 512;
    const bf16* ApP = XCT + ((size_t)((wave * kwp) >> 5) * 64 + lane) * 8;
    const bf16* BpP = T + ((size_t)((kb * 4) * KB2 + ((wave * kwp) >> 5)) * 64 + lane) * 8;
    const bf16* ApQ = ApP + hoff; const bf16* BpQ = BpP + hoff;
    f32x4 acc[4][4];
#pragma unroll
    for (int mt = 0; mt < 4; ++mt)
#pragma unroll
        for (int nt = 0; nt < 4; ++nt) acc[mt][nt] = (f32x4){0.f, 0.f, 0.f, 0.f};
#define FOU_LOAD(A_, B_, AP_, BP_, ks_) do { _Pragma("unroll") for (int mt = 0; mt < 4; ++mt) A_[mt] = *(const bf16x8*)(AP_ + mt * g16 + (size_t)(ks_) * 16); \
                                   _Pragma("unroll") for (int nt = 0; nt < 4; ++nt) B_[nt] = *(const bf16x8*)(BP_ + nt * g16 + (size_t)(ks_) * 16); } while (0)
#define FOU_MMA(A_, B_) do { _Pragma("unroll") for (int mt = 0; mt < 4; ++mt) _Pragma("unroll") for (int nt = 0; nt < 4; ++nt) \
                                   acc[mt][nt] = __builtin_amdgcn_mfma_f32_16x16x32_bf16(A_[mt], B_[nt], acc[mt][nt], 0, 0, 0); } while (0)
    LAS float* red = (LAS float*)F.lds;
    LAS float* myslot = red + (size_t)(wave * 64 + j16) * 68 + 4 * (lane >> 4);
#define FOU_PARK() do { _Pragma("unroll") for (int mt = 0; mt < 4; ++mt) _Pragma("unroll") for (int nt = 0; nt < 4; ++nt) { \
                                   *(LAS f32x4*)(myslot + (16 * nt) * 68 + 16 * mt) = acc[mt][nt]; acc[mt][nt] = (f32x4){0.f, 0.f, 0.f, 0.f}; } } while (0)
    bf16x8 fa0[4], fb0[4], fa1[4], fb1[4], fa2[4], fb2[4];
    if (kwp == 32) { FOU_LOAD(fa0, fb0, ApP, BpP, 0); FOU_LOAD(fa1, fb1, ApQ, BpQ, 0); FOU_MMA(fa0, fb0); FOU_PARK(); FOU_MMA(fa1, fb1); }
    else {
        FOU_LOAD(fa0, fb0, ApP, BpP, 0); FOU_LOAD(fa1, fb1, ApP, BpP, 32); FOU_LOAD(fa2, fb2, ApP, BpP, 64);
        FOU_MMA(fa0, fb0); FOU_LOAD(fa0, fb0, ApP, BpP, 96);
        FOU_MMA(fa1, fb1); FOU_LOAD(fa1, fb1, ApQ, BpQ, 0);
        FOU_MMA(fa2, fb2); FOU_LOAD(fa2, fb2, ApQ, BpQ, 32);
        FOU_MMA(fa0, fb0); FOU_LOAD(fa0, fb0, ApQ, BpQ, 64);
        FOU_PARK();
        FOU_MMA(fa1, fb1); FOU_LOAD(fa1, fb1, ApQ, BpQ, 96);
        FOU_MMA(fa2, fb2); FOU_MMA(fa0, fb0); FOU_MMA(fa1, fb1);
    }
#undef FOU_LOAD
#undef FOU_MMA
#undef FOU_PARK
    LRU_STAMP(1);
    bf16* CATo = (bf16*)(F.ws + WS_CAT) + (size_t)row0 * DMODEL + 768 + 64 * hd;
#pragma unroll
    for (int ps = 0; ps < 2; ++ps) {
#pragma unroll
        for (int mt = 0; mt < 4; ++mt)
#pragma unroll
            for (int nt = 0; nt < 4; ++nt) { LAS f32x4* sp = (LAS f32x4*)(myslot + (16 * nt) * 68 + 16 * mt); *sp = ps == 0 ? *sp + acc[mt][nt] : *sp - 2.0f * acc[mt][nt]; }
        __syncthreads();
        { const int kp = F.tid >> 3, mg = F.tid & 7, k = 64 * kb + kp;
            f32x4 s0 = {0.f, 0.f, 0.f, 0.f}, s1 = s0;
#pragma unroll
            for (int w = 0; w < 8; ++w) { const LAS f32x4* p = (const LAS f32x4*)(red + (size_t)(w * 64 + kp) * 68 + 8 * mg); s0 += p[0]; s1 += p[1]; }
            v4u o; o.x = pk2(s0[0], s0[1]); o.y = pk2(s0[2], s0[3]); o.z = pk2(s1[0], s1[1]); o.w = pk2(s1[2], s1[3]);
            if (ps == 0 || k != 0) *(v4u*)(CATo + (size_t)(ps == 0 ? k : L - k) * DMODEL + 8 * mg) = o; }
        __syncthreads();
    }
    if (kb == 0) {
        const int mm = F.tid >> 3, part = F.tid & 7, nv = L >> 6;
        const bf16* xp = XCT + ((size_t)((mm >> 4) * KB2) * 64 + (mm & 15)) * 8;
        float s = 0.f;
#pragma unroll 4
        for (int v = 0; v < nv; ++v) { const int l8 = part * nv + v;
            const v4u x = *(const v4u*)(xp + ((size_t)(l8 >> 2) * 64 + (l8 & 3) * 16) * 8);
            s += (bflo(x.x) - bfhi(x.x)) + (bflo(x.y) - bfhi(x.y)) + (bflo(x.z) - bfhi(x.z)) + (bflo(x.w) - bfhi(x.w)); }
        s += __shfl_xor(s, 1); s += __shfl_xor(s, 2); s += __shfl_xor(s, 4);
        if (part == 0) CATo[(size_t)(L >> 1) * DMODEL + mm] = (bf16)f2bf(s * (L == 256 ? 0.0625f : 0.03125f));
    }
    LRU_STAMP(3);
}
#ifndef REP_LRU
#define REP_LRU 1
#endif
#ifndef REP_FOU
#define REP_FOU 1
#endif
#ifndef REP_POOL
#define REP_POOL 1
#endif
__device__ __forceinline__ void mixer_phase(const Frame& F, int l) {
    for (int vb = F.bid; vb < 256; vb += F.G) {
        int nf, fseq, fhd, fkb;
        if (vb < 192) {
            const bool lat = vb < 64; const int i = lat ? vb : vb - 64;
#ifndef SKIP_FOU
            if (!lat) fourier_unit_ctx(F, i >> 3, (i >> 1) & 3, i & 1);
#endif
#ifndef SKIP_LRU
            lru_unit(F, l, lat ? 16 + (i >> 5) : 4 * (i >> 5), (i >> 2) & 7, i & 3, 4);
#endif
            nf = 0; fseq = 0; fhd = 0; fkb = 0;
        } else {
            const int i = vb - 192;
#ifndef SKIP_POOL
            pool2d_unit(F, i >> 5, (i >> 3) & 3, i & 7);
#endif
            nf = 1; fseq = 16 + ((i & 7) >> 2); fhd = i & 3; fkb = i >> 3;
        }
#ifndef SKIP_FOU
        for (int k = 0; k < nf; ++k) { if (fseq < 16) fourier_unit_ctx(F, fseq, fhd, fkb); else fourier_unit(F, fseq, fhd, fkb); }
#endif
#ifndef SKIP_POOL
        if (vb >= 192) { const int i = vb - 192; pool1d_unit(F, i >> 2, i & 3); }
#endif
    }
}
#ifndef MK_PER_PHASE
#define MK_PER_PHASE 0
#endif
#ifndef MK_BARRIER
#define MK_BARRIER 1
#endif
#ifndef REP_P0
#define REP_P0 1
#endif
#ifndef REP_MIX
#define REP_MIX 1
#endif
#ifndef REP_G1
#define REP_G1 1
#endif
#ifndef REP_G3
#define REP_G3 1
#endif
#ifndef TS_SEL
#define TS_SEL -1
#endif
#ifndef TS_MODE
#define TS_MODE 0
#endif
#ifndef TS_BLK
#define TS_BLK 0
#endif
#ifndef TSX_OFF
#define TSX_OFF 0
#endif
#ifndef TS_SCALE
#define TS_SCALE 1e-6f
#endif
constexpr int N_PHASES = 2 + 5 * DEPTHL + 1;
constexpr int CW_BAR = 4096;
__device__ __forceinline__ void final_norm(const Frame& F) {
    const int gw = F.bid * NWAVES + F.wave, NGW = F.G * NWAVES;
    const float* X = (const float*)(F.ws + WS_X); const float* ssq = (const float*)(F.ws + WS_SSQ) + (size_t)8 * M_TOK * 16;
    const f32x4* gp = (const f32x4*)F.inp(I_FG) + F.lane;
    for (int r = gw; r < M_TOK; r += NGW) {
        const float rs = pg8::row_rstd(ssq, r);
        const f32x4* xr = (const f32x4*)(X + (size_t)r * 1024) + F.lane; f32x4* o = (f32x4*)(F.out + (size_t)r * 1024) + F.lane;
#pragma unroll
        for (int j = 0; j < 4; ++j) o[64 * j] = xr[64 * j] * rs * gp[64 * j];
    }
}
__global__ void __launch_bounds__(NTHREADS, 2) mega(Params p) {
    extern __shared__ __attribute__((aligned(16))) unsigned char lds[];
    Frame F;
    F.lds = (LAS unsigned char*)lds; F.tid = threadIdx.x; F.lane = F.tid & 63; F.wave = __builtin_amdgcn_readfirstlane(F.tid >> 6);
    F.G = gridDim.x; F.bid = blockIdx.x; F.in = (const CAS cfp_t*)__builtin_amdgcn_kernarg_segment_ptr(); F.out0 = p.out; F.ws0 = p.ws; F.out = p.out; F.ws = p.ws; F.tsx = nullptr;
#if MK_BARRIER
    volatile unsigned* bst = (volatile unsigned*)(p.ws + WS_CTL) + 1024 + 2 * blockIdx.x;
    XcdBarrier bar = xcd_barrier_post((unsigned*)(p.ws + WS_CTL) + CW_BAR, bst);
#else
    cg::grid_group grid = cg::this_grid();
#endif
#if TS_SEL >= 0
    unsigned long long* TS = (unsigned long long*)(p.ws + WS_CTL + 2048);
    if (blockIdx.x == TS_BLK && threadIdx.x == 0) TS[31] = __builtin_amdgcn_s_memrealtime();
#endif
    for (int ph = p.ph_lo; ph < p.ph_hi; ++ph) {
        { size_t z = 0; asm volatile("" : "+s"(z)); F.ws = F.ws0 + z; }
        bf16* A = (bf16*)(F.ws + WS_A); bf16* CAT = (bf16*)(F.ws + WS_CAT); bf16* HID = (bf16*)(F.ws + WS_HID); bf16* U = (bf16*)(F.ws + WS_U); bf16* XCT = (bf16*)(F.ws + WS_XCT);
        float* X = (float*)(F.ws + WS_X); float* SSQ = (float*)(F.ws + WS_SSQ); const float* MODS = (const float*)(F.ws + WS_MODS); const float* GV = (const float*)(F.ws + WS_GV);
        if (ph == 0) {
#ifndef SKIP_P0A
 F.relaunder(); p0a_mods(F);
#endif
 }
        else if (ph == 1) {
#ifndef SKIP_P0B
 F.relaunder();
 { const bool defer = false && F.G >= 224;
   p0b_items(F, 0, defer ? 1 : DEPTHL, F.bid * NWAVES + F.wave, F.G * NWAVES, true); p0b_tail(F, 1, 0, F.bid * NTHREADS + F.tid, F.G * NTHREADS); }
#endif
 }
        else if (ph == N_PHASES - 1) { F.relaunder(); final_norm(F); }
        else {
#ifdef PADN
            asm volatile(".rept %0\n s_nop 0\n .endr" :: "n"(PADN));
#endif
            const int l = (ph - 2) / 5, k = (ph - 2) % 5;
            if (k == 0) {
                F.relaunder();
                pg8::Gemm g{A, (const bf16*)(F.ws + WS_WIN) + (size_t)l * NINP * 1024, M_TOK, NINP, 1024}; pg8::StaticOrder S; S.init(M_TOK, NINP, F.G, F.bid, 3);
                pg8::EpiIn E{U, XCT, SSQ + (size_t)(2 * l) * M_TOK * 16, (const float*)(F.ws + WS_BIASIN) + (size_t)l * 3 * NINP};
#ifndef SKIP_G1
                pg8::gemm_phase<pg8::EpiIn, pg8::StaticOrder, true, true>(F.lds, g, S, E, F.tid);
#endif
                {
                    const int nwg1 = (M_TOK / 256) * (NINP / 256);
                    const int tw = 2 | (l == 0 ? 4 : 0);
                    if (F.G > nwg1) { if (F.bid >= nwg1) { w2_strips(F, l, F.wave * (F.G - nwg1) + (F.bid - nwg1), NWAVES * (F.G - nwg1));
                                                           p0b_tail(F, tw, l, (F.bid - nwg1) * NTHREADS + F.tid, (F.G - nwg1) * NTHREADS); } }
                    else { w2_strips(F, l, F.bid * NWAVES + F.wave, F.G * NWAVES); p0b_tail(F, tw, l, F.bid * NTHREADS + F.tid, F.G * NTHREADS); }
                }
            } else if (k == 1) {
#ifndef SKIP_MIX
                for (int rep = 0; rep < REP_MIX; ++rep) mixer_phase(F, l);
#endif
            } else if (k == 2 || k == 4) {
#ifdef SLEEP_G4
                if (k == 4) { const unsigned long long t0 = __builtin_amdgcn_s_memrealtime(); while (__builtin_amdgcn_s_memrealtime() - t0 < SLEEP_G4) __builtin_amdgcn_s_sleep(8); }
#endif
                F.relaunder();
                const bool dn = k == 4;
                pg8::Gemm g{dn ? HID : CAT, dn ? (const bf16*)(F.ws + WS_W2) + (size_t)l * FFD * 1024 : (const bf16*)(F.ws + WS_WOUT) + (size_t)l * 1024 * 1024, M_TOK, 1024, dn ? FFD : 1024};
                pg8::StaticOrder192 S; S.init(M_TOK, 1024, F.G, F.bid);
                const float* Gn = dn ? (l < DEPTHL - 1 ? GV + (size_t)((l + 1) * 2 * 3) * 1024 : nullptr) : GV + (size_t)((l * 2 + 1) * 3) * 1024;
                const int inst = dn ? (l < DEPTHL - 1 ? 2 * (l + 1) : 8) : 2 * l + 1;
                const bool first = !dn && l == 0;
                pg8::EpiRes192 E{X, A, MODS + (size_t)l * 3 * 6144 + (dn ? 5 : 2) * 1024, Gn, SSQ + (size_t)inst * M_TOK * 16, first ? F.inp(I_XP) : X, first ? F.inp(I_XS) : X + (size_t)M_CTX * 1024};
#ifndef SKIP_G24
                #if TS_SEL >= 0
                pg8::gemm_phase_m192<pg8::EpiRes192, pg8::StaticOrder192>(F.lds, g, S, E, F.tid, ph == TS_SEL ? (unsigned long long*)(p.ws + WS_CTL + 2048) + 64 : nullptr);
#else
                pg8::gemm_phase_m192<pg8::EpiRes192, pg8::StaticOrder192>(F.lds, g, S, E, F.tid);
#endif
                if (false && dn && l + 1 < DEPTHL && F.G >= 224 && F.bid >= 192) p0b_items(F, l + 1, l + 2, (F.bid - 192) * NWAVES + F.wave, (F.G - 192) * NWAVES, false);
#endif
            } else {
                F.relaunder();
                { pg8::Gemm g{A, (const bf16*)(F.ws + WS_W1) + (size_t)l * FFD * 1024, M_CTX, FFD, 1024}; pg8::StaticOrder S; S.init(M_CTX, FFD, F.G, F.bid);
                  pg8::EpiUp E{HID, SSQ + (size_t)(2 * l + 1) * M_TOK * 16, (const float*)(F.ws + WS_BIAS1) + (size_t)l * 3 * FFD};
#ifndef SKIP_G3
                  pg8::gemm_phase<pg8::EpiUp, pg8::StaticOrder, true, true>(F.lds, g, S, E, F.tid);
#endif
                }
                F.relaunder();
                { const int l2 = launder_s(l);
                  pg8::Gemm g{(const bf16*)(F.ws + WS_A), (const bf16*)(F.ws + WS_W1) + (size_t)l2 * FFD * 1024, M_TOK, FFD, 1024}; pg8::StaticOrder128 S; S.init(M_TOK - M_CTX, FFD, F.G, F.bid, M_CTX / 256);
                  pg8::EpiUp128 E{(bf16*)(F.ws + WS_HID), (const float*)(F.ws + WS_SSQ) + (size_t)(2 * l2 + 1) * M_TOK * 16, (const float*)(F.ws + WS_BIAS1) + (size_t)l2 * 3 * FFD};
#ifndef SKIP_G3
                  pg8::gemm_phase_n128<pg8::EpiUp128, pg8::StaticOrder128>(F.lds, g, S, E, F.tid);
#endif
                }
            }
        }
#if TS_SEL >= 0
        if (blockIdx.x == TS_BLK && F.wave == 0) __hip_atomic_store(TS + 32 + ph, (unsigned long long)__builtin_amdgcn_s_memrealtime(), __ATOMIC_RELAXED, __HIP_MEMORY_SCOPE_AGENT);
        if (ph == TS_SEL && threadIdx.x == 0) __hip_atomic_fetch_max(TS + 100, ((unsigned long long)__builtin_amdgcn_s_memrealtime() << 8) | (unsigned long long)blockIdx.x, __ATOMIC_RELAXED, __HIP_MEMORY_SCOPE_AGENT);
#endif
#if MK_BARRIER
        if (ph + 1 < p.ph_hi) xcd_barrier(bar);
#else
        if (ph + 1 < p.ph_hi) grid.sync();
#endif
#if TS_SEL >= 0
        if (blockIdx.x == TS_BLK && F.wave == 0) __hip_atomic_store(TS + ph, (unsigned long long)__builtin_amdgcn_s_memrealtime(), __ATOMIC_RELAXED, __HIP_MEMORY_SCOPE_AGENT);
        if (ph == N_PHASES - 2 && blockIdx.x == 255 - TS_BLK) {
            const unsigned long long te = __hip_atomic_load(TS + TS_SEL, __ATOMIC_RELAXED, __HIP_MEMORY_SCOPE_AGENT), tb = __hip_atomic_load(TS + 32 + TS_SEL, __ATOMIC_RELAXED, __HIP_MEMORY_SCOPE_AGENT),
                                     ts = __hip_atomic_load(TS + (TS_SEL == 0 ? 31 : TS_SEL - 1), __ATOMIC_RELAXED, __HIP_MEMORY_SCOPE_AGENT);
            unsigned long long t1 = TS_MODE == 1 ? tb : te, t0 = TS_MODE == 2 ? tb : ts;
            if (TS_MODE == 3) { t0 = __hip_atomic_load(TS + 31, __ATOMIC_RELAXED, __HIP_MEMORY_SCOPE_AGENT); t1 = te; }
            if (TS_MODE >= 10) { unsigned long long x[8]; for (int i = 0; i < 8; ++i) x[i] = __hip_atomic_load(TS + 64 + TSX_OFF + i, __ATOMIC_RELAXED, __HIP_MEMORY_SCOPE_AGENT);
                if (TS_MODE == 10) { t0 = ts; t1 = x[0]; } else if (TS_MODE == 14) { t0 = x[3]; t1 = tb; } else { t0 = x[TS_MODE - 11]; t1 = x[TS_MODE - 10]; } }
            float us = (float)(t1 - t0) * 0.01f;
            if (TS_MODE >= 20) { const unsigned long long mx = __hip_atomic_load(TS + 100, __ATOMIC_RELAXED, __HIP_MEMORY_SCOPE_AGENT); us = TS_MODE == 20 ? (float)((mx >> 8) - ts) * 0.01f : (float)(mx & 255ull); }
            const float f = 1.0f + sqrtf(TS_SCALE * us);
            float* st = p.out + (size_t)M_TOK * DMODEL;
            F.relaunder();
            for (int i = F.tid; i < 16 * 4 * 2 * 512; i += NTHREADS) st[i] *= f;
        }
#endif
    }
}

extern "C" void kernel_launch(void* const* d_in, const int* in_sizes, int n_in, void* d_out, int out_size, void* d_ws, size_t ws_size, hipStream_t stream) {
    static int grid = 0;
    if (grid == 0) {
        if (n_in != 24 || ws_size < WS_END) { fprintf(stderr, "kernel_launch: expected 24 inputs and >= %zu bytes of workspace (got %d, %zu)\n", (size_t)WS_END, n_in, ws_size); grid = -1; return; }
        int dev = 0, cus = 0, per_cu = 0;
        if (hipGetDevice(&dev) != hipSuccess || hipDeviceGetAttribute(&cus, hipDeviceAttributeMultiprocessorCount, dev) != hipSuccess) { grid = -1; return; }
        if (hipFuncSetAttribute((const void*)mega, hipFuncAttributeMaxDynamicSharedMemorySize, LDS_BYTES) != hipSuccess) { fprintf(stderr, "kernel_launch: hipFuncSetAttribute failed\n"); grid = -1; return; }
        if (hipOccupancyMaxActiveBlocksPerMultiprocessor(&per_cu, (const void*)mega, NTHREADS, LDS_BYTES) != hipSuccess || per_cu < 1) { fprintf(stderr, "kernel_launch: occupancy query says %d blocks per CU\n", per_cu); grid = -1; return; }
        grid = cus;
    }
    if (grid < 0) return;
    Params p{};
    for (int i = 0; i < 24; ++i) p.in[i] = (const float*)d_in[i];
    p.out = (float*)d_out; p.ws = (unsigned char*)d_ws;
    hipMemsetAsync((char*)d_ws + WS_CTL, 0, 32768, stream);
#if MK_PER_PHASE
    for (int ph = 0; ph < N_PHASES; ++ph) { p.ph_lo = ph; p.ph_hi = ph + 1; hipLaunchKernelGGL(mega, dim3(grid), dim3(NTHREADS), LDS_BYTES, stream, p); }
#else
    p.ph_lo = 0; p.ph_hi = N_PHASES;
    void* args[] = {&p};
    hipError_t e = hipLaunchCooperativeKernel((const void*)mega, dim3(grid), dim3(NTHREADS), args, LDS_BYTES, stream);
    if (e != hipSuccess) fprintf(stderr, "kernel_launch: cooperative launch failed: %s (grid %d)\n", hipGetErrorString(e), grid);
#endif
}
```
